# Optimizing an MI355X kernel written in HIP

```python
import jax, jax.numpy as jnp
from jax import lax
import numpy as np

D_MODEL = 1024
BATCH = 8
SEQ = 4096
DEPTH = 2

PLE_DIM = 256
N_EVEN = (DEPTH + 1) // 2
N_ODD = DEPTH // 2
RG_WIDTH = 512
RG_BLOCKS = 8
RG_BLOCK = RG_WIDTH // RG_BLOCKS
RG_CONV = 4
RG_C = 8.0
ML_HEADS = 4
ML_HEAD_DIM = 128
ML_WIDTH = ML_HEADS * ML_HEAD_DIM
ML_CONV = 4
ML_CHUNK = 64
HY_IN = 2 * RG_WIDTH + 4 * ML_WIDTH + 2 * ML_HEADS
HY_MIX = RG_WIDTH + ML_WIDTH
AT_HEADS = 16
AT_KV_HEADS = 4
AT_HEAD_DIM = 64
WINDOW = 128
ROPE_THETA = 10000.0
AT_QKV = (AT_HEADS + 2 * AT_KV_HEADS) * AT_HEAD_DIM
FF_DIM = 3 * D_MODEL
FF_CONV = 3
EPS = 1e-6

kernel_name = 'hybrid_rglru_mlstm_swa_trunk'


def rms_norm(x, g):
    xf = x.astype(jnp.float32)
    y = xf * lax.rsqrt(jnp.mean(xf * xf, axis=-1, keepdims=True) + EPS)
    return (y * g.astype(jnp.float32)).astype(x.dtype)


def causal_dwconv(x, w, b):
    k_w = w.shape[0]
    s = x.shape[1]
    xp = jnp.pad(x, ((0, 0), (k_w - 1, 0), (0, 0)))
    y = xp[:, 0:s] * w[0]
    for j in range(1, k_w):
        y = y + xp[:, j:j + s] * w[j]
    return y + b


def _linear_recurrence_combine(left, right):
    a_l, b_l = left
    a_r, b_r = right
    return a_l * a_r, a_r * b_l + b_r


def rg_lru(x, w_a, b_a, w_x, b_x, lam):
    f32 = jnp.float32
    bsz, s, _ = x.shape
    xf = x.astype(f32)
    xb = xf.reshape(bsz, s, RG_BLOCKS, RG_BLOCK)
    r = jax.nn.sigmoid(jnp.einsum('bsni,nij->bsnj', xb, w_a.astype(f32)).reshape(bsz, s, RG_WIDTH) + b_a.astype(f32))
    i = jax.nn.sigmoid(jnp.einsum('bsni,nij->bsnj', xb, w_x.astype(f32)).reshape(bsz, s, RG_WIDTH) + b_x.astype(f32))
    log_a = -RG_C * r * jax.nn.softplus(-lam.astype(f32))
    a = jnp.exp(log_a)
    u = jnp.sqrt(-jnp.expm1(2.0 * log_a)) * (i * xf)
    _, h = lax.associative_scan(_linear_recurrence_combine, (a, u), axis=1)
    return h


def mlstm_chunkwise(q, k, v, i_pre, f_pre):
    f32 = jnp.float32
    bsz, s, nh, dh = q.shape
    nc = s // ML_CHUNK

    def to_chunks(t):
        return t.astype(f32).reshape(bsz, nc, ML_CHUNK, nh, dh).transpose(0, 3, 1, 2, 4)

    def gate_chunks(t):
        return t.astype(f32).reshape(bsz, nc, ML_CHUNK, nh).transpose(0, 3, 1, 2)

    qc = to_chunks(q)
    kc = to_chunks(k) * (dh ** -0.5)
    vc = to_chunks(v)
    log_i = gate_chunks(i_pre)
    log_f = jax.nn.log_sigmoid(gate_chunks(f_pre))
    b = jnp.cumsum(log_f, axis=-1)
    b_last = b[..., -1]

    g = b_last[..., None] - b + log_i
    m_loc = jnp.max(g, axis=-1)
    w_loc = jnp.exp(g - m_loc[..., None])
    c_loc = jnp.einsum('bhcl,bhcld,bhcle->bhcde', w_loc, kc, vc)
    n_loc = jnp.einsum('bhcl,bhcld->bhcd', w_loc, kc)

    def step(carry, inp):
        c_st, n_st, m_st = carry
        c_l, n_l, m_l, b_l = inp
        m_new = jnp.maximum(b_l + m_st, m_l)
        a_prev = jnp.exp(b_l + m_st - m_new)
        a_loc = jnp.exp(m_l - m_new)
        c_new = a_prev[..., None, None] * c_st + a_loc[..., None, None] * c_l
        n_new = a_prev[..., None] * n_st + a_loc[..., None] * n_l
        return (c_new, n_new, m_new), (c_st, n_st, m_st)

    init = (jnp.zeros((bsz, nh, dh, dh), f32), jnp.zeros((bsz, nh, dh), f32), jnp.full((bsz, nh), -jnp.inf, f32))
    xs = (jnp.moveaxis(c_loc, 2, 0), jnp.moveaxis(n_loc, 2, 0), jnp.moveaxis(m_loc, 2, 0), jnp.moveaxis(b_last, 2, 0))
    _, (c_prev, n_prev, m_prev) = lax.scan(step, init, xs)
    c_prev = jnp.moveaxis(c_prev, 0, 2)
    n_prev = jnp.moveaxis(n_prev, 0, 2)
    m_prev = jnp.moveaxis(m_prev, 0, 2)

    idx = jnp.arange(ML_CHUNK)
    causal = idx[:, None] >= idx[None, :]
    d_log = b[..., :, None] - b[..., None, :] + log_i[..., None, :]
    d_log = jnp.where(causal, d_log, -jnp.inf)
    inter_log = b + m_prev[..., None]
    m_t = jnp.maximum(inter_log, jnp.max(d_log, axis=-1))
    w_intra = jnp.exp(d_log - m_t[..., None])
    a_inter = jnp.exp(inter_log - m_t)
    s_qk = jnp.einsum('bhctd,bhcsd->bhcts', qc, kc) * w_intra
    num = jnp.einsum('bhcts,bhcse->bhcte', s_qk, vc) + a_inter[..., None] * jnp.einsum('bhctd,bhcde->bhcte', qc, c_prev)
    den = jnp.sum(s_qk, axis=-1) + a_inter * jnp.einsum('bhctd,bhcd->bhct', qc, n_prev)
    h = num / jnp.maximum(jnp.abs(den), jnp.exp(-m_t))[..., None]
    return h.transpose(0, 2, 3, 1, 4).reshape(bsz, s, nh, dh)


def rglru_mlstm_mixer(h, w_in, b_in, rg_conv_w, rg_conv_b, rg_w_a, rg_b_a, rg_w_x, rg_b_x, rg_lambda,
                      ml_conv_w, ml_conv_b, ml_norm, w_out):
    f32 = jnp.float32
    bsz, s, _ = h.shape
    z = h @ w_in + b_in
    cuts = [RG_WIDTH, 2 * RG_WIDTH, 2 * RG_WIDTH + ML_WIDTH, 2 * RG_WIDTH + 2 * ML_WIDTH,
            2 * RG_WIDTH + 3 * ML_WIDTH, 2 * RG_WIDTH + 4 * ML_WIDTH, 2 * RG_WIDTH + 4 * ML_WIDTH + ML_HEADS]
    x_rg, g_rg, q, k, v, o, i_pre, f_pre = jnp.split(z, cuts, axis=-1)
    xc = causal_dwconv(x_rg, rg_conv_w, rg_conv_b)
    y_rg = rg_lru(xc, rg_w_a, rg_b_a, rg_w_x, rg_b_x, rg_lambda) * jax.nn.gelu(g_rg.astype(f32), approximate=True)
    qk = jax.nn.silu(causal_dwconv(jnp.concatenate([q, k], axis=-1), ml_conv_w, ml_conv_b))
    q, k = jnp.split(qk, 2, axis=-1)
    hm = mlstm_chunkwise(q.reshape(bsz, s, ML_HEADS, ML_HEAD_DIM), k.reshape(bsz, s, ML_HEADS, ML_HEAD_DIM),
                         v.reshape(bsz, s, ML_HEADS, ML_HEAD_DIM), i_pre, f_pre)
    hm = rms_norm(hm, ml_norm.reshape(ML_HEADS, ML_HEAD_DIM))
    y_ml = jax.nn.sigmoid(o.astype(f32)) * hm.reshape(bsz, s, ML_WIDTH)
    y = jnp.concatenate([y_rg, y_ml], axis=-1).astype(h.dtype)
    return y @ w_out


def rope_tables(positions):
    half = AT_HEAD_DIM // 2
    inv_freq = ROPE_THETA ** (-jnp.arange(half, dtype=jnp.float32) * (2.0 / AT_HEAD_DIM))
    ang = positions.astype(jnp.float32)[..., None] * inv_freq
    return jnp.cos(ang)[:, :, None, :], jnp.sin(ang)[:, :, None, :]


def apply_rope(x, cos, sin):
    xf = x.astype(jnp.float32)
    x1, x2 = jnp.split(xf, 2, axis=-1)
    return jnp.concatenate([x1 * cos - x2 * sin, x2 * cos + x1 * sin], axis=-1)


def banded_sink_attention(q, k, v, sinks):
    f32 = jnp.float32
    bsz, s, _, dh = q.shape
    nb = s // WINDOW
    grp = AT_HEADS // AT_KV_HEADS
    qb = q.astype(f32).reshape(bsz, nb, WINDOW, AT_KV_HEADS, grp, dh)

    def key_window(t):
        tb = t.astype(f32).reshape(bsz, nb, WINDOW, AT_KV_HEADS, dh)
        prev = jnp.pad(tb, ((0, 0), (1, 0), (0, 0), (0, 0), (0, 0)))[:, :-1]
        return jnp.concatenate([prev, tb], axis=2)

    kw = key_window(k)
    vw = key_window(v)
    logits = jnp.einsum('bnqhgd,bnkhd->bnhgqk', qb, kw) * (dh ** -0.5)
    qi = jnp.arange(WINDOW)[:, None]
    kj = jnp.arange(2 * WINDOW)[None, :]
    band = (kj > qi) & (kj <= qi + WINDOW)
    blk = jnp.arange(nb)[:, None, None]
    valid = band[None] & ((blk > 0) | (kj >= WINDOW)[None])
    logits = jnp.where(valid[None, :, None, None], logits, -jnp.inf)
    sink = sinks.astype(f32).reshape(AT_KV_HEADS, grp)[:, :, None]
    m = jnp.maximum(jnp.max(logits, axis=-1), sink)
    probs = jnp.exp(logits - m[..., None])
    denom = jnp.sum(probs, axis=-1) + jnp.exp(sink - m)
    out = jnp.einsum('bnhgqk,bnkhd->bnhgqd', probs, vw) / denom[..., None]
    return out.transpose(0, 1, 4, 2, 3, 5).reshape(bsz, s, AT_HEADS * dh)


def swa_sink_mixer(h, positions, w_qkv, q_norm, k_norm, sinks, w_out):
    bsz, s, _ = h.shape
    qkv = h @ w_qkv
    q, k, v = jnp.split(qkv, [AT_HEADS * AT_HEAD_DIM, (AT_HEADS + AT_KV_HEADS) * AT_HEAD_DIM], axis=-1)
    q = q.reshape(bsz, s, AT_HEADS, AT_HEAD_DIM)
    k = k.reshape(bsz, s, AT_KV_HEADS, AT_HEAD_DIM)
    v = v.reshape(bsz, s, AT_KV_HEADS, AT_HEAD_DIM)
    cos, sin = rope_tables(positions)
    q = apply_rope(rms_norm(q, q_norm), cos, sin)
    k = apply_rope(rms_norm(k, k_norm), cos, sin)
    o = banded_sink_attention(q, k, v, sinks)
    return o.astype(h.dtype) @ w_out


def conv_ffn(h, w_up, conv_w, conv_b, w_down):
    g, u = jnp.split(h @ w_up, 2, axis=-1)
    g = causal_dwconv(g, conv_w, conv_b)
    return (jax.nn.gelu(g, approximate=True) * u) @ w_down


def _normal(key, shape, scale):
    return jax.random.normal(key, shape, jnp.float32) * scale


def setup_inputs(seed: int = 0) -> dict:
    key = jax.random.key(seed)
    ks = jax.random.split(key, 30)
    x = _normal(ks[0], (BATCH, SEQ, D_MODEL), 1.0)
    p = _normal(ks[1], (DEPTH, BATCH, SEQ, PLE_DIM), 1.0)
    offs = jax.random.randint(ks[2], (BATCH, 1), 0, 1024, dtype=jnp.int32)
    positions = offs + jnp.arange(SEQ, dtype=jnp.int32)[None, :]
    norm_mix = 1.0 + _normal(ks[3], (DEPTH, D_MODEL), 0.05)
    norm_ffn = 1.0 + _normal(ks[4], (DEPTH, D_MODEL), 0.05)
    norm_ple = 1.0 + _normal(ks[5], (DEPTH, D_MODEL), 0.05)
    hy_w_in = _normal(ks[6], (N_EVEN, D_MODEL, HY_IN), D_MODEL ** -0.5)
    hy_b_in = _normal(ks[7], (N_EVEN, HY_IN), 0.02)
    hy_b_in = hy_b_in.at[:, HY_IN - ML_HEADS:].add(jnp.linspace(3.0, 6.0, ML_HEADS))
    rg_conv_w = _normal(ks[8], (N_EVEN, RG_CONV, RG_WIDTH), RG_CONV ** -0.5)
    rg_conv_b = _normal(ks[9], (N_EVEN, RG_WIDTH), 0.02)
    rg_w_a = _normal(ks[10], (N_EVEN, RG_BLOCKS, RG_BLOCK, RG_BLOCK), RG_BLOCK ** -0.5)
    rg_b_a = _normal(ks[11], (N_EVEN, RG_WIDTH), 0.02)
    rg_w_x = _normal(ks[12], (N_EVEN, RG_BLOCKS, RG_BLOCK, RG_BLOCK), RG_BLOCK ** -0.5)
    rg_b_x = _normal(ks[13], (N_EVEN, RG_WIDTH), 0.02)
    a_c = jax.random.uniform(ks[14], (N_EVEN, RG_WIDTH), jnp.float32, 0.9, 0.999)
    a_base = a_c ** (1.0 / RG_C)
    rg_lambda = jnp.log(a_base) - jnp.log1p(-a_base)
    ml_conv_w = _normal(ks[15], (N_EVEN, ML_CONV, 2 * ML_WIDTH), ML_CONV ** -0.5)
    ml_conv_b = _normal(ks[16], (N_EVEN, 2 * ML_WIDTH), 0.02)
    ml_norm = 1.0 + _normal(ks[17], (N_EVEN, ML_WIDTH), 0.05)
    hy_w_out = _normal(ks[18], (N_EVEN, HY_MIX, D_MODEL), HY_MIX ** -0.5)
    at_w_qkv = _normal(ks[19], (N_ODD, D_MODEL, AT_QKV), D_MODEL ** -0.5)
    at_q_norm = 1.0 + _normal(ks[20], (N_ODD, AT_HEAD_DIM), 0.05)
    at_k_norm = 1.0 + _normal(ks[21], (N_ODD, AT_HEAD_DIM), 0.05)
    at_sinks = _normal(ks[22], (N_ODD, AT_HEADS), 0.5)
    at_w_out = _normal(ks[23], (N_ODD, AT_HEADS * AT_HEAD_DIM, D_MODEL), (AT_HEADS * AT_HEAD_DIM) ** -0.5)
    ff_w_up = _normal(ks[24], (DEPTH, D_MODEL, 2 * FF_DIM), D_MODEL ** -0.5)
    ff_conv_w = _normal(ks[25], (DEPTH, FF_CONV, FF_DIM), FF_CONV ** -0.5)
    ff_conv_b = _normal(ks[26], (DEPTH, FF_DIM), 0.02)
    ff_w_down = _normal(ks[27], (DEPTH, FF_DIM, D_MODEL), FF_DIM ** -0.5)
    ple_w_gate = _normal(ks[28], (DEPTH, D_MODEL, D_MODEL), D_MODEL ** -0.5)
    ple_w_proj = _normal(ks[29], (DEPTH, PLE_DIM, D_MODEL), PLE_DIM ** -0.5)
    return {'x': x, 'p': p, 'positions': positions,
            'norm_mix': norm_mix, 'norm_ffn': norm_ffn, 'norm_ple': norm_ple,
            'hy_w_in': hy_w_in, 'hy_b_in': hy_b_in,
            'rg_conv_w': rg_conv_w, 'rg_conv_b': rg_conv_b, 'rg_w_a': rg_w_a, 'rg_b_a': rg_b_a,
            'rg_w_x': rg_w_x, 'rg_b_x': rg_b_x, 'rg_lambda': rg_lambda,
            'ml_conv_w': ml_conv_w, 'ml_conv_b': ml_conv_b, 'ml_norm': ml_norm, 'hy_w_out': hy_w_out,
            'at_w_qkv': at_w_qkv, 'at_q_norm': at_q_norm, 'at_k_norm': at_k_norm, 'at_sinks': at_sinks,
            'at_w_out': at_w_out,
            'ff_w_up': ff_w_up, 'ff_conv_w': ff_conv_w, 'ff_conv_b': ff_conv_b, 'ff_w_down': ff_w_down,
            'ple_w_gate': ple_w_gate, 'ple_w_proj': ple_w_proj}


def reference(x, p, positions, norm_mix, norm_ffn, norm_ple, hy_w_in, hy_b_in,
              rg_conv_w, rg_conv_b, rg_w_a, rg_b_a, rg_w_x, rg_b_x, rg_lambda,
              ml_conv_w, ml_conv_b, ml_norm, hy_w_out,
              at_w_qkv, at_q_norm, at_k_norm, at_sinks, at_w_out,
              ff_w_up, ff_conv_w, ff_conv_b, ff_w_down, ple_w_gate, ple_w_proj):
    for layer in range(DEPTH):
        h = rms_norm(x, norm_mix[layer])
        if layer % 2 == 0:
            e = layer // 2
            mix = rglru_mlstm_mixer(h, hy_w_in[e], hy_b_in[e], rg_conv_w[e], rg_conv_b[e], rg_w_a[e], rg_b_a[e],
                                    rg_w_x[e], rg_b_x[e], rg_lambda[e], ml_conv_w[e], ml_conv_b[e], ml_norm[e],
                                    hy_w_out[e])
        else:
            o = layer // 2
            mix = swa_sink_mixer(h, positions, at_w_qkv[o], at_q_norm[o], at_k_norm[o], at_sinks[o], at_w_out[o])
        x = x + mix.astype(x.dtype)
        x = x + conv_ffn(rms_norm(x, norm_ffn[layer]), ff_w_up[layer], ff_conv_w[layer], ff_conv_b[layer],
                         ff_w_down[layer]).astype(x.dtype)
        gate = jax.nn.sigmoid(rms_norm(x, norm_ple[layer]) @ ple_w_gate[layer])
        x = x + (gate * (p[layer] @ ple_w_proj[layer])).astype(x.dtype)
    return x
```

```cpp
#include <hip/hip_runtime.h>
#include <cstdio>
#include <cstdint>
#include <cmath>
namespace pg8 {
#define PG8_LAS __attribute__((address_space(3)))
typedef unsigned short bf16_t;
typedef short bf16x8 __attribute__((ext_vector_type(8)));
typedef float f32x4 __attribute__((ext_vector_type(4)));
typedef unsigned u32x4 __attribute__((ext_vector_type(4)));
constexpr int BM = 256, BK = 64, HALF = 128, HTB = HALF * BK * 2  , STAGE_BYTES = 8 * HTB, NXCD = 8, WGM = 8;

__host__ __device__ __forceinline__ int lds_byte(int r, int c) { const int st = (r >> 4) * 2 + (c >> 5), rr = r & 15, cc = c & 31, ob = rr * 64 + cc * 2; return st * 1024 + (ob ^ (((ob >> 9) & 1) << 5)); }
__host__ __device__ __forceinline__ void stage_rc(int b, int& R, int& C) { const int st = b / 1024, sb = b % 1024, swz = sb ^ (((sb >> 9) & 1) << 5); R = (st >> 1) * 16 + swz / 64; C = (st & 1) * 32 + (swz % 64) / 2; }
__host__ __device__ __forceinline__ int perm32(int rho) { const int n = rho >> 4, i = rho & 15; return 8 * (i >> 2) + 4 * n + (i & 3); }

struct Unit { int pm, pn; };
struct Gemm { const bf16_t* A; const bf16_t* Bt; int M, N, K; };

struct StaticOrder {
    int nM, nN, nwg, G, c;
    __host__ __device__ void init(int M, int N, int G_, int c_) { nM = M / BM; nN = N / BM; nwg = nM * nN; G = G_; c = c_; }
    __host__ __device__ bool next(int i, Unit& u) const {
        const long L = (long)i * G + c; if (L >= nwg) return false;
        int wgid = (int)L; { const int q = nwg / NXCD, r = nwg % NXCD, xcd = wgid % NXCD, off = wgid / NXCD; wgid = (xcd < r ? xcd * (q + 1) : r * (q + 1) + (xcd - r) * q) + off; }
        const int nig = WGM * nN, gid = wgid / nig, fm = gid * WGM, gsz = (nM - fm) < WGM ? (nM - fm) : WGM;
        u.pm = fm + ((wgid % nig) % gsz); u.pn = (wgid % nig) / gsz; return true;
    }
    __device__ __forceinline__ void a_ready(const Unit&) const {}
    __device__ __forceinline__ void done(const Unit&) const {}
};

typedef float f32x2_t __attribute__((ext_vector_type(2))); typedef __bf16 bf16x2_t __attribute__((ext_vector_type(2)));
__device__ __forceinline__ unsigned pk2(float lo, float hi) { f32x2_t v = {lo, hi}; bf16x2_t b = __builtin_convertvector(v, bf16x2_t); return __builtin_bit_cast(unsigned, b); }
__device__ __forceinline__ float bflo(unsigned w) { return __uint_as_float(w << 16); }
__device__ __forceinline__ float bfhi(unsigned w) { return __uint_as_float(w & 0xffff0000u); }
__device__ __forceinline__ float fsigmoid(float x) { return __builtin_amdgcn_rcpf(1.0f + __expf(-x)); }
__device__ __forceinline__ float gelu_tanh(float x) { const float t = x * (1.5957691216f + 0.0713548163f * x * x); return x * __builtin_amdgcn_rcpf(1.0f + __expf(-t)); }
__device__ __forceinline__ u32x4 pk8(const f32x4& a, const f32x4& b) { u32x4 w; w.x = pk2(a[0], a[1]); w.y = pk2(a[2], a[3]); w.z = pk2(b[0], b[1]); w.w = pk2(b[2], b[3]); return w; }
__device__ __forceinline__ float dot4(const f32x4& a) { return (a[0] * a[0] + a[1] * a[1]) + (a[2] * a[2] + a[3] * a[3]); }
__device__ __forceinline__ float row_rstd(const float* ss, int row) {
    const f32x4* p = (const f32x4*)(ss + (size_t)row * 16);
    const f32x4 a = p[0], b = p[1], c = p[2], d = p[3];
    const float s = (((a[0] + a[1]) + (a[2] + a[3])) + ((b[0] + b[1]) + (b[2] + b[3]))) + (((c[0] + c[1]) + (c[2] + c[3])) + ((d[0] + d[1]) + (d[2] + d[3])));
    return rsqrtf(s * (1.0f / 1024.0f) + 1e-6f);
}

struct EpiZ {
    static constexpr bool PERM = true, AFTER_DRAIN = false;
    bf16_t* O; int ldc; const float* bias; const float* ss;
    __device__ __forceinline__ void operator()(const f32x4 (&acc)[2][2][4][2], const Unit& u, int wr, int wc, int fr, int fq) const {
        const int row0 = u.pm * BM + wr * 64 + fr, col0 = u.pn * BM + wc * 32 + 8 * fq;
        f32x4 bv[2][2];
#pragma unroll
        for (int bj = 0; bj < 2; ++bj)
#pragma unroll
            for (int n = 0; n < 2; ++n) bv[bj][n] = bias ? *(const f32x4*)(bias + col0 + bj * HALF + 4 * n) : (f32x4){0.f, 0.f, 0.f, 0.f};
#pragma unroll
        for (int ai = 0; ai < 2; ++ai)
#pragma unroll
            for (int m = 0; m < 4; ++m) { const int row = row0 + ai * HALF + m * 16; const float rs = ss ? row_rstd(ss, row) : 1.0f;
                bf16_t* rowp = O + (size_t)row * ldc + col0;
#pragma unroll
                for (int bj = 0; bj < 2; ++bj) { const f32x4 v0 = acc[ai][bj][m][0] * rs + bv[bj][0], v1 = acc[ai][bj][m][1] * rs + bv[bj][1];
                    *(u32x4*)(rowp + bj * HALF) = pk8(v0, v1); } }
    }
};

struct EpiRes {
    static constexpr bool PERM = true, AFTER_DRAIN = false;
    const float* src; float* dst; bf16_t* xb; float* sso;
    __device__ __forceinline__ void operator()(const f32x4 (&acc)[2][2][4][2], const Unit& u, int wr, int wc, int fr, int fq) const {
        const int row0 = u.pm * BM + wr * 64 + fr, col0 = u.pn * BM + wc * 32 + 8 * fq;
#pragma unroll
        for (int ai = 0; ai < 2; ++ai)
#pragma unroll
            for (int m = 0; m < 4; ++m) { const int row = row0 + ai * HALF + m * 16; const size_t off = (size_t)row * 1024 + col0; float sq = 0.f;
#pragma unroll
                for (int bj = 0; bj < 2; ++bj) {
                    const f32x4 r0 = *(const f32x4*)(src + off + bj * HALF), r1 = *(const f32x4*)(src + off + bj * HALF + 4);
                    const f32x4 v0 = r0 + acc[ai][bj][m][0], v1 = r1 + acc[ai][bj][m][1];
                    *(f32x4*)(dst + off + bj * HALF) = v0; *(f32x4*)(dst + off + bj * HALF + 4) = v1;
                    *(u32x4*)(xb + off + bj * HALF) = pk8(v0, v1);
                    sq += dot4(v0) + dot4(v1); }
                sq += __shfl_xor(sq, 16); sq += __shfl_xor(sq, 32);
                if (fq == 0) sso[(size_t)row * 16 + 4 * u.pn + wc] = sq; }
    }
};

struct EpiPle {
    static constexpr bool PERM = true, AFTER_DRAIN = false;
    const float* ss; const bf16_t* pp; float* R; bf16_t* xb; float* sso;
    __device__ __forceinline__ void operator()(const f32x4 (&acc)[2][2][4][2], const Unit& u, int wr, int wc, int fr, int fq) const {
        const int row0 = u.pm * BM + wr * 64 + fr, col0 = u.pn * BM + wc * 32 + 8 * fq;
#pragma unroll
        for (int ai = 0; ai < 2; ++ai)
#pragma unroll
            for (int m = 0; m < 4; ++m) { const int row = row0 + ai * HALF + m * 16; const size_t off = (size_t)row * 1024 + col0; const float rs = row_rstd(ss, row); float sq = 0.f;
#pragma unroll
                for (int bj = 0; bj < 2; ++bj) {
                    const f32x4 r0 = *(const f32x4*)(R + off + bj * HALF), r1 = *(const f32x4*)(R + off + bj * HALF + 4);
                    const u32x4 pw = *(const u32x4*)(pp + off + bj * HALF);
                    const f32x4 a0 = acc[ai][bj][m][0] * rs, a1 = acc[ai][bj][m][1] * rs;
                    f32x4 v0, v1;
                    v0[0] = r0[0] + fsigmoid(a0[0]) * bflo(pw.x); v0[1] = r0[1] + fsigmoid(a0[1]) * bfhi(pw.x); v0[2] = r0[2] + fsigmoid(a0[2]) * bflo(pw.y); v0[3] = r0[3] + fsigmoid(a0[3]) * bfhi(pw.y);
                    v1[0] = r1[0] + fsigmoid(a1[0]) * bflo(pw.z); v1[1] = r1[1] + fsigmoid(a1[1]) * bfhi(pw.z); v1[2] = r1[2] + fsigmoid(a1[2]) * bflo(pw.w); v1[3] = r1[3] + fsigmoid(a1[3]) * bfhi(pw.w);
                    *(f32x4*)(R + off + bj * HALF) = v0; *(f32x4*)(R + off + bj * HALF + 4) = v1;
                    if (xb) { *(u32x4*)(xb + off + bj * HALF) = pk8(v0, v1); sq += dot4(v0) + dot4(v1); } }
                if (xb) { sq += __shfl_xor(sq, 16); sq += __shfl_xor(sq, 32);
                    if (fq == 0) sso[(size_t)row * 16 + 4 * u.pn + wc] = sq; } }
    }
};

struct EpiQkv {
    static constexpr bool PERM = true, AFTER_DRAIN = false;
    const float* ss; const float* rope; const float* qn; const float* kn; bf16_t* Q; bf16_t* K; bf16_t* V;
    __device__ __forceinline__ void operator()(const f32x4 (&acc)[2][2][4][2], const Unit& u, int wr, int wc, int fr, int fq) const {
        const int row0 = u.pm * BM + wr * 64 + fr;
        if (u.pn == 5) {
#pragma unroll
            for (int ai = 0; ai < 2; ++ai)
#pragma unroll
                for (int m = 0; m < 4; ++m) { const int row = row0 + ai * HALF + m * 16; const float rs = row_rstd(ss, row);
#pragma unroll
                    for (int bj = 0; bj < 2; ++bj) *(u32x4*)(V + (size_t)row * 256 + 64 * wc + 32 * bj + 8 * fq) = pk8(acc[ai][bj][m][0] * rs, acc[ai][bj][m][1] * rs); }
            return;
        }
        const bool isq = u.pn < 4; const float* gn = isq ? qn : kn; const float osc = isq ? 0.125f : 1.0f;
        bf16_t* dst = isq ? Q + (size_t)(64 * (4 * u.pn + wc)) : K + (size_t)(64 * wc); const int ldd = isq ? 1024 : 256;
        f32x4 g[2][2];
#pragma unroll
        for (int bj = 0; bj < 2; ++bj)
#pragma unroll
            for (int n = 0; n < 2; ++n) g[bj][n] = *(const f32x4*)(gn + 32 * bj + 8 * fq + 4 * n);
#pragma unroll
        for (int ai = 0; ai < 2; ++ai)
#pragma unroll
            for (int m = 0; m < 4; ++m) { const int row = row0 + ai * HALF + m * 16; const float rs = row_rstd(ss, row);
                f32x4 v[2][2]; float sq = 0.f;
#pragma unroll
                for (int bj = 0; bj < 2; ++bj)
#pragma unroll
                    for (int n = 0; n < 2; ++n) { v[bj][n] = acc[ai][bj][m][n] * rs; sq += dot4(v[bj][n]); }
                sq += __shfl_xor(sq, 16); sq += __shfl_xor(sq, 32);
                const float hr = rsqrtf(sq * (1.0f / 64.0f) + 1e-6f) ;
#pragma unroll
                for (int bj = 0; bj < 2; ++bj)
#pragma unroll
                    for (int n = 0; n < 2; ++n) v[bj][n] = v[bj][n] * hr * g[bj][n];
                const float* rp = rope + (size_t)row * 64 + 8 * fq;
                f32x4 o[2][2];
#pragma unroll
                for (int n = 0; n < 2; ++n) { const f32x4 cs = *(const f32x4*)(rp + 4 * n), sn = *(const f32x4*)(rp + 32 + 4 * n);
                    o[0][n] = (v[0][n] * cs - v[1][n] * sn) * osc; o[1][n] = (v[1][n] * cs + v[0][n] * sn) * osc; }
#pragma unroll
                for (int bj = 0; bj < 2; ++bj) *(u32x4*)(dst + (size_t)row * ldd + 32 * bj + 8 * fq) = pk8(o[bj][0], o[bj][1]); }
    }
};

struct EpiUp {
    static constexpr bool PERM = true, AFTER_DRAIN = false;
    const float* ss; const float* cw; const float* cb; bf16_t* A2; bf16_t* GH; bf16_t* UH; bf16_t* GT;
    __device__ __forceinline__ void operator()(const f32x4 (&acc)[2][2][4][2], const Unit& u, int wr, int wc, int fr, int fq) const {
        const int lane = fq * 16 + fr, ch0 = u.pn * 128 + wc * 32 + 8 * fq;
        const int src1 = (lane & 48) | ((fr - 1) & 15), src2 = (lane & 48) | ((fr - 2) & 15);
        f32x4 w0[2], w1[2], w2[2], bb[2];
#pragma unroll
        for (int n = 0; n < 2; ++n) { w0[n] = *(const f32x4*)(cw + ch0 + 4 * n); w1[n] = *(const f32x4*)(cw + 3072 + ch0 + 4 * n); w2[n] = *(const f32x4*)(cw + 6144 + ch0 + 4 * n); bb[n] = *(const f32x4*)(cb + ch0 + 4 * n); }
#pragma unroll
        for (int ai = 0; ai < 2; ++ai) {
            const int grp = 4 * u.pm + 2 * ai + wr;
            unsigned pp0 = 0u, pp1 = 0u, pp2 = 0u, pp3 = 0u;
#pragma unroll
            for (int m = 0; m < 4; ++m) { const int row = u.pm * BM + ai * HALF + wr * 64 + m * 16 + fr; const float rs = row_rstd(ss, row);
                const f32x4 g0 = acc[ai][0][m][0] * rs, g1 = acc[ai][0][m][1] * rs, u0 = acc[ai][1][m][0] * rs, u1 = acc[ai][1][m][1] * rs;
                const unsigned c0 = pk2(g0[0], g0[1]), c1 = pk2(g0[2], g0[3]), c2 = pk2(g1[0], g1[1]), c3 = pk2(g1[2], g1[3]);
                unsigned a1_0 = __shfl(c0, src1), a1_1 = __shfl(c1, src1), a1_2 = __shfl(c2, src1), a1_3 = __shfl(c3, src1);
                unsigned a2_0 = __shfl(c0, src2), a2_1 = __shfl(c1, src2), a2_2 = __shfl(c2, src2), a2_3 = __shfl(c3, src2);
                if (m > 0) {
                    const unsigned b1_0 = __shfl(pp0, src1), b1_1 = __shfl(pp1, src1), b1_2 = __shfl(pp2, src1), b1_3 = __shfl(pp3, src1);
                    const unsigned b2_0 = __shfl(pp0, src2), b2_1 = __shfl(pp1, src2), b2_2 = __shfl(pp2, src2), b2_3 = __shfl(pp3, src2);
                    if (fr < 1) { a1_0 = b1_0; a1_1 = b1_1; a1_2 = b1_2; a1_3 = b1_3; }
                    if (fr < 2) { a2_0 = b2_0; a2_1 = b2_1; a2_2 = b2_2; a2_3 = b2_3; }
                }
                const f32x4 p1a = {bflo(a1_0), bfhi(a1_0), bflo(a1_1), bfhi(a1_1)}, p1b = {bflo(a1_2), bfhi(a1_2), bflo(a1_3), bfhi(a1_3)};
                const f32x4 p2a = {bflo(a2_0), bfhi(a2_0), bflo(a2_1), bfhi(a2_1)}, p2b = {bflo(a2_2), bfhi(a2_2), bflo(a2_3), bfhi(a2_3)};
                const f32x4 y0 = w0[0] * p2a + w1[0] * p1a + w2[0] * g0 + bb[0], y1 = w0[1] * p2b + w1[1] * p1b + w2[1] * g1 + bb[1];
                f32x4 o0, o1;
#pragma unroll
                for (int e = 0; e < 4; ++e) { o0[e] = gelu_tanh(y0[e]) * u0[e]; o1[e] = gelu_tanh(y1[e]) * u1[e]; }
                const bool head = (m == 0) && (fr < 2);
                if (!head) *(u32x4*)(A2 + (size_t)row * 3072 + ch0) = pk8(o0, o1);
                else { const size_t so = ((size_t)grp * 2 + fr) * 3072 + ch0; u32x4 gw; gw.x = c0; gw.y = c1; gw.z = c2; gw.w = c3; *(u32x4*)(GH + so) = gw; *(u32x4*)(UH + so) = pk8(u0, u1); }
                if (m == 3 && fr >= 14) { const size_t so = ((size_t)grp * 2 + (fr - 14)) * 3072 + ch0; u32x4 gw; gw.x = c0; gw.y = c1; gw.z = c2; gw.w = c3; *(u32x4*)(GT + so) = gw; }
                pp0 = c0; pp1 = c1; pp2 = c2; pp3 = c3; }
        }
    }
};
template <class Epi, class Sched, bool ALIGN_EPI = false, bool SP2 = false>
__device__ __forceinline__ void gemm_phase(PG8_LAS unsigned char* lds, const Gemm g, const Sched& S, const Epi& E) {
    int tid_ = threadIdx.x; asm volatile("" : "+v"(tid_));
    const int tid = tid_, wid = __builtin_amdgcn_readfirstlane(tid >> 6), lane = tid & 63, wr = wid >> 2, wc = wid & 3, fr = lane & 15, fq = lane >> 4;
    const int K = g.K, nt = K / BK;
    unsigned voffA[2], voffB[2];
#pragma unroll
    for (int i = 0; i < 2; ++i) { int R, C; stage_rc(tid * 16 + i * 8192, R, C); const int Rb = Epi::PERM ? ((R & ~31) + perm32(R & 31)) : R;
        voffA[i] = (unsigned)(R * K + C) * 2u; voffB[i] = (unsigned)(Rb * K + C) * 2u; }
    const size_t kstep = (size_t)(BK * 2);
    const size_t hstep = (size_t)HALF * K * 2;
    const size_t tstep = 2 * hstep;
    const unsigned ldsw = (unsigned)wid * 1024u;
    const int aoff = lds_byte(wr * 64 + fr, fq * 8), boff = lds_byte(wc * 32 + fr, fq * 8);
#define PG8_SA(b, h) (((b) * 2 + (h)) * HTB)
#define PG8_SB(b, h) ((4 + (b) * 2 + (h)) * HTB)
#define PG8_STAGE(bufoff, gbase, voff) do { _Pragma("unroll") for (int _i = 0; _i < 2; ++_i) \
        __builtin_amdgcn_global_load_lds((const unsigned*)((const char*)(gbase) + (voff)[_i]), (PG8_LAS unsigned*)(lds + (bufoff) + ldsw + _i * 8192), 16, 0, 0); } while (0)
#define PG8_LDA(dst, b, h) do { _Pragma("unroll") for (int m = 0; m < 4; ++m) _Pragma("unroll") for (int k = 0; k < 2; ++k) dst[m][k] = *(const PG8_LAS bf16x8*)(lds + PG8_SA(b, h) + aoff + m * 2048 + k * 1024); } while (0)
#define PG8_LDB(dst, b, h) do { _Pragma("unroll") for (int n = 0; n < 2; ++n) _Pragma("unroll") for (int k = 0; k < 2; ++k) dst[n][k] = *(const PG8_LAS bf16x8*)(lds + PG8_SB(b, h) + boff + n * 2048 + k * 1024); } while (0)
#define PG8_MMA(ai, bj, At, Bt) do { __builtin_amdgcn_s_setprio(1); _Pragma("unroll") for (int m = 0; m < 4; ++m) _Pragma("unroll") for (int n = 0; n < 2; ++n) _Pragma("unroll") for (int k = 0; k < 2; ++k) \
        acc[ai][bj][m][n] = __builtin_amdgcn_mfma_f32_16x16x32_bf16(Bt[n][k], At[m][k], acc[ai][bj][m][n], 0, 0, 0); __builtin_amdgcn_s_setprio(0); } while (0)
#define PG8_WAIT_V(n) asm volatile("s_waitcnt vmcnt(" #n ")" ::: "memory")
#define PG8_WAIT_L(n) asm volatile("s_waitcnt lgkmcnt(" #n ")" ::: "memory")
#define PG8_BAR __builtin_amdgcn_s_barrier()
#define PG8_SCHED __builtin_amdgcn_sched_barrier(0)
    Unit cur, nxt; int ui = 0;
    if (!S.next(0, cur)) return;
    f32x4 acc[2][2][4][2];
#pragma unroll
    for (int a = 0; a < 2; ++a)
#pragma unroll
        for (int b = 0; b < 2; ++b)
#pragma unroll
            for (int m = 0; m < 4; ++m)
#pragma unroll
                for (int n = 0; n < 2; ++n) acc[a][b][m][n] = (f32x4){0.f, 0.f, 0.f, 0.f};
    bf16x8 At[4][2], B0[2][2], B1[2][2];
    const char* cA = (const char*)g.A + (size_t)cur.pm * tstep; const char* cB = (const char*)g.Bt + (size_t)cur.pn * tstep;
    S.a_ready(cur);
    if constexpr (SP2) {
        PG8_STAGE(PG8_SB(0, 0), cB, voffB); PG8_STAGE(PG8_SB(0, 1), cB + hstep, voffB); PG8_STAGE(PG8_SA(0, 0), cA, voffA); PG8_STAGE(PG8_SA(0, 1), cA + hstep, voffA);
        if (wr == 1) PG8_BAR;
        PG8_WAIT_V(2); PG8_BAR;
        PG8_STAGE(PG8_SB(1, 0), cB + kstep, voffB); PG8_STAGE(PG8_SA(1, 0), cA + kstep, voffA); PG8_STAGE(PG8_SB(1, 1), cB + hstep + kstep, voffB);
        PG8_WAIT_V(6); PG8_BAR;
    } else {
        PG8_STAGE(PG8_SB(0, 0), cB, voffB); PG8_STAGE(PG8_SA(0, 0), cA, voffA); PG8_STAGE(PG8_SB(0, 1), cB + hstep, voffB); PG8_STAGE(PG8_SA(0, 1), cA + hstep, voffA);
        if (wr == 1) PG8_BAR;
        PG8_WAIT_V(4); PG8_BAR;
        PG8_STAGE(PG8_SB(1, 0), cB + kstep, voffB); PG8_STAGE(PG8_SA(1, 0), cA + kstep, voffA); PG8_STAGE(PG8_SB(1, 1), cB + hstep + kstep, voffB);
        PG8_WAIT_V(6); PG8_BAR;
    }
    for (;;) {
        const bool has_next = S.next(ui + 1, nxt);
        const char* nA = has_next ? (const char*)g.A + (size_t)nxt.pm * tstep : cA; const char* nB = has_next ? (const char*)g.Bt + (size_t)nxt.pn * tstep : cB;
        for (int t = 0; t < nt; t += 2) {
            const bool last = (t == nt - 2);
            const char* a1 = cA + (size_t)(t + 1) * kstep;
            const char* a2 = last ? nA : cA + (size_t)(t + 2) * kstep; const char* b2 = last ? nB : cB + (size_t)(t + 2) * kstep;
            const char* a3 = a2 + kstep; const char* b3 = b2 + kstep;
            if (last && has_next) S.a_ready(nxt);
            if constexpr (SP2) {
            PG8_LDB(B0, 0, 0); PG8_LDB(B1, 0, 1); PG8_SCHED; PG8_LDA(At, 0, 0); PG8_STAGE(PG8_SA(1, 1), a1 + hstep, voffA);
            PG8_WAIT_V(8); PG8_WAIT_L(0); PG8_BAR; PG8_MMA(0, 0, At, B0); PG8_MMA(0, 1, At, B1); PG8_BAR; PG8_SCHED;
            PG8_LDA(At, 0, 1); PG8_STAGE(PG8_SB(0, 0), b2, voffB); PG8_STAGE(PG8_SB(0, 1), b2 + hstep, voffB); PG8_STAGE(PG8_SA(0, 0), a2, voffA);
            PG8_WAIT_V(8); PG8_WAIT_L(0); PG8_BAR; PG8_MMA(1, 0, At, B0); PG8_MMA(1, 1, At, B1); PG8_BAR; PG8_SCHED;
            PG8_LDB(B0, 1, 0); PG8_LDB(B1, 1, 1); PG8_SCHED; PG8_LDA(At, 1, 0); PG8_STAGE(PG8_SA(0, 1), a2 + hstep, voffA);
            PG8_WAIT_V(8); PG8_WAIT_L(0); PG8_BAR; PG8_MMA(0, 0, At, B0); PG8_MMA(0, 1, At, B1); PG8_BAR; PG8_SCHED;
            PG8_LDA(At, 1, 1); PG8_STAGE(PG8_SB(1, 0), b3, voffB); PG8_STAGE(PG8_SB(1, 1), b3 + hstep, voffB); PG8_STAGE(PG8_SA(1, 0), a3, voffA);
            PG8_WAIT_V(8); PG8_WAIT_L(0); PG8_BAR; PG8_MMA(1, 0, At, B0); PG8_MMA(1, 1, At, B1); PG8_BAR; PG8_SCHED;
            } else {
            PG8_LDB(B0, 0, 0); PG8_SCHED; PG8_LDA(At, 0, 0); PG8_STAGE(PG8_SA(1, 1), a1 + hstep, voffA);
            PG8_WAIT_L(8); PG8_BAR; PG8_WAIT_L(0); PG8_MMA(0, 0, At, B0); PG8_BAR; PG8_SCHED;
            PG8_LDB(B1, 0, 1); PG8_STAGE(PG8_SB(0, 0), b2, voffB);
            PG8_BAR; PG8_WAIT_L(0); PG8_MMA(0, 1, At, B1); PG8_BAR;
            PG8_LDA(At, 0, 1); PG8_STAGE(PG8_SA(0, 0), a2, voffA);
            PG8_BAR; PG8_WAIT_L(0); PG8_MMA(1, 0, At, B0); PG8_BAR; PG8_SCHED;
            PG8_STAGE(PG8_SB(0, 1), b2 + hstep, voffB);
            PG8_WAIT_V(6); PG8_BAR; PG8_MMA(1, 1, At, B1); PG8_BAR;
            PG8_LDB(B0, 1, 0); PG8_SCHED; PG8_LDA(At, 1, 0); PG8_STAGE(PG8_SA(0, 1), a2 + hstep, voffA);
            PG8_WAIT_L(8); PG8_BAR; PG8_WAIT_L(0); PG8_MMA(0, 0, At, B0); PG8_BAR; PG8_SCHED;
            PG8_LDB(B1, 1, 1); PG8_STAGE(PG8_SB(1, 0), b3, voffB);
            PG8_BAR; PG8_WAIT_L(0); PG8_MMA(0, 1, At, B1); PG8_BAR;
            PG8_LDA(At, 1, 1); PG8_STAGE(PG8_SA(1, 0), a3, voffA);
            PG8_BAR; PG8_WAIT_L(0); PG8_MMA(1, 0, At, B0); PG8_BAR; PG8_SCHED;
            PG8_STAGE(PG8_SB(1, 1), b3 + hstep, voffB);
            PG8_WAIT_V(6); PG8_BAR; PG8_MMA(1, 1, At, B1); PG8_BAR;
            }
        }
        if constexpr (ALIGN_EPI) { if (wr == 0) PG8_BAR; }
        if constexpr (!Epi::AFTER_DRAIN) { E(acc, cur, wr, wc, fr, fq); S.done(cur); }
        if (!has_next) break;
#pragma unroll
        for (int a = 0; a < 2; ++a)
#pragma unroll
            for (int b = 0; b < 2; ++b)
#pragma unroll
                for (int m = 0; m < 4; ++m)
#pragma unroll
                    for (int n = 0; n < 2; ++n) acc[a][b][m][n] = (f32x4){0.f, 0.f, 0.f, 0.f};
        cur = nxt; cA = nA; cB = nB; ++ui;
        if constexpr (ALIGN_EPI) { if (wr == 1) PG8_BAR; }
    }
    PG8_WAIT_V(0);
    if constexpr (!ALIGN_EPI) { if (wr == 0) PG8_BAR; }
    PG8_BAR;
    if constexpr (Epi::AFTER_DRAIN) { E.fused(acc, cur, wr, wc, fr, fq, lds, wid, lane); S.done(cur); }
#undef PG8_SA
#undef PG8_SB
#undef PG8_STAGE
#undef PG8_LDA
#undef PG8_LDB
#undef PG8_MMA
#undef PG8_WAIT_V
#undef PG8_WAIT_L
#undef PG8_BAR
#undef PG8_SCHED
}
}

constexpr int NWAVES = 8;
constexpr int NB = 8, SEQ = 4096, T = NB * SEQ, DM = 1024, ZW = 3072, FFD = 3072, HYIN = 3080;
#ifndef DBG_STOP
#define DBG_STOP 99
#endif

constexpr size_t MiB = 1u << 20;
constexpr size_t WS_CTL = 0, CTL_ZERO_BYTES = 1 * MiB;
constexpr size_t WS_WIN = 2 * MiB, WS_WOUT0 = 8 * MiB, WS_WUP0 = 10 * MiB, WS_WDN0 = 22 * MiB, WS_WGT0 = 28 * MiB, WS_WPJ0 = 30 * MiB,
                 WS_WQKV = 31 * MiB, WS_WO1 = 34 * MiB, WS_WUP1 = 36 * MiB, WS_WDN1 = 48 * MiB, WS_WGT1 = 54 * MiB, WS_WPJ1 = 56 * MiB, WS_RGW = 57 * MiB;
constexpr size_t WS_GATES = 58 * MiB, WS_SSA = 59 * MiB, WS_SSB = 61 * MiB, WS_ROPE = 63 * MiB, WS_NLOC = 71 * MiB, WS_NPREV = 72 * MiB, WS_MSC = 73 * MiB,
                 WS_RGA = 74 * MiB, WS_RGH = 75 * MiB, WS_RGC = 76 * MiB;
constexpr size_t WS_PB = 78 * MiB, WS_XBA = 110 * MiB, WS_XBB = 174 * MiB, WS_CST = 238 * MiB, WS_BIG = 302 * MiB, WS_END = 494 * MiB;
constexpr int CW_BAR = 4096;

constexpr int RING_BYTES = 131072;
constexpr int LDSCTL_OFF = RING_BYTES, MISC_OFF = LDSCTL_OFF + 320;
constexpr int LDS_BYTES = 147456;

#define GAS __attribute__((address_space(1)))
#define LAS __attribute__((address_space(3)))
typedef unsigned short bf16;
typedef unsigned v4u __attribute__((ext_vector_type(4)));
typedef unsigned v2u __attribute__((ext_vector_type(2)));
typedef float f32x4 __attribute__((ext_vector_type(4)));
typedef float f32x16 __attribute__((ext_vector_type(16)));
typedef short bf16x8 __attribute__((ext_vector_type(8)));
typedef short s16x4 __attribute__((ext_vector_type(4)));
typedef GAS unsigned gu32;
typedef LAS unsigned char* ldsp;
#define LDS_WAIT() asm volatile("s_waitcnt lgkmcnt(0)" ::: "memory")
using pg8::pk2; using pg8::bflo; using pg8::bfhi; using pg8::fsigmoid; using pg8::gelu_tanh;
__device__ __forceinline__ unsigned short f2bf1(float x) { return (unsigned short)(pk2(x, 0.f) & 0xffffu); }
__device__ __forceinline__ float bf2f(unsigned short b) { return __uint_as_float(((unsigned)b) << 16); }
__device__ __forceinline__ float fsilu(float x) { return x * __builtin_amdgcn_rcpf(1.0f + __expf(-x)); }
#define MFMA16(a, b, c) __builtin_amdgcn_mfma_f32_16x16x32_bf16((a), (b), (c), 0, 0, 0)
#define MFMA32(a, b, c) __builtin_amdgcn_mfma_f32_32x32x16_bf16((a), (b), (c), 0, 0, 0)

#define XB_TMO      128
#define XB_XCNT(j)  (256  + 64 * (j))
#define XB_XSUB(j)  (1280 + 64 * (j))
#define XB_XGEN(j)  (2304 + 64 * (j))
#define XB_TOP      3328
#define XB_TOPGEN   3392
#define XCD_BAR_WORDS 3456
#define XB_SPIN_CAP (1u << 18)

__device__ __forceinline__ unsigned xb_ld(unsigned* p)              { return __hip_atomic_load(p, __ATOMIC_RELAXED, __HIP_MEMORY_SCOPE_AGENT); }
__device__ __forceinline__ unsigned xb_add(unsigned* p, unsigned v) { return __hip_atomic_fetch_add(p, v, __ATOMIC_RELAXED, __HIP_MEMORY_SCOPE_AGENT); }
__device__ __forceinline__ unsigned xb_xcc_id() { return (unsigned)__builtin_amdgcn_s_getreg((3 << 11) | 20) & 0xFu; }
#define XB_SPIN(cond, bar) do { unsigned _sp = 0; while (cond) { __builtin_amdgcn_s_sleep(1); \
    if ((++_sp & 255u) == 0u) { if (xb_ld(&(bar)[XB_TMO])) break; if (_sp > XB_SPIN_CAP) { atomicAdd(&(bar)[XB_TMO], 1u); break; } } } } while (0)

struct XcdBarrier {
    unsigned* bar; unsigned x;
    volatile LAS unsigned* st;
};

__device__ __forceinline__ XcdBarrier xcd_barrier_post(unsigned* bar, volatile LAS unsigned* st) {
    XcdBarrier b; b.bar = bar; b.x = xb_xcc_id(); b.st = st;
    if (threadIdx.x == 0) (void)xb_add(&bar[XB_XCNT(b.x)], 1u);
    return b;
}
__device__ __forceinline__ void xcd_barrier_complete(unsigned* bar, unsigned x, unsigned& nloc, unsigned& nx) {
    const unsigned G = gridDim.x * gridDim.y * gridDim.z;
    unsigned sum, cnt, mine, sp = 0u;
    for (;;) {
        sum = 0u; cnt = 0u; mine = 0u;
#pragma unroll
        for (unsigned j = 0; j < 16; ++j) { const unsigned c = xb_ld(&bar[XB_XCNT(j)]); sum += c; cnt += (c > 0u) ? 1u : 0u; mine = (j == x) ? c : mine; }
        if (sum == G) break;
        __builtin_amdgcn_s_sleep(1);
        if ((++sp & 255u) == 0u) { if (xb_ld(&bar[XB_TMO])) break; if (sp > XB_SPIN_CAP) { atomicAdd(&bar[XB_TMO], 1u); break; } }
    }
    nloc = mine > 0u ? mine : 1u; nx = cnt > 0u ? cnt : 1u;
}

__device__ __forceinline__ void xcd_barrier(const XcdBarrier& b) {
    asm volatile("s_waitcnt vmcnt(0)" ::: "memory");
    __syncthreads();
    if (threadIdx.x == 0) {
        unsigned* bar = b.bar;
        __builtin_amdgcn_s_waitcnt(0);
        unsigned nloc = b.st[0], nx = b.st[1];
        if (nloc == 0u) { xcd_barrier_complete(bar, b.x, nloc, nx); b.st[0] = nloc; b.st[1] = nx; }
        const unsigned old = xb_add(&bar[XB_XSUB(b.x)], 1u);
        const unsigned gen = old / nloc;
        if (old + 1u == (gen + 1u) * nloc) {
            __builtin_amdgcn_fence(__ATOMIC_RELEASE, "agent");
            asm volatile("s_waitcnt vmcnt(0)" ::: "memory");
            const unsigned og = xb_add(&bar[XB_TOP], 1u);
            const unsigned tg = og / nx;
            if (og + 1u == (tg + 1u) * nx) xb_add(&bar[XB_TOPGEN], 1u);
            else XB_SPIN(xb_ld(&bar[XB_TOPGEN]) == tg, bar);
            __builtin_amdgcn_fence(__ATOMIC_ACQUIRE, "agent");
            xb_add(&bar[XB_XGEN(b.x)], 1u);
            asm volatile("s_waitcnt vmcnt(0)" ::: "memory");
        } else {
            XB_SPIN(xb_ld(&bar[XB_XGEN(b.x)]) == gen, bar);
            __builtin_amdgcn_fence(__ATOMIC_ACQUIRE, "agent");
            asm volatile("s_waitcnt vmcnt(0)" ::: "memory");
        }
    }
    __syncthreads();
}

struct Frame {
    ldsp lds; volatile LAS unsigned* MISC;
    int tid, lane, wave, vcu, G;
    unsigned char* ws; unsigned long long kb; float* out;
};
__device__ __forceinline__ const float* karg(const Frame& F, int i) { unsigned long long a = F.kb; asm volatile("" : "+s"(a) :: "memory"); return (const float*)(((const __attribute__((address_space(4))) unsigned long long*)a)[i]); }
#define P_Z     ((bf16*)(F.ws + WS_BIG))
#define P_YBUF  ((bf16*)(F.ws + WS_XBA))
#define P_CST   ((bf16*)(F.ws + WS_CST))
#define P_RGW   ((bf16*)(F.ws + WS_RGW))
#define P_GATES ((float*)(F.ws + WS_GATES))
#define P_NLOC  ((float*)(F.ws + WS_NLOC))
#define P_NPREV ((float*)(F.ws + WS_NPREV))
#define P_MLOC  ((float*)(F.ws + WS_MSC))
#define P_BLAST ((float*)(F.ws + WS_MSC) + 2048)
#define P_MPREV ((float*)(F.ws + WS_MSC) + 4096)
#define P_RGA   ((float*)(F.ws + WS_RGA))
#define P_RGH   ((float*)(F.ws + WS_RGH))
#define P_RGC   ((float*)(F.ws + WS_RGC))
#define P_ROPE  ((float*)(F.ws + WS_ROPE))

__device__ __forceinline__ void tr_item(const float* W, int ldw, int srcc, const float* scale, bf16* WT, int K, int dst_row0, int k0, LAS float* scr, int lane) {
#pragma unroll 8
    for (int i = 0; i < 32; ++i) { const int kk = 2 * i + (lane >> 5); const float s = scale ? scale[k0 + kk] : 1.0f; scr[kk * 33 + (lane & 31)] = W[(size_t)(k0 + kk) * ldw + srcc + (lane & 31)] * s; }
    LDS_WAIT(); asm volatile("" ::: "memory");
    const int c = lane & 7;
#pragma unroll
    for (int j = 0; j < 4; ++j) { const int n = (lane >> 3) + 8 * j; const LAS float* s = scr + (8 * c) * 33 + n;
        v4u o; o.x = pk2(s[0 * 33], s[1 * 33]); o.y = pk2(s[2 * 33], s[3 * 33]); o.z = pk2(s[4 * 33], s[5 * 33]); o.w = pk2(s[6 * 33], s[7 * 33]);
        *(GAS v4u*)(WT + (size_t)(dst_row0 + n) * K + k0 + 8 * c) = o; }
    LDS_WAIT(); asm volatile("" ::: "memory");
}
__device__ __forceinline__ int tr_srcc(int mode, int nb) {
    if (mode == 1) { const int j = nb >> 3, r8 = nb & 7; return r8 < 4 ? 128 * j + 32 * r8 : 3072 + 128 * j + 32 * (r8 - 4); }
    if (mode == 2) { const int pn = nb >> 3, bj = (nb >> 2) & 1, wc = nb & 3; return 64 * (4 * pn + wc) + 32 * bj; }
    return 32 * nb;
}
__device__ __forceinline__ bool tr_matrix(int& r, const float* W, int ldw, int K, int Nd, int mode, const float* scale, bf16* WT, LAS float* scr, int lane) {
    const int nblk = Nd / 32, items = (K / 64) * nblk;
    if (r >= items) { r -= items; return false; }
    const int kb = r / nblk, nb = r % nblk;
    tr_item(W, ldw, tr_srcc(mode, nb), scale, WT, K, 32 * nb, 64 * kb, scr, lane);
    return true;
}
__device__ __forceinline__ float wave_sum(float v) {
#pragma unroll
    for (int o = 1; o < 64; o <<= 1) v += __shfl_xor(v, o);
    return v;
}
__device__ __forceinline__ void p0_prologue(Frame& F) { const float* x = karg(F, 0); const float* p = karg(F, 1); const int* pos = (const int*)karg(F, 2); const float* norm_mix = karg(F, 3); const float* norm_ffn = karg(F, 4); const float* norm_ple = karg(F, 5); const float* hy_w_in = karg(F, 6); const float* hy_b_in = karg(F, 7); const float* rg_wa = karg(F, 10); const float* rg_wx = karg(F, 12); const float* hy_w_out = karg(F, 18); const float* at_w_qkv = karg(F, 19); const float* at_w_out = karg(F, 23); const float* ff_w_up = karg(F, 24); const float* ff_w_down = karg(F, 27); const float* ple_w_gate = karg(F, 28); const float* ple_w_proj = karg(F, 29);
    LAS float* scr = (LAS float*)(F.lds + F.wave * 8448);
    const int gw = F.vcu * NWAVES + F.wave, NGW = F.G * NWAVES;
    unsigned char* ws = F.ws;
    LAS float* GW = (LAS float*)(F.lds + 73728);
    for (int i = F.tid; i < 8192; i += NWAVES * 64) { const int k = i >> 3, g = i & 7; GW[i] = hy_w_in[(size_t)k * HYIN + 3072 + g] * norm_mix[k]; }
    constexpr int NITEMS = 1536 + 512 + 2 * 3072 + 2 * 1536 + 2 * 512 + 2 * 128 + 768 + 512 + 32;
    for (int it = gw; it < NITEMS; it += NGW) {
        int r = it;
        if (tr_matrix(r, hy_w_in, HYIN, 1024, 3072, 0, norm_mix, (bf16*)(ws + WS_WIN), scr, F.lane)) continue;
        if (tr_matrix(r, hy_w_out, 1024, 1024, 1024, 0, nullptr, (bf16*)(ws + WS_WOUT0), scr, F.lane)) continue;
        if (tr_matrix(r, ff_w_up, 6144, 1024, 6144, 1, norm_ffn, (bf16*)(ws + WS_WUP0), scr, F.lane)) continue;
        if (tr_matrix(r, ff_w_up + (size_t)1024 * 6144, 6144, 1024, 6144, 1, norm_ffn + 1024, (bf16*)(ws + WS_WUP1), scr, F.lane)) continue;
        if (tr_matrix(r, ff_w_down, 1024, 3072, 1024, 0, nullptr, (bf16*)(ws + WS_WDN0), scr, F.lane)) continue;
        if (tr_matrix(r, ff_w_down + (size_t)3072 * 1024, 1024, 3072, 1024, 0, nullptr, (bf16*)(ws + WS_WDN1), scr, F.lane)) continue;
        if (tr_matrix(r, ple_w_gate, 1024, 1024, 1024, 0, norm_ple, (bf16*)(ws + WS_WGT0), scr, F.lane)) continue;
        if (tr_matrix(r, ple_w_gate + (size_t)1024 * 1024, 1024, 1024, 1024, 0, norm_ple + 1024, (bf16*)(ws + WS_WGT1), scr, F.lane)) continue;
        if (tr_matrix(r, ple_w_proj, 1024, 256, 1024, 0, nullptr, (bf16*)(ws + WS_WPJ0), scr, F.lane)) continue;
        if (tr_matrix(r, ple_w_proj + (size_t)256 * 1024, 1024, 256, 1024, 0, nullptr, (bf16*)(ws + WS_WPJ1), scr, F.lane)) continue;
        if (tr_matrix(r, at_w_qkv, 1536, 1024, 1536, 2, norm_mix + 1024, (bf16*)(ws + WS_WQKV), scr, F.lane)) continue;
        if (tr_matrix(r, at_w_out, 1024, 1024, 1024, 0, nullptr, (bf16*)(ws + WS_WO1), scr, F.lane)) continue;
        { const int blk = r >> 1, nb = r & 1, g = blk >> 3, n = blk & 7;
          tr_item((g ? rg_wx : rg_wa) + (size_t)n * 4096, 64, 32 * nb, nullptr, P_RGW + (size_t)blk * 4096, 64, 32 * nb, 0, scr, F.lane); }
    }
    __syncthreads();
    bf16* xb = (bf16*)(ws + WS_XBA); float* ssA = (float*)(ws + WS_SSA);
    for (int row = gw; row < T; row += NGW) {
        const GAS f32x4* xr = (const GAS f32x4*)(x + (size_t)row * DM) + F.lane;
        f32x4 v[4]; float s = 0.f; float d[8];
#pragma unroll
        for (int g = 0; g < 8; ++g) d[g] = 0.f;
#pragma unroll
        for (int j = 0; j < 4; ++j) { v[j] = xr[64 * j]; s += (v[j].x * v[j].x + v[j].y * v[j].y) + (v[j].z * v[j].z + v[j].w * v[j].w);
#pragma unroll
            for (int e = 0; e < 4; ++e) { const int k = 4 * (F.lane + 64 * j) + e; const f32x4 w0 = *(const LAS f32x4*)(GW + k * 8), w1 = *(const LAS f32x4*)(GW + k * 8 + 4);
                const float xv = v[j][e];
                d[0] += xv * w0[0]; d[1] += xv * w0[1]; d[2] += xv * w0[2]; d[3] += xv * w0[3]; d[4] += xv * w1[0]; d[5] += xv * w1[1]; d[6] += xv * w1[2]; d[7] += xv * w1[3]; } }
        s = wave_sum(s);
#pragma unroll
        for (int g = 0; g < 8; ++g) d[g] = wave_sum(d[g]);
        const float rstd = rsqrtf(s * (1.0f / DM) + 1e-6f);
        if (F.lane < 16) ssA[(size_t)row * 16 + F.lane] = (F.lane == 0) ? s : 0.f;
        if (F.lane < 8) { float dv = d[0];
#pragma unroll
            for (int g = 1; g < 8; ++g) dv = (F.lane == g) ? d[g] : dv;
            P_GATES[(size_t)row * 8 + F.lane] = rstd * dv + hy_b_in[3072 + F.lane]; }
        GAS unsigned long long* o8 = (GAS unsigned long long*)(xb + (size_t)row * DM) + F.lane;
#pragma unroll
        for (int j = 0; j < 4; ++j) o8[64 * j] = (unsigned long long)pk2(v[j].x, v[j].y) | ((unsigned long long)pk2(v[j].z, v[j].w) << 32);
#if DBG_STOP < 3
        { GAS f32x4* oo = (GAS f32x4*)(F.out + (size_t)row * DM) + F.lane;
#pragma unroll
          for (int j = 0; j < 4; ++j) oo[64 * j] = v[j]; }
#endif
    }
    { const GAS f32x4* ps = (const GAS f32x4*)p; GAS v4u* pd = (GAS v4u*)(ws + WS_PB); const int n8 = 2 * T * 256 / 8;
      for (int i = gw * 64 + F.lane; i < n8; i += NGW * 64) { const f32x4 a = ps[2 * i], b = ps[2 * i + 1]; v4u o; o.x = pk2(a.x, a.y); o.y = pk2(a.z, a.w); o.z = pk2(b.x, b.y); o.w = pk2(b.z, b.w); pd[i] = o; } }
    for (int i = (F.vcu * NWAVES * 64) + F.tid; i < T * 32; i += F.G * NWAVES * 64) { const int t = i >> 5, f = i & 31;
        const double inv = exp2(-(double)f * (13.287712379549449 / 32.0));
        const double ang = (double)pos[t] * inv; const double k = rint(ang * 0.15915494309189535); const float r = (float)(ang - k * 6.283185307179586);
        P_ROPE[(size_t)t * 64 + f] = cosf(r); P_ROPE[(size_t)t * 64 + 32 + f] = sinf(r); }
}

__device__ __forceinline__ void ld8f(const bf16* p, float (&o)[8]) { const v4u v = *(const v4u*)p; o[0] = bflo(v.x); o[1] = bfhi(v.x); o[2] = bflo(v.y); o[3] = bfhi(v.y); o[4] = bflo(v.z); o[5] = bfhi(v.z); o[6] = bflo(v.w); o[7] = bfhi(v.w); }
__device__ __forceinline__ void conv4x8(const bf16* zp, int s, const float* cw, int ldw, const float* cb, float (&out)[8]) {
    { const f32x4 b0 = *(const f32x4*)cb, b1 = *(const f32x4*)(cb + 4); out[0] = b0[0]; out[1] = b0[1]; out[2] = b0[2]; out[3] = b0[3]; out[4] = b1[0]; out[5] = b1[1]; out[6] = b1[2]; out[7] = b1[3]; }
#pragma unroll
    for (int j = 0; j < 4; ++j) if (s - 3 + j >= 0) { float xv[8]; ld8f(zp + (ptrdiff_t)(j - 3) * ZW, xv);
        const f32x4 w0 = *(const f32x4*)(cw + j * ldw), w1 = *(const f32x4*)(cw + j * ldw + 4);
        out[0] += w0[0] * xv[0]; out[1] += w0[1] * xv[1]; out[2] += w0[2] * xv[2]; out[3] += w0[3] * xv[3]; out[4] += w1[0] * xv[4]; out[5] += w1[1] * xv[5]; out[6] += w1[2] * xv[6]; out[7] += w1[3] * xv[7]; }
}
__device__ __forceinline__ v4u pk8f(const float (&a)[8]) { v4u o; o.x = pk2(a[0], a[1]); o.y = pk2(a[2], a[3]); o.z = pk2(a[4], a[5]); o.w = pk2(a[6], a[7]); return o; }
__device__ __forceinline__ float logsig(float f) { return fminf(f, 0.f) - log1pf(expf(-fabsf(f))); }

__device__ __forceinline__ void mlA_unit(Frame& F, int u) { const float* ml_cw = karg(F, 15); const float* ml_cb = karg(F, 16);
    const int c = u & 63, bh = u >> 6, h = bh & 3, b = bh >> 2, tok0 = b * SEQ + c * 64;
    ldsp L = F.lds;
    LAS unsigned short* KT = (LAS unsigned short*)L;
    LAS unsigned short* VT = (LAS unsigned short*)(L + 18432);
    LAS float* WL = (LAS float*)(L + 39168);
    if (F.wave == 0) {
        const int l = F.lane; const float ip = P_GATES[(size_t)(tok0 + l) * 8 + h], fp = P_GATES[(size_t)(tok0 + l) * 8 + 4 + h];
        float bc = logsig(fp);
#pragma unroll
        for (int o = 1; o < 64; o <<= 1) { const float v = __shfl_up(bc, o); if (l >= o) bc += v; }
        const float bl = __shfl(bc, 63); const float g = bl - bc + ip; float mx = g;
#pragma unroll
        for (int o = 32; o > 0; o >>= 1) mx = fmaxf(mx, __shfl_xor(mx, o));
        WL[l] = expf(g - mx);
        if (l == 0) { P_MLOC[u] = mx; P_BLAST[u] = bl; }
    }
    for (int i = F.tid; i < 16 * 64; i += NWAVES * 64) { const int r = i >> 6, l = i & 63; VT[(128 + r) * 72 + l] = (r == 0) ? (unsigned short)0x3F80 : (unsigned short)0; }
    __syncthreads();
    { const int ch = F.tid & 15;
#pragma unroll
      for (int it = 0; it < 2; ++it) { const int l = (F.tid >> 4) + 32 * it, tok = tok0 + l, s = c * 64 + l;
        float kc[8]; conv4x8(P_Z + (size_t)tok * ZW + 1536 + 128 * h + 8 * ch, s, ml_cw + 512 + 128 * h + 8 * ch, 1024, ml_cb + 512 + 128 * h + 8 * ch, kc);
        const float wl = WL[l] * 0.08838834764831845f;
#pragma unroll
        for (int i = 0; i < 8; ++i) KT[(8 * ch + i) * 72 + l] = f2bf1(fsilu(kc[i]) * wl);
        const v4u vv = *(const v4u*)(P_Z + (size_t)tok * ZW + 2048 + 128 * h + 8 * ch);
        VT[(8 * ch + 0) * 72 + l] = (unsigned short)(vv.x & 0xffffu); VT[(8 * ch + 1) * 72 + l] = (unsigned short)(vv.x >> 16);
        VT[(8 * ch + 2) * 72 + l] = (unsigned short)(vv.y & 0xffffu); VT[(8 * ch + 3) * 72 + l] = (unsigned short)(vv.y >> 16);
        VT[(8 * ch + 4) * 72 + l] = (unsigned short)(vv.z & 0xffffu); VT[(8 * ch + 5) * 72 + l] = (unsigned short)(vv.z >> 16);
        VT[(8 * ch + 6) * 72 + l] = (unsigned short)(vv.w & 0xffffu); VT[(8 * ch + 7) * 72 + l] = (unsigned short)(vv.w >> 16); } }
    __syncthreads();
    { const int fr = F.lane & 15, fq = F.lane >> 4, w = F.wave;
      bf16x8 a[2];
#pragma unroll
      for (int ks = 0; ks < 2; ++ks) a[ks] = *(const LAS bf16x8*)(L + (16 * w + fr) * 144 + (32 * ks + 8 * fq) * 2);
#pragma unroll
      for (int nt = 0; nt < 9; ++nt) { f32x4 acc = {0.f, 0.f, 0.f, 0.f};
#pragma unroll
        for (int ks = 0; ks < 2; ++ks) { const bf16x8 bb = *(const LAS bf16x8*)(L + 18432 + (16 * nt + fr) * 144 + (32 * ks + 8 * fq) * 2); acc = MFMA16(a[ks], bb, acc); }
        if (nt < 8) { v2u o; o.x = pk2(acc[0], acc[1]); o.y = pk2(acc[2], acc[3]); *(v2u*)(P_CST + (size_t)u * 16384 + (16 * nt + fr) * 128 + 16 * w + 4 * fq) = o; }
        else if (fr == 0) { *(f32x4*)(P_NLOC + (size_t)u * 128 + 16 * w + 4 * fq) = acc; } } }
    __syncthreads();
}

__device__ __forceinline__ void mlC_unit(Frame& F, int u) { const float* ml_cw = karg(F, 15); const float* ml_cb = karg(F, 16); const float* ml_norm = karg(F, 17);
    const int c = u & 63, bh = u >> 6, h = bh & 3, b = bh >> 2, tok0 = b * SEQ + c * 64;
    ldsp L = F.lds;
    constexpr int QI = 0, KI = 17408, VTO = 34816, SQO = 53248, HFO = 62464, ARR = 96256;
    LAS unsigned short* VT = (LAS unsigned short*)(L + VTO); LAS unsigned short* SQ = (LAS unsigned short*)(L + SQO); LAS float* HF = (LAS float*)(L + HFO);
    LAS float* DV = (LAS float*)(L + ARR); LAS float* MU = DV + 64; LAS float* AI = DV + 128; LAS float* EM = DV + 192; LAS float* DENP = DV + 256  ; LAS float* DNI = DV + 384; LAS float* NP = DV + 448  ;
    if (F.wave == 0) {
        const int l = F.lane; const float ip = P_GATES[(size_t)(tok0 + l) * 8 + h], fp = P_GATES[(size_t)(tok0 + l) * 8 + 4 + h];
        float bc = logsig(fp);
#pragma unroll
        for (int o = 1; o < 64; o <<= 1) { const float v = __shfl_up(bc, o); if (l >= o) bc += v; }
        const float mp = P_MPREV[u]; const float dv = ip - bc; float cm = dv;
#pragma unroll
        for (int o = 1; o < 64; o <<= 1) { const float v = __shfl_up(cm, o); if (l >= o) cm = fmaxf(cm, v); }
        const float bm = bc + mp, mt = fmaxf(bm, bc + cm);
        AI[l] = expf(bm - mt); MU[l] = mt - bc; DV[l] = dv; EM[l] = expf(-mt);
    }
    if (F.tid >= 128 && F.tid < 256) NP[F.tid - 128] = P_NPREV[(size_t)u * 128 + F.tid - 128];
    { const int ch = F.tid & 15;
#pragma unroll
      for (int it = 0; it < 2; ++it) { const int l = (F.tid >> 4) + 32 * it, tok = tok0 + l, s = c * 64 + l;
        float qc[8], kc[8];
        conv4x8(P_Z + (size_t)tok * ZW + 1024 + 128 * h + 8 * ch, s, ml_cw + 128 * h + 8 * ch, 1024, ml_cb + 128 * h + 8 * ch, qc);
        conv4x8(P_Z + (size_t)tok * ZW + 1536 + 128 * h + 8 * ch, s, ml_cw + 512 + 128 * h + 8 * ch, 1024, ml_cb + 512 + 128 * h + 8 * ch, kc);
#pragma unroll
        for (int i = 0; i < 8; ++i) { qc[i] = fsilu(qc[i]); kc[i] = fsilu(kc[i]) * 0.08838834764831845f; }
        *(LAS v4u*)(L + QI + l * 272 + 16 * ch) = pk8f(qc); *(LAS v4u*)(L + KI + l * 272 + 16 * ch) = pk8f(kc);
        const v4u vv = *(const v4u*)(P_Z + (size_t)tok * ZW + 2048 + 128 * h + 8 * ch);
        VT[(8 * ch + 0) * 72 + l] = (unsigned short)(vv.x & 0xffffu); VT[(8 * ch + 1) * 72 + l] = (unsigned short)(vv.x >> 16);
        VT[(8 * ch + 2) * 72 + l] = (unsigned short)(vv.y & 0xffffu); VT[(8 * ch + 3) * 72 + l] = (unsigned short)(vv.y >> 16);
        VT[(8 * ch + 4) * 72 + l] = (unsigned short)(vv.z & 0xffffu); VT[(8 * ch + 5) * 72 + l] = (unsigned short)(vv.z >> 16);
        VT[(8 * ch + 6) * 72 + l] = (unsigned short)(vv.w & 0xffffu); VT[(8 * ch + 7) * 72 + l] = (unsigned short)(vv.w >> 16); } }
    __syncthreads();
    const int fr = F.lane & 15, fq = F.lane >> 4, w = F.wave, tt = w >> 1;
    {
      float rs[4] = {0.f, 0.f, 0.f, 0.f};
#pragma unroll
      for (int si = 0; si < 2; ++si) { const int st = 2 * (w & 1) + si; f32x4 acc = {0.f, 0.f, 0.f, 0.f};
#pragma unroll
        for (int ks = 0; ks < 4; ++ks) { const bf16x8 a = *(const LAS bf16x8*)(L + QI + (16 * tt + fr) * 272 + (32 * ks + 8 * fq) * 2), bb = *(const LAS bf16x8*)(L + KI + (16 * st + fr) * 272 + (32 * ks + 8 * fq) * 2); acc = MFMA16(a, bb, acc); }
        const int s = 16 * st + fr; const float dvs = DV[s];
#pragma unroll
        for (int r = 0; r < 4; ++r) { const int t = 16 * tt + 4 * fq + r; const float wgt = (s <= t) ? __expf(dvs - MU[t]) : 0.f; const float v = acc[r] * wgt; rs[r] += v; SQ[t * 72 + s] = f2bf1(v); } }
#pragma unroll
      for (int r = 0; r < 4; ++r) { float v = rs[r]; v += __shfl_xor(v, 1); v += __shfl_xor(v, 2); v += __shfl_xor(v, 4); v += __shfl_xor(v, 8); if (fr == 0) DENP[(w & 1) * 64 + 16 * tt + 4 * fq + r] = v; }
      const int t = F.tid >> 3, part = F.tid & 7; float acc = 0.f;
      { const v4u v0 = *(const LAS v4u*)(L + QI + t * 272 + 32 * part), v1 = *(const LAS v4u*)(L + QI + t * 272 + 32 * part + 16);
        const float q0[8] = {bflo(v0.x), bfhi(v0.x), bflo(v0.y), bfhi(v0.y), bflo(v0.z), bfhi(v0.z), bflo(v0.w), bfhi(v0.w)};
        const float q1[8] = {bflo(v1.x), bfhi(v1.x), bflo(v1.y), bfhi(v1.y), bflo(v1.z), bfhi(v1.z), bflo(v1.w), bfhi(v1.w)};
#pragma unroll
        for (int i = 0; i < 8; ++i) acc += q0[i] * NP[16 * part + i] + q1[i] * NP[16 * part + 8 + i]; }
      acc += __shfl_xor(acc, 1); acc += __shfl_xor(acc, 2); acc += __shfl_xor(acc, 4);
      if (part == 0) DNI[t] = acc; }
    __syncthreads();
    {
#pragma unroll
      for (int ei = 0; ei < 4; ++ei) { const int et = 4 * (w & 1) + ei; f32x4 ai_ = {0.f, 0.f, 0.f, 0.f}, ax = {0.f, 0.f, 0.f, 0.f};
#pragma unroll
        for (int ks = 0; ks < 2; ++ks) { const bf16x8 a = *(const LAS bf16x8*)(L + SQO + (16 * tt + fr) * 144 + (32 * ks + 8 * fq) * 2), bb = *(const LAS bf16x8*)(L + VTO + (16 * et + fr) * 144 + (32 * ks + 8 * fq) * 2); ai_ = MFMA16(a, bb, ai_); }
#pragma unroll
        for (int ks = 0; ks < 4; ++ks) { const bf16x8 a = *(const LAS bf16x8*)(L + QI + (16 * tt + fr) * 272 + (32 * ks + 8 * fq) * 2), bb = *(const bf16x8*)(P_CST + (size_t)u * 16384 + (16 * et + fr) * 128 + 32 * ks + 8 * fq); ax = MFMA16(a, bb, ax); }
#pragma unroll
        for (int r = 0; r < 4; ++r) { const int t = 16 * tt + 4 * fq + r; const float aint = AI[t]; const float den = DENP[t] + DENP[64 + t] + aint * DNI[t]; const float dd = fmaxf(fabsf(den), EM[t]);
            HF[t * 132 + 16 * et + fr] = (ai_[r] + aint * ax[r]) / dd; } } }
    __syncthreads();
    {
      const int t = F.tid >> 3, part = F.tid & 7; f32x4 hv[4]; float ss = 0.f;
#pragma unroll
      for (int i = 0; i < 4; ++i) { hv[i] = *(const LAS f32x4*)(HF + t * 132 + 16 * part + 4 * i); ss += pg8::dot4(hv[i]); }
      ss += __shfl_xor(ss, 1); ss += __shfl_xor(ss, 2); ss += __shfl_xor(ss, 4);
      const float rstd = rsqrtf(ss * (1.0f / 128.0f) + 1e-6f);
      const bf16* op = P_Z + (size_t)(tok0 + t) * ZW + 2560 + 128 * h + 16 * part; float o0[8], o1[8]; ld8f(op, o0); ld8f(op + 8, o1);
      const float* gp = ml_norm + 128 * h + 16 * part; float y0[8], y1[8];
#pragma unroll
      for (int i = 0; i < 8; ++i) { y0[i] = hv[i >> 2][i & 3] * rstd * gp[i] * fsigmoid(o0[i]); y1[i] = hv[2 + (i >> 2)][i & 3] * rstd * gp[8 + i] * fsigmoid(o1[i]); }
      bf16* yp = P_YBUF + (size_t)(tok0 + t) * DM + 512 + 128 * h + 16 * part; *(v4u*)yp = pk8f(y0); *(v4u*)(yp + 8) = pk8f(y1); }
    __syncthreads();
}

template <bool FINAL> __device__ __forceinline__ void rg_unit(Frame& F, int u) { const float* rg_cw = karg(F, 8); const float* rg_cb = karg(F, 9); const float* rg_ba = karg(F, 11); const float* rg_bx = karg(F, 13); const float* rg_lam = karg(F, 14);
    const int n = u & 7, bc = u >> 3, c = bc & 63, b = bc >> 6, tok0 = b * SEQ + c * 64;
    ldsp L = F.lds;
    constexpr int XC = 0, XFO = 9216, AAO = 25856, MMO = 42496, IXO = 59136, SPO = 75776, SHO = 77824;
    LAS float* XF = (LAS float*)(L + XFO); LAS float* AA = (LAS float*)(L + AAO); LAS float* MM = (LAS float*)(L + MMO); LAS float* IX = (LAS float*)(L + IXO); LAS float* SP = (LAS float*)(L + SPO); LAS float* SH = (LAS float*)(L + SHO);
    { const int t = F.tid >> 3, chk = F.tid & 7; float xc[8];
      conv4x8(P_Z + (size_t)(tok0 + t) * ZW + 64 * n + 8 * chk, c * 64 + t, rg_cw + 64 * n + 8 * chk, 512, rg_cb + 64 * n + 8 * chk, xc);
      *(LAS v4u*)(L + XC + t * 144 + 16 * chk) = pk8f(xc);
#pragma unroll
      for (int i = 0; i < 8; ++i) XF[t * 65 + 8 * chk + i] = xc[i]; }
    __syncthreads();
    { const int fr = F.lane & 15, fq = F.lane >> 4, gate = F.wave >> 2, tt = F.wave & 3;
      const bf16* Wg = P_RGW + (size_t)(gate * 8 + n) * 4096;
      bf16x8 a[2];
#pragma unroll
      for (int ks = 0; ks < 2; ++ks) a[ks] = *(const LAS bf16x8*)(L + XC + (16 * tt + fr) * 144 + (32 * ks + 8 * fq) * 2);
#pragma unroll
      for (int jt = 0; jt < 4; ++jt) { f32x4 acc = {0.f, 0.f, 0.f, 0.f};
#pragma unroll
        for (int ks = 0; ks < 2; ++ks) { const bf16x8 bb = *(const bf16x8*)(Wg + (16 * jt + fr) * 64 + 32 * ks + 8 * fq); acc = MFMA16(a[ks], bb, acc); }
        const int j = 16 * jt + fr, chn = 64 * n + j;
        if (gate == 0) { const float bias = rg_ba[chn], sp8 = 8.0f * log1pf(expf(-rg_lam[chn]));
#pragma unroll
            for (int r = 0; r < 4; ++r) { const int t = 16 * tt + 4 * fq + r; const float sg = 1.0f / (1.0f + expf(-(acc[r] + bias))); const float la = -sg * sp8; AA[t * 65 + j] = expf(la); MM[t * 65 + j] = sqrtf(-expm1f(2.0f * la)); } }
        else { const float bias = rg_bx[chn];
#pragma unroll
            for (int r = 0; r < 4; ++r) { const int t = 16 * tt + 4 * fq + r; const float sg = 1.0f / (1.0f + expf(-(acc[r] + bias))); IX[t * 65 + j] = sg * XF[t * 65 + j]; } } } }
    __syncthreads();
    const int ch = F.tid & 63, sub = F.wave;
    { float P = 1.f, hl = 0.f;
#pragma unroll
      for (int k = 0; k < 8; ++k) { const int t = 8 * sub + k; const float a = AA[t * 65 + ch], uu = MM[t * 65 + ch] * IX[t * 65 + ch]; hl = a * hl + uu; P *= a; }
      SP[sub * 64 + ch] = P; SH[sub * 64 + ch] = hl; }
    __syncthreads();
    if (!FINAL) {
        if (sub == 0) { float P = 1.f, hh = 0.f;
#pragma unroll
            for (int s = 0; s < 8; ++s) { const float ps = SP[s * 64 + ch]; hh = ps * hh + SH[s * 64 + ch]; P *= ps; }
            P_RGA[(size_t)bc * 512 + 64 * n + ch] = P; P_RGH[(size_t)bc * 512 + 64 * n + ch] = hh; }
    } else {
        float hin = P_RGC[(size_t)bc * 512 + 64 * n + ch];
#pragma unroll
        for (int s = 0; s < 8; ++s) if (s < sub) hin = SP[s * 64 + ch] * hin + SH[s * 64 + ch];
#pragma unroll
        for (int k = 0; k < 8; ++k) { const int t = 8 * sub + k; const float a = AA[t * 65 + ch], uu = MM[t * 65 + ch] * IX[t * 65 + ch]; hin = a * hin + uu;
            const float gr = bf2f(P_Z[(size_t)(tok0 + t) * ZW + 512 + 64 * n + ch]);
            P_YBUF[(size_t)(tok0 + t) * DM + 64 * n + ch] = f2bf1(hin * gelu_tanh(gr)); }
    }
    __syncthreads();
}

__device__ __forceinline__ void mixB_unit(Frame& F, int unit) {
    const int bh = unit >> 3, sl = unit & 7; ldsp L = F.lds;
    LAS float* AP = (LAS float*)L; LAS float* AL = AP + 64;
    if (F.wave == 0) { float mst = -INFINITY;
        for (int c = 0; c < 64; ++c) { const float ml = P_MLOC[bh * 64 + c], bl = P_BLAST[bh * 64 + c]; const float mn = fmaxf(bl + mst, ml);
            if (F.lane == 0) { AP[c] = expf(bl + mst - mn); AL[c] = expf(ml - mn); if (sl == 0) P_MPREV[bh * 64 + c] = mst; }
            mst = mn; } }
    __syncthreads();
    { float st[4] = {0.f, 0.f, 0.f, 0.f}; bf16* base = P_CST + (size_t)bh * 64 * 16384 + sl * 2048 + F.tid * 4;
      for (int c0 = 0; c0 < 64; c0 += 8) { v2u cl[8];
#pragma unroll
        for (int k = 0; k < 8; ++k) cl[k] = *(const v2u*)(base + (size_t)(c0 + k) * 16384);
#pragma unroll
        for (int k = 0; k < 8; ++k) { v2u o; o.x = pk2(st[0], st[1]); o.y = pk2(st[2], st[3]); *(v2u*)(base + (size_t)(c0 + k) * 16384) = o;
            const float ap = AP[c0 + k], al = AL[c0 + k];
            st[0] = ap * st[0] + al * bflo(cl[k].x); st[1] = ap * st[1] + al * bfhi(cl[k].x); st[2] = ap * st[2] + al * bflo(cl[k].y); st[3] = ap * st[3] + al * bfhi(cl[k].y); } } }
    if (sl == 0 && F.tid < 128) { float ns = 0.f;
        for (int c = 0; c < 64; ++c) { const size_t o = (size_t)(bh * 64 + c) * 128 + F.tid; const float nl = P_NLOC[o]; P_NPREV[o] = ns; ns = AP[c] * ns + AL[c] * nl; } }
    if (F.tid < 16) { const int idx = unit * 16 + F.tid, b = idx >> 9, chn = idx & 511; float cr = 0.f;
        for (int c = 0; c < 64; ++c) { const size_t o = (size_t)(b * 64 + c) * 512 + chn; P_RGC[o] = cr; cr = P_RGA[o] * cr + P_RGH[o]; } }
    __syncthreads();
}

__device__ __forceinline__ void attn_unit(Frame& F, int u, const bf16* Qb, const bf16* Kb, const bf16* Vb, bf16* Ob) { const float* at_sinks = karg(F, 22);
    const int qb = u & 31, kvh = (u >> 5) & 3, b = u >> 7; const int row0 = b * SEQ + 128 * qb;
    ldsp L = F.lds;
    constexpr int KI = 0, VTO = 36864;
    LAS unsigned short* VT = (LAS unsigned short*)(L + VTO);
#pragma unroll
    for (int it = 0; it < 4; ++it) { const int idx = F.tid + 512 * it, kr = idx >> 3, chk = idx & 7; const bool ok = (qb > 0) || (kr >= 128);
        v4u kv = {0u, 0u, 0u, 0u}, vv = {0u, 0u, 0u, 0u};
        if (ok) { const size_t o = (size_t)(row0 - 128 + kr) * 256 + 64 * kvh + 8 * chk; kv = *(const v4u*)(Kb + o); vv = *(const v4u*)(Vb + o); }
        *(LAS v4u*)(L + KI + kr * 144 + 16 * chk) = kv;
        VT[(8 * chk + 0) * 260 + kr] = (unsigned short)(vv.x & 0xffffu); VT[(8 * chk + 1) * 260 + kr] = (unsigned short)(vv.x >> 16);
        VT[(8 * chk + 2) * 260 + kr] = (unsigned short)(vv.y & 0xffffu); VT[(8 * chk + 3) * 260 + kr] = (unsigned short)(vv.y >> 16);
        VT[(8 * chk + 4) * 260 + kr] = (unsigned short)(vv.z & 0xffffu); VT[(8 * chk + 5) * 260 + kr] = (unsigned short)(vv.z >> 16);
        VT[(8 * chk + 6) * 260 + kr] = (unsigned short)(vv.w & 0xffffu); VT[(8 * chk + 7) * 260 + kr] = (unsigned short)(vv.w >> 16); }
    __syncthreads();
    const int r = F.lane & 31, hh = F.lane >> 5, w = F.wave, head = 4 * kvh + (w >> 1);
    const float sink = at_sinks[head];
#pragma unroll 1
    for (int qt = 0; qt < 2; ++qt) {
        const int q0 = 64 * (w & 1) + 32 * qt, kt0 = q0 >> 5; const size_t qrow = (size_t)(row0 + q0 + r);
        bf16x8 qf[4];
#pragma unroll
        for (int ks = 0; ks < 4; ++ks) qf[ks] = *(const bf16x8*)(Qb + qrow * 1024 + 64 * head + 16 * ks + 8 * hh);
        f32x16 S[5];
#pragma unroll
        for (int i = 0; i < 5; ++i) {
#pragma unroll
            for (int e = 0; e < 16; ++e) S[i][e] = 0.f;
#pragma unroll
            for (int ks = 0; ks < 4; ++ks) { const bf16x8 kf = *(const LAS bf16x8*)(L + KI + (32 * (kt0 + i) + r) * 144 + (16 * ks + 8 * hh) * 2); S[i] = MFMA32(kf, qf[ks], S[i]); } }
        float mx = sink;
#pragma unroll
        for (int i = 0; i < 5; ++i)
#pragma unroll
            for (int e = 0; e < 16; ++e) { const int cr = (e & 3) + 8 * (e >> 2) + 4 * hh; bool ok = true;
                if (i == 0) ok = cr > r; if (i == 4) ok = cr <= r;
                if (qb == 0) ok = ok && (32 * (kt0 + i) + cr >= 128);
                const float v = ok ? S[i][e] : -INFINITY; S[i][e] = v; mx = fmaxf(mx, v); }
        mx = fmaxf(mx, __shfl_xor(mx, 32));
        float sum = 0.f;
#pragma unroll
        for (int i = 0; i < 5; ++i)
#pragma unroll
            for (int e = 0; e < 16; ++e) { const float p = __expf(S[i][e] - mx); S[i][e] = p; sum += p; }
        sum += __shfl_xor(sum, 32); sum += __expf(sink - mx);
        const float inv = 1.0f / sum;
        f32x16 O[2];
#pragma unroll
        for (int e = 0; e < 16; ++e) { O[0][e] = 0.f; O[1][e] = 0.f; }
#pragma unroll
        for (int i = 0; i < 5; ++i)
#pragma unroll
            for (int s = 0; s < 2; ++s) {
                v4u pw; pw.x = pk2(S[i][8 * s + 0], S[i][8 * s + 1]); pw.y = pk2(S[i][8 * s + 2], S[i][8 * s + 3]); pw.z = pk2(S[i][8 * s + 4], S[i][8 * s + 5]); pw.w = pk2(S[i][8 * s + 6], S[i][8 * s + 7]);
                const bf16x8 pf = __builtin_bit_cast(bf16x8, pw);
#pragma unroll
                for (int dt = 0; dt < 2; ++dt) { const int ko = (32 * dt + r) * 520 + (32 * (kt0 + i) + 16 * s + 4 * hh) * 2;
                    const s16x4 lo = *(const LAS s16x4*)(L + VTO + ko), hi = *(const LAS s16x4*)(L + VTO + ko + 16);
                    const bf16x8 vf = __builtin_shufflevector(lo, hi, 0, 1, 2, 3, 4, 5, 6, 7);
                    O[dt] = MFMA32(vf, pf, O[dt]); } }
        bf16* op = Ob + qrow * 1024 + 64 * head + 4 * hh;
#pragma unroll
        for (int dt = 0; dt < 2; ++dt)
#pragma unroll
            for (int g4 = 0; g4 < 4; ++g4) { v2u o; o.x = pk2(O[dt][4 * g4] * inv, O[dt][4 * g4 + 1] * inv); o.y = pk2(O[dt][4 * g4 + 2] * inv, O[dt][4 * g4 + 3] * inv); *(v2u*)(op + 32 * dt + 8 * g4) = o; }
    }
    __syncthreads();
}

__device__ __forceinline__ void fixup_phase(Frame& F, const float* cw, const float* cb, bf16* A2, const bf16* GH, const bf16* UH, const bf16* GT) {
    constexpr int TOTAL = (T / 64) * 2 * 384;
    for (int idx = F.vcu * NWAVES * 64 + F.tid; idx < TOTAL; idx += F.G * NWAVES * 64) {
        const int chk = idx % 384, rg = idx / 384, rr = rg & 1, grp = rg >> 1, ch0 = 8 * chk; const bool first = (grp & 63) == 0;
        float g0[8], u0[8], p1[8], p2[8];
        ld8f(GH + ((size_t)grp * 2 + rr) * 3072 + ch0, g0); ld8f(UH + ((size_t)grp * 2 + rr) * 3072 + ch0, u0);
#pragma unroll
        for (int i = 0; i < 8; ++i) { p1[i] = 0.f; p2[i] = 0.f; }
        if (rr == 1) { ld8f(GH + ((size_t)grp * 2) * 3072 + ch0, p1); if (!first) ld8f(GT + ((size_t)(grp - 1) * 2 + 1) * 3072 + ch0, p2); }
        else if (!first) { ld8f(GT + ((size_t)(grp - 1) * 2 + 1) * 3072 + ch0, p1); ld8f(GT + ((size_t)(grp - 1) * 2) * 3072 + ch0, p2); }
        float o[8];
#pragma unroll
        for (int i = 0; i < 8; ++i) { const float y = cw[ch0 + i] * p2[i] + cw[3072 + ch0 + i] * p1[i] + cw[6144 + ch0 + i] * g0[i] + cb[ch0 + i]; o[i] = gelu_tanh(y) * u0[i]; }
        *(v4u*)(A2 + ((size_t)grp * 64 + rr) * 3072 + ch0) = pk8f(o);
    }
}


#define GRID_BAR() xcd_barrier(bar)
template <int L> __device__ __forceinline__ bool layer_part(Frame& F, const XcdBarrier& bar) {
    constexpr int l = L;
    unsigned char* ws = F.ws; const int bx = (int)blockIdx.x;
    bf16* const XBA = (bf16*)(ws + WS_XBA); bf16* const XBB = (bf16*)(ws + WS_XBB);
    float* const SSA = (float*)(ws + WS_SSA); float* const SSB = (float*)(ws + WS_SSB);
    bf16* const PP = (bf16*)(ws + WS_CST); bf16* const A2 = (bf16*)(ws + WS_BIG);

        if (l == 1) {
            bf16* const Qb = (bf16*)(ws + WS_BIG); bf16* const Kb = (bf16*)(ws + WS_BIG + 64 * MiB); bf16* const Vb = (bf16*)(ws + WS_BIG + 80 * MiB); bf16* const Ob = (bf16*)(ws + WS_BIG + 96 * MiB);
            { pg8::Gemm g{XBB, (const bf16*)(ws + WS_WQKV), T, 1536, DM}; pg8::StaticOrder S; S.init(T, 1536, F.G, bx);
              pg8::EpiQkv E{SSB, P_ROPE, karg(F, 20), karg(F, 21), Qb, Kb, Vb};
              pg8::gemm_phase<pg8::EpiQkv, pg8::StaticOrder, true, true>(F.lds, g, S, E); }
            { pg8::Gemm g{(const bf16*)(ws + WS_PB) + (size_t)T * 256, (const bf16*)(ws + WS_WPJ1), T, DM, 256}; pg8::StaticOrder S; S.init(T, DM, F.G, bx);
              pg8::EpiZ E{PP, DM, nullptr, nullptr};
              pg8::gemm_phase<pg8::EpiZ, pg8::StaticOrder, true, true>(F.lds, g, S, E); }
            GRID_BAR();
            for (int u = F.vcu; u < 1024; u += F.G) attn_unit(F, u, Qb, Kb, Vb, Ob);
            GRID_BAR();
            { pg8::Gemm g{Ob, (const bf16*)(ws + WS_WO1), T, DM, DM}; pg8::StaticOrder S; S.init(T, DM, F.G, bx);
              pg8::EpiRes E{F.out, F.out, XBA, SSA};
              pg8::gemm_phase<pg8::EpiRes, pg8::StaticOrder, true, true>(F.lds, g, S, E); }
            GRID_BAR();
            if (DBG_STOP == 9) return true;
        } else {
            { pg8::Gemm g{P_YBUF, (const bf16*)(ws + WS_WOUT0), T, DM, DM}; pg8::StaticOrder S; S.init(T, DM, F.G, bx);
              pg8::EpiRes E{karg(F, 0), F.out, XBB, SSB};
              pg8::gemm_phase<pg8::EpiRes, pg8::StaticOrder, true, true>(F.lds, g, S, E); }
            { pg8::Gemm g{(const bf16*)(ws + WS_PB), (const bf16*)(ws + WS_WPJ0), T, DM, 256}; pg8::StaticOrder S; S.init(T, DM, F.G, bx);
              pg8::EpiZ E{PP, DM, nullptr, nullptr};
              pg8::gemm_phase<pg8::EpiZ, pg8::StaticOrder, true, true>(F.lds, g, S, E); }
            GRID_BAR();
            if (DBG_STOP == 3) return true;
        }
        const bf16* xin = l ? XBA : XBB; const float* ssin = l ? SSA : SSB; bf16* side = l ? XBB : XBA;
        bf16* const GH = side; bf16* const UH = side + (size_t)3 * MiB; bf16* const GT = side + (size_t)6 * MiB;
        const float* cw = karg(F, 25) + (size_t)l * 3 * 3072; const float* cb = karg(F, 26) + (size_t)l * 3072;
        { pg8::Gemm g{xin, (const bf16*)(ws + (l ? WS_WUP1 : WS_WUP0)), T, 2 * FFD, DM}; pg8::StaticOrder S; S.init(T, 2 * FFD, F.G, bx);
          pg8::EpiUp E{ssin, cw, cb, A2, GH, UH, GT};
          pg8::gemm_phase<pg8::EpiUp, pg8::StaticOrder, true, true>(F.lds, g, S, E); }
        GRID_BAR();
        fixup_phase(F, cw, cb, A2, GH, UH, GT);
        GRID_BAR();
        bf16* const xdn = l ? XBB : XBA; float* const ssdn = l ? SSB : SSA;
        { pg8::Gemm g{A2, (const bf16*)(ws + (l ? WS_WDN1 : WS_WDN0)), T, DM, FFD}; pg8::StaticOrder S; S.init(T, DM, F.G, bx);
          pg8::EpiRes E{F.out, F.out, xdn, ssdn};
          pg8::gemm_phase<pg8::EpiRes, pg8::StaticOrder, true, true>(F.lds, g, S, E); }
        GRID_BAR();
        if ((l == 0 && DBG_STOP == 5) || (l == 1 && DBG_STOP == 11)) return true;
        { pg8::Gemm g{xdn, (const bf16*)(ws + (l ? WS_WGT1 : WS_WGT0)), T, DM, DM}; pg8::StaticOrder S; S.init(T, DM, F.G, bx);
          pg8::EpiPle E{ssdn, PP, F.out, l ? (bf16*)nullptr : XBB, SSB};
          pg8::gemm_phase<pg8::EpiPle, pg8::StaticOrder, true, true>(F.lds, g, S, E); }
        if (l == 0) GRID_BAR();
        if (l == 0 && DBG_STOP == 6) return true;

    return false;
}
struct Args { const void* in[30]; float* out; unsigned char* ws; };
__global__ void __launch_bounds__(NWAVES * 64, 2) hy_fwd(Args args) {
    extern __shared__ __attribute__((aligned(16))) unsigned char lds[];
    Frame F;
    F.lds = (ldsp)lds; F.MISC = (volatile LAS unsigned*)(F.lds + MISC_OFF);
    F.tid = threadIdx.x; F.lane = F.tid & 63; F.wave = __builtin_amdgcn_readfirstlane(F.tid >> 6);
    F.G = gridDim.x; { const int bx = blockIdx.x; F.vcu = (F.G % 8 == 0) ? (bx % 8) * (F.G / 8) + bx / 8 : bx; }
    unsigned char* ws = args.ws; F.ws = ws; F.out = args.out;
    F.kb = (unsigned long long)__builtin_amdgcn_kernarg_segment_ptr();
    for (int i = F.tid; i < (LDS_BYTES - LDSCTL_OFF) / 4; i += NWAVES * 64) ((LAS unsigned*)(F.lds + LDSCTL_OFF))[i] = 0u;
    __syncthreads();
    XcdBarrier bar = xcd_barrier_post((unsigned*)(ws + WS_CTL) + CW_BAR, F.MISC + 8);
    bf16* const XBA = (bf16*)(ws + WS_XBA); bf16* const XBB = (bf16*)(ws + WS_XBB);
    float* const SSA = (float*)(ws + WS_SSA); float* const SSB = (float*)(ws + WS_SSB);
    bf16* const PP = (bf16*)(ws + WS_CST); bf16* const A2 = (bf16*)(ws + WS_BIG);
    const int bx = (int)blockIdx.x;

    p0_prologue(F);
    GRID_BAR();
#if DBG_STOP >= 1
    { pg8::Gemm g{XBA, (const bf16*)(ws + WS_WIN), T, ZW, DM}; pg8::StaticOrder S; S.init(T, ZW, F.G, bx);
      pg8::EpiZ E{P_Z, ZW, karg(F, 7), SSA};
      pg8::gemm_phase<pg8::EpiZ, pg8::StaticOrder, true, true>(F.lds, g, S, E); }
    GRID_BAR();
    for (int u = F.vcu; u < 2048 + 4096; u += F.G) { if (u < 2048) mlA_unit(F, u); else rg_unit<false>(F, u - 2048); }
    GRID_BAR();
    for (int u = F.vcu; u < 256; u += F.G) mixB_unit(F, u);
    GRID_BAR();
    for (int u = F.vcu; u < 2048 + 4096; u += F.G) { if (u < 2048) mlC_unit(F, u); else rg_unit<true>(F, u - 2048); }
    GRID_BAR();
#endif
#if DBG_STOP >= 3
    if (layer_part<0>(F, bar)) return;
    if (layer_part<1>(F, bar)) return;
#endif
}

extern "C" void kernel_launch(void* const* d_in, const int* in_sizes, int n_in, void* d_out, int out_size, void* d_ws, size_t ws_size, hipStream_t stream) {
    static int grid = 0;
    if (grid == 0) {
        if (n_in != 30 || in_sizes[0] != T * DM || out_size != T * DM || ws_size < WS_END) { fprintf(stderr, "kernel_launch: unexpected shapes (n_in %d, in0 %d, out %d, ws %zu < %zu); nothing launched\n", n_in, n_in > 0 ? in_sizes[0] : -1, out_size, ws_size, (size_t)WS_END); grid = -1; return; }
        int dev = 0, cus = 0, per_cu = 0;
        if (hipGetDevice(&dev) != hipSuccess || hipDeviceGetAttribute(&cus, hipDeviceAttributeMultiprocessorCount, dev) != hipSuccess) { fprintf(stderr, "kernel_launch: device query failed\n"); grid = -1; return; }
        if (hipFuncSetAttribute((const void*)hy_fwd, hipFuncAttributeMaxDynamicSharedMemorySize, LDS_BYTES) != hipSuccess) { fprintf(stderr, "kernel_launch: hipFuncSetAttribute failed\n"); grid = -1; return; }
        if (hipOccupancyMaxActiveBlocksPerMultiprocessor(&per_cu, (const void*)hy_fwd, NWAVES * 64, LDS_BYTES) != hipSuccess || per_cu < 1) { fprintf(stderr, "kernel_launch: occupancy query says %d workgroups per CU; nothing launched\n", per_cu); (void)hipGetLastError(); grid = -1; return; }
        grid = cus;
    }
    if (grid < 0) return;
    if (hipMemsetAsync((char*)d_ws + WS_CTL, 0, CTL_ZERO_BYTES, stream) != hipSuccess) { fprintf(stderr, "kernel_launch: hipMemsetAsync failed\n"); return; }
    Args a{};
    for (int i = 0; i < 30; ++i) a.in[i] = d_in[i];
    a.out = (float*)d_out; a.ws = (unsigned char*)d_ws;
    hipLaunchKernelGGL(hy_fwd, dim3(grid), dim3(NWAVES * 64), LDS_BYTES, stream, a);
    const hipError_t le = hipPeekAtLastError();
    if (le != hipSuccess) fprintf(stderr, "kernel_launch: launch failed: %s\n", hipGetErrorName(le));
}
```

```cpp
#include <hip/hip_runtime.h>
#include <cstdio>
#include <cstdint>
#include <cmath>
namespace pg8 {
#define PG8_LAS __attribute__((address_space(3)))
typedef unsigned short bf16_t;
typedef short bf16x8 __attribute__((ext_vector_type(8)));
typedef float f32x4 __attribute__((ext_vector_type(4)));
typedef unsigned u32x4 __attribute__((ext_vector_type(4)));
constexpr int BM = 256, BK = 64, HALF = 128, HTB = HALF * BK * 2  , STAGE_BYTES = 8 * HTB, NXCD = 8, WGM = 8;

__host__ __device__ __forceinline__ int lds_byte(int r, int c) { const int st = (r >> 4) * 2 + (c >> 5), rr = r & 15, cc = c & 31, ob = rr * 64 + cc * 2; return st * 1024 + (ob ^ (((ob >> 9) & 1) << 5)); }
__host__ __device__ __forceinline__ void stage_rc(int b, int& R, int& C) { const int st = b / 1024, sb = b % 1024, swz = sb ^ (((sb >> 9) & 1) << 5); R = (st >> 1) * 16 + swz / 64; C = (st & 1) * 32 + (swz % 64) / 2; }
__host__ __device__ __forceinline__ int perm32(int rho) { const int n = rho >> 4, i = rho & 15; return 8 * (i >> 2) + 4 * n + (i & 3); }

struct Unit { int pm, pn; };
struct Gemm { const bf16_t* A; const bf16_t* Bt; int M, N, K; };

struct StaticOrder {
    int nM, nN, nwg, G, c;
    __host__ __device__ void init(int M, int N, int G_, int c_) { nM = M / BM; nN = N / BM; nwg = nM * nN; G = G_; c = c_; }
    __host__ __device__ bool next(int i, Unit& u) const {
        const long L = (long)i * G + c; if (L >= nwg) return false;
        int wgid = (int)L; { const int q = nwg / NXCD, r = nwg % NXCD, xcd = wgid % NXCD, off = wgid / NXCD; wgid = (xcd < r ? xcd * (q + 1) : r * (q + 1) + (xcd - r) * q) + off; }
        const int nig = WGM * nN, gid = wgid / nig, fm = gid * WGM, gsz = (nM - fm) < WGM ? (nM - fm) : WGM;
        u.pm = fm + ((wgid % nig) % gsz); u.pn = (wgid % nig) / gsz; return true;
    }
    __device__ __forceinline__ void a_ready(const Unit&) const {}
    __device__ __forceinline__ void done(const Unit&) const {}
};

typedef float f32x2_t __attribute__((ext_vector_type(2))); typedef __bf16 bf16x2_t __attribute__((ext_vector_type(2)));
__device__ __forceinline__ unsigned pk2(float lo, float hi) { f32x2_t v = {lo, hi}; bf16x2_t b = __builtin_convertvector(v, bf16x2_t); return __builtin_bit_cast(unsigned, b); }
__device__ __forceinline__ float bflo(unsigned w) { return __uint_as_float(w << 16); }
__device__ __forceinline__ float bfhi(unsigned w) { return __uint_as_float(w & 0xffff0000u); }
__device__ __forceinline__ float fsigmoid(float x) { return __builtin_amdgcn_rcpf(1.0f + __expf(-x)); }
__device__ __forceinline__ float gelu_tanh(float x) { const float t = x * (1.5957691216f + 0.0713548163f * x * x); return x * __builtin_amdgcn_rcpf(1.0f + __expf(-t)); }
__device__ __forceinline__ u32x4 pk8(const f32x4& a, const f32x4& b) { u32x4 w; w.x = pk2(a[0], a[1]); w.y = pk2(a[2], a[3]); w.z = pk2(b[0], b[1]); w.w = pk2(b[2], b[3]); return w; }
__device__ __forceinline__ float dot4(const f32x4& a) { return (a[0] * a[0] + a[1] * a[1]) + (a[2] * a[2] + a[3] * a[3]); }
__device__ __forceinline__ float row_rstd(const float* ss, int row) {
    const f32x4* p = (const f32x4*)(ss + (size_t)row * 16);
    const f32x4 a = p[0], b = p[1], c = p[2], d = p[3];
    const float s = (((a[0] + a[1]) + (a[2] + a[3])) + ((b[0] + b[1]) + (b[2] + b[3]))) + (((c[0] + c[1]) + (c[2] + c[3])) + ((d[0] + d[1]) + (d[2] + d[3])));
    return rsqrtf(s * (1.0f / 1024.0f) + 1e-6f);
}

struct EpiZ {
    static constexpr bool PERM = true, AFTER_DRAIN = false;
    bf16_t* O; int ldc; const float* bias; const float* ss;
    __device__ __forceinline__ void operator()(const f32x4 (&acc)[2][2][4][2], const Unit& u, int wr, int wc, int fr, int fq) const {
        const int row0 = u.pm * BM + wr * 64 + fr, col0 = u.pn * BM + wc * 32 + 8 * fq;
        f32x4 bv[2][2];
#pragma unroll
        for (int bj = 0; bj < 2; ++bj)
#pragma unroll
            for (int n = 0; n < 2; ++n) bv[bj][n] = bias ? *(const f32x4*)(bias + col0 + bj * HALF + 4 * n) : (f32x4){0.f, 0.f, 0.f, 0.f};
#pragma unroll
        for (int ai = 0; ai < 2; ++ai)
#pragma unroll
            for (int m = 0; m < 4; ++m) { const int row = row0 + ai * HALF + m * 16; const float rs = ss ? row_rstd(ss, row) : 1.0f;
                bf16_t* rowp = O + (size_t)row * ldc + col0;
#pragma unroll
                for (int bj = 0; bj < 2; ++bj) { const f32x4 v0 = acc[ai][bj][m][0] * rs + bv[bj][0], v1 = acc[ai][bj][m][1] * rs + bv[bj][1];
                    *(u32x4*)(rowp + bj * HALF) = pk8(v0, v1); } }
    }
};

__device__ __forceinline__ void unpack8(const u32x4& w, f32x4& a, f32x4& b) { a[0] = bflo(w.x); a[1] = bfhi(w.x); a[2] = bflo(w.y); a[3] = bfhi(w.y); b[0] = bflo(w.z); b[1] = bfhi(w.z); b[2] = bflo(w.w); b[3] = bfhi(w.w); }
template <bool SRCF32> struct EpiRes {
    static constexpr bool PERM = true, AFTER_DRAIN = false;
    const void* src; bf16_t* xb; float* sso;
    __device__ __forceinline__ void operator()(const f32x4 (&acc)[2][2][4][2], const Unit& u, int wr, int wc, int fr, int fq) const {
        const int row0 = u.pm * BM + wr * 64 + fr, col0 = u.pn * BM + wc * 32 + 8 * fq;
#pragma unroll
        for (int ai = 0; ai < 2; ++ai)
#pragma unroll
            for (int m = 0; m < 4; ++m) { const int row = row0 + ai * HALF + m * 16; const size_t off = (size_t)row * 1024 + col0; float sq = 0.f;
#pragma unroll
                for (int bj = 0; bj < 2; ++bj) {
                    f32x4 r0, r1;
                    if (SRCF32) { r0 = *(const f32x4*)((const float*)src + off + bj * HALF); r1 = *(const f32x4*)((const float*)src + off + bj * HALF + 4); }
                    else unpack8(*(const u32x4*)((const bf16_t*)src + off + bj * HALF), r0, r1);
                    const f32x4 v0 = r0 + acc[ai][bj][m][0], v1 = r1 + acc[ai][bj][m][1];
                    *(u32x4*)(xb + off + bj * HALF) = pk8(v0, v1);
                    sq += dot4(v0) + dot4(v1); }
                sq += __shfl_xor(sq, 16); sq += __shfl_xor(sq, 32);
                if (fq == 0) sso[(size_t)row * 16 + 4 * u.pn + wc] = sq; }
    }
};

template <bool FINAL> struct EpiPle {
    static constexpr bool PERM = true, AFTER_DRAIN = false;
    const float* ss; const bf16_t* pp; const bf16_t* xin; bf16_t* xb; float* sso; float* out;
    __device__ __forceinline__ void operator()(const f32x4 (&acc)[2][2][4][2], const Unit& u, int wr, int wc, int fr, int fq) const {
        const int row0 = u.pm * BM + wr * 64 + fr, col0 = u.pn * BM + wc * 32 + 8 * fq;
#pragma unroll
        for (int ai = 0; ai < 2; ++ai)
#pragma unroll
            for (int m = 0; m < 4; ++m) { const int row = row0 + ai * HALF + m * 16; const size_t off = (size_t)row * 1024 + col0; const float rs = row_rstd(ss, row); float sq = 0.f;
#pragma unroll
                for (int bj = 0; bj < 2; ++bj) {
                    f32x4 r0, r1, p0, p1; unpack8(*(const u32x4*)(xin + off + bj * HALF), r0, r1); unpack8(*(const u32x4*)(pp + off + bj * HALF), p0, p1);
                    const f32x4 a0 = acc[ai][bj][m][0] * rs, a1 = acc[ai][bj][m][1] * rs;
                    f32x4 v0, v1;
#pragma unroll
                    for (int e = 0; e < 4; ++e) { v0[e] = r0[e] + fsigmoid(a0[e]) * p0[e]; v1[e] = r1[e] + fsigmoid(a1[e]) * p1[e]; }
                    if (FINAL) { *(f32x4*)(out + off + bj * HALF) = v0; *(f32x4*)(out + off + bj * HALF + 4) = v1; }
                    else { *(u32x4*)(xb + off + bj * HALF) = pk8(v0, v1); sq += dot4(v0) + dot4(v1); } }
                if (!FINAL) { sq += __shfl_xor(sq, 16); sq += __shfl_xor(sq, 32);
                    if (fq == 0) sso[(size_t)row * 16 + 4 * u.pn + wc] = sq; } }
    }
};

struct EpiQkv {
    static constexpr bool PERM = true, AFTER_DRAIN = false;
    const float* ss; const float* rope; const float* qn; const float* kn; bf16_t* Q; bf16_t* K; bf16_t* V;
    __device__ __forceinline__ void operator()(const f32x4 (&acc)[2][2][4][2], const Unit& u, int wr, int wc, int fr, int fq) const {
        const int row0 = u.pm * BM + wr * 64 + fr;
        if (u.pn == 5) {
#pragma unroll
            for (int ai = 0; ai < 2; ++ai)
#pragma unroll
                for (int m = 0; m < 4; ++m) { const int row = row0 + ai * HALF + m * 16; const float rs = row_rstd(ss, row);
#pragma unroll
                    for (int bj = 0; bj < 2; ++bj) *(u32x4*)(V + (size_t)row * 256 + 64 * wc + 32 * bj + 8 * fq) = pk8(acc[ai][bj][m][0] * rs, acc[ai][bj][m][1] * rs); }
            return;
        }
        const bool isq = u.pn < 4; const float* gn = isq ? qn : kn; const float osc = isq ? 0.125f : 1.0f;
        bf16_t* dst = isq ? Q + (size_t)(64 * (4 * u.pn + wc)) : K + (size_t)(64 * wc); const int ldd = isq ? 1024 : 256;
        f32x4 g[2][2];
#pragma unroll
        for (int bj = 0; bj < 2; ++bj)
#pragma unroll
            for (int n = 0; n < 2; ++n) g[bj][n] = *(const f32x4*)(gn + 32 * bj + 8 * fq + 4 * n);
#pragma unroll
        for (int ai = 0; ai < 2; ++ai)
#pragma unroll
            for (int m = 0; m < 4; ++m) { const int row = row0 + ai * HALF + m * 16; const float rs = row_rstd(ss, row);
                f32x4 v[2][2]; float sq = 0.f;
#pragma unroll
                for (int bj = 0; bj < 2; ++bj)
#pragma unroll
                    for (int n = 0; n < 2; ++n) { v[bj][n] = acc[ai][bj][m][n] * rs; sq += dot4(v[bj][n]); }
                sq += __shfl_xor(sq, 16); sq += __shfl_xor(sq, 32);
                const float hr = rsqrtf(sq * (1.0f / 64.0f) + 1e-6f) ;
#pragma unroll
                for (int bj = 0; bj < 2; ++bj)
#pragma unroll
                    for (int n = 0; n < 2; ++n) v[bj][n] = v[bj][n] * hr * g[bj][n];
                const float* rp = rope + (size_t)row * 64 + 8 * fq;
                f32x4 o[2][2];
#pragma unroll
                for (int n = 0; n < 2; ++n) { const f32x4 cs = *(const f32x4*)(rp + 4 * n), sn = *(const f32x4*)(rp + 32 + 4 * n);
                    o[0][n] = (v[0][n] * cs - v[1][n] * sn) * osc; o[1][n] = (v[1][n] * cs + v[0][n] * sn) * osc; }
#pragma unroll
                for (int bj = 0; bj < 2; ++bj) *(u32x4*)(dst + (size_t)row * ldd + 32 * bj + 8 * fq) = pk8(o[bj][0], o[bj][1]); }
    }
};

struct EpiUp {
    static constexpr bool PERM = true, AFTER_DRAIN = false;
    const float* ss; const float* cw; const float* cb; bf16_t* A2; bf16_t* GH; bf16_t* UH; bf16_t* GT;
    __device__ __forceinline__ void operator()(const f32x4 (&acc)[2][2][4][2], const Unit& u, int wr, int wc, int fr, int fq) const {
        const int lane = fq * 16 + fr, ch0 = u.pn * 128 + wc * 32 + 8 * fq;
        const int src1 = (lane & 48) | ((fr - 1) & 15), src2 = (lane & 48) | ((fr - 2) & 15);
        f32x4 w0[2], w1[2], w2[2], bb[2];
#pragma unroll
        for (int n = 0; n < 2; ++n) { w0[n] = *(const f32x4*)(cw + ch0 + 4 * n); w1[n] = *(const f32x4*)(cw + 3072 + ch0 + 4 * n); w2[n] = *(const f32x4*)(cw + 6144 + ch0 + 4 * n); bb[n] = *(const f32x4*)(cb + ch0 + 4 * n); }
#pragma unroll
        for (int ai = 0; ai < 2; ++ai) {
            const int grp = 4 * u.pm + 2 * ai + wr;
            unsigned pp0 = 0u, pp1 = 0u, pp2 = 0u, pp3 = 0u;
#pragma unroll
            for (int m = 0; m < 4; ++m) { const int row = u.pm * BM + ai * HALF + wr * 64 + m * 16 + fr; const float rs = row_rstd(ss, row);
                const f32x4 g0 = acc[ai][0][m][0] * rs, g1 = acc[ai][0][m][1] * rs, u0 = acc[ai][1][m][0] * rs, u1 = acc[ai][1][m][1] * rs;
                const unsigned c0 = pk2(g0[0], g0[1]), c1 = pk2(g0[2], g0[3]), c2 = pk2(g1[0], g1[1]), c3 = pk2(g1[2], g1[3]);
                unsigned a1_0 = __shfl(c0, src1), a1_1 = __shfl(c1, src1), a1_2 = __shfl(c2, src1), a1_3 = __shfl(c3, src1);
                unsigned a2_0 = __shfl(c0, src2), a2_1 = __shfl(c1, src2), a2_2 = __shfl(c2, src2), a2_3 = __shfl(c3, src2);
                if (m > 0) {
                    const unsigned b1_0 = __shfl(pp0, src1), b1_1 = __shfl(pp1, src1), b1_2 = __shfl(pp2, src1), b1_3 = __shfl(pp3, src1);
                    const unsigned b2_0 = __shfl(pp0, src2), b2_1 = __shfl(pp1, src2), b2_2 = __shfl(pp2, src2), b2_3 = __shfl(pp3, src2);
                    if (fr < 1) { a1_0 = b1_0; a1_1 = b1_1; a1_2 = b1_2; a1_3 = b1_3; }
                    if (fr < 2) { a2_0 = b2_0; a2_1 = b2_1; a2_2 = b2_2; a2_3 = b2_3; }
                }
                const f32x4 p1a = {bflo(a1_0), bfhi(a1_0), bflo(a1_1), bfhi(a1_1)}, p1b = {bflo(a1_2), bfhi(a1_2), bflo(a1_3), bfhi(a1_3)};
                const f32x4 p2a = {bflo(a2_0), bfhi(a2_0), bflo(a2_1), bfhi(a2_1)}, p2b = {bflo(a2_2), bfhi(a2_2), bflo(a2_3), bfhi(a2_3)};
                const f32x4 y0 = w0[0] * p2a + w1[0] * p1a + w2[0] * g0 + bb[0], y1 = w0[1] * p2b + w1[1] * p1b + w2[1] * g1 + bb[1];
                f32x4 o0, o1;
#pragma unroll
                for (int e = 0; e < 4; ++e) { o0[e] = gelu_tanh(y0[e]) * u0[e]; o1[e] = gelu_tanh(y1[e]) * u1[e]; }
                const bool head = (m == 0) && (fr < 2);
                if (!head) *(u32x4*)(A2 + (size_t)row * 3072 + ch0) = pk8(o0, o1);
                else { const size_t so = ((size_t)grp * 2 + fr) * 3072 + ch0; u32x4 gw; gw.x = c0; gw.y = c1; gw.z = c2; gw.w = c3; *(u32x4*)(GH + so) = gw; *(u32x4*)(UH + so) = pk8(u0, u1); }
                if (m == 3 && fr >= 14) { const size_t so = ((size_t)grp * 2 + (fr - 14)) * 3072 + ch0; u32x4 gw; gw.x = c0; gw.y = c1; gw.z = c2; gw.w = c3; *(u32x4*)(GT + so) = gw; }
                pp0 = c0; pp1 = c1; pp2 = c2; pp3 = c3; }
        }
    }
};

struct EpiNone {
    static constexpr bool PERM = true, AFTER_DRAIN = false;
    __device__ __forceinline__ void operator()(const f32x4 (&acc)[2][2][4][2], const Unit& u, int wr, int wc, int fr, int fq) const {
#pragma unroll
        for (int ai = 0; ai < 2; ++ai)
#pragma unroll
            for (int m = 0; m < 4; ++m)
#pragma unroll
                for (int bj = 0; bj < 2; ++bj) { asm volatile("" :: "v"(acc[ai][bj][m][0]), "v"(acc[ai][bj][m][1])); }
    }
};
template <class Epi, class Sched, bool ALIGN_EPI = false, bool SP2 = false>
__device__ __forceinline__ void gemm_phase(PG8_LAS unsigned char* lds, const Gemm g, const Sched& S, const Epi& E) {
    int tid_ = threadIdx.x; asm volatile("" : "+v"(tid_));
    const int tid = tid_, wid = __builtin_amdgcn_readfirstlane(tid >> 6), lane = tid & 63, wr = wid >> 2, wc = wid & 3, fr = lane & 15, fq = lane >> 4;
    const int K = g.K, nt = K / BK;
    unsigned voffA[2], voffB[2];
#pragma unroll
    for (int i = 0; i < 2; ++i) { int R, C; stage_rc(tid * 16 + i * 8192, R, C); const int Rb = Epi::PERM ? ((R & ~31) + perm32(R & 31)) : R;
        voffA[i] = (unsigned)(R * K + C) * 2u; voffB[i] = (unsigned)(Rb * K + C) * 2u; }
    const size_t kstep = (size_t)(BK * 2);
    const size_t hstep = (size_t)HALF * K * 2;
    const size_t tstep = 2 * hstep;
    const unsigned ldsw = (unsigned)wid * 1024u;
    const int aoff = lds_byte(wr * 64 + fr, fq * 8), boff = lds_byte(wc * 32 + fr, fq * 8);
#define PG8_SA(b, h) (((b) * 2 + (h)) * HTB)
#define PG8_SB(b, h) ((4 + (b) * 2 + (h)) * HTB)
#define PG8_STAGE(bufoff, gbase, voff) do { _Pragma("unroll") for (int _i = 0; _i < 2; ++_i) \
        __builtin_amdgcn_global_load_lds((const unsigned*)((const char*)(gbase) + (voff)[_i]), (PG8_LAS unsigned*)(lds + (bufoff) + ldsw + _i * 8192), 16, 0, 0); } while (0)
#define PG8_LDA(dst, b, h) do { _Pragma("unroll") for (int m = 0; m < 4; ++m) _Pragma("unroll") for (int k = 0; k < 2; ++k) dst[m][k] = *(const PG8_LAS bf16x8*)(lds + PG8_SA(b, h) + aoff + m * 2048 + k * 1024); } while (0)
#define PG8_LDB(dst, b, h) do { _Pragma("unroll") for (int n = 0; n < 2; ++n) _Pragma("unroll") for (int k = 0; k < 2; ++k) dst[n][k] = *(const PG8_LAS bf16x8*)(lds + PG8_SB(b, h) + boff + n * 2048 + k * 1024); } while (0)
#define PG8_MMA(ai, bj, At, Bt) do { __builtin_amdgcn_s_setprio(1); _Pragma("unroll") for (int m = 0; m < 4; ++m) _Pragma("unroll") for (int n = 0; n < 2; ++n) _Pragma("unroll") for (int k = 0; k < 2; ++k) \
        acc[ai][bj][m][n] = __builtin_amdgcn_mfma_f32_16x16x32_bf16(Bt[n][k], At[m][k], acc[ai][bj][m][n], 0, 0, 0); __builtin_amdgcn_s_setprio(0); } while (0)
#define PG8_WAIT_V(n) asm volatile("s_waitcnt vmcnt(" #n ")" ::: "memory")
#define PG8_WAIT_L(n) asm volatile("s_waitcnt lgkmcnt(" #n ")" ::: "memory")
#define PG8_BAR __builtin_amdgcn_s_barrier()
#define PG8_SCHED __builtin_amdgcn_sched_barrier(0)
    Unit cur, nxt; int ui = 0;
    if (!S.next(0, cur)) return;
    f32x4 acc[2][2][4][2];
#pragma unroll
    for (int a = 0; a < 2; ++a)
#pragma unroll
        for (int b = 0; b < 2; ++b)
#pragma unroll
            for (int m = 0; m < 4; ++m)
#pragma unroll
                for (int n = 0; n < 2; ++n) acc[a][b][m][n] = (f32x4){0.f, 0.f, 0.f, 0.f};
    bf16x8 At[4][2], B0[2][2], B1[2][2];
    const char* cA = (const char*)g.A + (size_t)cur.pm * tstep; const char* cB = (const char*)g.Bt + (size_t)cur.pn * tstep;
    S.a_ready(cur);
    if constexpr (SP2) {
        PG8_STAGE(PG8_SB(0, 0), cB, voffB); PG8_STAGE(PG8_SB(0, 1), cB + hstep, voffB); PG8_STAGE(PG8_SA(0, 0), cA, voffA); PG8_STAGE(PG8_SA(0, 1), cA + hstep, voffA);
        if (wr == 1) PG8_BAR;
        PG8_WAIT_V(2); PG8_BAR;
        PG8_STAGE(PG8_SB(1, 0), cB + kstep, voffB); PG8_STAGE(PG8_SA(1, 0), cA + kstep, voffA); PG8_STAGE(PG8_SB(1, 1), cB + hstep + kstep, voffB);
        PG8_WAIT_V(6); PG8_BAR;
    } else {
        PG8_STAGE(PG8_SB(0, 0), cB, voffB); PG8_STAGE(PG8_SA(0, 0), cA, voffA); PG8_STAGE(PG8_SB(0, 1), cB + hstep, voffB); PG8_STAGE(PG8_SA(0, 1), cA + hstep, voffA);
        if (wr == 1) PG8_BAR;
        PG8_WAIT_V(4); PG8_BAR;
        PG8_STAGE(PG8_SB(1, 0), cB + kstep, voffB); PG8_STAGE(PG8_SA(1, 0), cA + kstep, voffA); PG8_STAGE(PG8_SB(1, 1), cB + hstep + kstep, voffB);
        PG8_WAIT_V(6); PG8_BAR;
    }
    for (;;) {
        const bool has_next = S.next(ui + 1, nxt);
        const char* nA = has_next ? (const char*)g.A + (size_t)nxt.pm * tstep : cA; const char* nB = has_next ? (const char*)g.Bt + (size_t)nxt.pn * tstep : cB;
        for (int t = 0; t < nt; t += 2) {
            const bool last = (t == nt - 2);
            const char* a1 = cA + (size_t)(t + 1) * kstep;
            const char* a2 = last ? nA : cA + (size_t)(t + 2) * kstep; const char* b2 = last ? nB : cB + (size_t)(t + 2) * kstep;
            const char* a3 = a2 + kstep; const char* b3 = b2 + kstep;
            if (last && has_next) S.a_ready(nxt);
            if constexpr (SP2) {
            PG8_LDB(B0, 0, 0); PG8_LDB(B1, 0, 1); PG8_SCHED; PG8_LDA(At, 0, 0); PG8_STAGE(PG8_SA(1, 1), a1 + hstep, voffA);
            PG8_WAIT_V(8); PG8_WAIT_L(0); PG8_BAR; PG8_MMA(0, 0, At, B0); PG8_MMA(0, 1, At, B1); PG8_BAR; PG8_SCHED;
            PG8_LDA(At, 0, 1); PG8_STAGE(PG8_SB(0, 0), b2, voffB); PG8_STAGE(PG8_SB(0, 1), b2 + hstep, voffB); PG8_STAGE(PG8_SA(0, 0), a2, voffA);
            PG8_WAIT_V(8); PG8_WAIT_L(0); PG8_BAR; PG8_MMA(1, 0, At, B0); PG8_MMA(1, 1, At, B1); PG8_BAR; PG8_SCHED;
            PG8_LDB(B0, 1, 0); PG8_LDB(B1, 1, 1); PG8_SCHED; PG8_LDA(At, 1, 0); PG8_STAGE(PG8_SA(0, 1), a2 + hstep, voffA);
            PG8_WAIT_V(8); PG8_WAIT_L(0); PG8_BAR; PG8_MMA(0, 0, At, B0); PG8_MMA(0, 1, At, B1); PG8_BAR; PG8_SCHED;
            PG8_LDA(At, 1, 1); PG8_STAGE(PG8_SB(1, 0), b3, voffB); PG8_STAGE(PG8_SB(1, 1), b3 + hstep, voffB); PG8_STAGE(PG8_SA(1, 0), a3, voffA);
            PG8_WAIT_V(8); PG8_WAIT_L(0); PG8_BAR; PG8_MMA(1, 0, At, B0); PG8_MMA(1, 1, At, B1); PG8_BAR; PG8_SCHED;
            } else {
            PG8_LDB(B0, 0, 0); PG8_SCHED; PG8_LDA(At, 0, 0); PG8_STAGE(PG8_SA(1, 1), a1 + hstep, voffA);
            PG8_WAIT_L(8); PG8_BAR; PG8_WAIT_L(0); PG8_MMA(0, 0, At, B0); PG8_BAR; PG8_SCHED;
            PG8_LDB(B1, 0, 1); PG8_STAGE(PG8_SB(0, 0), b2, voffB);
            PG8_BAR; PG8_WAIT_L(0); PG8_MMA(0, 1, At, B1); PG8_BAR;
            PG8_LDA(At, 0, 1); PG8_STAGE(PG8_SA(0, 0), a2, voffA);
            PG8_BAR; PG8_WAIT_L(0); PG8_MMA(1, 0, At, B0); PG8_BAR; PG8_SCHED;
            PG8_STAGE(PG8_SB(0, 1), b2 + hstep, voffB);
            PG8_WAIT_V(6); PG8_BAR; PG8_MMA(1, 1, At, B1); PG8_BAR;
            PG8_LDB(B0, 1, 0); PG8_SCHED; PG8_LDA(At, 1, 0); PG8_STAGE(PG8_SA(0, 1), a2 + hstep, voffA);
            PG8_WAIT_L(8); PG8_BAR; PG8_WAIT_L(0); PG8_MMA(0, 0, At, B0); PG8_BAR; PG8_SCHED;
            PG8_LDB(B1, 1, 1); PG8_STAGE(PG8_SB(1, 0), b3, voffB);
            PG8_BAR; PG8_WAIT_L(0); PG8_MMA(0, 1, At, B1); PG8_BAR;
            PG8_LDA(At, 1, 1); PG8_STAGE(PG8_SA(1, 0), a3, voffA);
            PG8_BAR; PG8_WAIT_L(0); PG8_MMA(1, 0, At, B0); PG8_BAR; PG8_SCHED;
            PG8_STAGE(PG8_SB(1, 1), b3 + hstep, voffB);
            PG8_WAIT_V(6); PG8_BAR; PG8_MMA(1, 1, At, B1); PG8_BAR;
            }
        }
        if constexpr (ALIGN_EPI) { if (wr == 0) PG8_BAR; }
        if constexpr (!Epi::AFTER_DRAIN) { E(acc, cur, wr, wc, fr, fq); S.done(cur); }
        if (!has_next) break;
#pragma unroll
        for (int a = 0; a < 2; ++a)
#pragma unroll
            for (int b = 0; b < 2; ++b)
#pragma unroll
                for (int m = 0; m < 4; ++m)
#pragma unroll
                    for (int n = 0; n < 2; ++n) acc[a][b][m][n] = (f32x4){0.f, 0.f, 0.f, 0.f};
        cur = nxt; cA = nA; cB = nB; ++ui;
        if constexpr (ALIGN_EPI) { if (wr == 1) PG8_BAR; }
    }
    PG8_WAIT_V(0);
    if constexpr (!ALIGN_EPI) { if (wr == 0) PG8_BAR; }
    PG8_BAR;
    if constexpr (Epi::AFTER_DRAIN) { E.fused(acc, cur, wr, wc, fr, fq, lds, wid, lane); S.done(cur); }
#undef PG8_SA
#undef PG8_SB
#undef PG8_STAGE
#undef PG8_LDA
#undef PG8_LDB
#undef PG8_MMA
#undef PG8_WAIT_V
#undef PG8_WAIT_L
#undef PG8_BAR
#undef PG8_SCHED
}
}

constexpr int NWAVES = 8;
constexpr int NB = 8, SEQ = 4096, T = NB * SEQ, DM = 1024, ZW = 3072, FFD = 3072, HYIN = 3080;
#ifndef PROBE_PHASE
#define PROBE_PHASE 0
#define PROBE_N 0
#endif
#define PREP(id) for (int rep_ = 0; rep_ < 1 + ((PROBE_PHASE == (id)) ? PROBE_N : 0); ++rep_)
#ifndef DBG_STOP
#define DBG_STOP 99
#endif

constexpr size_t MiB = 1u << 20;
constexpr size_t WS_CTL = 0, CTL_ZERO_BYTES = 1 * MiB;
constexpr size_t WS_WIN = 2 * MiB, WS_WOUT0 = 8 * MiB, WS_WUP0 = 10 * MiB, WS_WDN0 = 22 * MiB, WS_WGT0 = 28 * MiB, WS_WPJ0 = 30 * MiB,
                 WS_WQKV = 31 * MiB, WS_WO1 = 34 * MiB, WS_WUP1 = 36 * MiB, WS_WDN1 = 48 * MiB, WS_WGT1 = 54 * MiB, WS_WPJ1 = 56 * MiB, WS_RGW = 57 * MiB;
constexpr size_t WS_GATES = 58 * MiB, WS_SSA = 59 * MiB, WS_SSB = 61 * MiB, WS_ROPE = 63 * MiB, WS_NLOC = 71 * MiB, WS_NPREV = 72 * MiB, WS_MSC = 73 * MiB,
                 WS_RGA = 74 * MiB, WS_RGH = 75 * MiB, WS_RGC = 76 * MiB;
constexpr size_t WS_PB = 78 * MiB, WS_XBA = 110 * MiB, WS_XBB = 174 * MiB, WS_CST = 238 * MiB, WS_BIG = 302 * MiB, WS_END = 494 * MiB;
constexpr int CW_BAR = 4096;

constexpr int RING_BYTES = 131072;
constexpr int LDSCTL_OFF = RING_BYTES, MISC_OFF = LDSCTL_OFF + 320;
constexpr int LDS_BYTES = 147456;

#define GAS __attribute__((address_space(1)))
#define LAS __attribute__((address_space(3)))
typedef unsigned short bf16;
typedef unsigned v4u __attribute__((ext_vector_type(4)));
typedef unsigned v2u __attribute__((ext_vector_type(2)));
typedef float f32x4 __attribute__((ext_vector_type(4)));
typedef float f32x16 __attribute__((ext_vector_type(16)));
typedef short bf16x8 __attribute__((ext_vector_type(8)));
typedef short s16x4 __attribute__((ext_vector_type(4)));
typedef GAS unsigned gu32;
typedef LAS unsigned char* ldsp;
#define LDS_WAIT() asm volatile("s_waitcnt lgkmcnt(0)" ::: "memory")
using pg8::pk2; using pg8::bflo; using pg8::bfhi; using pg8::fsigmoid; using pg8::gelu_tanh;
__device__ __forceinline__ unsigned short f2bf1(float x) { return (unsigned short)(pk2(x, 0.f) & 0xffffu); }
__device__ __forceinline__ float bf2f(unsigned short b) { return __uint_as_float(((unsigned)b) << 16); }
__device__ __forceinline__ float fsilu(float x) { return x * __builtin_amdgcn_rcpf(1.0f + __expf(-x)); }
#define MFMA16(a, b, c) __builtin_amdgcn_mfma_f32_16x16x32_bf16((a), (b), (c), 0, 0, 0)
#define MFMA32(a, b, c) __builtin_amdgcn_mfma_f32_32x32x16_bf16((a), (b), (c), 0, 0, 0)

#define XB_TMO      128
#define XB_XCNT(j)  (256  + 64 * (j))
#define XB_XSUB(j)  (1280 + 64 * (j))
#define XB_XGEN(j)  (2304 + 64 * (j))
#define XB_TOP      3328
#define XB_TOPGEN   3392
#define XCD_BAR_WORDS 3456
#define XB_SPIN_CAP (1u << 18)

__device__ __forceinline__ unsigned xb_ld(unsigned* p)              { return __hip_atomic_load(p, __ATOMIC_RELAXED, __HIP_MEMORY_SCOPE_AGENT); }
__device__ __forceinline__ unsigned xb_add(unsigned* p, unsigned v) { return __hip_atomic_fetch_add(p, v, __ATOMIC_RELAXED, __HIP_MEMORY_SCOPE_AGENT); }
__device__ __forceinline__ unsigned xb_xcc_id() { return (unsigned)__builtin_amdgcn_s_getreg((3 << 11) | 20) & 0xFu; }
#define XB_SPIN(cond, bar) do { unsigned _sp = 0; while (cond) { __builtin_amdgcn_s_sleep(1); \
    if ((++_sp & 255u) == 0u) { if (xb_ld(&(bar)[XB_TMO])) break; if (_sp > XB_SPIN_CAP) { atomicAdd(&(bar)[XB_TMO], 1u); break; } } } } while (0)

struct XcdBarrier {
    unsigned* bar; unsigned x;
    volatile LAS unsigned* st;
};

__device__ __forceinline__ XcdBarrier xcd_barrier_post(unsigned* bar, volatile LAS unsigned* st) {
    XcdBarrier b; b.bar = bar; b.x = xb_xcc_id(); b.st = st;
    if (threadIdx.x == 0) (void)xb_add(&bar[XB_XCNT(b.x)], 1u);
    return b;
}
__device__ __forceinline__ void xcd_barrier_complete(unsigned* bar, unsigned x, unsigned& nloc, unsigned& nx) {
    const unsigned G = gridDim.x * gridDim.y * gridDim.z;
    unsigned sum, cnt, mine, sp = 0u;
    for (;;) {
        sum = 0u; cnt = 0u; mine = 0u;
#pragma unroll
        for (unsigned j = 0; j < 16; ++j) { const unsigned c = xb_ld(&bar[XB_XCNT(j)]); sum += c; cnt += (c > 0u) ? 1u : 0u; mine = (j == x) ? c : mine; }
        if (sum == G) break;
        __builtin_amdgcn_s_sleep(1);
        if ((++sp & 255u) == 0u) { if (xb_ld(&bar[XB_TMO])) break; if (sp > XB_SPIN_CAP) { atomicAdd(&bar[XB_TMO], 1u); break; } }
    }
    nloc = mine > 0u ? mine : 1u; nx = cnt > 0u ? cnt : 1u;
}

__device__ __forceinline__ void xcd_barrier(const XcdBarrier& b) {
    asm volatile("s_waitcnt vmcnt(0)" ::: "memory");
    __syncthreads();
    if (threadIdx.x == 0) {
        unsigned* bar = b.bar;
        __builtin_amdgcn_s_waitcnt(0);
        unsigned nloc = b.st[0], nx = b.st[1];
        if (nloc == 0u) { xcd_barrier_complete(bar, b.x, nloc, nx); b.st[0] = nloc; b.st[1] = nx; }
        const unsigned old = xb_add(&bar[XB_XSUB(b.x)], 1u);
        const unsigned gen = old / nloc;
        if (old + 1u == (gen + 1u) * nloc) {
            __builtin_amdgcn_fence(__ATOMIC_RELEASE, "agent");
            asm volatile("s_waitcnt vmcnt(0)" ::: "memory");
            const unsigned og = xb_add(&bar[XB_TOP], 1u);
            const unsigned tg = og / nx;
            if (og + 1u == (tg + 1u) * nx) xb_add(&bar[XB_TOPGEN], 1u);
            else XB_SPIN(xb_ld(&bar[XB_TOPGEN]) == tg, bar);
            __builtin_amdgcn_fence(__ATOMIC_ACQUIRE, "agent");
            xb_add(&bar[XB_XGEN(b.x)], 1u);
            asm volatile("s_waitcnt vmcnt(0)" ::: "memory");
        } else {
            XB_SPIN(xb_ld(&bar[XB_XGEN(b.x)]) == gen, bar);
            __builtin_amdgcn_fence(__ATOMIC_ACQUIRE, "agent");
            asm volatile("s_waitcnt vmcnt(0)" ::: "memory");
        }
    }
    __syncthreads();
}

struct Frame {
    ldsp lds; volatile LAS unsigned* MISC;
    int tid, lane, wave, vcu, G;
    unsigned char* ws; unsigned long long kb; float* out;
};
__device__ __forceinline__ const float* karg(const Frame& F, int i) { unsigned long long a = F.kb; asm volatile("" : "+s"(a) :: "memory"); return (const float*)(((const __attribute__((address_space(4))) unsigned long long*)a)[i]); }
#define P_Z     ((bf16*)(F.ws + WS_BIG))
#define P_YBUF  ((bf16*)(F.ws + WS_XBA))
#define P_CST   ((bf16*)(F.ws + WS_CST))
#define P_RGW   ((bf16*)(F.ws + WS_RGW))
#define P_GATES ((float*)(F.ws + WS_GATES))
#define P_NLOC  ((float*)(F.ws + WS_NLOC))
#define P_NPREV ((float*)(F.ws + WS_NPREV))
#define P_MLOC  ((float*)(F.ws + WS_MSC))
#define P_BLAST ((float*)(F.ws + WS_MSC) + 2048)
#define P_MPREV ((float*)(F.ws + WS_MSC) + 4096)
#define P_RGA   ((float*)(F.ws + WS_RGA))
#define P_RGH   ((float*)(F.ws + WS_RGH))
#define P_RGC   ((float*)(F.ws + WS_RGC))
#define P_ROPE  ((float*)(F.ws + WS_ROPE))

__device__ __forceinline__ void tr_item(const float* W, int ldw, int srcc, const float* scale, bf16* WT, int K, int dst_row0, int k0, LAS float* scr, int lane) {
#pragma unroll 8
    for (int i = 0; i < 32; ++i) { const int kk = 2 * i + (lane >> 5); const float s = scale ? scale[k0 + kk] : 1.0f; scr[kk * 33 + (lane & 31)] = W[(size_t)(k0 + kk) * ldw + srcc + (lane & 31)] * s; }
    LDS_WAIT(); asm volatile("" ::: "memory");
    const int c = lane & 7;
#pragma unroll
    for (int j = 0; j < 4; ++j) { const int n = (lane >> 3) + 8 * j; const LAS float* s = scr + (8 * c) * 33 + n;
        v4u o; o.x = pk2(s[0 * 33], s[1 * 33]); o.y = pk2(s[2 * 33], s[3 * 33]); o.z = pk2(s[4 * 33], s[5 * 33]); o.w = pk2(s[6 * 33], s[7 * 33]);
        *(GAS v4u*)(WT + (size_t)(dst_row0 + n) * K + k0 + 8 * c) = o; }
    LDS_WAIT(); asm volatile("" ::: "memory");
}
__device__ __forceinline__ int tr_srcc(int mode, int nb) {
    if (mode == 1) { const int j = nb >> 3, r8 = nb & 7; return r8 < 4 ? 128 * j + 32 * r8 : 3072 + 128 * j + 32 * (r8 - 4); }
    if (mode == 2) { const int pn = nb >> 3, bj = (nb >> 2) & 1, wc = nb & 3; return 64 * (4 * pn + wc) + 32 * bj; }
    return 32 * nb;
}
__device__ __forceinline__ bool tr_matrix(int& r, const float* W, int ldw, int K, int Nd, int mode, const float* scale, bf16* WT, LAS float* scr, int lane) {
    const int nblk = Nd / 32, items = (K / 64) * nblk;
    if (r >= items) { r -= items; return false; }
    const int kb = r / nblk, nb = r % nblk;
    tr_item(W, ldw, tr_srcc(mode, nb), scale, WT, K, 32 * nb, 64 * kb, scr, lane);
    return true;
}
__device__ __forceinline__ float wave_sum(float v) {
#pragma unroll
    for (int o = 1; o < 64; o <<= 1) v += __shfl_xor(v, o);
    return v;
}
__device__ __forceinline__ void p0_prologue(Frame& F) { const float* x = karg(F, 0); const float* p = karg(F, 1); const int* pos = (const int*)karg(F, 2); const float* norm_mix = karg(F, 3); const float* norm_ffn = karg(F, 4); const float* norm_ple = karg(F, 5); const float* hy_w_in = karg(F, 6); const float* hy_b_in = karg(F, 7); const float* rg_wa = karg(F, 10); const float* rg_wx = karg(F, 12); const float* hy_w_out = karg(F, 18); const float* at_w_qkv = karg(F, 19); const float* at_w_out = karg(F, 23); const float* ff_w_up = karg(F, 24); const float* ff_w_down = karg(F, 27); const float* ple_w_gate = karg(F, 28); const float* ple_w_proj = karg(F, 29);
    LAS float* scr = (LAS float*)(F.lds + F.wave * 8448);
    const int gw = F.vcu * NWAVES + F.wave, NGW = F.G * NWAVES;
    unsigned char* ws = F.ws;
    LAS float* GW = (LAS float*)(F.lds + 73728);
    for (int i = F.tid; i < 8192; i += NWAVES * 64) { const int k = i >> 3, g = i & 7; GW[i] = hy_w_in[(size_t)k * HYIN + 3072 + g] * norm_mix[k]; }
    constexpr int NITEMS = 1536 + 512 + 2 * 3072 + 2 * 1536 + 2 * 512 + 2 * 128 + 768 + 512 + 32;
    for (int it = gw; it < NITEMS; it += NGW) {
        int r = it;
        if (tr_matrix(r, hy_w_in, HYIN, 1024, 3072, 0, norm_mix, (bf16*)(ws + WS_WIN), scr, F.lane)) continue;
        if (tr_matrix(r, hy_w_out, 1024, 1024, 1024, 0, nullptr, (bf16*)(ws + WS_WOUT0), scr, F.lane)) continue;
        if (tr_matrix(r, ff_w_up, 6144, 1024, 6144, 1, norm_ffn, (bf16*)(ws + WS_WUP0), scr, F.lane)) continue;
        if (tr_matrix(r, ff_w_up + (size_t)1024 * 6144, 6144, 1024, 6144, 1, norm_ffn + 1024, (bf16*)(ws + WS_WUP1), scr, F.lane)) continue;
        if (tr_matrix(r, ff_w_down, 1024, 3072, 1024, 0, nullptr, (bf16*)(ws + WS_WDN0), scr, F.lane)) continue;
        if (tr_matrix(r, ff_w_down + (size_t)3072 * 1024, 1024, 3072, 1024, 0, nullptr, (bf16*)(ws + WS_WDN1), scr, F.lane)) continue;
        if (tr_matrix(r, ple_w_gate, 1024, 1024, 1024, 0, norm_ple, (bf16*)(ws + WS_WGT0), scr, F.lane)) continue;
        if (tr_matrix(r, ple_w_gate + (size_t)1024 * 1024, 1024, 1024, 1024, 0, norm_ple + 1024, (bf16*)(ws + WS_WGT1), scr, F.lane)) continue;
        if (tr_matrix(r, ple_w_proj, 1024, 256, 1024, 0, nullptr, (bf16*)(ws + WS_WPJ0), scr, F.lane)) continue;
        if (tr_matrix(r, ple_w_proj + (size_t)256 * 1024, 1024, 256, 1024, 0, nullptr, (bf16*)(ws + WS_WPJ1), scr, F.lane)) continue;
        if (tr_matrix(r, at_w_qkv, 1536, 1024, 1536, 2, norm_mix + 1024, (bf16*)(ws + WS_WQKV), scr, F.lane)) continue;
        if (tr_matrix(r, at_w_out, 1024, 1024, 1024, 0, nullptr, (bf16*)(ws + WS_WO1), scr, F.lane)) continue;
        { const int blk = r >> 1, nb = r & 1, g = blk >> 3, n = blk & 7;
          tr_item((g ? rg_wx : rg_wa) + (size_t)n * 4096, 64, 32 * nb, nullptr, P_RGW + (size_t)blk * 4096, 64, 32 * nb, 0, scr, F.lane); }
    }
    __syncthreads();
    bf16* xb = (bf16*)(ws + WS_XBA); float* ssA = (float*)(ws + WS_SSA);
    for (int row = gw; row < T; row += NGW) {
        const GAS f32x4* xr = (const GAS f32x4*)(x + (size_t)row * DM) + F.lane;
        f32x4 v[4]; float s = 0.f; float d[8];
#pragma unroll
        for (int g = 0; g < 8; ++g) d[g] = 0.f;
#pragma unroll
        for (int j = 0; j < 4; ++j) { v[j] = xr[64 * j]; s += (v[j].x * v[j].x + v[j].y * v[j].y) + (v[j].z * v[j].z + v[j].w * v[j].w);
#pragma unroll
            for (int e = 0; e < 4; ++e) { const int k = 4 * (F.lane + 64 * j) + e; const f32x4 w0 = *(const LAS f32x4*)(GW + k * 8), w1 = *(const LAS f32x4*)(GW + k * 8 + 4);
                const float xv = v[j][e];
                d[0] += xv * w0[0]; d[1] += xv * w0[1]; d[2] += xv * w0[2]; d[3] += xv * w0[3]; d[4] += xv * w1[0]; d[5] += xv * w1[1]; d[6] += xv * w1[2]; d[7] += xv * w1[3]; } }
        s = wave_sum(s);
#pragma unroll
        for (int g = 0; g < 8; ++g) d[g] = wave_sum(d[g]);
        const float rstd = rsqrtf(s * (1.0f / DM) + 1e-6f);
        if (F.lane < 16) ssA[(size_t)row * 16 + F.lane] = (F.lane == 0) ? s : 0.f;
        if (F.lane < 8) { float dv = d[0];
#pragma unroll
            for (int g = 1; g < 8; ++g) dv = (F.lane == g) ? d[g] : dv;
            P_GATES[(size_t)row * 8 + F.lane] = rstd * dv + hy_b_in[3072 + F.lane]; }
        GAS unsigned long long* o8 = (GAS unsigned long long*)(xb + (size_t)row * DM) + F.lane;
#pragma unroll
        for (int j = 0; j < 4; ++j) o8[64 * j] = (unsigned long long)pk2(v[j].x, v[j].y) | ((unsigned long long)pk2(v[j].z, v[j].w) << 32);
#if DBG_STOP < 3
        { GAS f32x4* oo = (GAS f32x4*)(F.out + (size_t)row * DM) + F.lane;
#pragma unroll
          for (int j = 0; j < 4; ++j) oo[64 * j] = v[j]; }
#endif
    }
    { const GAS f32x4* ps = (const GAS f32x4*)p; GAS v4u* pd = (GAS v4u*)(ws + WS_PB); const int n8 = 2 * T * 256 / 8;
      for (int i = gw * 64 + F.lane; i < n8; i += NGW * 64) { const f32x4 a = ps[2 * i], b = ps[2 * i + 1]; v4u o; o.x = pk2(a.x, a.y); o.y = pk2(a.z, a.w); o.z = pk2(b.x, b.y); o.w = pk2(b.z, b.w); pd[i] = o; } }
    for (int i = (F.vcu * NWAVES * 64) + F.tid; i < T * 32; i += F.G * NWAVES * 64) { const int t = i >> 5, f = i & 31;
        const double inv = exp2(-(double)f * (13.287712379549449 / 32.0));
        const double ang = (double)pos[t] * inv; const double k = rint(ang * 0.15915494309189535); const float r = (float)(ang - k * 6.283185307179586);
        P_ROPE[(size_t)t * 64 + f] = cosf(r); P_ROPE[(size_t)t * 64 + 32 + f] = sinf(r); }
}

__device__ __forceinline__ void ld8f(const bf16* p, float (&o)[8]) { const v4u v = *(const v4u*)p; o[0] = bflo(v.x); o[1] = bfhi(v.x); o[2] = bflo(v.y); o[3] = bfhi(v.y); o[4] = bflo(v.z); o[5] = bfhi(v.z); o[6] = bflo(v.w); o[7] = bfhi(v.w); }
__device__ __forceinline__ void conv4x8(const bf16* zp, int s, const float* cw, int ldw, const float* cb, float (&out)[8]) {
    { const f32x4 b0 = *(const f32x4*)cb, b1 = *(const f32x4*)(cb + 4); out[0] = b0[0]; out[1] = b0[1]; out[2] = b0[2]; out[3] = b0[3]; out[4] = b1[0]; out[5] = b1[1]; out[6] = b1[2]; out[7] = b1[3]; }
#pragma unroll
    for (int j = 0; j < 4; ++j) if (s - 3 + j >= 0) { float xv[8]; ld8f(zp + (ptrdiff_t)(j - 3) * ZW, xv);
        const f32x4 w0 = *(const f32x4*)(cw + j * ldw), w1 = *(const f32x4*)(cw + j * ldw + 4);
        out[0] += w0[0] * xv[0]; out[1] += w0[1] * xv[1]; out[2] += w0[2] * xv[2]; out[3] += w0[3] * xv[3]; out[4] += w1[0] * xv[4]; out[5] += w1[1] * xv[5]; out[6] += w1[2] * xv[6]; out[7] += w1[3] * xv[7]; }
}
__device__ __forceinline__ v4u pk8f(const float (&a)[8]) { v4u o; o.x = pk2(a[0], a[1]); o.y = pk2(a[2], a[3]); o.z = pk2(a[4], a[5]); o.w = pk2(a[6], a[7]); return o; }
__device__ __forceinline__ float logsig(float f) { return fminf(f, 0.f) - log1pf(expf(-fabsf(f))); }

__device__ __forceinline__ void mlA_unit(Frame& F, int u) { const float* ml_cw = karg(F, 15); const float* ml_cb = karg(F, 16);
    const int c = u & 63, bh = u >> 6, h = bh & 3, b = bh >> 2, tok0 = b * SEQ + c * 64;
    ldsp L = F.lds;
    LAS unsigned short* KT = (LAS unsigned short*)L;
    LAS unsigned short* VT = (LAS unsigned short*)(L + 18432);
    LAS float* WL = (LAS float*)(L + 39168);
    if (F.wave == 0) {
        const int l = F.lane; const float ip = P_GATES[(size_t)(tok0 + l) * 8 + h], fp = P_GATES[(size_t)(tok0 + l) * 8 + 4 + h];
        float bc = logsig(fp);
#pragma unroll
        for (int o = 1; o < 64; o <<= 1) { const float v = __shfl_up(bc, o); if (l >= o) bc += v; }
        const float bl = __shfl(bc, 63); const float g = bl - bc + ip; float mx = g;
#pragma unroll
        for (int o = 32; o > 0; o >>= 1) mx = fmaxf(mx, __shfl_xor(mx, o));
        WL[l] = expf(g - mx);
        if (l == 0) { P_MLOC[u] = mx; P_BLAST[u] = bl; }
    }
    for (int i = F.tid; i < 16 * 64; i += NWAVES * 64) { const int r = i >> 6, l = i & 63; VT[(128 + r) * 72 + l] = (r == 0) ? (unsigned short)0x3F80 : (unsigned short)0; }
    __syncthreads();
    { const int ch = F.tid & 15;
#pragma unroll
      for (int it = 0; it < 2; ++it) { const int l = (F.tid >> 4) + 32 * it, tok = tok0 + l, s = c * 64 + l;
        float kc[8]; conv4x8(P_Z + (size_t)tok * ZW + 1536 + 128 * h + 8 * ch, s, ml_cw + 512 + 128 * h + 8 * ch, 1024, ml_cb + 512 + 128 * h + 8 * ch, kc);
        const float wl = WL[l] * 0.08838834764831845f;
#pragma unroll
        for (int i = 0; i < 8; ++i) KT[(8 * ch + i) * 72 + l] = f2bf1(fsilu(kc[i]) * wl);
        const v4u vv = *(const v4u*)(P_Z + (size_t)tok * ZW + 2048 + 128 * h + 8 * ch);
        VT[(8 * ch + 0) * 72 + l] = (unsigned short)(vv.x & 0xffffu); VT[(8 * ch + 1) * 72 + l] = (unsigned short)(vv.x >> 16);
        VT[(8 * ch + 2) * 72 + l] = (unsigned short)(vv.y & 0xffffu); VT[(8 * ch + 3) * 72 + l] = (unsigned short)(vv.y >> 16);
        VT[(8 * ch + 4) * 72 + l] = (unsigned short)(vv.z & 0xffffu); VT[(8 * ch + 5) * 72 + l] = (unsigned short)(vv.z >> 16);
        VT[(8 * ch + 6) * 72 + l] = (unsigned short)(vv.w & 0xffffu); VT[(8 * ch + 7) * 72 + l] = (unsigned short)(vv.w >> 16); } }
    __syncthreads();
    { const int fr = F.lane & 15, fq = F.lane >> 4, w = F.wave;
      bf16x8 a[2];
#pragma unroll
      for (int ks = 0; ks < 2; ++ks) a[ks] = *(const LAS bf16x8*)(L + (16 * w + fr) * 144 + (32 * ks + 8 * fq) * 2);
#pragma unroll
      for (int nt = 0; nt < 9; ++nt) { f32x4 acc = {0.f, 0.f, 0.f, 0.f};
#pragma unroll
        for (int ks = 0; ks < 2; ++ks) { const bf16x8 bb = *(const LAS bf16x8*)(L + 18432 + (16 * nt + fr) * 144 + (32 * ks + 8 * fq) * 2); acc = MFMA16(a[ks], bb, acc); }
        if (nt < 8) { v2u o; o.x = pk2(acc[0], acc[1]); o.y = pk2(acc[2], acc[3]); *(v2u*)(P_CST + (size_t)u * 16384 + (16 * nt + fr) * 128 + 16 * w + 4 * fq) = o; }
        else if (fr == 0) { *(f32x4*)(P_NLOC + (size_t)u * 128 + 16 * w + 4 * fq) = acc; } } }
    __syncthreads();
}

__device__ __forceinline__ void mlC_unit(Frame& F, int u) { const float* ml_cw = karg(F, 15); const float* ml_cb = karg(F, 16); const float* ml_norm = karg(F, 17);
    const int c = u & 63, bh = u >> 6, h = bh & 3, b = bh >> 2, tok0 = b * SEQ + c * 64;
    ldsp L = F.lds;
    constexpr int QI = 0, KI = 17408, VTO = 34816, SQO = 53248, HFO = 62464, ARR = 96256;
    LAS unsigned short* VT = (LAS unsigned short*)(L + VTO); LAS unsigned short* SQ = (LAS unsigned short*)(L + SQO); LAS float* HF = (LAS float*)(L + HFO);
    LAS float* DV = (LAS float*)(L + ARR); LAS float* MU = DV + 64; LAS float* AI = DV + 128; LAS float* EM = DV + 192; LAS float* DENP = DV + 256  ; LAS float* DNI = DV + 384; LAS float* NP = DV + 448  ;
    if (F.wave == 0) {
        const int l = F.lane; const float ip = P_GATES[(size_t)(tok0 + l) * 8 + h], fp = P_GATES[(size_t)(tok0 + l) * 8 + 4 + h];
        float bc = logsig(fp);
#pragma unroll
        for (int o = 1; o < 64; o <<= 1) { const float v = __shfl_up(bc, o); if (l >= o) bc += v; }
        const float mp = P_MPREV[u]; const float dv = ip - bc; float cm = dv;
#pragma unroll
        for (int o = 1; o < 64; o <<= 1) { const float v = __shfl_up(cm, o); if (l >= o) cm = fmaxf(cm, v); }
        const float bm = bc + mp, mt = fmaxf(bm, bc + cm);
        AI[l] = expf(bm - mt); MU[l] = mt - bc; DV[l] = dv; EM[l] = expf(-mt);
    }
    if (F.tid >= 128 && F.tid < 256) NP[F.tid - 128] = P_NPREV[(size_t)u * 128 + F.tid - 128];
    { const int ch = F.tid & 15;
#pragma unroll
      for (int it = 0; it < 2; ++it) { const int l = (F.tid >> 4) + 32 * it, tok = tok0 + l, s = c * 64 + l;
        float qc[8], kc[8];
        conv4x8(P_Z + (size_t)tok * ZW + 1024 + 128 * h + 8 * ch, s, ml_cw + 128 * h + 8 * ch, 1024, ml_cb + 128 * h + 8 * ch, qc);
        conv4x8(P_Z + (size_t)tok * ZW + 1536 + 128 * h + 8 * ch, s, ml_cw + 512 + 128 * h + 8 * ch, 1024, ml_cb + 512 + 128 * h + 8 * ch, kc);
#pragma unroll
        for (int i = 0; i < 8; ++i) { qc[i] = fsilu(qc[i]); kc[i] = fsilu(kc[i]) * 0.08838834764831845f; }
        *(LAS v4u*)(L + QI + l * 272 + 16 * ch) = pk8f(qc); *(LAS v4u*)(L + KI + l * 272 + 16 * ch) = pk8f(kc);
        const v4u vv = *(const v4u*)(P_Z + (size_t)tok * ZW + 2048 + 128 * h + 8 * ch);
        VT[(8 * ch + 0) * 72 + l] = (unsigned short)(vv.x & 0xffffu); VT[(8 * ch + 1) * 72 + l] = (unsigned short)(vv.x >> 16);
        VT[(8 * ch + 2) * 72 + l] = (unsigned short)(vv.y & 0xffffu); VT[(8 * ch + 3) * 72 + l] = (unsigned short)(vv.y >> 16);
        VT[(8 * ch + 4) * 72 + l] = (unsigned short)(vv.z & 0xffffu); VT[(8 * ch + 5) * 72 + l] = (unsigned short)(vv.z >> 16);
        VT[(8 * ch + 6) * 72 + l] = (unsigned short)(vv.w & 0xffffu); VT[(8 * ch + 7) * 72 + l] = (unsigned short)(vv.w >> 16); } }
    __syncthreads();
    const int fr = F.lane & 15, fq = F.lane >> 4, w = F.wave, tt = w >> 1;
    {
      float rs[4] = {0.f, 0.f, 0.f, 0.f};
#pragma unroll
      for (int si = 0; si < 2; ++si) { const int st = 2 * (w & 1) + si; f32x4 acc = {0.f, 0.f, 0.f, 0.f};
#pragma unroll
        for (int ks = 0; ks < 4; ++ks) { const bf16x8 a = *(const LAS bf16x8*)(L + QI + (16 * tt + fr) * 272 + (32 * ks + 8 * fq) * 2), bb = *(const LAS bf16x8*)(L + KI + (16 * st + fr) * 272 + (32 * ks + 8 * fq) * 2); acc = MFMA16(a, bb, acc); }
        const int s = 16 * st + fr; const float dvs = DV[s];
#pragma unroll
        for (int r = 0; r < 4; ++r) { const int t = 16 * tt + 4 * fq + r; const float wgt = (s <= t) ? __expf(dvs - MU[t]) : 0.f; const float v = acc[r] * wgt; rs[r] += v; SQ[t * 72 + s] = f2bf1(v); } }
#pragma unroll
      for (int r = 0; r < 4; ++r) { float v = rs[r]; v += __shfl_xor(v, 1); v += __shfl_xor(v, 2); v += __shfl_xor(v, 4); v += __shfl_xor(v, 8); if (fr == 0) DENP[(w & 1) * 64 + 16 * tt + 4 * fq + r] = v; }
      const int t = F.tid >> 3, part = F.tid & 7; float acc = 0.f;
      { const v4u v0 = *(const LAS v4u*)(L + QI + t * 272 + 32 * part), v1 = *(const LAS v4u*)(L + QI + t * 272 + 32 * part + 16);
        const float q0[8] = {bflo(v0.x), bfhi(v0.x), bflo(v0.y), bfhi(v0.y), bflo(v0.z), bfhi(v0.z), bflo(v0.w), bfhi(v0.w)};
        const float q1[8] = {bflo(v1.x), bfhi(v1.x), bflo(v1.y), bfhi(v1.y), bflo(v1.z), bfhi(v1.z), bflo(v1.w), bfhi(v1.w)};
#pragma unroll
        for (int i = 0; i < 8; ++i) acc += q0[i] * NP[16 * part + i] + q1[i] * NP[16 * part + 8 + i]; }
      acc += __shfl_xor(acc, 1); acc += __shfl_xor(acc, 2); acc += __shfl_xor(acc, 4);
      if (part == 0) DNI[t] = acc; }
    __syncthreads();
    {
#pragma unroll
      for (int ei = 0; ei < 4; ++ei) { const int et = 4 * (w & 1) + ei; f32x4 ai_ = {0.f, 0.f, 0.f, 0.f}, ax = {0.f, 0.f, 0.f, 0.f};
#pragma unroll
        for (int ks = 0; ks < 2; ++ks) { const bf16x8 a = *(const LAS bf16x8*)(L + SQO + (16 * tt + fr) * 144 + (32 * ks + 8 * fq) * 2), bb = *(const LAS bf16x8*)(L + VTO + (16 * et + fr) * 144 + (32 * ks + 8 * fq) * 2); ai_ = MFMA16(a, bb, ai_); }
#pragma unroll
        for (int ks = 0; ks < 4; ++ks) { const bf16x8 a = *(const LAS bf16x8*)(L + QI + (16 * tt + fr) * 272 + (32 * ks + 8 * fq) * 2), bb = *(const bf16x8*)(P_CST + (size_t)u * 16384 + (16 * et + fr) * 128 + 32 * ks + 8 * fq); ax = MFMA16(a, bb, ax); }
#pragma unroll
        for (int r = 0; r < 4; ++r) { const int t = 16 * tt + 4 * fq + r; const float aint = AI[t]; const float den = DENP[t] + DENP[64 + t] + aint * DNI[t]; const float dd = fmaxf(fabsf(den), EM[t]);
            HF[t * 132 + 16 * et + fr] = (ai_[r] + aint * ax[r]) / dd; } } }
    __syncthreads();
    {
      const int t = F.tid >> 3, part = F.tid & 7; f32x4 hv[4]; float ss = 0.f;
#pragma unroll
      for (int i = 0; i < 4; ++i) { hv[i] = *(const LAS f32x4*)(HF + t * 132 + 16 * part + 4 * i); ss += pg8::dot4(hv[i]); }
      ss += __shfl_xor(ss, 1); ss += __shfl_xor(ss, 2); ss += __shfl_xor(ss, 4);
      const float rstd = rsqrtf(ss * (1.0f / 128.0f) + 1e-6f);
      const bf16* op = P_Z + (size_t)(tok0 + t) * ZW + 2560 + 128 * h + 16 * part; float o0[8], o1[8]; ld8f(op, o0); ld8f(op + 8, o1);
      const float* gp = ml_norm + 128 * h + 16 * part; float y0[8], y1[8];
#pragma unroll
      for (int i = 0; i < 8; ++i) { y0[i] = hv[i >> 2][i & 3] * rstd * gp[i] * fsigmoid(o0[i]); y1[i] = hv[2 + (i >> 2)][i & 3] * rstd * gp[8 + i] * fsigmoid(o1[i]); }
      bf16* yp = P_YBUF + (size_t)(tok0 + t) * DM + 512 + 128 * h + 16 * part; *(v4u*)yp = pk8f(y0); *(v4u*)(yp + 8) = pk8f(y1); }
    __syncthreads();
}

template <bool FINAL> __device__ __forceinline__ void rg_unit(Frame& F, int u) { const float* rg_cw = karg(F, 8); const float* rg_cb = karg(F, 9); const float* rg_ba = karg(F, 11); const float* rg_bx = karg(F, 13); const float* rg_lam = karg(F, 14);
    const int n = u & 7, bc = u >> 3, c = bc & 63, b = bc >> 6, tok0 = b * SEQ + c * 64;
    ldsp L = F.lds;
    constexpr int XC = 0, XFO = 9216, AAO = 25856, MMO = 42496, IXO = 59136, SPO = 75776, SHO = 77824;
    LAS float* XF = (LAS float*)(L + XFO); LAS float* AA = (LAS float*)(L + AAO); LAS float* MM = (LAS float*)(L + MMO); LAS float* IX = (LAS float*)(L + IXO); LAS float* SP = (LAS float*)(L + SPO); LAS float* SH = (LAS float*)(L + SHO);
    { const int t = F.tid >> 3, chk = F.tid & 7; float xc[8];
      conv4x8(P_Z + (size_t)(tok0 + t) * ZW + 64 * n + 8 * chk, c * 64 + t, rg_cw + 64 * n + 8 * chk, 512, rg_cb + 64 * n + 8 * chk, xc);
      *(LAS v4u*)(L + XC + t * 144 + 16 * chk) = pk8f(xc);
#pragma unroll
      for (int i = 0; i < 8; ++i) XF[t * 65 + 8 * chk + i] = xc[i]; }
    __syncthreads();
    { const int fr = F.lane & 15, fq = F.lane >> 4, gate = F.wave >> 2, tt = F.wave & 3;
      const bf16* Wg = P_RGW + (size_t)(gate * 8 + n) * 4096;
      bf16x8 a[2];
#pragma unroll
      for (int ks = 0; ks < 2; ++ks) a[ks] = *(const LAS bf16x8*)(L + XC + (16 * tt + fr) * 144 + (32 * ks + 8 * fq) * 2);
#pragma unroll
      for (int jt = 0; jt < 4; ++jt) { f32x4 acc = {0.f, 0.f, 0.f, 0.f};
#pragma unroll
        for (int ks = 0; ks < 2; ++ks) { const bf16x8 bb = *(const bf16x8*)(Wg + (16 * jt + fr) * 64 + 32 * ks + 8 * fq); acc = MFMA16(a[ks], bb, acc); }
        const int j = 16 * jt + fr, chn = 64 * n + j;
        if (gate == 0) { const float bias = rg_ba[chn], sp8 = 8.0f * log1pf(expf(-rg_lam[chn]));
#pragma unroll
            for (int r = 0; r < 4; ++r) { const int t = 16 * tt + 4 * fq + r; const float sg = 1.0f / (1.0f + expf(-(acc[r] + bias))); const float la = -sg * sp8; AA[t * 65 + j] = expf(la); MM[t * 65 + j] = sqrtf(-expm1f(2.0f * la)); } }
        else { const float bias = rg_bx[chn];
#pragma unroll
            for (int r = 0; r < 4; ++r) { const int t = 16 * tt + 4 * fq + r; const float sg = 1.0f / (1.0f + expf(-(acc[r] + bias))); IX[t * 65 + j] = sg * XF[t * 65 + j]; } } } }
    __syncthreads();
    const int ch = F.tid & 63, sub = F.wave;
    { float P = 1.f, hl = 0.f;
#pragma unroll
      for (int k = 0; k < 8; ++k) { const int t = 8 * sub + k; const float a = AA[t * 65 + ch], uu = MM[t * 65 + ch] * IX[t * 65 + ch]; hl = a * hl + uu; P *= a; }
      SP[sub * 64 + ch] = P; SH[sub * 64 + ch] = hl; }
    __syncthreads();
    if (!FINAL) {
        if (sub == 0) { float P = 1.f, hh = 0.f;
#pragma unroll
            for (int s = 0; s < 8; ++s) { const float ps = SP[s * 64 + ch]; hh = ps * hh + SH[s * 64 + ch]; P *= ps; }
            P_RGA[(size_t)bc * 512 + 64 * n + ch] = P; P_RGH[(size_t)bc * 512 + 64 * n + ch] = hh; }
    } else {
        float hin = P_RGC[(size_t)bc * 512 + 64 * n + ch];
#pragma unroll
        for (int s = 0; s < 8; ++s) if (s < sub) hin = SP[s * 64 + ch] * hin + SH[s * 64 + ch];
#pragma unroll
        for (int k = 0; k < 8; ++k) { const int t = 8 * sub + k; const float a = AA[t * 65 + ch], uu = MM[t * 65 + ch] * IX[t * 65 + ch]; hin = a * hin + uu;
            const float gr = bf2f(P_Z[(size_t)(tok0 + t) * ZW + 512 + 64 * n + ch]);
            P_YBUF[(size_t)(tok0 + t) * DM + 64 * n + ch] = f2bf1(hin * gelu_tanh(gr)); }
    }
    __syncthreads();
}

__device__ __forceinline__ void mixB_unit(Frame& F, int unit) {
    const int bh = unit >> 3, sl = unit & 7; ldsp L = F.lds;
    LAS float* AP = (LAS float*)L; LAS float* AL = AP + 64;
    if (F.wave == 0) { float mst = -INFINITY;
        for (int c = 0; c < 64; ++c) { const float ml = P_MLOC[bh * 64 + c], bl = P_BLAST[bh * 64 + c]; const float mn = fmaxf(bl + mst, ml);
            if (F.lane == 0) { AP[c] = expf(bl + mst - mn); AL[c] = expf(ml - mn); if (sl == 0) P_MPREV[bh * 64 + c] = mst; }
            mst = mn; } }
    __syncthreads();
    { float st[4] = {0.f, 0.f, 0.f, 0.f}; bf16* base = P_CST + (size_t)bh * 64 * 16384 + sl * 2048 + F.tid * 4;
      for (int c0 = 0; c0 < 64; c0 += 8) { v2u cl[8];
#pragma unroll
        for (int k = 0; k < 8; ++k) cl[k] = *(const v2u*)(base + (size_t)(c0 + k) * 16384);
#pragma unroll
        for (int k = 0; k < 8; ++k) { v2u o; o.x = pk2(st[0], st[1]); o.y = pk2(st[2], st[3]); *(v2u*)(base + (size_t)(c0 + k) * 16384) = o;
            const float ap = AP[c0 + k], al = AL[c0 + k];
            st[0] = ap * st[0] + al * bflo(cl[k].x); st[1] = ap * st[1] + al * bfhi(cl[k].x); st[2] = ap * st[2] + al * bflo(cl[k].y); st[3] = ap * st[3] + al * bfhi(cl[k].y); } } }
    if (sl == 0 && F.tid < 128) { float ns = 0.f;
        for (int c = 0; c < 64; ++c) { const size_t o = (size_t)(bh * 64 + c) * 128 + F.tid; const float nl = P_NLOC[o]; P_NPREV[o] = ns; ns = AP[c] * ns + AL[c] * nl; } }
    if (F.tid < 16) { const int idx = unit * 16 + F.tid, b = idx >> 9, chn = idx & 511; float cr = 0.f;
        for (int c = 0; c < 64; ++c) { const size_t o = (size_t)(b * 64 + c) * 512 + chn; P_RGC[o] = cr; cr = P_RGA[o] * cr + P_RGH[o]; } }
    __syncthreads();
}

__device__ __forceinline__ void attn_unit(Frame& F, int u, const bf16* Qb, const bf16* Kb, const bf16* Vb, bf16* Ob) { const float* at_sinks = karg(F, 22);
    const int qb = u & 31, kvh = (u >> 5) & 3, b = u >> 7; const int row0 = b * SEQ + 128 * qb;
    ldsp L = F.lds;
    constexpr int KI = 0, VTO = 36864;
    LAS unsigned short* VT = (LAS unsigned short*)(L + VTO);
#pragma unroll
    for (int it = 0; it < 4; ++it) { const int idx = F.tid + 512 * it, kr = idx >> 3, chk = idx & 7; const bool ok = (qb > 0) || (kr >= 128);
        v4u kv = {0u, 0u, 0u, 0u}, vv = {0u, 0u, 0u, 0u};
        if (ok) { const size_t o = (size_t)(row0 - 128 + kr) * 256 + 64 * kvh + 8 * chk; kv = *(const v4u*)(Kb + o); vv = *(const v4u*)(Vb + o); }
        *(LAS v4u*)(L + KI + kr * 144 + 16 * chk) = kv;
        VT[(8 * chk + 0) * 260 + kr] = (unsigned short)(vv.x & 0xffffu); VT[(8 * chk + 1) * 260 + kr] = (unsigned short)(vv.x >> 16);
        VT[(8 * chk + 2) * 260 + kr] = (unsigned short)(vv.y & 0xffffu); VT[(8 * chk + 3) * 260 + kr] = (unsigned short)(vv.y >> 16);
        VT[(8 * chk + 4) * 260 + kr] = (unsigned short)(vv.z & 0xffffu); VT[(8 * chk + 5) * 260 + kr] = (unsigned short)(vv.z >> 16);
        VT[(8 * chk + 6) * 260 + kr] = (unsigned short)(vv.w & 0xffffu); VT[(8 * chk + 7) * 260 + kr] = (unsigned short)(vv.w >> 16); }
    __syncthreads();
    const int r = F.lane & 31, hh = F.lane >> 5, w = F.wave, head = 4 * kvh + (w >> 1);
    const float sink = at_sinks[head];
#pragma unroll 1
    for (int qt = 0; qt < 2; ++qt) {
        const int q0 = 64 * (w & 1) + 32 * qt, kt0 = q0 >> 5; const size_t qrow = (size_t)(row0 + q0 + r);
        bf16x8 qf[4];
#pragma unroll
        for (int ks = 0; ks < 4; ++ks) qf[ks] = *(const bf16x8*)(Qb + qrow * 1024 + 64 * head + 16 * ks + 8 * hh);
        f32x16 S[5];
#pragma unroll
        for (int i = 0; i < 5; ++i) {
#pragma unroll
            for (int e = 0; e < 16; ++e) S[i][e] = 0.f;
#pragma unroll
            for (int ks = 0; ks < 4; ++ks) { const bf16x8 kf = *(const LAS bf16x8*)(L + KI + (32 * (kt0 + i) + r) * 144 + (16 * ks + 8 * hh) * 2); S[i] = MFMA32(kf, qf[ks], S[i]); } }
        float mx = sink;
#pragma unroll
        for (int i = 0; i < 5; ++i)
#pragma unroll
            for (int e = 0; e < 16; ++e) { const int cr = (e & 3) + 8 * (e >> 2) + 4 * hh; bool ok = true;
                if (i == 0) ok = cr > r; if (i == 4) ok = cr <= r;
                if (qb == 0) ok = ok && (32 * (kt0 + i) + cr >= 128);
                const float v = ok ? S[i][e] : -INFINITY; S[i][e] = v; mx = fmaxf(mx, v); }
        mx = fmaxf(mx, __shfl_xor(mx, 32));
        float sum = 0.f;
#pragma unroll
        for (int i = 0; i < 5; ++i)
#pragma unroll
            for (int e = 0; e < 16; ++e) { const float p = __expf(S[i][e] - mx); S[i][e] = p; sum += p; }
        sum += __shfl_xor(sum, 32); sum += __expf(sink - mx);
        const float inv = 1.0f / sum;
        f32x16 O[2];
#pragma unroll
        for (int e = 0; e < 16; ++e) { O[0][e] = 0.f; O[1][e] = 0.f; }
#pragma unroll
        for (int i = 0; i < 5; ++i)
#pragma unroll
            for (int s = 0; s < 2; ++s) {
                v4u pw; pw.x = pk2(S[i][8 * s + 0], S[i][8 * s + 1]); pw.y = pk2(S[i][8 * s + 2], S[i][8 * s + 3]); pw.z = pk2(S[i][8 * s + 4], S[i][8 * s + 5]); pw.w = pk2(S[i][8 * s + 6], S[i][8 * s + 7]);
                const bf16x8 pf = __builtin_bit_cast(bf16x8, pw);
#pragma unroll
                for (int dt = 0; dt < 2; ++dt) { const int ko = (32 * dt + r) * 520 + (32 * (kt0 + i) + 16 * s + 4 * hh) * 2;
                    const s16x4 lo = *(const LAS s16x4*)(L + VTO + ko), hi = *(const LAS s16x4*)(L + VTO + ko + 16);
                    const bf16x8 vf = __builtin_shufflevector(lo, hi, 0, 1, 2, 3, 4, 5, 6, 7);
                    O[dt] = MFMA32(vf, pf, O[dt]); } }
        bf16* op = Ob + qrow * 1024 + 64 * head + 4 * hh;
#pragma unroll
        for (int dt = 0; dt < 2; ++dt)
#pragma unroll
            for (int g4 = 0; g4 < 4; ++g4) { v2u o; o.x = pk2(O[dt][4 * g4] * inv, O[dt][4 * g4 + 1] * inv); o.y = pk2(O[dt][4 * g4 + 2] * inv, O[dt][4 * g4 + 3] * inv); *(v2u*)(op + 32 * dt + 8 * g4) = o; }
    }
    __syncthreads();
}

__device__ __forceinline__ void fixup_phase(Frame& F, const float* cw, const float* cb, bf16* A2, const bf16* GH, const bf16* UH, const bf16* GT) {
    constexpr int TOTAL = (T / 64) * 2 * 384;
    for (int idx = F.vcu * NWAVES * 64 + F.tid; idx < TOTAL; idx += F.G * NWAVES * 64) {
        const int chk = idx % 384, rg = idx / 384, rr = rg & 1, grp = rg >> 1, ch0 = 8 * chk; const bool first = (grp & 63) == 0;
        float g0[8], u0[8], p1[8], p2[8];
        ld8f(GH + ((size_t)grp * 2 + rr) * 3072 + ch0, g0); ld8f(UH + ((size_t)grp * 2 + rr) * 3072 + ch0, u0);
#pragma unroll
        for (int i = 0; i < 8; ++i) { p1[i] = 0.f; p2[i] = 0.f; }
        if (rr == 1) { ld8f(GH + ((size_t)grp * 2) * 3072 + ch0, p1); if (!first) ld8f(GT + ((size_t)(grp - 1) * 2 + 1) * 3072 + ch0, p2); }
        else if (!first) { ld8f(GT + ((size_t)(grp - 1) * 2 + 1) * 3072 + ch0, p1); ld8f(GT + ((size_t)(grp - 1) * 2) * 3072 + ch0, p2); }
        float o[8];
#pragma unroll
        for (int i = 0; i < 8; ++i) { const float y = cw[ch0 + i] * p2[i] + cw[3072 + ch0 + i] * p1[i] + cw[6144 + ch0 + i] * g0[i] + cb[ch0 + i]; o[i] = gelu_tanh(y) * u0[i]; }
        *(v4u*)(A2 + ((size_t)grp * 64 + rr) * 3072 + ch0) = pk8f(o);
    }
}


#define GRID_BAR() xcd_barrier(bar)
template <int L> __device__ __forceinline__ bool layer_part(Frame& F, const XcdBarrier& bar) {
    constexpr int l = L;
    unsigned char* ws = F.ws; const int bx = (int)blockIdx.x;
    bf16* const XBA = (bf16*)(ws + WS_XBA); bf16* const XBB = (bf16*)(ws + WS_XBB);
    float* const SSA = (float*)(ws + WS_SSA); float* const SSB = (float*)(ws + WS_SSB);
    bf16* const PP = (bf16*)(ws + WS_CST); bf16* const A2 = (bf16*)(ws + WS_BIG);

        if (l == 1) {
            bf16* const Qb = (bf16*)(ws + WS_BIG); bf16* const Kb = (bf16*)(ws + WS_BIG + 64 * MiB); bf16* const Vb = (bf16*)(ws + WS_BIG + 80 * MiB); bf16* const Ob = (bf16*)(ws + WS_BIG + 96 * MiB);
PREP(7) {
            { pg8::Gemm g{XBB, (const bf16*)(ws + WS_WQKV), T, 1536, DM}; pg8::StaticOrder S; S.init(T, 1536, F.G, bx);
              pg8::EpiQkv E{SSB, P_ROPE, karg(F, 20), karg(F, 21), Qb, Kb, Vb};
              pg8::gemm_phase<pg8::EpiQkv, pg8::StaticOrder, true, true>(F.lds, g, S, E); }
            { pg8::Gemm g{(const bf16*)(ws + WS_PB) + (size_t)T * 256, (const bf16*)(ws + WS_WPJ1), T, DM, 256}; pg8::StaticOrder S; S.init(T, DM, F.G, bx);
              pg8::EpiZ E{PP, DM, nullptr, nullptr};
              pg8::gemm_phase<pg8::EpiZ, pg8::StaticOrder, true, true>(F.lds, g, S, E); }
            GRID_BAR();
    }

            PREP(8) {
            for (int u = F.vcu; u < 1024; u += F.G) attn_unit(F, u, Qb, Kb, Vb, Ob);
            GRID_BAR();
            }
            { pg8::Gemm g{Ob, (const bf16*)(ws + WS_WO1), T, DM, DM}; pg8::StaticOrder S; S.init(T, DM, F.G, bx);
              pg8::EpiRes<false> E{XBB, XBA, SSA};
              pg8::gemm_phase<pg8::EpiRes<false>, pg8::StaticOrder, true, true>(F.lds, g, S, E); }
            GRID_BAR();
            if (DBG_STOP == 9) return true;
        } else {
PREP(3) {
            { pg8::Gemm g{P_YBUF, (const bf16*)(ws + WS_WOUT0), T, DM, DM}; pg8::StaticOrder S; S.init(T, DM, F.G, bx);
              pg8::EpiRes<true> E{karg(F, 0), XBB, SSB};
              pg8::gemm_phase<pg8::EpiRes<true>, pg8::StaticOrder, true, true>(F.lds, g, S, E); }
            { pg8::Gemm g{(const bf16*)(ws + WS_PB), (const bf16*)(ws + WS_WPJ0), T, DM, 256}; pg8::StaticOrder S; S.init(T, DM, F.G, bx);
              pg8::EpiZ E{PP, DM, nullptr, nullptr};
              pg8::gemm_phase<pg8::EpiZ, pg8::StaticOrder, true, true>(F.lds, g, S, E); }
            GRID_BAR();
    }

            if (DBG_STOP == 3) return true;
        }
        const bf16* xin = l ? XBA : XBB; const float* ssin = l ? SSA : SSB; bf16* side = l ? XBB : XBA;
        bf16* const GH = side; bf16* const UH = side + (size_t)3 * MiB; bf16* const GT = side + (size_t)6 * MiB;
        const float* cw = karg(F, 25) + (size_t)l * 3 * 3072; const float* cb = karg(F, 26) + (size_t)l * 3072;
        PREP(10 + 10 * l) {
        { pg8::Gemm g{xin, (const bf16*)(ws + (l ? WS_WUP1 : WS_WUP0)), T, 2 * FFD, DM}; pg8::StaticOrder S; S.init(T, 2 * FFD, F.G, bx);
          pg8::EpiUp E{ssin, cw, cb, A2, GH, UH, GT};
          pg8::gemm_phase<pg8::EpiUp, pg8::StaticOrder, true, true>(F.lds, g, S, E); }
        GRID_BAR();
        }
        PREP(11 + 10 * l) {
        fixup_phase(F, cw, cb, A2, GH, UH, GT);
        GRID_BAR();
        }
        bf16* const xdn = l ? XBB : XBA; float* const ssdn = l ? SSB : SSA;
        { pg8::Gemm g{A2, (const bf16*)(ws + (l ? WS_WDN1 : WS_WDN0)), T, DM, FFD}; pg8::StaticOrder S; S.init(T, DM, F.G, bx);
          pg8::EpiRes<false> E{xin, xdn, ssdn};
          pg8::gemm_phase<pg8::EpiRes<false>, pg8::StaticOrder, true, true>(F.lds, g, S, E); }
        GRID_BAR();
        if ((l == 0 && DBG_STOP == 5) || (l == 1 && DBG_STOP == 11)) return true;
        { pg8::Gemm g{xdn, (const bf16*)(ws + (l ? WS_WGT1 : WS_WGT0)), T, DM, DM}; pg8::StaticOrder S; S.init(T, DM, F.G, bx);
          pg8::EpiPle<(L == 1)> E{ssdn, PP, xdn, XBB, SSB, F.out};
          pg8::gemm_phase<pg8::EpiPle<(L == 1)>, pg8::StaticOrder, true, true>(F.lds, g, S, E); }
        if (l == 0) GRID_BAR();
        if (l == 0 && DBG_STOP == 6) return true;

    return false;
}
struct Args { const void* in[30]; float* out; unsigned char* ws; };
__global__ void __launch_bounds__(NWAVES * 64, 2) hy_fwd(Args args) {
    extern __shared__ __attribute__((aligned(16))) unsigned char lds[];
    Frame F;
    F.lds = (ldsp)lds; F.MISC = (volatile LAS unsigned*)(F.lds + MISC_OFF);
    F.tid = threadIdx.x; F.lane = F.tid & 63; F.wave = __builtin_amdgcn_readfirstlane(F.tid >> 6);
    F.G = gridDim.x; { const int bx = blockIdx.x; F.vcu = (F.G % 8 == 0) ? (bx % 8) * (F.G / 8) + bx / 8 : bx; }
    unsigned char* ws = args.ws; F.ws = ws; F.out = args.out;
    F.kb = (unsigned long long)__builtin_amdgcn_kernarg_segment_ptr();
    for (int i = F.tid; i < (LDS_BYTES - LDSCTL_OFF) / 4; i += NWAVES * 64) ((LAS unsigned*)(F.lds + LDSCTL_OFF))[i] = 0u;
    __syncthreads();
    XcdBarrier bar = xcd_barrier_post((unsigned*)(ws + WS_CTL) + CW_BAR, F.MISC + 8);
    bf16* const XBA = (bf16*)(ws + WS_XBA); bf16* const XBB = (bf16*)(ws + WS_XBB);
    float* const SSA = (float*)(ws + WS_SSA); float* const SSB = (float*)(ws + WS_SSB);
    bf16* const PP = (bf16*)(ws + WS_CST); bf16* const A2 = (bf16*)(ws + WS_BIG);
    const int bx = (int)blockIdx.x;

    PREP(100) {
    p0_prologue(F);
    GRID_BAR();
    }
#if DBG_STOP >= 1
PREP(1) {
    { pg8::Gemm g{XBA, (const bf16*)(ws + WS_WIN), T, ZW, DM}; pg8::StaticOrder S; S.init(T, ZW, F.G, bx);
#if PROBE_PHASE == 1 && defined(PROBE_VARIANT)
      if (rep_ < PROBE_N) {
#if PROBE_VARIANT == 1
        pg8::EpiNone E0{}; pg8::gemm_phase<pg8::EpiNone, pg8::StaticOrder, true, true>(F.lds, g, S, E0);
#else
        pg8::EpiZ E0{P_Z, ZW, nullptr, nullptr}; pg8::gemm_phase<pg8::EpiZ, pg8::StaticOrder, true, true>(F.lds, g, S, E0);
#endif
      } else
#endif
      { pg8::EpiZ E{P_Z, ZW, karg(F, 7), SSA};
      pg8::gemm_phase<pg8::EpiZ, pg8::StaticOrder, true, true>(F.lds, g, S, E); } }
    GRID_BAR();
    }

    PREP(2) {
    for (int u = F.vcu; u < 2048 + 4096; u += F.G) { if (u < 2048) mlA_unit(F, u); else rg_unit<false>(F, u - 2048); }
    GRID_BAR();
    }
    for (int u = F.vcu; u < 256; u += F.G) mixB_unit(F, u);
    GRID_BAR();
    PREP(4) {
    for (int u = F.vcu; u < 2048 + 4096; u += F.G) { if (u < 2048) mlC_unit(F, u); else rg_unit<true>(F, u - 2048); }
    GRID_BAR();
    }
#endif
    PREP(99) { if (rep_ > 0) GRID_BAR(); }
#if DBG_STOP >= 3
    if (layer_part<0>(F, bar)) return;
    if (layer_part<1>(F, bar)) return;
#endif
}

extern "C" void kernel_launch(void* const* d_in, const int* in_sizes, int n_in, void* d_out, int out_size, void* d_ws, size_t ws_size, hipStream_t stream) {
    static int grid = 0;
    if (grid == 0) {
        if (n_in != 30 || in_sizes[0] != T * DM || out_size != T * DM || ws_size < WS_END) { fprintf(stderr, "kernel_launch: unexpected shapes (n_in %d, in0 %d, out %d, ws %zu < %zu); nothing launched\n", n_in, n_in > 0 ? in_sizes[0] : -1, out_size, ws_size, (size_t)WS_END); grid = -1; return; }
        int dev = 0, cus = 0, per_cu = 0;
        if (hipGetDevice(&dev) != hipSuccess || hipDeviceGetAttribute(&cus, hipDeviceAttributeMultiprocessorCount, dev) != hipSuccess) { fprintf(stderr, "kernel_launch: device query failed\n"); grid = -1; return; }
        if (hipFuncSetAttribute((const void*)hy_fwd, hipFuncAttributeMaxDynamicSharedMemorySize, LDS_BYTES) != hipSuccess) { fprintf(stderr, "kernel_launch: hipFuncSetAttribute failed\n"); grid = -1; return; }
        if (hipOccupancyMaxActiveBlocksPerMultiprocessor(&per_cu, (const void*)hy_fwd, NWAVES * 64, LDS_BYTES) != hipSuccess || per_cu < 1) { fprintf(stderr, "kernel_launch: occupancy query says %d workgroups per CU; nothing launched\n", per_cu); (void)hipGetLastError(); grid = -1; return; }
        grid = cus;
    }
    if (grid < 0) return;
    if (hipMemsetAsync((char*)d_ws + WS_CTL, 0, CTL_ZERO_BYTES, stream) != hipSuccess) { fprintf(stderr, "kernel_launch: hipMemsetAsync failed\n"); return; }
    Args a{};
    for (int i = 0; i < 30; ++i) a.in[i] = d_in[i];
    a.out = (float*)d_out; a.ws = (unsigned char*)d_ws;
    hipLaunchKernelGGL(hy_fwd, dim3(grid), dim3(NWAVES * 64), LDS_BYTES, stream, a);
    const hipError_t le = hipPeekAtLastError();
    if (le != hipSuccess) fprintf(stderr, "kernel_launch: launch failed: %s\n", hipGetErrorName(le));
}
```

```cpp
#include <hip/hip_runtime.h>
#include <cstdio>
#include <cstdint>
#include <cmath>
namespace pg8 {
#define PG8_LAS __attribute__((address_space(3)))
typedef unsigned short bf16_t;
typedef short bf16x8 __attribute__((ext_vector_type(8)));
typedef float f32x4 __attribute__((ext_vector_type(4)));
typedef unsigned u32x4 __attribute__((ext_vector_type(4)));
constexpr int BM = 256, BK = 64, HALF = 128, HTB = HALF * BK * 2  , STAGE_BYTES = 8 * HTB, NXCD = 8, WGM = 8;

__host__ __device__ __forceinline__ int lds_byte(int r, int c) { const int st = (r >> 4) * 2 + (c >> 5), rr = r & 15, cc = c & 31, ob = rr * 64 + cc * 2; return st * 1024 + (ob ^ (((ob >> 9) & 1) << 5)); }
__host__ __device__ __forceinline__ void stage_rc(int b, int& R, int& C) { const int st = b / 1024, sb = b % 1024, swz = sb ^ (((sb >> 9) & 1) << 5); R = (st >> 1) * 16 + swz / 64; C = (st & 1) * 32 + (swz % 64) / 2; }
__host__ __device__ __forceinline__ int perm32(int rho) { const int n = rho >> 4, i = rho & 15; return 8 * (i >> 2) + 4 * n + (i & 3); }

struct Unit { int pm, pn; };
struct Gemm { const bf16_t* A; const bf16_t* Bt; int M, N, K; };

struct StaticOrder {
    int nM, nN, nwg, G, c;
    __host__ __device__ void init(int M, int N, int G_, int c_) { nM = M / BM; nN = N / BM; nwg = nM * nN; G = G_; c = c_; }
    __host__ __device__ bool next(int i, Unit& u) const {
        const long L = (long)i * G + c; if (L >= nwg) return false;
        int wgid = (int)L; { const int q = nwg / NXCD, r = nwg % NXCD, xcd = wgid % NXCD, off = wgid / NXCD; wgid = (xcd < r ? xcd * (q + 1) : r * (q + 1) + (xcd - r) * q) + off; }
        const int nig = WGM * nN, gid = wgid / nig, fm = gid * WGM, gsz = (nM - fm) < WGM ? (nM - fm) : WGM;
        u.pm = fm + ((wgid % nig) % gsz); u.pn = (wgid % nig) / gsz; return true;
    }
    __device__ __forceinline__ void a_ready(const Unit&) const {}
    __device__ __forceinline__ void done(const Unit&) const {}
};

typedef float f32x2_t __attribute__((ext_vector_type(2))); typedef __bf16 bf16x2_t __attribute__((ext_vector_type(2)));
__device__ __forceinline__ unsigned pk2(float lo, float hi) { f32x2_t v = {lo, hi}; bf16x2_t b = __builtin_convertvector(v, bf16x2_t); return __builtin_bit_cast(unsigned, b); }
__device__ __forceinline__ float bflo(unsigned w) { return __uint_as_float(w << 16); }
__device__ __forceinline__ float bfhi(unsigned w) { return __uint_as_float(w & 0xffff0000u); }
__device__ __forceinline__ float fsigmoid(float x) { return __builtin_amdgcn_rcpf(1.0f + __expf(-x)); }
__device__ __forceinline__ float gelu_tanh(float x) { const float t = x * (1.5957691216f + 0.0713548163f * x * x); return x * __builtin_amdgcn_rcpf(1.0f + __expf(-t)); }
__device__ __forceinline__ u32x4 pk8(const f32x4& a, const f32x4& b) { u32x4 w; w.x = pk2(a[0], a[1]); w.y = pk2(a[2], a[3]); w.z = pk2(b[0], b[1]); w.w = pk2(b[2], b[3]); return w; }
__device__ __forceinline__ float dot4(const f32x4& a) { return (a[0] * a[0] + a[1] * a[1]) + (a[2] * a[2] + a[3] * a[3]); }
__device__ __forceinline__ float row_rstd(const float* ss, int row) {
    const f32x4* p = (const f32x4*)(ss + (size_t)row * 16);
    const f32x4 a = p[0], b = p[1], c = p[2], d = p[3];
    const float s = (((a[0] + a[1]) + (a[2] + a[3])) + ((b[0] + b[1]) + (b[2] + b[3]))) + (((c[0] + c[1]) + (c[2] + c[3])) + ((d[0] + d[1]) + (d[2] + d[3])));
    return rsqrtf(s * (1.0f / 1024.0f) + 1e-6f);
}

struct EpiZ {
    static constexpr bool PERM = true, AFTER_DRAIN = false;
    bf16_t* O; int ldc; const float* bias; const float* ss;
    __device__ __forceinline__ void operator()(const f32x4 (&acc)[2][2][4][2], const Unit& u, int wr, int wc, int fr, int fq) const {
        const int row0 = u.pm * BM + wr * 64 + fr, col0 = u.pn * BM + wc * 32 + 8 * fq;
        f32x4 bv[2][2];
#pragma unroll
        for (int bj = 0; bj < 2; ++bj)
#pragma unroll
            for (int n = 0; n < 2; ++n) bv[bj][n] = bias ? *(const f32x4*)(bias + col0 + bj * HALF + 4 * n) : (f32x4){0.f, 0.f, 0.f, 0.f};
#pragma unroll
        for (int ai = 0; ai < 2; ++ai)
#pragma unroll
            for (int m = 0; m < 4; ++m) { const int row = row0 + ai * HALF + m * 16; const float rs = ss ? row_rstd(ss, row) : 1.0f;
                bf16_t* rowp = O + (size_t)row * ldc + col0;
#pragma unroll
                for (int bj = 0; bj < 2; ++bj) { const f32x4 v0 = acc[ai][bj][m][0] * rs + bv[bj][0], v1 = acc[ai][bj][m][1] * rs + bv[bj][1];
                    *(u32x4*)(rowp + bj * HALF) = pk8(v0, v1); } }
    }
};

__device__ __forceinline__ void unpack8(const u32x4& w, f32x4& a, f32x4& b) { a[0] = bflo(w.x); a[1] = bfhi(w.x); a[2] = bflo(w.y); a[3] = bfhi(w.y); b[0] = bflo(w.z); b[1] = bfhi(w.z); b[2] = bflo(w.w); b[3] = bfhi(w.w); }
template <bool SRCF32> struct EpiRes {
    static constexpr bool PERM = true, AFTER_DRAIN = false;
    const void* src; bf16_t* xb; float* sso;
    __device__ __forceinline__ void operator()(const f32x4 (&acc)[2][2][4][2], const Unit& u, int wr, int wc, int fr, int fq) const {
        const int row0 = u.pm * BM + wr * 64 + fr, col0 = u.pn * BM + wc * 32 + 8 * fq;
#pragma unroll
        for (int ai = 0; ai < 2; ++ai)
#pragma unroll
            for (int m = 0; m < 4; ++m) { const int row = row0 + ai * HALF + m * 16; const size_t off = (size_t)row * 1024 + col0; float sq = 0.f;
#pragma unroll
                for (int bj = 0; bj < 2; ++bj) {
                    f32x4 r0, r1;
                    if (SRCF32) { r0 = *(const f32x4*)((const float*)src + off + bj * HALF); r1 = *(const f32x4*)((const float*)src + off + bj * HALF + 4); }
                    else unpack8(*(const u32x4*)((const bf16_t*)src + off + bj * HALF), r0, r1);
                    const f32x4 v0 = r0 + acc[ai][bj][m][0], v1 = r1 + acc[ai][bj][m][1];
                    *(u32x4*)(xb + off + bj * HALF) = pk8(v0, v1);
                    sq += dot4(v0) + dot4(v1); }
                sq += __shfl_xor(sq, 16); sq += __shfl_xor(sq, 32);
                if (fq == 0) sso[(size_t)row * 16 + 4 * u.pn + wc] = sq; }
    }
};

template <bool FINAL> struct EpiPle {
    static constexpr bool PERM = true, AFTER_DRAIN = false;
    const float* ss; const bf16_t* pp; const bf16_t* xin; bf16_t* xb; float* sso; float* out;
    __device__ __forceinline__ void operator()(const f32x4 (&acc)[2][2][4][2], const Unit& u, int wr, int wc, int fr, int fq) const {
        const int row0 = u.pm * BM + wr * 64 + fr, col0 = u.pn * BM + wc * 32 + 8 * fq;
#pragma unroll
        for (int ai = 0; ai < 2; ++ai)
#pragma unroll
            for (int m = 0; m < 4; ++m) { const int row = row0 + ai * HALF + m * 16; const size_t off = (size_t)row * 1024 + col0; const float rs = row_rstd(ss, row); float sq = 0.f;
#pragma unroll
                for (int bj = 0; bj < 2; ++bj) {
                    f32x4 r0, r1, p0, p1; unpack8(*(const u32x4*)(xin + off + bj * HALF), r0, r1); unpack8(*(const u32x4*)(pp + off + bj * HALF), p0, p1);
                    const f32x4 a0 = acc[ai][bj][m][0] * rs, a1 = acc[ai][bj][m][1] * rs;
                    f32x4 v0, v1;
#pragma unroll
                    for (int e = 0; e < 4; ++e) { v0[e] = r0[e] + fsigmoid(a0[e]) * p0[e]; v1[e] = r1[e] + fsigmoid(a1[e]) * p1[e]; }
                    if (FINAL) { *(f32x4*)(out + off + bj * HALF) = v0; *(f32x4*)(out + off + bj * HALF + 4) = v1; }
                    else { *(u32x4*)(xb + off + bj * HALF) = pk8(v0, v1); sq += dot4(v0) + dot4(v1); } }
                if (!FINAL) { sq += __shfl_xor(sq, 16); sq += __shfl_xor(sq, 32);
                    if (fq == 0) sso[(size_t)row * 16 + 4 * u.pn + wc] = sq; } }
    }
};

struct EpiQkv {
    static constexpr bool PERM = true, AFTER_DRAIN = false;
    const float* ss; const float* rope; const float* qn; const float* kn; bf16_t* Q; bf16_t* K; bf16_t* V;
    __device__ __forceinline__ void operator()(const f32x4 (&acc)[2][2][4][2], const Unit& u, int wr, int wc, int fr, int fq) const {
        const int row0 = u.pm * BM + wr * 64 + fr;
        if (u.pn == 5) {
#pragma unroll
            for (int ai = 0; ai < 2; ++ai)
#pragma unroll
                for (int m = 0; m < 4; ++m) { const int row = row0 + ai * HALF + m * 16; const float rs = row_rstd(ss, row);
#pragma unroll
                    for (int bj = 0; bj < 2; ++bj) *(u32x4*)(V + (size_t)row * 256 + 64 * wc + 32 * bj + 8 * fq) = pk8(acc[ai][bj][m][0] * rs, acc[ai][bj][m][1] * rs); }
            return;
        }
        const bool isq = u.pn < 4; const float* gn = isq ? qn : kn; const float osc = isq ? 0.125f : 1.0f;
        bf16_t* dst = isq ? Q + (size_t)(64 * (4 * u.pn + wc)) : K + (size_t)(64 * wc); const int ldd = isq ? 1024 : 256;
        f32x4 g[2][2];
#pragma unroll
        for (int bj = 0; bj < 2; ++bj)
#pragma unroll
            for (int n = 0; n < 2; ++n) g[bj][n] = *(const f32x4*)(gn + 32 * bj + 8 * fq + 4 * n);
#pragma unroll
        for (int ai = 0; ai < 2; ++ai)
#pragma unroll
            for (int m = 0; m < 4; ++m) { const int row = row0 + ai * HALF + m * 16; const float rs = row_rstd(ss, row);
                f32x4 v[2][2]; float sq = 0.f;
#pragma unroll
                for (int bj = 0; bj < 2; ++bj)
#pragma unroll
                    for (int n = 0; n < 2; ++n) { v[bj][n] = acc[ai][bj][m][n] * rs; sq += dot4(v[bj][n]); }
                sq += __shfl_xor(sq, 16); sq += __shfl_xor(sq, 32);
                const float hr = rsqrtf(sq * (1.0f / 64.0f) + 1e-6f) ;
#pragma unroll
                for (int bj = 0; bj < 2; ++bj)
#pragma unroll
                    for (int n = 0; n < 2; ++n) v[bj][n] = v[bj][n] * hr * g[bj][n];
                const float* rp = rope + (size_t)row * 64 + 8 * fq;
                f32x4 o[2][2];
#pragma unroll
                for (int n = 0; n < 2; ++n) { const f32x4 cs = *(const f32x4*)(rp + 4 * n), sn = *(const f32x4*)(rp + 32 + 4 * n);
                    o[0][n] = (v[0][n] * cs - v[1][n] * sn) * osc; o[1][n] = (v[1][n] * cs + v[0][n] * sn) * osc; }
#pragma unroll
                for (int bj = 0; bj < 2; ++bj) *(u32x4*)(dst + (size_t)row * ldd + 32 * bj + 8 * fq) = pk8(o[bj][0], o[bj][1]); }
    }
};

struct EpiUp {
    static constexpr bool PERM = true, AFTER_DRAIN = false;
    const float* ss; const float* cw; const float* cb; bf16_t* A2; bf16_t* GH; bf16_t* UH; bf16_t* GT;
    __device__ __forceinline__ void operator()(const f32x4 (&acc)[2][2][4][2], const Unit& u, int wr, int wc, int fr, int fq) const {
        const int lane = fq * 16 + fr, ch0 = u.pn * 128 + wc * 32 + 8 * fq;
        const int src1 = (lane & 48) | ((fr - 1) & 15), src2 = (lane & 48) | ((fr - 2) & 15);
        f32x4 w0[2], w1[2], w2[2], bb[2];
#pragma unroll
        for (int n = 0; n < 2; ++n) { w0[n] = *(const f32x4*)(cw + ch0 + 4 * n); w1[n] = *(const f32x4*)(cw + 3072 + ch0 + 4 * n); w2[n] = *(const f32x4*)(cw + 6144 + ch0 + 4 * n); bb[n] = *(const f32x4*)(cb + ch0 + 4 * n); }
#pragma unroll
        for (int ai = 0; ai < 2; ++ai) {
            const int grp = 4 * u.pm + 2 * ai + wr;
            unsigned pp0 = 0u, pp1 = 0u, pp2 = 0u, pp3 = 0u;
#pragma unroll
            for (int m = 0; m < 4; ++m) { const int row = u.pm * BM + ai * HALF + wr * 64 + m * 16 + fr; const float rs = row_rstd(ss, row);
                const f32x4 g0 = acc[ai][0][m][0] * rs, g1 = acc[ai][0][m][1] * rs, u0 = acc[ai][1][m][0] * rs, u1 = acc[ai][1][m][1] * rs;
                const unsigned c0 = pk2(g0[0], g0[1]), c1 = pk2(g0[2], g0[3]), c2 = pk2(g1[0], g1[1]), c3 = pk2(g1[2], g1[3]);
                unsigned a1_0 = __shfl(c0, src1), a1_1 = __shfl(c1, src1), a1_2 = __shfl(c2, src1), a1_3 = __shfl(c3, src1);
                unsigned a2_0 = __shfl(c0, src2), a2_1 = __shfl(c1, src2), a2_2 = __shfl(c2, src2), a2_3 = __shfl(c3, src2);
                if (m > 0) {
                    const unsigned b1_0 = __shfl(pp0, src1), b1_1 = __shfl(pp1, src1), b1_2 = __shfl(pp2, src1), b1_3 = __shfl(pp3, src1);
                    const unsigned b2_0 = __shfl(pp0, src2), b2_1 = __shfl(pp1, src2), b2_2 = __shfl(pp2, src2), b2_3 = __shfl(pp3, src2);
                    if (fr < 1) { a1_0 = b1_0; a1_1 = b1_1; a1_2 = b1_2; a1_3 = b1_3; }
                    if (fr < 2) { a2_0 = b2_0; a2_1 = b2_1; a2_2 = b2_2; a2_3 = b2_3; }
                }
                const f32x4 p1a = {bflo(a1_0), bfhi(a1_0), bflo(a1_1), bfhi(a1_1)}, p1b = {bflo(a1_2), bfhi(a1_2), bflo(a1_3), bfhi(a1_3)};
                const f32x4 p2a = {bflo(a2_0), bfhi(a2_0), bflo(a2_1), bfhi(a2_1)}, p2b = {bflo(a2_2), bfhi(a2_2), bflo(a2_3), bfhi(a2_3)};
                const f32x4 y0 = w0[0] * p2a + w1[0] * p1a + w2[0] * g0 + bb[0], y1 = w0[1] * p2b + w1[1] * p1b + w2[1] * g1 + bb[1];
                f32x4 o0, o1;
#pragma unroll
                for (int e = 0; e < 4; ++e) { o0[e] = gelu_tanh(y0[e]) * u0[e]; o1[e] = gelu_tanh(y1[e]) * u1[e]; }
                const bool head = (m == 0) && (fr < 2);
                if (!head) *(u32x4*)(A2 + (size_t)row * 3072 + ch0) = pk8(o0, o1);
                else { const size_t so = ((size_t)grp * 2 + fr) * 3072 + ch0; u32x4 gw; gw.x = c0; gw.y = c1; gw.z = c2; gw.w = c3; *(u32x4*)(GH + so) = gw; *(u32x4*)(UH + so) = pk8(u0, u1); }
                if (m == 3 && fr >= 14) { const size_t so = ((size_t)grp * 2 + (fr - 14)) * 3072 + ch0; u32x4 gw; gw.x = c0; gw.y = c1; gw.z = c2; gw.w = c3; *(u32x4*)(GT + so) = gw; }
                pp0 = c0; pp1 = c1; pp2 = c2; pp3 = c3; }
        }
    }
};

struct EpiNone {
    static constexpr bool PERM = true, AFTER_DRAIN = false;
    __device__ __forceinline__ void operator()(const f32x4 (&acc)[2][2][4][2], const Unit& u, int wr, int wc, int fr, int fq) const {
#pragma unroll
        for (int ai = 0; ai < 2; ++ai)
#pragma unroll
            for (int m = 0; m < 4; ++m)
#pragma unroll
                for (int bj = 0; bj < 2; ++bj) { asm volatile("" :: "v"(acc[ai][bj][m][0]), "v"(acc[ai][bj][m][1])); }
    }
};
template <class Epi, class Sched, bool ALIGN_EPI = false, bool SP2 = false>
__device__ __forceinline__ void gemm_phase(PG8_LAS unsigned char* lds, const Gemm g, const Sched& S, const Epi& E) {
    int tid_ = threadIdx.x; asm volatile("" : "+v"(tid_));
    const int tid = tid_, wid = __builtin_amdgcn_readfirstlane(tid >> 6), lane = tid & 63, wr = wid >> 2, wc = wid & 3, fr = lane & 15, fq = lane >> 4;
    const int K = g.K, nt = K / BK;
    unsigned voffA[2], voffB[2];
#pragma unroll
    for (int i = 0; i < 2; ++i) { int R, C; stage_rc(tid * 16 + i * 8192, R, C); const int Rb = Epi::PERM ? ((R & ~31) + perm32(R & 31)) : R;
        voffA[i] = (unsigned)(R * K + C) * 2u; voffB[i] = (unsigned)(Rb * K + C) * 2u; }
    const size_t kstep = (size_t)(BK * 2);
    const size_t hstep = (size_t)HALF * K * 2;
    const size_t tstep = 2 * hstep;
    const unsigned ldsw = (unsigned)wid * 1024u;
    const int aoff = lds_byte(wr * 64 + fr, fq * 8), boff = lds_byte(wc * 32 + fr, fq * 8);
#define PG8_SA(b, h) (((b) * 2 + (h)) * HTB)
#define PG8_SB(b, h) ((4 + (b) * 2 + (h)) * HTB)
#define PG8_STAGE(bufoff, gbase, voff) do { _Pragma("unroll") for (int _i = 0; _i < 2; ++_i) \
        __builtin_amdgcn_global_load_lds((const unsigned*)((const char*)(gbase) + (voff)[_i]), (PG8_LAS unsigned*)(lds + (bufoff) + ldsw + _i * 8192), 16, 0, 0); } while (0)
#define PG8_LDA(dst, b, h) do { _Pragma("unroll") for (int m = 0; m < 4; ++m) _Pragma("unroll") for (int k = 0; k < 2; ++k) dst[m][k] = *(const PG8_LAS bf16x8*)(lds + PG8_SA(b, h) + aoff + m * 2048 + k * 1024); } while (0)
#define PG8_LDB(dst, b, h) do { _Pragma("unroll") for (int n = 0; n < 2; ++n) _Pragma("unroll") for (int k = 0; k < 2; ++k) dst[n][k] = *(const PG8_LAS bf16x8*)(lds + PG8_SB(b, h) + boff + n * 2048 + k * 1024); } while (0)
#define PG8_MMA(ai, bj, At, Bt) do { __builtin_amdgcn_s_setprio(1); _Pragma("unroll") for (int m = 0; m < 4; ++m) _Pragma("unroll") for (int n = 0; n < 2; ++n) _Pragma("unroll") for (int k = 0; k < 2; ++k) \
        acc[ai][bj][m][n] = __builtin_amdgcn_mfma_f32_16x16x32_bf16(Bt[n][k], At[m][k], acc[ai][bj][m][n], 0, 0, 0); __builtin_amdgcn_s_setprio(0); } while (0)
#define PG8_WAIT_V(n) asm volatile("s_waitcnt vmcnt(" #n ")" ::: "memory")
#define PG8_WAIT_L(n) asm volatile("s_waitcnt lgkmcnt(" #n ")" ::: "memory")
#define PG8_BAR __builtin_amdgcn_s_barrier()
#define PG8_SCHED __builtin_amdgcn_sched_barrier(0)
    Unit cur, nxt; int ui = 0;
    if (!S.next(0, cur)) return;
    f32x4 acc[2][2][4][2];
#pragma unroll
    for (int a = 0; a < 2; ++a)
#pragma unroll
        for (int b = 0; b < 2; ++b)
#pragma unroll
            for (int m = 0; m < 4; ++m)
#pragma unroll
                for (int n = 0; n < 2; ++n) acc[a][b][m][n] = (f32x4){0.f, 0.f, 0.f, 0.f};
    bf16x8 At[4][2], B0[2][2], B1[2][2];
    const char* cA = (const char*)g.A + (size_t)cur.pm * tstep; const char* cB = (const char*)g.Bt + (size_t)cur.pn * tstep;
    S.a_ready(cur);
    if constexpr (SP2) {
        PG8_STAGE(PG8_SB(0, 0), cB, voffB); PG8_STAGE(PG8_SB(0, 1), cB + hstep, voffB); PG8_STAGE(PG8_SA(0, 0), cA, voffA); PG8_STAGE(PG8_SA(0, 1), cA + hstep, voffA);
        if (wr == 1) PG8_BAR;
        PG8_WAIT_V(2); PG8_BAR;
        PG8_STAGE(PG8_SB(1, 0), cB + kstep, voffB); PG8_STAGE(PG8_SA(1, 0), cA + kstep, voffA); PG8_STAGE(PG8_SB(1, 1), cB + hstep + kstep, voffB);
        PG8_WAIT_V(6); PG8_BAR;
    } else {
        PG8_STAGE(PG8_SB(0, 0), cB, voffB); PG8_STAGE(PG8_SA(0, 0), cA, voffA); PG8_STAGE(PG8_SB(0, 1), cB + hstep, voffB); PG8_STAGE(PG8_SA(0, 1), cA + hstep, voffA);
        if (wr == 1) PG8_BAR;
        PG8_WAIT_V(4); PG8_BAR;
        PG8_STAGE(PG8_SB(1, 0), cB + kstep, voffB); PG8_STAGE(PG8_SA(1, 0), cA + kstep, voffA); PG8_STAGE(PG8_SB(1, 1), cB + hstep + kstep, voffB);
        PG8_WAIT_V(6); PG8_BAR;
    }
    for (;;) {
        const bool has_next = S.next(ui + 1, nxt);
        const char* nA = has_next ? (const char*)g.A + (size_t)nxt.pm * tstep : cA; const char* nB = has_next ? (const char*)g.Bt + (size_t)nxt.pn * tstep : cB;
        for (int t = 0; t < nt; t += 2) {
            const bool last = (t == nt - 2);
            const char* a1 = cA + (size_t)(t + 1) * kstep;
            const char* a2 = last ? nA : cA + (size_t)(t + 2) * kstep; const char* b2 = last ? nB : cB + (size_t)(t + 2) * kstep;
            const char* a3 = a2 + kstep; const char* b3 = b2 + kstep;
            if (last && has_next) S.a_ready(nxt);
            if constexpr (SP2) {
            PG8_LDB(B0, 0, 0); PG8_LDB(B1, 0, 1); PG8_SCHED; PG8_LDA(At, 0, 0); PG8_STAGE(PG8_SA(1, 1), a1 + hstep, voffA);
            PG8_WAIT_V(8); PG8_WAIT_L(0); PG8_BAR; PG8_MMA(0, 0, At, B0); PG8_MMA(0, 1, At, B1); PG8_BAR; PG8_SCHED;
            PG8_LDA(At, 0, 1); PG8_STAGE(PG8_SB(0, 0), b2, voffB); PG8_STAGE(PG8_SB(0, 1), b2 + hstep, voffB); PG8_STAGE(PG8_SA(0, 0), a2, voffA);
            PG8_WAIT_V(8); PG8_WAIT_L(0); PG8_BAR; PG8_MMA(1, 0, At, B0); PG8_MMA(1, 1, At, B1); PG8_BAR; PG8_SCHED;
            PG8_LDB(B0, 1, 0); PG8_LDB(B1, 1, 1); PG8_SCHED; PG8_LDA(At, 1, 0); PG8_STAGE(PG8_SA(0, 1), a2 + hstep, voffA);
            PG8_WAIT_V(8); PG8_WAIT_L(0); PG8_BAR; PG8_MMA(0, 0, At, B0); PG8_MMA(0, 1, At, B1); PG8_BAR; PG8_SCHED;
            PG8_LDA(At, 1, 1); PG8_STAGE(PG8_SB(1, 0), b3, voffB); PG8_STAGE(PG8_SB(1, 1), b3 + hstep, voffB); PG8_STAGE(PG8_SA(1, 0), a3, voffA);
            PG8_WAIT_V(8); PG8_WAIT_L(0); PG8_BAR; PG8_MMA(1, 0, At, B0); PG8_MMA(1, 1, At, B1); PG8_BAR; PG8_SCHED;
            } else {
            PG8_LDB(B0, 0, 0); PG8_SCHED; PG8_LDA(At, 0, 0); PG8_STAGE(PG8_SA(1, 1), a1 + hstep, voffA);
            PG8_WAIT_L(8); PG8_BAR; PG8_WAIT_L(0); PG8_MMA(0, 0, At, B0); PG8_BAR; PG8_SCHED;
            PG8_LDB(B1, 0, 1); PG8_STAGE(PG8_SB(0, 0), b2, voffB);
            PG8_BAR; PG8_WAIT_L(0); PG8_MMA(0, 1, At, B1); PG8_BAR;
            PG8_LDA(At, 0, 1); PG8_STAGE(PG8_SA(0, 0), a2, voffA);
            PG8_BAR; PG8_WAIT_L(0); PG8_MMA(1, 0, At, B0); PG8_BAR; PG8_SCHED;
            PG8_STAGE(PG8_SB(0, 1), b2 + hstep, voffB);
            PG8_WAIT_V(6); PG8_BAR; PG8_MMA(1, 1, At, B1); PG8_BAR;
            PG8_LDB(B0, 1, 0); PG8_SCHED; PG8_LDA(At, 1, 0); PG8_STAGE(PG8_SA(0, 1), a2 + hstep, voffA);
            PG8_WAIT_L(8); PG8_BAR; PG8_WAIT_L(0); PG8_MMA(0, 0, At, B0); PG8_BAR; PG8_SCHED;
            PG8_LDB(B1, 1, 1); PG8_STAGE(PG8_SB(1, 0), b3, voffB);
            PG8_BAR; PG8_WAIT_L(0); PG8_MMA(0, 1, At, B1); PG8_BAR;
            PG8_LDA(At, 1, 1); PG8_STAGE(PG8_SA(1, 0), a3, voffA);
            PG8_BAR; PG8_WAIT_L(0); PG8_MMA(1, 0, At, B0); PG8_BAR; PG8_SCHED;
            PG8_STAGE(PG8_SB(1, 1), b3 + hstep, voffB);
            PG8_WAIT_V(6); PG8_BAR; PG8_MMA(1, 1, At, B1); PG8_BAR;
            }
        }
        if constexpr (ALIGN_EPI) { if (wr == 0) PG8_BAR; }
        if constexpr (!Epi::AFTER_DRAIN) { E(acc, cur, wr, wc, fr, fq); S.done(cur); }
        if (!has_next) break;
#pragma unroll
        for (int a = 0; a < 2; ++a)
#pragma unroll
            for (int b = 0; b < 2; ++b)
#pragma unroll
                for (int m = 0; m < 4; ++m)
#pragma unroll
                    for (int n = 0; n < 2; ++n) acc[a][b][m][n] = (f32x4){0.f, 0.f, 0.f, 0.f};
        cur = nxt; cA = nA; cB = nB; ++ui;
        if constexpr (ALIGN_EPI) { if (wr == 1) PG8_BAR; }
    }
    PG8_WAIT_V(0);
    if constexpr (!ALIGN_EPI) { if (wr == 0) PG8_BAR; }
    PG8_BAR;
    if constexpr (Epi::AFTER_DRAIN) { E.fused(acc, cur, wr, wc, fr, fq, lds, wid, lane); S.done(cur); }
#undef PG8_SA
#undef PG8_SB
#undef PG8_STAGE
#undef PG8_LDA
#undef PG8_LDB
#undef PG8_MMA
#undef PG8_WAIT_V
#undef PG8_WAIT_L
#undef PG8_BAR
#undef PG8_SCHED
}
}

constexpr int NWAVES = 8;
constexpr int NB = 8, SEQ = 4096, T = NB * SEQ, DM = 1024, ZW = 3072, FFD = 3072, HYIN = 3080;
#ifndef PROBE_PHASE
#define PROBE_PHASE 0
#define PROBE_N 0
#endif
#define PREP(id) for (int rep_ = 0; rep_ < 1 + ((PROBE_PHASE == (id)) ? PROBE_N : 0); ++rep_)
#ifndef DBG_STOP
#define DBG_STOP 99
#endif

constexpr size_t MiB = 1u << 20;
constexpr size_t WS_CTL = 0, CTL_ZERO_BYTES = 1 * MiB;
constexpr size_t WS_WIN = 2 * MiB, WS_WOUT0 = 8 * MiB, WS_WUP0 = 10 * MiB, WS_WDN0 = 22 * MiB, WS_WGT0 = 28 * MiB, WS_WPJ0 = 30 * MiB,
                 WS_WQKV = 31 * MiB, WS_WO1 = 34 * MiB, WS_WUP1 = 36 * MiB, WS_WDN1 = 48 * MiB, WS_WGT1 = 54 * MiB, WS_WPJ1 = 56 * MiB, WS_RGW = 57 * MiB;
constexpr size_t WS_GATES = 58 * MiB, WS_SSA = 59 * MiB, WS_SSB = 61 * MiB, WS_ROPE = 63 * MiB, WS_NLOC = 71 * MiB, WS_NPREV = 72 * MiB, WS_MSC = 73 * MiB,
                 WS_RGA = 74 * MiB, WS_RGH = 75 * MiB, WS_RGC = 76 * MiB;
constexpr size_t WS_PB = 78 * MiB, WS_XBA = 110 * MiB, WS_XBB = 174 * MiB, WS_CST = 238 * MiB, WS_BIG = 302 * MiB, WS_END = 494 * MiB;
constexpr int CW_BAR = 4096;

constexpr int RING_BYTES = 131072;
constexpr int LDSCTL_OFF = 146944, MISC_OFF = LDSCTL_OFF + 320;
constexpr int LDS_BYTES = 147456;

#define GAS __attribute__((address_space(1)))
#define LAS __attribute__((address_space(3)))
typedef unsigned short bf16;
typedef unsigned v4u __attribute__((ext_vector_type(4)));
typedef unsigned v2u __attribute__((ext_vector_type(2)));
typedef float f32x4 __attribute__((ext_vector_type(4)));
typedef float f32x16 __attribute__((ext_vector_type(16)));
typedef short bf16x8 __attribute__((ext_vector_type(8)));
typedef short s16x4 __attribute__((ext_vector_type(4)));
typedef GAS unsigned gu32;
typedef LAS unsigned char* ldsp;
#define LDS_WAIT() asm volatile("s_waitcnt lgkmcnt(0)" ::: "memory")
using pg8::pk2; using pg8::bflo; using pg8::bfhi; using pg8::fsigmoid; using pg8::gelu_tanh;
__device__ __forceinline__ unsigned short f2bf1(float x) { return (unsigned short)(pk2(x, 0.f) & 0xffffu); }
__device__ __forceinline__ float bf2f(unsigned short b) { return __uint_as_float(((unsigned)b) << 16); }
__device__ __forceinline__ float fsilu(float x) { return x * __builtin_amdgcn_rcpf(1.0f + __expf(-x)); }
#define MFMA16(a, b, c) __builtin_amdgcn_mfma_f32_16x16x32_bf16((a), (b), (c), 0, 0, 0)
#define MFMA32(a, b, c) __builtin_amdgcn_mfma_f32_32x32x16_bf16((a), (b), (c), 0, 0, 0)

#define PHASE_FENCE(F) asm volatile("" : "+v"((F).tid), "+v"((F).lane) :: "memory")
#define XB_TMO      128
#define XB_XCNT(j)  (256  + 64 * (j))
#define XB_XSUB(j)  (1280 + 64 * (j))
#define XB_XGEN(j)  (2304 + 64 * (j))
#define XB_TOP      3328
#define XB_TOPGEN   3392
#define XCD_BAR_WORDS 3456
#define XB_SPIN_CAP (1u << 18)

__device__ __forceinline__ unsigned xb_ld(unsigned* p)              { return __hip_atomic_load(p, __ATOMIC_RELAXED, __HIP_MEMORY_SCOPE_AGENT); }
__device__ __forceinline__ unsigned xb_add(unsigned* p, unsigned v) { return __hip_atomic_fetch_add(p, v, __ATOMIC_RELAXED, __HIP_MEMORY_SCOPE_AGENT); }
__device__ __forceinline__ unsigned xb_xcc_id() { return (unsigned)__builtin_amdgcn_s_getreg((3 << 11) | 20) & 0xFu; }
#define XB_SPIN(cond, bar) do { unsigned _sp = 0; while (cond) { __builtin_amdgcn_s_sleep(1); \
    if ((++_sp & 255u) == 0u) { if (xb_ld(&(bar)[XB_TMO])) break; if (_sp > XB_SPIN_CAP) { atomicAdd(&(bar)[XB_TMO], 1u); break; } } } } while (0)

struct XcdBarrier {
    unsigned* bar; unsigned x;
    volatile LAS unsigned* st;
};

__device__ __forceinline__ XcdBarrier xcd_barrier_post(unsigned* bar, volatile LAS unsigned* st) {
    XcdBarrier b; b.bar = bar; b.x = xb_xcc_id(); b.st = st;
    if (threadIdx.x == 0) (void)xb_add(&bar[XB_XCNT(b.x)], 1u);
    return b;
}
__device__ __forceinline__ void xcd_barrier_complete(unsigned* bar, unsigned x, unsigned& nloc, unsigned& nx) {
    const unsigned G = gridDim.x * gridDim.y * gridDim.z;
    unsigned sum, cnt, mine, sp = 0u;
    for (;;) {
        sum = 0u; cnt = 0u; mine = 0u;
#pragma unroll
        for (unsigned j = 0; j < 16; ++j) { const unsigned c = xb_ld(&bar[XB_XCNT(j)]); sum += c; cnt += (c > 0u) ? 1u : 0u; mine = (j == x) ? c : mine; }
        if (sum == G) break;
        __builtin_amdgcn_s_sleep(1);
        if ((++sp & 255u) == 0u) { if (xb_ld(&bar[XB_TMO])) break; if (sp > XB_SPIN_CAP) { atomicAdd(&bar[XB_TMO], 1u); break; } }
    }
    nloc = mine > 0u ? mine : 1u; nx = cnt > 0u ? cnt : 1u;
}

__device__ __forceinline__ void xcd_barrier(const XcdBarrier& b) {
    asm volatile("s_waitcnt vmcnt(0)" ::: "memory");
    __syncthreads();
    if (threadIdx.x == 0) {
        unsigned* bar = b.bar;
        __builtin_amdgcn_s_waitcnt(0);
        unsigned nloc = b.st[0], nx = b.st[1];
        if (nloc == 0u) { xcd_barrier_complete(bar, b.x, nloc, nx); b.st[0] = nloc; b.st[1] = nx; }
        const unsigned old = xb_add(&bar[XB_XSUB(b.x)], 1u);
        const unsigned gen = old / nloc;
        if (old + 1u == (gen + 1u) * nloc) {
            __builtin_amdgcn_fence(__ATOMIC_RELEASE, "agent");
            asm volatile("s_waitcnt vmcnt(0)" ::: "memory");
            const unsigned og = xb_add(&bar[XB_TOP], 1u);
            const unsigned tg = og / nx;
            if (og + 1u == (tg + 1u) * nx) xb_add(&bar[XB_TOPGEN], 1u);
            else XB_SPIN(xb_ld(&bar[XB_TOPGEN]) == tg, bar);
            __builtin_amdgcn_fence(__ATOMIC_ACQUIRE, "agent");
            xb_add(&bar[XB_XGEN(b.x)], 1u);
            asm volatile("s_waitcnt vmcnt(0)" ::: "memory");
        } else {
            XB_SPIN(xb_ld(&bar[XB_XGEN(b.x)]) == gen, bar);
            __builtin_amdgcn_fence(__ATOMIC_ACQUIRE, "agent");
            asm volatile("s_waitcnt vmcnt(0)" ::: "memory");
        }
    }
    __syncthreads();
}

struct Frame {
    ldsp lds; volatile LAS unsigned* MISC;
    int tid, lane, wave, vcu, G;
    unsigned char* ws; unsigned long long kb; float* out;
};
__device__ __forceinline__ const float* karg(const Frame& F, int i) { unsigned long long a = F.kb; asm volatile("" : "+s"(a) :: "memory"); return (const float*)(((const __attribute__((address_space(4))) unsigned long long*)a)[i]); }
#define P_Z     ((bf16*)(F.ws + WS_BIG))
#define P_YBUF  ((bf16*)(F.ws + WS_XBA))
#define P_CST   ((bf16*)(F.ws + WS_CST))
#define P_RGW   ((bf16*)(F.ws + WS_RGW))
#define P_GATES ((float*)(F.ws + WS_GATES))
#define P_NLOC  ((float*)(F.ws + WS_NLOC))
#define P_NPREV ((float*)(F.ws + WS_NPREV))
#define P_MLOC  ((float*)(F.ws + WS_MSC))
#define P_BLAST ((float*)(F.ws + WS_MSC) + 2048)
#define P_MPREV ((float*)(F.ws + WS_MSC) + 4096)
#define P_RGA   ((float*)(F.ws + WS_RGA))
#define P_RGH   ((float*)(F.ws + WS_RGH))
#define P_RGC   ((float*)(F.ws + WS_RGC))
#define P_ROPE  ((float*)(F.ws + WS_ROPE))

__device__ __forceinline__ void tr_item(const float* W, int ldw, int srcc, const float* scale, bf16* WT, int K, int dst_row0, int k0, LAS float* scr, int lane) {
#pragma unroll 8
    for (int i = 0; i < 32; ++i) { const int kk = 2 * i + (lane >> 5); const float s = scale ? scale[k0 + kk] : 1.0f; scr[kk * 33 + (lane & 31)] = W[(size_t)(k0 + kk) * ldw + srcc + (lane & 31)] * s; }
    LDS_WAIT(); asm volatile("" ::: "memory");
    const int c = lane & 7;
#pragma unroll
    for (int j = 0; j < 4; ++j) { const int n = (lane >> 3) + 8 * j; const LAS float* s = scr + (8 * c) * 33 + n;
        v4u o; o.x = pk2(s[0 * 33], s[1 * 33]); o.y = pk2(s[2 * 33], s[3 * 33]); o.z = pk2(s[4 * 33], s[5 * 33]); o.w = pk2(s[6 * 33], s[7 * 33]);
        *(GAS v4u*)(WT + (size_t)(dst_row0 + n) * K + k0 + 8 * c) = o; }
    LDS_WAIT(); asm volatile("" ::: "memory");
}
__device__ __forceinline__ int tr_srcc(int mode, int nb) {
    if (mode == 1) { const int j = nb >> 3, r8 = nb & 7; return r8 < 4 ? 128 * j + 32 * r8 : 3072 + 128 * j + 32 * (r8 - 4); }
    if (mode == 2) { const int pn = nb >> 3, bj = (nb >> 2) & 1, wc = nb & 3; return 64 * (4 * pn + wc) + 32 * bj; }
    return 32 * nb;
}
__device__ __forceinline__ bool tr_matrix(int& r, const float* W, int ldw, int K, int Nd, int mode, const float* scale, bf16* WT, LAS float* scr, int lane) {
    const int nblk = Nd / 32, items = (K / 64) * nblk;
    if (r >= items) { r -= items; return false; }
    const int kb = r / nblk, nb = r % nblk;
    tr_item(W, ldw, tr_srcc(mode, nb), scale, WT, K, 32 * nb, 64 * kb, scr, lane);
    return true;
}
__device__ __forceinline__ float wave_sum(float v) {
#pragma unroll
    for (int o = 1; o < 64; o <<= 1) v += __shfl_xor(v, o);
    return v;
}
__device__ __forceinline__ void p0_prologue(Frame& F) {
    PHASE_FENCE(F); const float* x = karg(F, 0); const float* p = karg(F, 1); const int* pos = (const int*)karg(F, 2); const float* norm_mix = karg(F, 3); const float* norm_ffn = karg(F, 4); const float* norm_ple = karg(F, 5); const float* hy_w_in = karg(F, 6); const float* hy_b_in = karg(F, 7); const float* rg_wa = karg(F, 10); const float* rg_wx = karg(F, 12); const float* hy_w_out = karg(F, 18); const float* at_w_qkv = karg(F, 19); const float* at_w_out = karg(F, 23); const float* ff_w_up = karg(F, 24); const float* ff_w_down = karg(F, 27); const float* ple_w_gate = karg(F, 28); const float* ple_w_proj = karg(F, 29);
    LAS float* scr = (LAS float*)(F.lds + F.wave * 8448);
    const int gw = F.vcu * NWAVES + F.wave, NGW = F.G * NWAVES;
    unsigned char* ws = F.ws;
    LAS float* GW = (LAS float*)(F.lds + 73728);
    for (int i = F.tid; i < 8192; i += NWAVES * 64) { const int k = i >> 3, g = i & 7; GW[i] = hy_w_in[(size_t)k * HYIN + 3072 + g] * norm_mix[k]; }
    constexpr int NITEMS = 1536 + 512 + 2 * 3072 + 2 * 1536 + 2 * 512 + 2 * 128 + 768 + 512 + 32;
    for (int it = gw; it < NITEMS; it += NGW) {
        int r = it;
        if (tr_matrix(r, hy_w_in, HYIN, 1024, 3072, 0, norm_mix, (bf16*)(ws + WS_WIN), scr, F.lane)) continue;
        if (tr_matrix(r, hy_w_out, 1024, 1024, 1024, 0, nullptr, (bf16*)(ws + WS_WOUT0), scr, F.lane)) continue;
        if (tr_matrix(r, ff_w_up, 6144, 1024, 6144, 1, norm_ffn, (bf16*)(ws + WS_WUP0), scr, F.lane)) continue;
        if (tr_matrix(r, ff_w_up + (size_t)1024 * 6144, 6144, 1024, 6144, 1, norm_ffn + 1024, (bf16*)(ws + WS_WUP1), scr, F.lane)) continue;
        if (tr_matrix(r, ff_w_down, 1024, 3072, 1024, 0, nullptr, (bf16*)(ws + WS_WDN0), scr, F.lane)) continue;
        if (tr_matrix(r, ff_w_down + (size_t)3072 * 1024, 1024, 3072, 1024, 0, nullptr, (bf16*)(ws + WS_WDN1), scr, F.lane)) continue;
        if (tr_matrix(r, ple_w_gate, 1024, 1024, 1024, 0, norm_ple, (bf16*)(ws + WS_WGT0), scr, F.lane)) continue;
        if (tr_matrix(r, ple_w_gate + (size_t)1024 * 1024, 1024, 1024, 1024, 0, norm_ple + 1024, (bf16*)(ws + WS_WGT1), scr, F.lane)) continue;
        if (tr_matrix(r, ple_w_proj, 1024, 256, 1024, 0, nullptr, (bf16*)(ws + WS_WPJ0), scr, F.lane)) continue;
        if (tr_matrix(r, ple_w_proj + (size_t)256 * 1024, 1024, 256, 1024, 0, nullptr, (bf16*)(ws + WS_WPJ1), scr, F.lane)) continue;
        if (tr_matrix(r, at_w_qkv, 1536, 1024, 1536, 2, norm_mix + 1024, (bf16*)(ws + WS_WQKV), scr, F.lane)) continue;
        if (tr_matrix(r, at_w_out, 1024, 1024, 1024, 0, nullptr, (bf16*)(ws + WS_WO1), scr, F.lane)) continue;
        { const int blk = r >> 1, nb = r & 1, g = blk >> 3, n = blk & 7;
          tr_item((g ? rg_wx : rg_wa) + (size_t)n * 4096, 64, 32 * nb, nullptr, P_RGW + (size_t)blk * 4096, 64, 32 * nb, 0, scr, F.lane); }
    }
    __syncthreads();
    bf16* xb = (bf16*)(ws + WS_XBA); float* ssA = (float*)(ws + WS_SSA);
    for (int row = gw; row < T; row += NGW) {
        const GAS f32x4* xr = (const GAS f32x4*)(x + (size_t)row * DM) + F.lane;
        f32x4 v[4]; float s = 0.f; float d[8];
#pragma unroll
        for (int g = 0; g < 8; ++g) d[g] = 0.f;
#pragma unroll
        for (int j = 0; j < 4; ++j) { v[j] = xr[64 * j]; s += (v[j].x * v[j].x + v[j].y * v[j].y) + (v[j].z * v[j].z + v[j].w * v[j].w);
#pragma unroll
            for (int e = 0; e < 4; ++e) { const int k = 4 * (F.lane + 64 * j) + e; const f32x4 w0 = *(const LAS f32x4*)(GW + k * 8), w1 = *(const LAS f32x4*)(GW + k * 8 + 4);
                const float xv = v[j][e];
                d[0] += xv * w0[0]; d[1] += xv * w0[1]; d[2] += xv * w0[2]; d[3] += xv * w0[3]; d[4] += xv * w1[0]; d[5] += xv * w1[1]; d[6] += xv * w1[2]; d[7] += xv * w1[3]; } }
        s = wave_sum(s);
#pragma unroll
        for (int g = 0; g < 8; ++g) d[g] = wave_sum(d[g]);
        const float rstd = rsqrtf(s * (1.0f / DM) + 1e-6f);
        if (F.lane < 16) ssA[(size_t)row * 16 + F.lane] = (F.lane == 0) ? s : 0.f;
        if (F.lane < 8) { float dv = d[0];
#pragma unroll
            for (int g = 1; g < 8; ++g) dv = (F.lane == g) ? d[g] : dv;
            P_GATES[(size_t)row * 8 + F.lane] = rstd * dv + hy_b_in[3072 + F.lane]; }
        GAS unsigned long long* o8 = (GAS unsigned long long*)(xb + (size_t)row * DM) + F.lane;
#pragma unroll
        for (int j = 0; j < 4; ++j) o8[64 * j] = (unsigned long long)pk2(v[j].x, v[j].y) | ((unsigned long long)pk2(v[j].z, v[j].w) << 32);
#if DBG_STOP < 3
        { GAS f32x4* oo = (GAS f32x4*)(F.out + (size_t)row * DM) + F.lane;
#pragma unroll
          for (int j = 0; j < 4; ++j) oo[64 * j] = v[j]; }
#endif
    }
    { const GAS f32x4* ps = (const GAS f32x4*)p; GAS v4u* pd = (GAS v4u*)(ws + WS_PB); const int n8 = 2 * T * 256 / 8;
      for (int i = gw * 64 + F.lane; i < n8; i += NGW * 64) { const f32x4 a = ps[2 * i], b = ps[2 * i + 1]; v4u o; o.x = pk2(a.x, a.y); o.y = pk2(a.z, a.w); o.z = pk2(b.x, b.y); o.w = pk2(b.z, b.w); pd[i] = o; } }
    for (int i = (F.vcu * NWAVES * 64) + F.tid; i < T * 32; i += F.G * NWAVES * 64) { const int t = i >> 5, f = i & 31;
        const double inv = exp2(-(double)f * (13.287712379549449 / 32.0));
        const double ang = (double)pos[t] * inv; const double k = rint(ang * 0.15915494309189535); const float r = (float)(ang - k * 6.283185307179586);
        P_ROPE[(size_t)t * 64 + f] = cosf(r); P_ROPE[(size_t)t * 64 + 32 + f] = sinf(r); }
}

__device__ __forceinline__ void ld8f(const bf16* p, float (&o)[8]) { const v4u v = *(const v4u*)p; o[0] = bflo(v.x); o[1] = bfhi(v.x); o[2] = bflo(v.y); o[3] = bfhi(v.y); o[4] = bflo(v.z); o[5] = bfhi(v.z); o[6] = bflo(v.w); o[7] = bfhi(v.w); }
__device__ __forceinline__ void conv4x8(const bf16* zp, int s, const float* cw, int ldw, const float* cb, float (&out)[8]) {
    { const f32x4 b0 = *(const f32x4*)cb, b1 = *(const f32x4*)(cb + 4); out[0] = b0[0]; out[1] = b0[1]; out[2] = b0[2]; out[3] = b0[3]; out[4] = b1[0]; out[5] = b1[1]; out[6] = b1[2]; out[7] = b1[3]; }
#pragma unroll
    for (int j = 0; j < 4; ++j) if (s - 3 + j >= 0) { float xv[8]; ld8f(zp + (ptrdiff_t)(j - 3) * ZW, xv);
        const f32x4 w0 = *(const f32x4*)(cw + j * ldw), w1 = *(const f32x4*)(cw + j * ldw + 4);
        out[0] += w0[0] * xv[0]; out[1] += w0[1] * xv[1]; out[2] += w0[2] * xv[2]; out[3] += w0[3] * xv[3]; out[4] += w1[0] * xv[4]; out[5] += w1[1] * xv[5]; out[6] += w1[2] * xv[6]; out[7] += w1[3] * xv[7]; }
}
__device__ __forceinline__ v4u pk8f(const float (&a)[8]) { v4u o; o.x = pk2(a[0], a[1]); o.y = pk2(a[2], a[3]); o.z = pk2(a[4], a[5]); o.w = pk2(a[6], a[7]); return o; }
__device__ __forceinline__ float logsig(float f) { return fminf(f, 0.f) - __logf(1.0f + __expf(-fabsf(f))); }

struct MlPre { v4u q[3], k[3], v[2]; float ip, fp, np, mp; };
template <bool PC> __device__ __forceinline__ void ml_prefetch(Frame& F, int u, MlPre& R) {
    const int c = u & 63, bh = u >> 6, h = bh & 3, b = bh >> 2, tok0 = b * SEQ + c * 64;
    const bf16* z = P_Z;
    int tid = F.tid; asm volatile("" : "+v"(tid));
#pragma unroll
    for (int s = 0; s < 3; ++s) { const int i = tid + 512 * s, row = i >> 4, ch = i & 15; const bool ok = (i < 1072) && (c > 0 || row >= 3);
        const bf16* zp = z + (size_t)(tok0 - 3 + row) * ZW + 128 * h + 8 * ch;
        R.k[s] = ok ? *(const v4u*)(zp + 1536) : (v4u){0u, 0u, 0u, 0u};
        if (PC) R.q[s] = ok ? *(const v4u*)(zp + 1024) : (v4u){0u, 0u, 0u, 0u}; }
#pragma unroll
    for (int s = 0; s < 2; ++s) { const int i = tid + 512 * s, l = i >> 4, ch = i & 15; R.v[s] = *(const v4u*)(z + (size_t)(tok0 + l) * ZW + 2048 + 128 * h + 8 * ch); }
    if (tid < 64) { R.ip = P_GATES[(size_t)(tok0 + tid) * 8 + h]; R.fp = P_GATES[(size_t)(tok0 + tid) * 8 + 4 + h]; }
    if (PC) {
        if (tid >= 128 && tid < 256) R.np = P_NPREV[(size_t)u * 128 + tid - 128];
        R.mp = P_MPREV[u];
    }
}
__device__ __forceinline__ void vt_scatter(LAS unsigned short* VT, int stride, int ch, int l, const v4u& vv) {
    VT[(8 * ch + 0) * stride + l] = (unsigned short)(vv.x & 0xffffu); VT[(8 * ch + 1) * stride + l] = (unsigned short)(vv.x >> 16);
    VT[(8 * ch + 2) * stride + l] = (unsigned short)(vv.y & 0xffffu); VT[(8 * ch + 3) * stride + l] = (unsigned short)(vv.y >> 16);
    VT[(8 * ch + 4) * stride + l] = (unsigned short)(vv.z & 0xffffu); VT[(8 * ch + 5) * stride + l] = (unsigned short)(vv.z >> 16);
    VT[(8 * ch + 6) * stride + l] = (unsigned short)(vv.w & 0xffffu); VT[(8 * ch + 7) * stride + l] = (unsigned short)(vv.w >> 16);
}
__device__ __forceinline__ void conv4_lds(ldsp raw, int l, int ch, const LAS float* cw, const LAS float* cb, float (&out)[8]) {
    { const f32x4 b0 = *(const LAS f32x4*)(cb + 8 * ch), b1 = *(const LAS f32x4*)(cb + 8 * ch + 4); out[0] = b0[0]; out[1] = b0[1]; out[2] = b0[2]; out[3] = b0[3]; out[4] = b1[0]; out[5] = b1[1]; out[6] = b1[2]; out[7] = b1[3]; }
#pragma unroll
    for (int j = 0; j < 4; ++j) { const v4u v = *(const LAS v4u*)(raw + (l + j) * 272 + 16 * ch); const f32x4 w0 = *(const LAS f32x4*)(cw + j * 128 + 8 * ch), w1 = *(const LAS f32x4*)(cw + j * 128 + 8 * ch + 4);
        out[0] += w0[0] * bflo(v.x); out[1] += w0[1] * bfhi(v.x); out[2] += w0[2] * bflo(v.y); out[3] += w0[3] * bfhi(v.y); out[4] += w1[0] * bflo(v.z); out[5] += w1[1] * bfhi(v.z); out[6] += w1[2] * bflo(v.w); out[7] += w1[3] * bfhi(v.w); }
}

__device__ __forceinline__ void mlA_phase(Frame& F) {
    PHASE_FENCE(F);
    const float* ml_cw = karg(F, 15); const float* ml_cb = karg(F, 16);
    ldsp L = F.lds;
    constexpr int RAWK = 0, KTO = 18432, VTO = 36864, WLO = 57600, CWO = 57856;
    LAS unsigned short* KT = (LAS unsigned short*)(L + KTO); LAS unsigned short* VT = (LAS unsigned short*)(L + VTO); LAS float* WL = (LAS float*)(L + WLO); LAS float* CW = (LAS float*)(L + CWO);
    int u = F.vcu; if (u >= 2048) return;
    { const int h = (u >> 6) & 3; for (int i = F.tid; i < 640; i += NWAVES * 64) CW[i] = (i < 512) ? ml_cw[(i >> 7) * 1024 + 512 + 128 * h + (i & 127)] : ml_cb[512 + 128 * h + (i - 512)]; }
    MlPre R; ml_prefetch<false>(F, u, R);
    for (; u < 2048; u += F.G) {
#pragma unroll
        for (int s = 0; s < 3; ++s) { const int i = F.tid + 512 * s; if (i < 1072) *(LAS v4u*)(L + RAWK + (i >> 4) * 272 + 16 * (i & 15)) = R.k[s]; }
#pragma unroll
        for (int s = 0; s < 2; ++s) { const int i = F.tid + 512 * s; vt_scatter(VT, 72, i & 15, i >> 4, R.v[s]); }
        for (int i = F.tid; i < 16 * 64; i += NWAVES * 64) { const int r = i >> 6, l = i & 63; VT[(128 + r) * 72 + l] = (r == 0) ? (unsigned short)0x3F80 : (unsigned short)0; }
        if (F.wave == 0) {
            const int l = F.lane; float bc = logsig(R.fp);
#pragma unroll
            for (int o = 1; o < 64; o <<= 1) { const float v = __shfl_up(bc, o); if (l >= o) bc += v; }
            const float bl = __shfl(bc, 63); const float g = bl - bc + R.ip; float mx = g;
#pragma unroll
            for (int o = 32; o > 0; o >>= 1) mx = fmaxf(mx, __shfl_xor(mx, o));
            WL[l] = __expf(g - mx);
            if (l == 0) { P_MLOC[u] = mx; P_BLAST[u] = bl; }
        }
        __syncthreads();
        if (u + F.G < 2048) ml_prefetch<false>(F, u + F.G, R);
        { const int ch = F.tid & 15;
#pragma unroll
          for (int it = 0; it < 2; ++it) { const int l = (F.tid >> 4) + 32 * it; float kc[8]; conv4_lds(L + RAWK, l, ch, CW, CW + 512, kc);
            const float wl = WL[l] * 0.08838834764831845f;
#pragma unroll
            for (int i = 0; i < 8; ++i) KT[(8 * ch + i) * 72 + l] = f2bf1(fsilu(kc[i]) * wl); } }
        __syncthreads();
        { const int fr = F.lane & 15, fq = F.lane >> 4, w = F.wave;
          bf16x8 a[2];
#pragma unroll
          for (int ks = 0; ks < 2; ++ks) a[ks] = *(const LAS bf16x8*)(L + KTO + (16 * w + fr) * 144 + (32 * ks + 8 * fq) * 2);
#pragma unroll
          for (int nt = 0; nt < 9; ++nt) { f32x4 acc = {0.f, 0.f, 0.f, 0.f};
#pragma unroll
            for (int ks = 0; ks < 2; ++ks) { const bf16x8 bb = *(const LAS bf16x8*)(L + VTO + (16 * nt + fr) * 144 + (32 * ks + 8 * fq) * 2); acc = MFMA16(a[ks], bb, acc); }
            if (nt < 8) { v2u o; o.x = pk2(acc[0], acc[1]); o.y = pk2(acc[2], acc[3]); *(v2u*)(P_CST + (size_t)u * 16384 + (16 * nt + fr) * 128 + 16 * w + 4 * fq) = o; }
            else if (fr == 0) { *(f32x4*)(P_NLOC + (size_t)u * 128 + 16 * w + 4 * fq) = acc; } } }
        __syncthreads();
    }
}

__device__ __forceinline__ void mlC_phase(Frame& F) {
    PHASE_FENCE(F);
    const float* ml_cw = karg(F, 15); const float* ml_cb = karg(F, 16); const float* ml_norm = karg(F, 17);
    ldsp L = F.lds;
    constexpr int RAWQ = 0, RAWK = 18432, QI = 36864, KI = 54272, VTO = 71680, SQO = 90112, CTO = 99328, ARR = 134144  , CWO = 136704  , HFO = 0;
    static_assert(ARR + 576 * 4 <= CWO && CWO + 1408 * 4 <= LDSCTL_OFF, "mlC LDS map");
    LAS unsigned short* VT = (LAS unsigned short*)(L + VTO); LAS unsigned short* SQ = (LAS unsigned short*)(L + SQO); LAS float* HF = (LAS float*)(L + HFO); LAS float* CW = (LAS float*)(L + CWO);
    LAS float* DV = (LAS float*)(L + ARR); LAS float* MU = DV + 64; LAS float* AI = DV + 128; LAS float* EM = DV + 192; LAS float* DENP = DV + 256  ; LAS float* DNI = DV + 384; LAS float* NP = DV + 448  ;
    int u = F.vcu; if (u >= 2048) return;
    const int h = (u >> 6) & 3;
    for (int i = F.tid; i < 1280; i += NWAVES * 64) { const int qk = i / 640, r = i % 640; CW[i] = (r < 512) ? ml_cw[(r >> 7) * 1024 + 512 * qk + 128 * h + (r & 127)] : ml_cb[512 * qk + 128 * h + (r - 512)]; }
    if (F.tid < 128) CW[1280 + F.tid] = ml_norm[128 * h + F.tid];
    MlPre R; ml_prefetch<true>(F, u, R);
    for (; u < 2048; u += F.G) {
        const int c = u & 63, bh = u >> 6, b = bh >> 2, tok0 = b * SEQ + c * 64;
#pragma unroll
        for (int s = 0; s < 3; ++s) { const int i = F.tid + 512 * s; if (i < 1072) { *(LAS v4u*)(L + RAWQ + (i >> 4) * 272 + 16 * (i & 15)) = R.q[s]; *(LAS v4u*)(L + RAWK + (i >> 4) * 272 + 16 * (i & 15)) = R.k[s]; } }
#pragma unroll
        for (int s = 0; s < 2; ++s) { const int i = F.tid + 512 * s; vt_scatter(VT, 72, i & 15, i >> 4, R.v[s]); }
        if (F.wave == 0) {
            const int l = F.lane; float bc = logsig(R.fp);
#pragma unroll
            for (int o = 1; o < 64; o <<= 1) { const float v = __shfl_up(bc, o); if (l >= o) bc += v; }
            const float dv = R.ip - bc; float cm = dv;
#pragma unroll
            for (int o = 1; o < 64; o <<= 1) { const float v = __shfl_up(cm, o); if (l >= o) cm = fmaxf(cm, v); }
            const float bm = bc + R.mp, mt = fmaxf(bm, bc + cm);
            AI[l] = __expf(bm - mt); MU[l] = mt - bc; DV[l] = dv; EM[l] = __expf(-mt);
        }
        if (F.tid >= 128 && F.tid < 256) NP[F.tid - 128] = R.np;
        __syncthreads();
        v4u ct[4];
#pragma unroll
        for (int s = 0; s < 4; ++s) ct[s] = *(const v4u*)(P_CST + (size_t)u * 16384 + (size_t)(F.tid + 512 * s) * 8);
        if (u + F.G < 2048) ml_prefetch<true>(F, u + F.G, R);
        { const int ch = F.tid & 15;
#pragma unroll
          for (int it = 0; it < 2; ++it) { const int l = (F.tid >> 4) + 32 * it; float qc[8], kc[8];
            conv4_lds(L + RAWQ, l, ch, CW, CW + 512, qc); conv4_lds(L + RAWK, l, ch, CW + 640, CW + 1152, kc);
#pragma unroll
            for (int i = 0; i < 8; ++i) { qc[i] = fsilu(qc[i]); kc[i] = fsilu(kc[i]) * 0.08838834764831845f; }
            *(LAS v4u*)(L + QI + l * 272 + 16 * ch) = pk8f(qc); *(LAS v4u*)(L + KI + l * 272 + 16 * ch) = pk8f(kc); } }
        __syncthreads();
        const int fr = F.lane & 15, fq = F.lane >> 4, w = F.wave, tt = w >> 1;
        {
          float rs[4] = {0.f, 0.f, 0.f, 0.f};
#pragma unroll
          for (int si = 0; si < 2; ++si) { const int st = 2 * (w & 1) + si; f32x4 acc = {0.f, 0.f, 0.f, 0.f};
#pragma unroll
            for (int ks = 0; ks < 4; ++ks) { const bf16x8 a = *(const LAS bf16x8*)(L + QI + (16 * tt + fr) * 272 + (32 * ks + 8 * fq) * 2), bb = *(const LAS bf16x8*)(L + KI + (16 * st + fr) * 272 + (32 * ks + 8 * fq) * 2); acc = MFMA16(a, bb, acc); }
            const int s = 16 * st + fr; const float dvs = DV[s];
#pragma unroll
            for (int r = 0; r < 4; ++r) { const int t = 16 * tt + 4 * fq + r; const float wgt = (s <= t) ? __expf(dvs - MU[t]) : 0.f; const float v = acc[r] * wgt; rs[r] += v; SQ[t * 72 + s] = f2bf1(v); } }
#pragma unroll
          for (int r = 0; r < 4; ++r) { float v = rs[r]; v += __shfl_xor(v, 1); v += __shfl_xor(v, 2); v += __shfl_xor(v, 4); v += __shfl_xor(v, 8); if (fr == 0) DENP[(w & 1) * 64 + 16 * tt + 4 * fq + r] = v; }
          const int t = F.tid >> 3, part = F.tid & 7; float acc = 0.f;
          { const v4u v0 = *(const LAS v4u*)(L + QI + t * 272 + 32 * part), v1 = *(const LAS v4u*)(L + QI + t * 272 + 32 * part + 16);
            const float q0[8] = {bflo(v0.x), bfhi(v0.x), bflo(v0.y), bfhi(v0.y), bflo(v0.z), bfhi(v0.z), bflo(v0.w), bfhi(v0.w)};
            const float q1[8] = {bflo(v1.x), bfhi(v1.x), bflo(v1.y), bfhi(v1.y), bflo(v1.z), bfhi(v1.z), bflo(v1.w), bfhi(v1.w)};
#pragma unroll
            for (int i = 0; i < 8; ++i) acc += q0[i] * NP[16 * part + i] + q1[i] * NP[16 * part + 8 + i]; }
          acc += __shfl_xor(acc, 1); acc += __shfl_xor(acc, 2); acc += __shfl_xor(acc, 4);
          if (part == 0) DNI[t] = acc; }
#pragma unroll
        for (int s = 0; s < 4; ++s) { const int i = F.tid + 512 * s; *(LAS v4u*)(L + CTO + (i >> 4) * 272 + 16 * (i & 15)) = ct[s]; }
        __syncthreads();
        v4u o0, o1; { const bf16* op = P_Z + (size_t)(tok0 + (F.tid >> 3)) * ZW + 2560 + 128 * h + 16 * (F.tid & 7); o0 = *(const v4u*)op; o1 = *(const v4u*)(op + 8); }
        {
#pragma unroll 1
          for (int ei = 0; ei < 4; ++ei) { const int et = 4 * (w & 1) + ei; f32x4 ai_ = {0.f, 0.f, 0.f, 0.f}, ax = {0.f, 0.f, 0.f, 0.f};
#pragma unroll
            for (int ks = 0; ks < 2; ++ks) { const bf16x8 a = *(const LAS bf16x8*)(L + SQO + (16 * tt + fr) * 144 + (32 * ks + 8 * fq) * 2), bb = *(const LAS bf16x8*)(L + VTO + (16 * et + fr) * 144 + (32 * ks + 8 * fq) * 2); ai_ = MFMA16(a, bb, ai_); }
#pragma unroll
            for (int ks = 0; ks < 4; ++ks) { const bf16x8 a = *(const LAS bf16x8*)(L + QI + (16 * tt + fr) * 272 + (32 * ks + 8 * fq) * 2), bb = *(const LAS bf16x8*)(L + CTO + (16 * et + fr) * 272 + (32 * ks + 8 * fq) * 2); ax = MFMA16(a, bb, ax); }
#pragma unroll
            for (int r = 0; r < 4; ++r) { const int t = 16 * tt + 4 * fq + r; const float aint = AI[t]; const float den = DENP[t] + DENP[64 + t] + aint * DNI[t]; const float dd = fmaxf(fabsf(den), EM[t]);
                HF[t * 132 + 16 * et + fr] = (ai_[r] + aint * ax[r]) / dd; } } }
        __syncthreads();
        {
          const int t = F.tid >> 3, part = F.tid & 7; f32x4 hv[4]; float ss = 0.f;
#pragma unroll
          for (int i = 0; i < 4; ++i) { hv[i] = *(const LAS f32x4*)(HF + t * 132 + 16 * part + 4 * i); ss += pg8::dot4(hv[i]); }
          ss += __shfl_xor(ss, 1); ss += __shfl_xor(ss, 2); ss += __shfl_xor(ss, 4);
          const float rstd = rsqrtf(ss * (1.0f / 128.0f) + 1e-6f);
          const float og0[8] = {bflo(o0.x), bfhi(o0.x), bflo(o0.y), bfhi(o0.y), bflo(o0.z), bfhi(o0.z), bflo(o0.w), bfhi(o0.w)};
          const float og1[8] = {bflo(o1.x), bfhi(o1.x), bflo(o1.y), bfhi(o1.y), bflo(o1.z), bfhi(o1.z), bflo(o1.w), bfhi(o1.w)};
          float y0[8], y1[8]; const LAS float* gn = CW + 1280 + 16 * part;
#pragma unroll
          for (int i = 0; i < 8; ++i) { y0[i] = hv[i >> 2][i & 3] * rstd * gn[i] * fsigmoid(og0[i]); y1[i] = hv[2 + (i >> 2)][i & 3] * rstd * gn[8 + i] * fsigmoid(og1[i]); }
          bf16* yp = P_YBUF + (size_t)(tok0 + t) * DM + 512 + 128 * h + 16 * part; *(v4u*)yp = pk8f(y0); *(v4u*)(yp + 8) = pk8f(y1); }
        __syncthreads();
    }
}

template <bool FINAL> __device__ __forceinline__ void rg_phase(Frame& F) {
    PHASE_FENCE(F);
    const float* rg_cw = karg(F, 8); const float* rg_cb = karg(F, 9); const float* rg_ba = karg(F, 11); const float* rg_bx = karg(F, 13); const float* rg_lam = karg(F, 14);
    ldsp L = F.lds;
    constexpr int XCO = 0, GRO = 66560;
    LAS unsigned short* XC = (LAS unsigned short*)(L + XCO); LAS unsigned short* GR = (LAS unsigned short*)(L + GRO);
    const int fr = F.lane & 15, fq = F.lane >> 4, w = F.wave;
    if (F.vcu >= 512) return;
    bf16x8 bfr[2][4][2]; float ba[4], bx[4], sp8[4];
#pragma unroll
    for (int g = 0; g < 2; ++g)
#pragma unroll
        for (int jt = 0; jt < 4; ++jt)
#pragma unroll
            for (int ks = 0; ks < 2; ++ks) bfr[g][jt][ks] = *(const bf16x8*)(P_RGW + (size_t)(g * 8 + w) * 4096 + (16 * jt + fr) * 64 + 32 * ks + 8 * fq);
#pragma unroll
    for (int jt = 0; jt < 4; ++jt) { const int chn = 64 * w + 16 * jt + fr; ba[jt] = rg_ba[chn]; bx[jt] = rg_bx[chn]; sp8[jt] = 8.0f * log1pf(__expf(-rg_lam[chn])); }
    for (int u = F.vcu; u < 512; u += F.G) {
        const int b = u >> 6, c = u & 63, tok0 = b * SEQ + c * 64;
        {
          const int chunk = F.tid & 63, run = F.tid >> 6, col0 = 8 * chunk; v4u raw[11];
#pragma unroll
          for (int k = 0; k < 11; ++k) { const int s = c * 64 + 8 * run - 3 + k; raw[k] = (s >= 0) ? *(const v4u*)(P_Z + (size_t)(tok0 + 8 * run - 3 + k) * ZW + col0) : (v4u){0u, 0u, 0u, 0u}; }
          f32x4 wa[4], wb[4];
#pragma unroll
          for (int j = 0; j < 4; ++j) { wa[j] = *(const f32x4*)(rg_cw + j * 512 + col0); wb[j] = *(const f32x4*)(rg_cw + j * 512 + col0 + 4); }
          const f32x4 b0 = *(const f32x4*)(rg_cb + col0), b1 = *(const f32x4*)(rg_cb + col0 + 4);
#pragma unroll
          for (int t = 0; t < 8; ++t) { f32x4 oa = b0, ob = b1;
#pragma unroll
              for (int j = 0; j < 4; ++j) { f32x4 xa, xb2; pg8::unpack8(raw[t + j], xa, xb2); oa += wa[j] * xa; ob += wb[j] * xb2; }
              *(LAS v4u*)(L + XCO + (8 * run + t) * 1040 + 16 * chunk) = pg8::pk8(oa, ob); }
          if (FINAL) {
#pragma unroll
              for (int t = 0; t < 8; ++t) *(LAS v4u*)(L + GRO + (8 * run + t) * 1024 + 16 * chunk) = *(const v4u*)(P_Z + (size_t)(tok0 + 8 * run + t) * ZW + 512 + col0); } }
        __syncthreads();
        float carry[4], ptot[4];
#pragma unroll
        for (int jt = 0; jt < 4; ++jt) { carry[jt] = FINAL ? P_RGC[(size_t)u * 512 + 64 * w + 16 * jt + fr] : 0.f; ptot[jt] = 1.f; }
#pragma unroll 1
        for (int tt = 0; tt < 4; ++tt) {
            bf16x8 a[2];
#pragma unroll
            for (int ks = 0; ks < 2; ++ks) a[ks] = *(const LAS bf16x8*)(L + XCO + (16 * tt + fr) * 1040 + (64 * w + 32 * ks + 8 * fq) * 2);
#pragma unroll
            for (int jt = 0; jt < 4; ++jt) { f32x4 ga = {0.f, 0.f, 0.f, 0.f}, gx = {0.f, 0.f, 0.f, 0.f};
#pragma unroll
                for (int ks = 0; ks < 2; ++ks) { ga = MFMA16(a[ks], bfr[0][jt][ks], ga); gx = MFMA16(a[ks], bfr[1][jt][ks], gx); }
                const int chn = 64 * w + 16 * jt + fr; float av[4], uv[4];
#pragma unroll
                for (int r = 0; r < 4; ++r) { const int t = 16 * tt + 4 * fq + r; const float xcv = bf2f(XC[t * 520 + chn]);
                    const float la = -fsigmoid(ga[r] + ba[jt]) * sp8[jt]; const float aa = __expf(la); av[r] = aa; uv[r] = sqrtf(fmaxf(1.0f - aa * aa, 0.f)) * fsigmoid(gx[r] + bx[jt]) * xcv; }
                float Pi = av[0] * av[1] * av[2] * av[3], hi = ((uv[0] * av[1] + uv[1]) * av[2] + uv[2]) * av[3] + uv[3];
                { const float tP = __shfl_up(Pi, 16), th = __shfl_up(hi, 16); if (fq >= 1) { hi = Pi * th + hi; Pi = Pi * tP; } }
                { const float tP = __shfl_up(Pi, 32), th = __shfl_up(hi, 32); if (fq >= 2) { hi = Pi * th + hi; Pi = Pi * tP; } }
                float Pe = __shfl_up(Pi, 16), he = __shfl_up(hi, 16); if (fq == 0) { Pe = 1.f; he = 0.f; }
                const float P3 = __shfl(Pi, 48 + fr), h3 = __shfl(hi, 48 + fr);
                if (FINAL) { float hc = Pe * carry[jt] + he;
#pragma unroll
                    for (int r = 0; r < 4; ++r) { const int t = 16 * tt + 4 * fq + r; hc = av[r] * hc + uv[r]; const float gr = bf2f(GR[t * 512 + chn]); GR[t * 512 + chn] = f2bf1(hc * gelu_tanh(gr)); } }
                carry[jt] = P3 * carry[jt] + h3; ptot[jt] *= P3; }
        }
        if (!FINAL) { if (fq == 0) {
#pragma unroll
            for (int jt = 0; jt < 4; ++jt) { P_RGA[(size_t)u * 512 + 64 * w + 16 * jt + fr] = ptot[jt]; P_RGH[(size_t)u * 512 + 64 * w + 16 * jt + fr] = carry[jt]; } } }
        else { __syncthreads();
#pragma unroll
            for (int k = 0; k < 8; ++k) { const int i = F.tid + 512 * k, t = i >> 6, chunk = i & 63; *(v4u*)(P_YBUF + (size_t)(tok0 + t) * DM + 8 * chunk) = *(const LAS v4u*)(L + GRO + t * 1024 + 16 * chunk); } }
        __syncthreads();
    }
}

__device__ __forceinline__ void mixB_unit(Frame& F, int unit) {
    PHASE_FENCE(F);
    const int bh = unit >> 3, sl = unit & 7; ldsp L = F.lds;
    LAS float* AP = (LAS float*)L; LAS float* AL = AP + 64;
    if (F.wave == 0) { float mst = -INFINITY;
        for (int c = 0; c < 64; ++c) { const float ml = P_MLOC[bh * 64 + c], bl = P_BLAST[bh * 64 + c]; const float mn = fmaxf(bl + mst, ml);
            if (F.lane == 0) { AP[c] = expf(bl + mst - mn); AL[c] = expf(ml - mn); if (sl == 0) P_MPREV[bh * 64 + c] = mst; }
            mst = mn; } }
    __syncthreads();
    { float st[4] = {0.f, 0.f, 0.f, 0.f}; bf16* base = P_CST + (size_t)bh * 64 * 16384 + sl * 2048 + F.tid * 4;
      for (int c0 = 0; c0 < 64; c0 += 8) { v2u cl[8];
#pragma unroll
        for (int k = 0; k < 8; ++k) cl[k] = *(const v2u*)(base + (size_t)(c0 + k) * 16384);
#pragma unroll
        for (int k = 0; k < 8; ++k) { v2u o; o.x = pk2(st[0], st[1]); o.y = pk2(st[2], st[3]); *(v2u*)(base + (size_t)(c0 + k) * 16384) = o;
            const float ap = AP[c0 + k], al = AL[c0 + k];
            st[0] = ap * st[0] + al * bflo(cl[k].x); st[1] = ap * st[1] + al * bfhi(cl[k].x); st[2] = ap * st[2] + al * bflo(cl[k].y); st[3] = ap * st[3] + al * bfhi(cl[k].y); } } }
    if (sl == 0 && F.tid < 128) { float ns = 0.f;
        for (int c = 0; c < 64; ++c) { const size_t o = (size_t)(bh * 64 + c) * 128 + F.tid; const float nl = P_NLOC[o]; P_NPREV[o] = ns; ns = AP[c] * ns + AL[c] * nl; } }
    if (F.tid < 16) { const int idx = unit * 16 + F.tid, b = idx >> 9, chn = idx & 511; float cr = 0.f;
        for (int c = 0; c < 64; ++c) { const size_t o = (size_t)(b * 64 + c) * 512 + chn; P_RGC[o] = cr; cr = P_RGA[o] * cr + P_RGH[o]; } }
    __syncthreads();
}

__device__ __forceinline__ void attn_unit(Frame& F, int u, const bf16* Qb, const bf16* Kb, const bf16* Vb, bf16* Ob) { const float* at_sinks = karg(F, 22);
    const int qb = u & 31, kvh = (u >> 5) & 3, b = u >> 7; const int row0 = b * SEQ + 128 * qb;
    ldsp L = F.lds;
    constexpr int KI = 0, VTO = 36864;
    LAS unsigned short* VT = (LAS unsigned short*)(L + VTO);
#pragma unroll
    for (int it = 0; it < 4; ++it) { const int idx = F.tid + 512 * it, kr = idx >> 3, chk = idx & 7; const bool ok = (qb > 0) || (kr >= 128);
        v4u kv = {0u, 0u, 0u, 0u}, vv = {0u, 0u, 0u, 0u};
        if (ok) { const size_t o = (size_t)(row0 - 128 + kr) * 256 + 64 * kvh + 8 * chk; kv = *(const v4u*)(Kb + o); vv = *(const v4u*)(Vb + o); }
        *(LAS v4u*)(L + KI + kr * 144 + 16 * chk) = kv;
        VT[(8 * chk + 0) * 260 + kr] = (unsigned short)(vv.x & 0xffffu); VT[(8 * chk + 1) * 260 + kr] = (unsigned short)(vv.x >> 16);
        VT[(8 * chk + 2) * 260 + kr] = (unsigned short)(vv.y & 0xffffu); VT[(8 * chk + 3) * 260 + kr] = (unsigned short)(vv.y >> 16);
        VT[(8 * chk + 4) * 260 + kr] = (unsigned short)(vv.z & 0xffffu); VT[(8 * chk + 5) * 260 + kr] = (unsigned short)(vv.z >> 16);
        VT[(8 * chk + 6) * 260 + kr] = (unsigned short)(vv.w & 0xffffu); VT[(8 * chk + 7) * 260 + kr] = (unsigned short)(vv.w >> 16); }
    __syncthreads();
    const int r = F.lane & 31, hh = F.lane >> 5, w = F.wave, head = 4 * kvh + (w >> 1);
    const float sink = at_sinks[head];
#pragma unroll 1
    for (int qt = 0; qt < 2; ++qt) {
        const int q0 = 64 * (w & 1) + 32 * qt, kt0 = q0 >> 5; const size_t qrow = (size_t)(row0 + q0 + r);
        bf16x8 qf[4];
#pragma unroll
        for (int ks = 0; ks < 4; ++ks) qf[ks] = *(const bf16x8*)(Qb + qrow * 1024 + 64 * head + 16 * ks + 8 * hh);
        f32x16 S[5];
#pragma unroll
        for (int i = 0; i < 5; ++i) {
#pragma unroll
            for (int e = 0; e < 16; ++e) S[i][e] = 0.f;
#pragma unroll
            for (int ks = 0; ks < 4; ++ks) { const bf16x8 kf = *(const LAS bf16x8*)(L + KI + (32 * (kt0 + i) + r) * 144 + (16 * ks + 8 * hh) * 2); S[i] = MFMA32(kf, qf[ks], S[i]); } }
        float mx = sink;
#pragma unroll
        for (int i = 0; i < 5; ++i)
#pragma unroll
            for (int e = 0; e < 16; ++e) { const int cr = (e & 3) + 8 * (e >> 2) + 4 * hh; bool ok = true;
                if (i == 0) ok = cr > r; if (i == 4) ok = cr <= r;
                if (qb == 0) ok = ok && (32 * (kt0 + i) + cr >= 128);
                const float v = ok ? S[i][e] : -INFINITY; S[i][e] = v; mx = fmaxf(mx, v); }
        mx = fmaxf(mx, __shfl_xor(mx, 32));
        float sum = 0.f;
#pragma unroll
        for (int i = 0; i < 5; ++i)
#pragma unroll
            for (int e = 0; e < 16; ++e) { const float p = __expf(S[i][e] - mx); S[i][e] = p; sum += p; }
        sum += __shfl_xor(sum, 32); sum += __expf(sink - mx);
        const float inv = 1.0f / sum;
        f32x16 O[2];
#pragma unroll
        for (int e = 0; e < 16; ++e) { O[0][e] = 0.f; O[1][e] = 0.f; }
#pragma unroll
        for (int i = 0; i < 5; ++i)
#pragma unroll
            for (int s = 0; s < 2; ++s) {
                v4u pw; pw.x = pk2(S[i][8 * s + 0], S[i][8 * s + 1]); pw.y = pk2(S[i][8 * s + 2], S[i][8 * s + 3]); pw.z = pk2(S[i][8 * s + 4], S[i][8 * s + 5]); pw.w = pk2(S[i][8 * s + 6], S[i][8 * s + 7]);
                const bf16x8 pf = __builtin_bit_cast(bf16x8, pw);
#pragma unroll
                for (int dt = 0; dt < 2; ++dt) { const int ko = (32 * dt + r) * 520 + (32 * (kt0 + i) + 16 * s + 4 * hh) * 2;
                    const s16x4 lo = *(const LAS s16x4*)(L + VTO + ko), hi = *(const LAS s16x4*)(L + VTO + ko + 16);
                    const bf16x8 vf = __builtin_shufflevector(lo, hi, 0, 1, 2, 3, 4, 5, 6, 7);
                    O[dt] = MFMA32(vf, pf, O[dt]); } }
        bf16* op = Ob + qrow * 1024 + 64 * head + 4 * hh;
#pragma unroll
        for (int dt = 0; dt < 2; ++dt)
#pragma unroll
            for (int g4 = 0; g4 < 4; ++g4) { v2u o; o.x = pk2(O[dt][4 * g4] * inv, O[dt][4 * g4 + 1] * inv); o.y = pk2(O[dt][4 * g4 + 2] * inv, O[dt][4 * g4 + 3] * inv); *(v2u*)(op + 32 * dt + 8 * g4) = o; }
    }
    __syncthreads();
}

__device__ __forceinline__ void fixup_phase(Frame& F, const float* cw, const float* cb, bf16* A2, const bf16* GH, const bf16* UH, const bf16* GT) {
    PHASE_FENCE(F);
    constexpr int TOTAL = (T / 64) * 2 * 384;
    for (int idx = F.vcu * NWAVES * 64 + F.tid; idx < TOTAL; idx += F.G * NWAVES * 64) {
        const int chk = idx % 384, rg = idx / 384, rr = rg & 1, grp = rg >> 1, ch0 = 8 * chk; const bool first = (grp & 63) == 0;
        float g0[8], u0[8], p1[8], p2[8];
        ld8f(GH + ((size_t)grp * 2 + rr) * 3072 + ch0, g0); ld8f(UH + ((size_t)grp * 2 + rr) * 3072 + ch0, u0);
#pragma unroll
        for (int i = 0; i < 8; ++i) { p1[i] = 0.f; p2[i] = 0.f; }
        if (rr == 1) { ld8f(GH + ((size_t)grp * 2) * 3072 + ch0, p1); if (!first) ld8f(GT + ((size_t)(grp - 1) * 2 + 1) * 3072 + ch0, p2); }
        else if (!first) { ld8f(GT + ((size_t)(grp - 1) * 2 + 1) * 3072 + ch0, p1); ld8f(GT + ((size_t)(grp - 1) * 2) * 3072 + ch0, p2); }
        float o[8];
#pragma unroll
        for (int i = 0; i < 8; ++i) { const float y = cw[ch0 + i] * p2[i] + cw[3072 + ch0 + i] * p1[i] + cw[6144 + ch0 + i] * g0[i] + cb[ch0 + i]; o[i] = gelu_tanh(y) * u0[i]; }
        *(v4u*)(A2 + ((size_t)grp * 64 + rr) * 3072 + ch0) = pk8f(o);
    }
}


#define GRID_BAR() xcd_barrier(bar)
template <int L> __device__ __forceinline__ bool layer_part(Frame& F, const XcdBarrier& bar) {
    constexpr int l = L;
    unsigned char* ws = F.ws; const int bx = (int)blockIdx.x;
    bf16* const XBA = (bf16*)(ws + WS_XBA); bf16* const XBB = (bf16*)(ws + WS_XBB);
    float* const SSA = (float*)(ws + WS_SSA); float* const SSB = (float*)(ws + WS_SSB);
    bf16* const PP = (bf16*)(ws + WS_CST); bf16* const A2 = (bf16*)(ws + WS_BIG);

        if (l == 1) {
            bf16* const Qb = (bf16*)(ws + WS_BIG); bf16* const Kb = (bf16*)(ws + WS_BIG + 64 * MiB); bf16* const Vb = (bf16*)(ws + WS_BIG + 80 * MiB); bf16* const Ob = (bf16*)(ws + WS_BIG + 96 * MiB);
PREP(7) {
            { pg8::Gemm g{XBB, (const bf16*)(ws + WS_WQKV), T, 1536, DM}; pg8::StaticOrder S; S.init(T, 1536, F.G, bx);
              pg8::EpiQkv E{SSB, P_ROPE, karg(F, 20), karg(F, 21), Qb, Kb, Vb};
              pg8::gemm_phase<pg8::EpiQkv, pg8::StaticOrder, true, true>(F.lds, g, S, E); }
            { pg8::Gemm g{(const bf16*)(ws + WS_PB) + (size_t)T * 256, (const bf16*)(ws + WS_WPJ1), T, DM, 256}; pg8::StaticOrder S; S.init(T, DM, F.G, bx);
              pg8::EpiZ E{PP, DM, nullptr, nullptr};
              pg8::gemm_phase<pg8::EpiZ, pg8::StaticOrder, true, true>(F.lds, g, S, E); }
            GRID_BAR();
    }

            PREP(8) {
            PHASE_FENCE(F); for (int u = F.vcu; u < 1024; u += F.G) attn_unit(F, u, Qb, Kb, Vb, Ob);
            GRID_BAR();
            }
            { pg8::Gemm g{Ob, (const bf16*)(ws + WS_WO1), T, DM, DM}; pg8::StaticOrder S; S.init(T, DM, F.G, bx);
              pg8::EpiRes<false> E{XBB, XBA, SSA};
              pg8::gemm_phase<pg8::EpiRes<false>, pg8::StaticOrder, true, true>(F.lds, g, S, E); }
            GRID_BAR();
            if (DBG_STOP == 9) return true;
        } else {
PREP(3) {
            { pg8::Gemm g{P_YBUF, (const bf16*)(ws + WS_WOUT0), T, DM, DM}; pg8::StaticOrder S; S.init(T, DM, F.G, bx);
              pg8::EpiRes<true> E{karg(F, 0), XBB, SSB};
              pg8::gemm_phase<pg8::EpiRes<true>, pg8::StaticOrder, true, true>(F.lds, g, S, E); }
            { pg8::Gemm g{(const bf16*)(ws + WS_PB), (const bf16*)(ws + WS_WPJ0), T, DM, 256}; pg8::StaticOrder S; S.init(T, DM, F.G, bx);
              pg8::EpiZ E{PP, DM, nullptr, nullptr};
              pg8::gemm_phase<pg8::EpiZ, pg8::StaticOrder, true, true>(F.lds, g, S, E); }
            GRID_BAR();
    }

            if (DBG_STOP == 3) return true;
        }
        const bf16* xin = l ? XBA : XBB; const float* ssin = l ? SSA : SSB; bf16* side = l ? XBB : XBA;
        bf16* const GH = side; bf16* const UH = side + (size_t)3 * MiB; bf16* const GT = side + (size_t)6 * MiB;
        const float* cw = karg(F, 25) + (size_t)l * 3 * 3072; const float* cb = karg(F, 26) + (size_t)l * 3072;
        PREP(10 + 10 * l) {
        { pg8::Gemm g{xin, (const bf16*)(ws + (l ? WS_WUP1 : WS_WUP0)), T, 2 * FFD, DM}; pg8::StaticOrder S; S.init(T, 2 * FFD, F.G, bx);
          pg8::EpiUp E{ssin, cw, cb, A2, GH, UH, GT};
          pg8::gemm_phase<pg8::EpiUp, pg8::StaticOrder, true, true>(F.lds, g, S, E); }
        GRID_BAR();
        }
        PREP(11 + 10 * l) {
        fixup_phase(F, cw, cb, A2, GH, UH, GT);
        GRID_BAR();
        }
        bf16* const xdn = l ? XBB : XBA; float* const ssdn = l ? SSB : SSA;
        { pg8::Gemm g{A2, (const bf16*)(ws + (l ? WS_WDN1 : WS_WDN0)), T, DM, FFD}; pg8::StaticOrder S; S.init(T, DM, F.G, bx);
          pg8::EpiRes<false> E{xin, xdn, ssdn};
          pg8::gemm_phase<pg8::EpiRes<false>, pg8::StaticOrder, true, true>(F.lds, g, S, E); }
        GRID_BAR();
        if ((l == 0 && DBG_STOP == 5) || (l == 1 && DBG_STOP == 11)) return true;
        { pg8::Gemm g{xdn, (const bf16*)(ws + (l ? WS_WGT1 : WS_WGT0)), T, DM, DM}; pg8::StaticOrder S; S.init(T, DM, F.G, bx);
          pg8::EpiPle<(L == 1)> E{ssdn, PP, xdn, XBB, SSB, F.out};
          pg8::gemm_phase<pg8::EpiPle<(L == 1)>, pg8::StaticOrder, true, true>(F.lds, g, S, E); }
        if (l == 0) GRID_BAR();
        if (l == 0 && DBG_STOP == 6) return true;

    return false;
}
struct Args { const void* in[30]; float* out; unsigned char* ws; };
__global__ void __launch_bounds__(NWAVES * 64, 2) hy_fwd(Args args) {
    extern __shared__ __attribute__((aligned(16))) unsigned char lds[];
    Frame F;
    F.lds = (ldsp)lds; F.MISC = (volatile LAS unsigned*)(F.lds + MISC_OFF);
    F.tid = threadIdx.x; F.lane = F.tid & 63; F.wave = __builtin_amdgcn_readfirstlane(F.tid >> 6);
    F.G = gridDim.x; { const int bx = blockIdx.x; F.vcu = (F.G % 8 == 0) ? (bx % 8) * (F.G / 8) + bx / 8 : bx; }
    unsigned char* ws = args.ws; F.ws = ws; F.out = args.out;
    F.kb = (unsigned long long)__builtin_amdgcn_kernarg_segment_ptr();
    for (int i = F.tid; i < (LDS_BYTES - LDSCTL_OFF) / 4; i += NWAVES * 64) ((LAS unsigned*)(F.lds + LDSCTL_OFF))[i] = 0u;
    __syncthreads();
    XcdBarrier bar = xcd_barrier_post((unsigned*)(ws + WS_CTL) + CW_BAR, F.MISC + 8);
    bf16* const XBA = (bf16*)(ws + WS_XBA); bf16* const XBB = (bf16*)(ws + WS_XBB);
    float* const SSA = (float*)(ws + WS_SSA); float* const SSB = (float*)(ws + WS_SSB);
    bf16* const PP = (bf16*)(ws + WS_CST); bf16* const A2 = (bf16*)(ws + WS_BIG);
    const int bx = (int)blockIdx.x;

    PREP(100) {
    p0_prologue(F);
    GRID_BAR();
    }
#if DBG_STOP >= 1
PREP(1) {
    { pg8::Gemm g{XBA, (const bf16*)(ws + WS_WIN), T, ZW, DM}; pg8::StaticOrder S; S.init(T, ZW, F.G, bx);
#if PROBE_PHASE == 1 && defined(PROBE_VARIANT)
      if (rep_ < PROBE_N) {
#if PROBE_VARIANT == 1
        pg8::EpiNone E0{}; pg8::gemm_phase<pg8::EpiNone, pg8::StaticOrder, true, true>(F.lds, g, S, E0);
#else
        pg8::EpiZ E0{P_Z, ZW, nullptr, nullptr}; pg8::gemm_phase<pg8::EpiZ, pg8::StaticOrder, true, true>(F.lds, g, S, E0);
#endif
      } else
#endif
      { pg8::EpiZ E{P_Z, ZW, karg(F, 7), SSA};
      pg8::gemm_phase<pg8::EpiZ, pg8::StaticOrder, true, true>(F.lds, g, S, E); } }
    GRID_BAR();
    }

    PREP(2) {
    mlA_phase(F); rg_phase<false>(F);
    GRID_BAR();
    }
    for (int u = F.vcu; u < 256; u += F.G) mixB_unit(F, u);
    GRID_BAR();
    PREP(4) {
    mlC_phase(F); rg_phase<true>(F);
    GRID_BAR();
    }
#endif
    PREP(99) { if (rep_ > 0) GRID_BAR(); }
#if DBG_STOP >= 3
    if (layer_part<0>(F, bar)) return;
    if (layer_part<1>(F, bar)) return;
#endif
}

extern "C" void kernel_launch(void* const* d_in, const int* in_sizes, int n_in, void* d_out, int out_size, void* d_ws, size_t ws_size, hipStream_t stream) {
    static int grid = 0;
    if (grid == 0) {
        if (n_in != 30 || in_sizes[0] != T * DM || out_size != T * DM || ws_size < WS_END) { fprintf(stderr, "kernel_launch: unexpected shapes (n_in %d, in0 %d, out %d, ws %zu < %zu); nothing launched\n", n_in, n_in > 0 ? in_sizes[0] : -1, out_size, ws_size, (size_t)WS_END); grid = -1; return; }
        int dev = 0, cus = 0, per_cu = 0;
        if (hipGetDevice(&dev) != hipSuccess || hipDeviceGetAttribute(&cus, hipDeviceAttributeMultiprocessorCount, dev) != hipSuccess) { fprintf(stderr, "kernel_launch: device query failed\n"); grid = -1; return; }
        if (hipFuncSetAttribute((const void*)hy_fwd, hipFuncAttributeMaxDynamicSharedMemorySize, LDS_BYTES) != hipSuccess) { fprintf(stderr, "kernel_launch: hipFuncSetAttribute failed\n"); grid = -1; return; }
        if (hipOccupancyMaxActiveBlocksPerMultiprocessor(&per_cu, (const void*)hy_fwd, NWAVES * 64, LDS_BYTES) != hipSuccess || per_cu < 1) { fprintf(stderr, "kernel_launch: occupancy query says %d workgroups per CU; nothing launched\n", per_cu); (void)hipGetLastError(); grid = -1; return; }
        grid = cus;
    }
    if (grid < 0) return;
    if (hipMemsetAsync((char*)d_ws + WS_CTL, 0, CTL_ZERO_BYTES, stream) != hipSuccess) { fprintf(stderr, "kernel_launch: hipMemsetAsync failed\n"); return; }
    Args a{};
    for (int i = 0; i < 30; ++i) a.in[i] = d_in[i];
    a.out = (float*)d_out; a.ws = (unsigned char*)d_ws;
    hipLaunchKernelGGL(hy_fwd, dim3(grid), dim3(NWAVES * 64), LDS_BYTES, stream, a);
    const hipError_t le = hipPeekAtLastError();
    if (le != hipSuccess) fprintf(stderr, "kernel_launch: launch failed: %s\n", hipGetErrorName(le));
}
```

```cpp
#include <hip/hip_runtime.h>
#include <cstdio>
#include <cstdint>
#include <cmath>
namespace pg8 {
#define PG8_LAS __attribute__((address_space(3)))
typedef unsigned short bf16_t;
typedef short bf16x8 __attribute__((ext_vector_type(8)));
typedef float f32x4 __attribute__((ext_vector_type(4)));
typedef unsigned u32x4 __attribute__((ext_vector_type(4)));
constexpr int BM = 256, BK = 64, HALF = 128, HTB = HALF * BK * 2  , STAGE_BYTES = 8 * HTB, NXCD = 8, WGM = 8;

__host__ __device__ __forceinline__ int lds_byte(int r, int c) { const int st = (r >> 4) * 2 + (c >> 5), rr = r & 15, cc = c & 31, ob = rr * 64 + cc * 2; return st * 1024 + (ob ^ (((ob >> 9) & 1) << 5)); }
__host__ __device__ __forceinline__ void stage_rc(int b, int& R, int& C) { const int st = b / 1024, sb = b % 1024, swz = sb ^ (((sb >> 9) & 1) << 5); R = (st >> 1) * 16 + swz / 64; C = (st & 1) * 32 + (swz % 64) / 2; }
__host__ __device__ __forceinline__ int perm32(int rho) { const int n = rho >> 4, i = rho & 15; return 8 * (i >> 2) + 4 * n + (i & 3); }

__device__ __forceinline__ int lane_now() { int l; asm volatile("v_mbcnt_lo_u32_b32 %0, -1, 0\n\tv_mbcnt_hi_u32_b32 %0, -1, %0" : "=v"(l)); return l; }

struct Unit { int pm, pn; };
struct Gemm { const bf16_t* A; const bf16_t* Bt; int M, N, K; };

struct StaticOrder {
    int nM, nN, nwg, G, c;
    __host__ __device__ void init(int M, int N, int G_, int c_) { nM = M / BM; nN = N / BM; nwg = nM * nN; G = G_; c = c_; }
    __host__ __device__ bool next(int i, Unit& u) const {
        const long L = (long)i * G + c; if (L >= nwg) return false;
        int wgid = (int)L; { const int q = nwg / NXCD, r = nwg % NXCD, xcd = wgid % NXCD, off = wgid / NXCD; wgid = (xcd < r ? xcd * (q + 1) : r * (q + 1) + (xcd - r) * q) + off; }
        const int nig = WGM * nN, gid = wgid / nig, fm = gid * WGM, gsz = (nM - fm) < WGM ? (nM - fm) : WGM;
        u.pm = fm + ((wgid % nig) % gsz); u.pn = (wgid % nig) / gsz; return true;
    }
    __device__ __forceinline__ void a_ready(const Unit&) const {}
    __device__ __forceinline__ void done(const Unit&) const {}
};

typedef float f32x2_t __attribute__((ext_vector_type(2))); typedef __bf16 bf16x2_t __attribute__((ext_vector_type(2)));
__device__ __forceinline__ unsigned pk2(float lo, float hi) { f32x2_t v = {lo, hi}; bf16x2_t b = __builtin_convertvector(v, bf16x2_t); return __builtin_bit_cast(unsigned, b); }
__device__ __forceinline__ float bflo(unsigned w) { return __uint_as_float(w << 16); }
__device__ __forceinline__ float bfhi(unsigned w) { return __uint_as_float(w & 0xffff0000u); }
__device__ __forceinline__ float fsigmoid(float x) { return __builtin_amdgcn_rcpf(1.0f + __expf(-x)); }
__device__ __forceinline__ float gelu_tanh(float x) { const float t2 = x * (2.3022082f + 0.10294324f * x * x); return x * __builtin_amdgcn_rcpf(1.0f + __builtin_amdgcn_exp2f(-t2)); }
__device__ __forceinline__ u32x4 pk8(const f32x4& a, const f32x4& b) { u32x4 w; w.x = pk2(a[0], a[1]); w.y = pk2(a[2], a[3]); w.z = pk2(b[0], b[1]); w.w = pk2(b[2], b[3]); return w; }
__device__ __forceinline__ float dot4(const f32x4& a) { return (a[0] * a[0] + a[1] * a[1]) + (a[2] * a[2] + a[3] * a[3]); }
__device__ __forceinline__ float sum_fq(float s) {
    { const auto r = __builtin_amdgcn_permlane16_swap(__float_as_uint(s), __float_as_uint(s), false, false); s = __uint_as_float(r[0]) + __uint_as_float(r[1]); }
    { const auto r = __builtin_amdgcn_permlane32_swap(__float_as_uint(s), __float_as_uint(s), false, false); s = __uint_as_float(r[0]) + __uint_as_float(r[1]); }
    return s;
}
__device__ __forceinline__ float row_rstd(const float* ss, int row) {
    const f32x4* p = (const f32x4*)(ss + (size_t)row * 16);
    const f32x4 a = p[0], b = p[1], c = p[2], d = p[3];
    const float s = (((a[0] + a[1]) + (a[2] + a[3])) + ((b[0] + b[1]) + (b[2] + b[3]))) + (((c[0] + c[1]) + (c[2] + c[3])) + ((d[0] + d[1]) + (d[2] + d[3])));
    return rsqrtf(s * (1.0f / 1024.0f) + 1e-6f);
}

__device__ __forceinline__ unsigned dpp_xor1(unsigned v) { return (unsigned)__builtin_amdgcn_update_dpp(0, (int)v, 0xB1, 0xF, 0xF, true); }
template <int N> __device__ __forceinline__ unsigned dpp_ror(unsigned v) { return (unsigned)__builtin_amdgcn_update_dpp(0, (int)v, 0x120 + N, 0xF, 0xF, true); }
__device__ __forceinline__ u32x4 shfl1(const u32x4& v) { u32x4 r; r.x = dpp_xor1(v.x); r.y = dpp_xor1(v.y); r.z = dpp_xor1(v.z); r.w = dpp_xor1(v.w); return r; }
__device__ __forceinline__ void xchg_out(const u32x4& X0, const u32x4& X1, bool odd, u32x4& PA, u32x4& PB) { const u32x4 recv = shfl1(odd ? X0 : X1); PA = odd ? recv : X0; PB = odd ? X1 : recv; }
__device__ __forceinline__ void xchg_in(const u32x4& LA, const u32x4& LB, bool odd, u32x4& X0, u32x4& X1) { const u32x4 recv = shfl1(odd ? LA : LB); X0 = odd ? recv : LA; X1 = odd ? LB : recv; }
__device__ __forceinline__ u32x4 f2u(const f32x4& v) { return __builtin_bit_cast(u32x4, v); }
__device__ __forceinline__ f32x4 u2f(const u32x4& v) { return __builtin_bit_cast(f32x4, v); }
__device__ __forceinline__ void unpack8(const u32x4& w, f32x4& a, f32x4& b) { a[0] = bflo(w.x); a[1] = bfhi(w.x); a[2] = bflo(w.y); a[3] = bfhi(w.y); b[0] = bflo(w.z); b[1] = bfhi(w.z); b[2] = bflo(w.w); b[3] = bfhi(w.w); }
__device__ __forceinline__ void store_bf16_lines(bf16_t* base, int ld, int rowE, int fr, int fq, const u32x4& X0, const u32x4& X1) {
    const bool odd = fr & 1; u32x4 PA, PB; xchg_out(X0, X1, odd, PA, PB); const int c8 = ((fr & 1) * 4 + fq) * 8;
    *(u32x4*)(base + (size_t)rowE * ld + c8) = PA; *(u32x4*)(base + (size_t)(rowE + 1) * ld + c8) = PB;
}
__device__ __forceinline__ void load_bf16_lines(const bf16_t* base, int ld, int rowE, int fr, int fq, u32x4& X0, u32x4& X1) {
    const bool odd = fr & 1; const int c8 = ((fr & 1) * 4 + fq) * 8;
    const u32x4 LA = *(const u32x4*)(base + (size_t)rowE * ld + c8), LB = *(const u32x4*)(base + (size_t)(rowE + 1) * ld + c8); xchg_in(LA, LB, odd, X0, X1);
}
__device__ __forceinline__ void store_f32_lines(float* base, int ld, int rowE, int fr, int fq, const f32x4& N0, const f32x4& N1) {
    const bool odd = fr & 1; u32x4 PA, PB; xchg_out(f2u(N0), f2u(N1), odd, PA, PB); const int c4 = (2 * fq + (fr & 1)) * 4;
    *(u32x4*)(base + (size_t)rowE * ld + c4) = PA; *(u32x4*)(base + (size_t)(rowE + 1) * ld + c4) = PB;
}
__device__ __forceinline__ void load_f32_lines(const float* base, int ld, int rowE, int fr, int fq, f32x4& N0, f32x4& N1) {
    const bool odd = fr & 1; const int c4 = (2 * fq + (fr & 1)) * 4;
    const u32x4 LA = *(const u32x4*)(base + (size_t)rowE * ld + c4), LB = *(const u32x4*)(base + (size_t)(rowE + 1) * ld + c4); u32x4 X0, X1; xchg_in(LA, LB, odd, X0, X1); N0 = u2f(X0); N1 = u2f(X1);
}
__device__ __forceinline__ size_t pair_off(int LD, int row, int colw, int fq) { return (size_t)(row >> 1) * (size_t)(2 * LD) + (size_t)((colw >> 6) * 128 + (row & 1) * 32 + 8 * fq); }

__device__ __forceinline__ f32x4 rstd_ld(const float* ss, int row, int fq) { return *(const f32x4*)(ss + (size_t)row * 16 + 4 * fq); }
__device__ __forceinline__ float rstd_fin(const f32x4& p) { float s = (p[0] + p[1]) + (p[2] + p[3]); s = sum_fq(s); return rsqrtf(s * (1.0f / 1024.0f) + 1e-6f); }

template <bool OPAIR> struct EpiZ {
    static constexpr bool PERM = true, AFTER_DRAIN = false, APERM = false;
    bf16_t* O; int ldc; const float* bias; const float* ss;
    __device__ __forceinline__ void operator()(const f32x4 (&acc)[2][2][4][2], const Unit& u, int wr, int wc, int fr, int fq) const {
        const int colw = u.pn * BM + 64 * wc;
        f32x4 bv[2][2];
#pragma unroll
        for (int bj = 0; bj < 2; ++bj)
#pragma unroll
            for (int n = 0; n < 2; ++n) bv[bj][n] = bias ? *(const f32x4*)(bias + colw + 32 * bj + 8 * fq + 4 * n) : (f32x4){0.f, 0.f, 0.f, 0.f};
#pragma unroll
        for (int ai = 0; ai < 2; ++ai) {
            f32x4 rp[4];
#pragma unroll
            for (int m = 0; m < 4; ++m) rp[m] = ss ? rstd_ld(ss, u.pm * BM + ai * HALF + wr * 64 + m * 16 + fr, fq) : (f32x4){0.f, 0.f, 0.f, 0.f};
#pragma unroll
            for (int m = 0; m < 4; ++m) { const int rowE = u.pm * BM + ai * HALF + wr * 64 + m * 16 + (fr & ~1); const float rs = ss ? rstd_fin(rp[m]) : 1.0f;
                const u32x4 X0 = pk8(acc[ai][0][m][0] * rs + bv[0][0], acc[ai][0][m][1] * rs + bv[0][1]), X1 = pk8(acc[ai][1][m][0] * rs + bv[1][0], acc[ai][1][m][1] * rs + bv[1][1]);
                if (OPAIR) { bf16_t* o = O + pair_off(ldc, rowE + (fr & 1), colw, fq); *(u32x4*)o = X0; *(u32x4*)(o + 64) = X1; }
                else store_bf16_lines(O + colw, ldc, rowE, fr, fq, X0, X1); } }
    }
};

template <bool SRCF32, bool AP> struct EpiRes {
    static constexpr bool PERM = true, AFTER_DRAIN = false, APERM = AP;
    const void* src; bf16_t* xb; float* sso;
    __device__ __forceinline__ void operator()(const f32x4 (&acc)[2][2][4][2], const Unit& u, int wr, int wc, int fr, int fq) const {
        const int colw = u.pn * BM + 64 * wc; const bool odd = fr & 1;
#pragma unroll
        for (int ah = 0; ah < (SRCF32 ? 4 : 2); ++ah) { const int ai = SRCF32 ? (ah >> 1) : ah, m0 = SRCF32 ? (ah & 1) * 2 : 0, m1 = SRCF32 ? m0 + 2 : 4;
            u32x4 LA[4][2], LB[4][2];
#pragma unroll
            for (int m = m0; m < m1; ++m) { const int rowE = u.pm * BM + ai * HALF + wr * 64 + m * 16 + (fr & ~1);
                if (SRCF32) { const int c4 = (2 * fq + (fr & 1)) * 4;
#pragma unroll
                    for (int bj = 0; bj < 2; ++bj) { const float* b = (const float*)src + colw + 32 * bj + c4; LA[m][bj] = *(const u32x4*)(b + (size_t)rowE * 1024); LB[m][bj] = *(const u32x4*)(b + (size_t)(rowE + 1) * 1024); } }
                else { const bf16_t* b = (const bf16_t*)src + pair_off(1024, rowE + (fr & 1), colw, fq); LA[m][0] = *(const u32x4*)b; LB[m][0] = *(const u32x4*)(b + 64); } }
#pragma unroll
            for (int m = m0; m < m1; ++m) { const int rowE = u.pm * BM + ai * HALF + wr * 64 + m * 16 + (fr & ~1), row = rowE + (fr & 1);
                f32x4 r[2][2];
                if (SRCF32) {
#pragma unroll
                    for (int bj = 0; bj < 2; ++bj) { u32x4 X0, X1; xchg_in(LA[m][bj], LB[m][bj], odd, X0, X1); r[bj][0] = u2f(X0); r[bj][1] = u2f(X1); } }
                else { unpack8(LA[m][0], r[0][0], r[0][1]); unpack8(LB[m][0], r[1][0], r[1][1]); }
                float sq = 0.f; f32x4 v[2][2];
#pragma unroll
                for (int bj = 0; bj < 2; ++bj)
#pragma unroll
                    for (int n = 0; n < 2; ++n) { v[bj][n] = r[bj][n] + acc[ai][bj][m][n]; sq += dot4(v[bj][n]); }
                { bf16_t* o = xb + pair_off(1024, row, colw, fq); *(u32x4*)o = pk8(v[0][0], v[0][1]); *(u32x4*)(o + 64) = pk8(v[1][0], v[1][1]); }
                sq = sum_fq(sq);
                if (fq == 0) sso[(size_t)row * 16 + 4 * u.pn + wc] = sq; } }
    }
};

template <bool FINAL> struct EpiPle {
    static constexpr bool PERM = true, AFTER_DRAIN = false, APERM = true;
    const float* ss; const bf16_t* pp; const bf16_t* xin; bf16_t* xb; float* sso; float* out;
    __device__ __forceinline__ void operator()(const f32x4 (&acc)[2][2][4][2], const Unit& u, int wr, int wc, int fr, int fq) const {
        const int colw = u.pn * BM + 64 * wc;
#pragma unroll
        for (int ah = 0; ah < 4; ++ah) { const int ai = ah >> 1, m0 = (ah & 1) * 2;
            u32x4 XA[4], XB[4], PA[4], PB[4]; f32x4 rp[4];
#pragma unroll
            for (int m = m0; m < m0 + 2; ++m) { const int rowE = u.pm * BM + ai * HALF + wr * 64 + m * 16 + (fr & ~1); const size_t o = pair_off(1024, rowE + (fr & 1), colw, fq);
                rp[m] = rstd_ld(ss, rowE + (fr & 1), fq);
                XA[m] = *(const u32x4*)(xin + o); XB[m] = *(const u32x4*)(xin + o + 64); PA[m] = *(const u32x4*)(pp + o); PB[m] = *(const u32x4*)(pp + o + 64); }
#pragma unroll
            for (int m = m0; m < m0 + 2; ++m) { const int rowE = u.pm * BM + ai * HALF + wr * 64 + m * 16 + (fr & ~1), row = rowE + (fr & 1); const float rs = rstd_fin(rp[m]);
                f32x4 r[2][2], p[2][2];
                unpack8(XA[m], r[0][0], r[0][1]); unpack8(XB[m], r[1][0], r[1][1]);
                unpack8(PA[m], p[0][0], p[0][1]); unpack8(PB[m], p[1][0], p[1][1]);
                float sq = 0.f; f32x4 v[2][2];
#pragma unroll
                for (int bj = 0; bj < 2; ++bj)
#pragma unroll
                    for (int n = 0; n < 2; ++n) { const f32x4 a = acc[ai][bj][m][n] * rs;
#pragma unroll
                        for (int e = 0; e < 4; ++e) v[bj][n][e] = r[bj][n][e] + fsigmoid(a[e]) * p[bj][n][e];
                        sq += dot4(v[bj][n]); }
                if (FINAL) { store_f32_lines(out + colw, 1024, rowE, fr, fq, v[0][0], v[0][1]); store_f32_lines(out + colw + 32, 1024, rowE, fr, fq, v[1][0], v[1][1]); }
                else { { bf16_t* o = xb + pair_off(1024, row, colw, fq); *(u32x4*)o = pk8(v[0][0], v[0][1]); *(u32x4*)(o + 64) = pk8(v[1][0], v[1][1]); }
                    sq = sum_fq(sq);
                    if (fq == 0) sso[(size_t)row * 16 + 4 * u.pn + wc] = sq; } } }
    }
};

struct EpiQkv {
    static constexpr bool PERM = true, AFTER_DRAIN = false, APERM = true;
    const float* ss; const float* rope; const float* qn; const float* kn; bf16_t* Q; bf16_t* K; bf16_t* V;
    __device__ __forceinline__ void operator()(const f32x4 (&acc)[2][2][4][2], const Unit& u, int wr, int wc, int fr, int fq) const {
        if (u.pn == 5) {
#pragma unroll
            for (int ai = 0; ai < 2; ++ai)
#pragma unroll
                for (int m = 0; m < 4; ++m) { const int rowE = u.pm * BM + ai * HALF + wr * 64 + m * 16 + (fr & ~1), row = rowE + (fr & 1); const float rs = rstd_fin(rstd_ld(ss, row, fq));
                    store_bf16_lines(V + 64 * wc, 256, rowE, fr, fq, pk8(acc[ai][0][m][0] * rs, acc[ai][0][m][1] * rs), pk8(acc[ai][1][m][0] * rs, acc[ai][1][m][1] * rs)); }
            return;
        }
        const bool isq = u.pn < 4; const float* gn = isq ? qn : kn; const float osc = isq ? 0.125f * 1.4426950408889634f : 1.0f;
        bf16_t* dst = isq ? Q + (size_t)(64 * (4 * u.pn + wc)) : K + (size_t)(64 * wc); const int ldd = isq ? 1024 : 256;
        f32x4 g[2][2];
#pragma unroll
        for (int bj = 0; bj < 2; ++bj)
#pragma unroll
            for (int n = 0; n < 2; ++n) g[bj][n] = *(const f32x4*)(gn + 32 * bj + 8 * fq + 4 * n);
#pragma unroll
        for (int ah = 0; ah < 4; ++ah) { const int ai = ah >> 1, m0 = (ah & 1) * 2;
          f32x4 rp[4], csn[4][4];
#pragma unroll
          for (int m = m0; m < m0 + 2; ++m) { const int row = u.pm * BM + ai * HALF + wr * 64 + m * 16 + fr; rp[m] = rstd_ld(ss, row, fq); const float* rq = rope + (size_t)row * 64 + 8 * fq;
              csn[m][0] = *(const f32x4*)rq; csn[m][1] = *(const f32x4*)(rq + 4); csn[m][2] = *(const f32x4*)(rq + 32); csn[m][3] = *(const f32x4*)(rq + 36); }
#pragma unroll
            for (int m = m0; m < m0 + 2; ++m) { const int rowE = u.pm * BM + ai * HALF + wr * 64 + m * 16 + (fr & ~1); const float rs = rstd_fin(rp[m]);
                f32x4 v[2][2]; float sq = 0.f;
#pragma unroll
                for (int bj = 0; bj < 2; ++bj)
#pragma unroll
                    for (int n = 0; n < 2; ++n) { v[bj][n] = acc[ai][bj][m][n] * rs; sq += dot4(v[bj][n]); }
                sq = sum_fq(sq);
                const float hr = rsqrtf(sq * (1.0f / 64.0f) + 1e-6f);
#pragma unroll
                for (int bj = 0; bj < 2; ++bj)
#pragma unroll
                    for (int n = 0; n < 2; ++n) v[bj][n] = v[bj][n] * hr * g[bj][n];
                f32x4 o[2][2];
#pragma unroll
                for (int n = 0; n < 2; ++n) { const f32x4 cs = csn[m][n], sn = csn[m][2 + n];
                    o[0][n] = (v[0][n] * cs - v[1][n] * sn) * osc; o[1][n] = (v[1][n] * cs + v[0][n] * sn) * osc; }
                store_bf16_lines(dst, ldd, rowE, fr, fq, pk8(o[0][0], o[0][1]), pk8(o[1][0], o[1][1])); } }
    }
};

struct EpiUp {
    static constexpr bool PERM = true, AFTER_DRAIN = false, APERM = true;
    const float* ss; const float* cw; const float* cb; bf16_t* A2; bf16_t* GH; bf16_t* UH; bf16_t* GT;
    template <int N> static __device__ __forceinline__ f32x4 ror4(const f32x4& v) { f32x4 r; r[0] = __uint_as_float(dpp_ror<N>(__float_as_uint(v[0]))); r[1] = __uint_as_float(dpp_ror<N>(__float_as_uint(v[1]))); r[2] = __uint_as_float(dpp_ror<N>(__float_as_uint(v[2]))); r[3] = __uint_as_float(dpp_ror<N>(__float_as_uint(v[3]))); return r; }
    __device__ __forceinline__ void operator()(const f32x4 (&acc)[2][2][4][2], const Unit& u, int wr, int wc, int fr, int fq) const {
        const int ch0 = u.pn * 128 + wc * 32 + 8 * fq;
        f32x4 w2[2], bb[2], w1o[2], w0o[2], w1m[2], w0m[2];
#pragma unroll
        for (int n = 0; n < 2; ++n) { const f32x4 w0 = *(const f32x4*)(cw + ch0 + 4 * n), w1 = *(const f32x4*)(cw + 3072 + ch0 + 4 * n); const f32x4 z4 = {0.f, 0.f, 0.f, 0.f};
            w2[n] = *(const f32x4*)(cw + 6144 + ch0 + 4 * n); bb[n] = *(const f32x4*)(cb + ch0 + 4 * n);
            w1o[n] = fr >= 1 ? w1 : z4; w1m[n] = fr >= 1 ? z4 : w1; w0o[n] = fr >= 2 ? w0 : z4; w0m[n] = fr >= 2 ? z4 : w0; }
#pragma unroll
        for (int ai = 0; ai < 2; ++ai) {
            const int grp = 4 * u.pm + 2 * ai + wr;
            f32x4 gp[2] = {{0.f, 0.f, 0.f, 0.f}, {0.f, 0.f, 0.f, 0.f}};
            f32x4 rpu[4];
#pragma unroll
            for (int m = 0; m < 4; ++m) rpu[m] = rstd_ld(ss, u.pm * BM + ai * HALF + wr * 64 + m * 16 + fr, fq);
#pragma unroll
            for (int m = 0; m < 4; ++m) { const int row = u.pm * BM + ai * HALF + wr * 64 + m * 16 + fr; const float rs = rstd_fin(rpu[m]);
                f32x4 g[2], uu[2], o[2];
#pragma unroll
                for (int n = 0; n < 2; ++n) { g[n] = acc[ai][0][m][n] * rs; uu[n] = acc[ai][1][m][n] * rs;
                    f32x4 y = bb[n] + w2[n] * g[n] + w1o[n] * ror4<1>(g[n]) + w0o[n] * ror4<2>(g[n]);
                    if (m > 0) y += w1m[n] * ror4<1>(gp[n]) + w0m[n] * ror4<2>(gp[n]);
#pragma unroll
                    for (int e = 0; e < 4; ++e) { const float yy = y[e]; const float t2 = yy * (2.3022082f + 0.10294324f * yy * yy);
                        o[n][e] = yy * __builtin_amdgcn_rcpf(1.0f + __builtin_amdgcn_exp2f(-t2)) * uu[n][e]; } }
                const bool head = (m == 0) && (fr < 2);
                if (!head) *(u32x4*)(A2 + (size_t)(row >> 1) * 6144 + ((ch0 >> 6) * 128 + ((ch0 >> 5) & 1) * 64 + (row & 1) * 32 + (ch0 & 31))) = pk8(o[0], o[1]);
                else { const size_t so = ((size_t)grp * 2 + fr) * 3072 + ch0; *(u32x4*)(GH + so) = pk8(g[0], g[1]); *(u32x4*)(UH + so) = pk8(uu[0], uu[1]); }
                if (m == 3 && fr >= 14) { const size_t so = ((size_t)grp * 2 + (fr - 14)) * 3072 + ch0; *(u32x4*)(GT + so) = pk8(g[0], g[1]); }
                gp[0] = g[0]; gp[1] = g[1]; }
        }
    }
};

struct EpiNone {
    static constexpr bool PERM = true, AFTER_DRAIN = false, APERM = false;
    __device__ __forceinline__ void operator()(const f32x4 (&acc)[2][2][4][2], const Unit& u, int wr, int wc, int fr, int fq) const {
#pragma unroll
        for (int ai = 0; ai < 2; ++ai)
#pragma unroll
            for (int m = 0; m < 4; ++m)
#pragma unroll
                for (int bj = 0; bj < 2; ++bj) { asm volatile("" :: "v"(acc[ai][bj][m][0]), "v"(acc[ai][bj][m][1])); }
    }
};

struct EpiZLine {
    static constexpr bool PERM = true, AFTER_DRAIN = false, APERM = false;
    bf16_t* O; int ldc;
    __device__ __forceinline__ void operator()(const f32x4 (&acc)[2][2][4][2], const Unit& u, int wr, int wc, int fr, int fq) const {
        const int col0 = u.pn * BM + 64 * wc + ((fr & 1) * 4 + fq) * 8;
#pragma unroll
        for (int ai = 0; ai < 2; ++ai)
#pragma unroll
            for (int m = 0; m < 4; ++m) {
#pragma unroll
                for (int bj = 0; bj < 2; ++bj) { const int row = u.pm * BM + ai * HALF + wr * 64 + m * 16 + (fr & ~1) + bj;
                    *(u32x4*)(O + (size_t)row * ldc + col0) = pk8(acc[ai][bj][m][0], acc[ai][bj][m][1]); } }
    }
};
template <class Epi, class Sched, bool ALIGN_EPI = false, bool SP2 = false>
__device__ __forceinline__ void gemm_phase(PG8_LAS unsigned char* lds, const Gemm g, const Sched& S, const Epi& E, int wave_id) {
    int tid_ = lane_now() + 64 * wave_id;
    const int tid = tid_, wid = __builtin_amdgcn_readfirstlane(tid >> 6), lane = tid & 63, wr = wid >> 2, wc = wid & 3, fr = lane & 15, fq = lane >> 4;
    const int K = g.K, nt = K / BK;
    unsigned voffA[2], voffB[2];
#pragma unroll
    for (int i = 0; i < 2; ++i) { int R, C; stage_rc(tid * 16 + i * 8192, R, C); const int Rb = Epi::PERM ? ((R & ~31) + perm32(R & 31)) : R;
        voffA[i] = Epi::APERM ? (unsigned)((R >> 1) * (4 * K) + ((C >> 5) & 1) * 128 + (R & 1) * 64 + (C & 31) * 2) : (unsigned)(R * K + C) * 2u;
        voffB[i] = (unsigned)((Rb >> 1) * (4 * K) + ((C >> 5) & 1) * 128 + (Rb & 1) * 64 + (C & 31) * 2); }
    const size_t kstepA = Epi::APERM ? (size_t)(BK * 4) : (size_t)(BK * 2), kstepB = (size_t)(BK * 4);
    const size_t hstep = (size_t)HALF * K * 2;
    const size_t tstep = 2 * hstep;
    const unsigned ldsw = (unsigned)wid * 1024u;
    const int aoff = lds_byte(wr * 64 + fr, fq * 8), boff = lds_byte(wc * 32 + fr, fq * 8);
#define PG8_SA(b, h) (((b) * 2 + (h)) * HTB)
#define PG8_SB(b, h) ((4 + (b) * 2 + (h)) * HTB)
#define PG8_STAGE(bufoff, gbase, voff) do { _Pragma("unroll") for (int _i = 0; _i < 2; ++_i) \
        __builtin_amdgcn_global_load_lds((const unsigned*)((const char*)(gbase) + (voff)[_i]), (PG8_LAS unsigned*)(lds + (bufoff) + ldsw + _i * 8192), 16, 0, 0); } while (0)
#define PG8_LDA(dst, b, h) do { _Pragma("unroll") for (int m = 0; m < 4; ++m) _Pragma("unroll") for (int k = 0; k < 2; ++k) dst[m][k] = *(const PG8_LAS bf16x8*)(lds + PG8_SA(b, h) + aoff + m * 2048 + k * 1024); } while (0)
#define PG8_LDB(dst, b, h) do { _Pragma("unroll") for (int n = 0; n < 2; ++n) _Pragma("unroll") for (int k = 0; k < 2; ++k) dst[n][k] = *(const PG8_LAS bf16x8*)(lds + PG8_SB(b, h) + boff + n * 2048 + k * 1024); } while (0)
#define PG8_MMA(ai, bj, At, Bt) do { __builtin_amdgcn_s_setprio(1); _Pragma("unroll") for (int m = 0; m < 4; ++m) _Pragma("unroll") for (int n = 0; n < 2; ++n) _Pragma("unroll") for (int k = 0; k < 2; ++k) \
        acc[ai][bj][m][n] = __builtin_amdgcn_mfma_f32_16x16x32_bf16(Bt[n][k], At[m][k], acc[ai][bj][m][n], 0, 0, 0); __builtin_amdgcn_s_setprio(0); } while (0)
#define PG8_WAIT_V(n) asm volatile("s_waitcnt vmcnt(" #n ")" ::: "memory")
#define PG8_WAIT_L(n) asm volatile("s_waitcnt lgkmcnt(" #n ")" ::: "memory")
#define PG8_BAR __builtin_amdgcn_s_barrier()
#define PG8_SCHED __builtin_amdgcn_sched_barrier(0)
    Unit cur, nxt; int ui = 0;
    if (!S.next(0, cur)) return;
    f32x4 acc[2][2][4][2];
#pragma unroll
    for (int a = 0; a < 2; ++a)
#pragma unroll
        for (int b = 0; b < 2; ++b)
#pragma unroll
            for (int m = 0; m < 4; ++m)
#pragma unroll
                for (int n = 0; n < 2; ++n) acc[a][b][m][n] = (f32x4){0.f, 0.f, 0.f, 0.f};
    bf16x8 At[4][2], B0[2][2], B1[2][2];
    const char* cA = (const char*)g.A + (size_t)cur.pm * tstep; const char* cB = (const char*)g.Bt + (size_t)cur.pn * tstep;
    S.a_ready(cur);
    if constexpr (SP2) {
        PG8_STAGE(PG8_SB(0, 0), cB, voffB); PG8_STAGE(PG8_SB(0, 1), cB + hstep, voffB); PG8_STAGE(PG8_SA(0, 0), cA, voffA); PG8_STAGE(PG8_SA(0, 1), cA + hstep, voffA);
        if (wr == 1) PG8_BAR;
        PG8_WAIT_V(2); PG8_BAR;
        PG8_STAGE(PG8_SB(1, 0), cB + kstepB, voffB); PG8_STAGE(PG8_SA(1, 0), cA + kstepA, voffA); PG8_STAGE(PG8_SB(1, 1), cB + hstep + kstepB, voffB);
        PG8_WAIT_V(6); PG8_BAR;
    } else {
        PG8_STAGE(PG8_SB(0, 0), cB, voffB); PG8_STAGE(PG8_SA(0, 0), cA, voffA); PG8_STAGE(PG8_SB(0, 1), cB + hstep, voffB); PG8_STAGE(PG8_SA(0, 1), cA + hstep, voffA);
        if (wr == 1) PG8_BAR;
        PG8_WAIT_V(4); PG8_BAR;
        PG8_STAGE(PG8_SB(1, 0), cB + kstepB, voffB); PG8_STAGE(PG8_SA(1, 0), cA + kstepA, voffA); PG8_STAGE(PG8_SB(1, 1), cB + hstep + kstepB, voffB);
        PG8_WAIT_V(6); PG8_BAR;
    }
    for (;;) {
        const bool has_next = S.next(ui + 1, nxt);
        const char* nA = has_next ? (const char*)g.A + (size_t)nxt.pm * tstep : cA; const char* nB = has_next ? (const char*)g.Bt + (size_t)nxt.pn * tstep : cB;
        for (int t = 0; t < nt; t += 2) {
            const bool last = (t == nt - 2);
            const char* a1 = cA + (size_t)(t + 1) * kstepA;
            const char* a2 = last ? nA : cA + (size_t)(t + 2) * kstepA; const char* b2 = last ? nB : cB + (size_t)(t + 2) * kstepB;
            const char* a3 = a2 + kstepA; const char* b3 = b2 + kstepB;
            if (last && has_next) S.a_ready(nxt);
            if constexpr (SP2) {
            PG8_LDB(B0, 0, 0); PG8_LDB(B1, 0, 1); PG8_SCHED; PG8_LDA(At, 0, 0); PG8_STAGE(PG8_SA(1, 1), a1 + hstep, voffA);
            PG8_WAIT_V(8); PG8_WAIT_L(0); PG8_BAR; PG8_MMA(0, 0, At, B0); PG8_MMA(0, 1, At, B1); PG8_BAR; PG8_SCHED;
            PG8_LDA(At, 0, 1); PG8_STAGE(PG8_SB(0, 0), b2, voffB); PG8_STAGE(PG8_SB(0, 1), b2 + hstep, voffB); PG8_STAGE(PG8_SA(0, 0), a2, voffA);
            PG8_WAIT_V(8); PG8_WAIT_L(0); PG8_BAR; PG8_MMA(1, 0, At, B0); PG8_MMA(1, 1, At, B1); PG8_BAR; PG8_SCHED;
            PG8_LDB(B0, 1, 0); PG8_LDB(B1, 1, 1); PG8_SCHED; PG8_LDA(At, 1, 0); PG8_STAGE(PG8_SA(0, 1), a2 + hstep, voffA);
            PG8_WAIT_V(8); PG8_WAIT_L(0); PG8_BAR; PG8_MMA(0, 0, At, B0); PG8_MMA(0, 1, At, B1); PG8_BAR; PG8_SCHED;
            PG8_LDA(At, 1, 1); PG8_STAGE(PG8_SB(1, 0), b3, voffB); PG8_STAGE(PG8_SB(1, 1), b3 + hstep, voffB); PG8_STAGE(PG8_SA(1, 0), a3, voffA);
            PG8_WAIT_V(8); PG8_WAIT_L(0); PG8_BAR; PG8_MMA(1, 0, At, B0); PG8_MMA(1, 1, At, B1); PG8_BAR; PG8_SCHED;
            } else {
            PG8_LDB(B0, 0, 0); PG8_SCHED; PG8_LDA(At, 0, 0); PG8_STAGE(PG8_SA(1, 1), a1 + hstep, voffA);
            PG8_WAIT_L(8); PG8_BAR; PG8_WAIT_L(0); PG8_MMA(0, 0, At, B0); PG8_BAR; PG8_SCHED;
            PG8_LDB(B1, 0, 1); PG8_STAGE(PG8_SB(0, 0), b2, voffB);
            PG8_BAR; PG8_WAIT_L(0); PG8_MMA(0, 1, At, B1); PG8_BAR;
            PG8_LDA(At, 0, 1); PG8_STAGE(PG8_SA(0, 0), a2, voffA);
            PG8_BAR; PG8_WAIT_L(0); PG8_MMA(1, 0, At, B0); PG8_BAR; PG8_SCHED;
            PG8_STAGE(PG8_SB(0, 1), b2 + hstep, voffB);
            PG8_WAIT_V(6); PG8_BAR; PG8_MMA(1, 1, At, B1); PG8_BAR;
            PG8_LDB(B0, 1, 0); PG8_SCHED; PG8_LDA(At, 1, 0); PG8_STAGE(PG8_SA(0, 1), a2 + hstep, voffA);
            PG8_WAIT_L(8); PG8_BAR; PG8_WAIT_L(0); PG8_MMA(0, 0, At, B0); PG8_BAR; PG8_SCHED;
            PG8_LDB(B1, 1, 1); PG8_STAGE(PG8_SB(1, 0), b3, voffB);
            PG8_BAR; PG8_WAIT_L(0); PG8_MMA(0, 1, At, B1); PG8_BAR;
            PG8_LDA(At, 1, 1); PG8_STAGE(PG8_SA(1, 0), a3, voffA);
            PG8_BAR; PG8_WAIT_L(0); PG8_MMA(1, 0, At, B0); PG8_BAR; PG8_SCHED;
            PG8_STAGE(PG8_SB(1, 1), b3 + hstep, voffB);
            PG8_WAIT_V(6); PG8_BAR; PG8_MMA(1, 1, At, B1); PG8_BAR;
            }
        }
        if constexpr (ALIGN_EPI) { if (wr == 0) PG8_BAR; }
        if constexpr (!Epi::AFTER_DRAIN) { E(acc, cur, wr, wc, fr, fq); S.done(cur); }
        if (!has_next) break;
#pragma unroll
        for (int a = 0; a < 2; ++a)
#pragma unroll
            for (int b = 0; b < 2; ++b)
#pragma unroll
                for (int m = 0; m < 4; ++m)
#pragma unroll
                    for (int n = 0; n < 2; ++n) acc[a][b][m][n] = (f32x4){0.f, 0.f, 0.f, 0.f};
        cur = nxt; cA = nA; cB = nB; ++ui;
        if constexpr (ALIGN_EPI) { if (wr == 1) PG8_BAR; }
    }
    PG8_WAIT_V(0);
    if constexpr (!ALIGN_EPI) { if (wr == 0) PG8_BAR; }
    PG8_BAR;
    if constexpr (Epi::AFTER_DRAIN) { E.fused(acc, cur, wr, wc, fr, fq, lds, wid, lane); S.done(cur); }
#undef PG8_SA
#undef PG8_SB
#undef PG8_STAGE
#undef PG8_LDA
#undef PG8_LDB
#undef PG8_MMA
#undef PG8_WAIT_V
#undef PG8_WAIT_L
#undef PG8_BAR
#undef PG8_SCHED
}
}

constexpr int NWAVES = 8;
constexpr int NB = 8, SEQ = 4096, T = NB * SEQ, DM = 1024, ZW = 3072, FFD = 3072, HYIN = 3080;
#ifndef PROBE_PHASE
#define PROBE_PHASE 0
#define PROBE_N 0
#endif
#define PREP(id) for (int rep_ = 0; rep_ < 1 + ((PROBE_PHASE == (id)) ? PROBE_N : 0); ++rep_)
#ifdef PROBE_TA
#define TSTAMP() do { if (blockIdx.x == 0 && threadIdx.x == 0) { F.MISC[16 + ts_n] = (unsigned)__builtin_amdgcn_s_memrealtime(); } ++ts_n; } while (0)
#else
#define TSTAMP() do { } while (0)
#endif
#ifndef DBG_STOP
#define DBG_STOP 99
#endif

constexpr size_t MiB = 1u << 20;
constexpr size_t WS_CTL = 0, CTL_ZERO_BYTES = 1 * MiB;
constexpr size_t WS_WIN = 2 * MiB, WS_WOUT0 = 8 * MiB, WS_WUP0 = 10 * MiB, WS_WDN0 = 22 * MiB, WS_WGT0 = 28 * MiB, WS_WPJ0 = 30 * MiB,
                 WS_WQKV = 31 * MiB, WS_WO1 = 34 * MiB, WS_WUP1 = 36 * MiB, WS_WDN1 = 48 * MiB, WS_WGT1 = 54 * MiB, WS_WPJ1 = 56 * MiB, WS_RGW = 57 * MiB;
constexpr size_t WS_GATES = 58 * MiB, WS_SSA = 59 * MiB, WS_SSB = 61 * MiB, WS_ROPE = 63 * MiB, WS_NLOC = 71 * MiB, WS_NPREV = 72 * MiB, WS_MSC = 73 * MiB,
                 WS_RGA = 74 * MiB, WS_RGH = 75 * MiB, WS_RGC = 76 * MiB;
constexpr size_t WS_PB = 78 * MiB, WS_XBA = 110 * MiB, WS_XBB = 174 * MiB, WS_CST = 238 * MiB, WS_BIG = 302 * MiB, WS_END = 494 * MiB;
constexpr int CW_BAR = 4096;

constexpr int RING_BYTES = 131072;
constexpr int LDSCTL_OFF = 163328, MISC_OFF = LDSCTL_OFF + 320;
constexpr int LDS_BYTES = 163840;

#define GAS __attribute__((address_space(1)))
#define LAS __attribute__((address_space(3)))
typedef unsigned short bf16;
typedef unsigned v4u __attribute__((ext_vector_type(4)));
typedef unsigned v2u __attribute__((ext_vector_type(2)));
typedef float f32x4 __attribute__((ext_vector_type(4)));
typedef float f32x16 __attribute__((ext_vector_type(16)));
typedef short bf16x8 __attribute__((ext_vector_type(8)));
typedef short s16x4 __attribute__((ext_vector_type(4)));
typedef GAS unsigned gu32;
typedef LAS unsigned char* ldsp;
#define LDS_WAIT() asm volatile("s_waitcnt lgkmcnt(0)" ::: "memory")
using pg8::pk2; using pg8::bflo; using pg8::bfhi; using pg8::fsigmoid; using pg8::gelu_tanh;
__device__ __forceinline__ unsigned short f2bf1(float x) { return (unsigned short)(pk2(x, 0.f) & 0xffffu); }
__device__ __forceinline__ float bf2f(unsigned short b) { return __uint_as_float(((unsigned)b) << 16); }
__device__ __forceinline__ float fsilu(float x) { return x * __builtin_amdgcn_rcpf(1.0f + __expf(-x)); }
#define MFMA16(a, b, c) __builtin_amdgcn_mfma_f32_16x16x32_bf16((a), (b), (c), 0, 0, 0)
#define MFMA32(a, b, c) __builtin_amdgcn_mfma_f32_32x32x16_bf16((a), (b), (c), 0, 0, 0)

#define PHASE_FENCE(F) do { asm volatile("" ::: "memory"); const int l_ = pg8::lane_now(); (F).lane = l_; (F).tid = l_ + 64 * (F).wave; } while (0)
#define XB_TMO      128
#define XB_XCNT(j)  (256  + 64 * (j))
#define XB_XSUB(j)  (1280 + 64 * (j))
#define XB_XGEN(j)  (2304 + 64 * (j))
#define XB_TOP      3328
#define XB_TOPGEN   3392
#define XCD_BAR_WORDS 3456
#define XB_SPIN_CAP (1u << 18)

__device__ __forceinline__ unsigned xb_ld(unsigned* p)              { return __hip_atomic_load(p, __ATOMIC_RELAXED, __HIP_MEMORY_SCOPE_AGENT); }
__device__ __forceinline__ unsigned xb_add(unsigned* p, unsigned v) { return __hip_atomic_fetch_add(p, v, __ATOMIC_RELAXED, __HIP_MEMORY_SCOPE_AGENT); }
__device__ __forceinline__ unsigned xb_xcc_id() { return (unsigned)__builtin_amdgcn_s_getreg((3 << 11) | 20) & 0xFu; }
#define XB_SPIN(cond, bar) do { unsigned _sp = 0; while (cond) { __builtin_amdgcn_s_sleep(1); \
    if ((++_sp & 255u) == 0u) { if (xb_ld(&(bar)[XB_TMO])) break; if (_sp > XB_SPIN_CAP) { atomicAdd(&(bar)[XB_TMO], 1u); break; } } } } while (0)

struct XcdBarrier {
    unsigned* bar; unsigned x; int w;
    volatile LAS unsigned* st;
};

__device__ __forceinline__ XcdBarrier xcd_barrier_post(unsigned* bar, volatile LAS unsigned* st, int wave) {
    XcdBarrier b; b.bar = bar; b.x = xb_xcc_id(); b.st = st; b.w = wave;
    if (threadIdx.x == 0) (void)xb_add(&bar[XB_XCNT(b.x)], 1u);
    return b;
}
__device__ __forceinline__ void xcd_barrier_complete(unsigned* bar, unsigned x, unsigned& nloc, unsigned& nx) {
    const unsigned G = gridDim.x * gridDim.y * gridDim.z;
    unsigned sum, cnt, mine, sp = 0u;
    for (;;) {
        sum = 0u; cnt = 0u; mine = 0u;
#pragma unroll
        for (unsigned j = 0; j < 16; ++j) { const unsigned c = xb_ld(&bar[XB_XCNT(j)]); sum += c; cnt += (c > 0u) ? 1u : 0u; mine = (j == x) ? c : mine; }
        if (sum == G) break;
        __builtin_amdgcn_s_sleep(1);
        if ((++sp & 255u) == 0u) { if (xb_ld(&bar[XB_TMO])) break; if (sp > XB_SPIN_CAP) { atomicAdd(&bar[XB_TMO], 1u); break; } }
    }
    nloc = mine > 0u ? mine : 1u; nx = cnt > 0u ? cnt : 1u;
}

__device__ __forceinline__ void xcd_barrier(const XcdBarrier& b) {
    asm volatile("s_waitcnt vmcnt(0)" ::: "memory");
    __syncthreads();
    if (b.w == 0 && pg8::lane_now() == 0) {
        unsigned* bar = b.bar;
        __builtin_amdgcn_s_waitcnt(0);
        unsigned nloc = b.st[0], nx = b.st[1];
        if (nloc == 0u) { xcd_barrier_complete(bar, b.x, nloc, nx); b.st[0] = nloc; b.st[1] = nx; }
        const unsigned old = xb_add(&bar[XB_XSUB(b.x)], 1u);
        const unsigned gen = old / nloc;
        if (old + 1u == (gen + 1u) * nloc) {
            __builtin_amdgcn_fence(__ATOMIC_RELEASE, "agent");
            asm volatile("s_waitcnt vmcnt(0)" ::: "memory");
            const unsigned og = xb_add(&bar[XB_TOP], 1u);
            const unsigned tg = og / nx;
            if (og + 1u == (tg + 1u) * nx) xb_add(&bar[XB_TOPGEN], 1u);
            else XB_SPIN(xb_ld(&bar[XB_TOPGEN]) == tg, bar);
            __builtin_amdgcn_fence(__ATOMIC_ACQUIRE, "agent");
            xb_add(&bar[XB_XGEN(b.x)], 1u);
            asm volatile("s_waitcnt vmcnt(0)" ::: "memory");
        } else {
            XB_SPIN(xb_ld(&bar[XB_XGEN(b.x)]) == gen, bar);
            __builtin_amdgcn_fence(__ATOMIC_ACQUIRE, "agent");
            asm volatile("s_waitcnt vmcnt(0)" ::: "memory");
        }
    }
    __syncthreads();
}

struct Frame {
    ldsp lds; volatile LAS unsigned* MISC;
    int tid, lane, wave, vcu, G;
    unsigned char* ws; unsigned long long kb; float* out;
};
__device__ __forceinline__ const float* karg(const Frame& F, int i) { unsigned long long a = F.kb; asm volatile("" : "+s"(a) :: "memory"); return (const float*)(((const __attribute__((address_space(4))) unsigned long long*)a)[i]); }
#define P_Z     ((bf16*)(F.ws + WS_BIG))
#define P_YBUF  ((bf16*)(F.ws + WS_XBA))
#define P_CST   ((bf16*)(F.ws + WS_CST))
#define P_RGW   ((bf16*)(F.ws + WS_RGW))
#define P_GATES ((float*)(F.ws + WS_GATES))
#define P_NLOC  ((float*)(F.ws + WS_NLOC))
#define P_NPREV ((float*)(F.ws + WS_NPREV))
#define P_MLOC  ((float*)(F.ws + WS_MSC))
#define P_BLAST ((float*)(F.ws + WS_MSC) + 2048)
#define P_MPREV ((float*)(F.ws + WS_MSC) + 4096)
#define P_RGA   ((float*)(F.ws + WS_RGA))
#define P_RGH   ((float*)(F.ws + WS_RGH))
#define P_RGC   ((float*)(F.ws + WS_RGC))
#define P_ROPE  ((float*)(F.ws + WS_ROPE))

__device__ __forceinline__ int tr_dst_row(int mode, int src) {
    if (mode == 1) { const int s2 = src < 3072 ? src : src - 3072; return 256 * (s2 >> 7) + (src < 3072 ? 0 : 128) + (s2 & 127); }
    if (mode == 2) return (src & ~255) + 128 * ((src >> 5) & 1) + 32 * ((src >> 6) & 3);
    return src;
}
template <bool PAIRED> __device__ __forceinline__ void tr_item(const float* W, int ldw, int srcc, int mode, const float* scale, bf16* WT, int K, int k0, LAS float* scr, int lane) {
#pragma unroll
    for (int i = 0; i < 16; ++i) { const int kk = 4 * i + (lane >> 4), n4 = (lane & 15) * 4; const float s = scale ? scale[k0 + kk] : 1.0f;
        const f32x4 v = *(const f32x4*)(W + (size_t)(k0 + kk) * ldw + srcc + n4);
        scr[kk * 65 + n4] = v[0] * s; scr[kk * 65 + n4 + 1] = v[1] * s; scr[kk * 65 + n4 + 2] = v[2] * s; scr[kk * 65 + n4 + 3] = v[3] * s; }
    LDS_WAIT(); asm volatile("" ::: "memory");
    const int c = lane & 7, d0 = tr_dst_row(mode, srcc), d1 = tr_dst_row(mode, srcc + 32);
#pragma unroll
    for (int j = 0; j < 8; ++j) { const int n = (lane >> 3) + 8 * j; const LAS float* s = scr + (8 * c) * 65 + n;
        v4u o; o.x = pk2(s[0 * 65], s[1 * 65]); o.y = pk2(s[2 * 65], s[3 * 65]); o.z = pk2(s[4 * 65], s[5 * 65]); o.w = pk2(s[6 * 65], s[7 * 65]);
        const int drow = (n < 32 ? d0 : d1) + (n & 31);
        if (PAIRED) *(GAS v4u*)(WT + (size_t)(drow >> 1) * (2 * K) + 2 * k0 + (c >> 2) * 64 + (drow & 1) * 32 + (c & 3) * 8) = o;
        else *(GAS v4u*)(WT + (size_t)drow * K + k0 + 8 * c) = o; }
    LDS_WAIT(); asm volatile("" ::: "memory");
}
__device__ __forceinline__ bool tr_matrix(int& r, const float* W, int ldw, int K, int Nd, int mode, const float* scale, bf16* WT, LAS float* scr, int lane) {
    const int nblk = Nd / 64, items = (K / 64) * nblk;
    if (r >= items) { r -= items; return false; }
    const int kb = r / nblk, sb = r % nblk;
    tr_item<true>(W, ldw, 64 * sb, mode, scale, WT, K, 64 * kb, scr, lane);
    return true;
}
__device__ __forceinline__ float wave_sum(float v) {
#pragma unroll
    for (int o = 1; o < 64; o <<= 1) v += __shfl_xor(v, o);
    return v;
}
#ifdef PROBE_P0SPLIT
#define P0_SPLIT() do { xcd_barrier(bar); TSTAMP(); } while (0)
#else
#define P0_SPLIT() do { } while (0)
#endif
__device__ __forceinline__ void p0_prologue(Frame& F, const XcdBarrier& bar, int& ts_n) {
    PHASE_FENCE(F); const float* x = karg(F, 0); const float* p = karg(F, 1); const int* pos = (const int*)karg(F, 2); const float* norm_mix = karg(F, 3); const float* norm_ffn = karg(F, 4); const float* norm_ple = karg(F, 5); const float* hy_w_in = karg(F, 6); const float* hy_b_in = karg(F, 7); const float* rg_wa = karg(F, 10); const float* rg_wx = karg(F, 12); const float* hy_w_out = karg(F, 18); const float* at_w_qkv = karg(F, 19); const float* at_w_out = karg(F, 23); const float* ff_w_up = karg(F, 24); const float* ff_w_down = karg(F, 27); const float* ple_w_gate = karg(F, 28); const float* ple_w_proj = karg(F, 29);
    LAS float* scr = (LAS float*)(F.lds + F.wave * 16640);
    const int gw = F.vcu * NWAVES + F.wave, NGW = F.G * NWAVES;
    unsigned char* ws = F.ws;
    LAS float* GW = (LAS float*)(F.lds);
    for (int i = F.tid; i < 8192; i += NWAVES * 64) { const int k = i >> 3, g = i & 7; GW[i] = hy_w_in[(size_t)k * HYIN + 3072 + g] * norm_mix[k]; }
    __syncthreads();
    P0_SPLIT();
    bf16* xb = (bf16*)(ws + WS_XBA); float* ssA = (float*)(ws + WS_SSA);
    const float bgate = (F.lane < 64) ? hy_b_in[3072 + (F.lane >> 3)] : 0.f;
    for (int row0 = 2 * gw; row0 < T; row0 += 2 * NGW) {
        f32x4 v[2][4];
#pragma unroll
        for (int rr = 0; rr < 2; ++rr) { const GAS f32x4* xr = (const GAS f32x4*)(x + (size_t)(row0 + rr) * DM) + F.lane;
#pragma unroll
            for (int j = 0; j < 4; ++j) v[rr][j] = xr[64 * j]; }
#pragma unroll
        for (int rr = 0; rr < 2; ++rr) { const int row = row0 + rr; float s = 0.f; float d[8];
#pragma unroll
            for (int g = 0; g < 8; ++g) d[g] = 0.f;
#pragma unroll
            for (int j = 0; j < 4; ++j) { s += (v[rr][j].x * v[rr][j].x + v[rr][j].y * v[rr][j].y) + (v[rr][j].z * v[rr][j].z + v[rr][j].w * v[rr][j].w);
#pragma unroll
                for (int e = 0; e < 4; ++e) { const int k = 4 * (F.lane + 64 * j) + e; const f32x4 w0 = *(const LAS f32x4*)(GW + k * 8), w1 = *(const LAS f32x4*)(GW + k * 8 + 4);
                    const float xv = v[rr][j][e];
                    d[0] += xv * w0[0]; d[1] += xv * w0[1]; d[2] += xv * w0[2]; d[3] += xv * w0[3]; d[4] += xv * w1[0]; d[5] += xv * w1[1]; d[6] += xv * w1[2]; d[7] += xv * w1[3]; } }
            s = wave_sum(s);
            const bool b5 = F.lane & 32, b4 = F.lane & 16, b3 = F.lane & 8; float r4[4], r2[2];
#pragma unroll
            for (int i = 0; i < 4; ++i) { const float recv = __shfl_xor(b5 ? d[i] : d[i + 4], 32); r4[i] = (b5 ? d[i + 4] : d[i]) + recv; }
#pragma unroll
            for (int i = 0; i < 2; ++i) { const float recv = __shfl_xor(b4 ? r4[i] : r4[i + 2], 16); r2[i] = (b4 ? r4[i + 2] : r4[i]) + recv; }
            float dg; { const float recv = __shfl_xor(b3 ? r2[0] : r2[1], 8); dg = (b3 ? r2[1] : r2[0]) + recv; }
            dg += __shfl_xor(dg, 1); dg += __shfl_xor(dg, 2); dg += __shfl_xor(dg, 4);
            const float rstd = rsqrtf(s * (1.0f / DM) + 1e-6f);
            if (F.lane < 16) ssA[(size_t)row * 16 + F.lane] = (F.lane == 0) ? s : 0.f;
            if ((F.lane & 7) == 0) P_GATES[(size_t)row * 8 + (F.lane >> 3)] = rstd * dg + bgate;
            GAS unsigned long long* o8 = (GAS unsigned long long*)(xb + (size_t)row * DM) + F.lane;
#pragma unroll
            for (int j = 0; j < 4; ++j) o8[64 * j] = (unsigned long long)pk2(v[rr][j].x, v[rr][j].y) | ((unsigned long long)pk2(v[rr][j].z, v[rr][j].w) << 32);
#if DBG_STOP < 3
            { GAS f32x4* oo = (GAS f32x4*)(F.out + (size_t)row * DM) + F.lane;
#pragma unroll
              for (int j = 0; j < 4; ++j) oo[64 * j] = v[rr][j]; }
#endif
        }
    }
    P0_SPLIT();
    { const GAS f32x4* ps = (const GAS f32x4*)p; GAS v4u* pd = (GAS v4u*)(ws + WS_PB); const int n8 = 2 * T * 256 / 8;
      for (int i0 = gw * 64 + F.lane; i0 < n8; i0 += 4 * NGW * 64) { f32x4 a[4], b[4];
#pragma unroll
          for (int k = 0; k < 4; ++k) { const int i = i0 + k * NGW * 64; if (i < n8) { a[k] = ps[2 * i]; b[k] = ps[2 * i + 1]; } }
#pragma unroll
          for (int k = 0; k < 4; ++k) { const int i = i0 + k * NGW * 64; if (i < n8) { v4u o; o.x = pk2(a[k].x, a[k].y); o.y = pk2(a[k].z, a[k].w); o.z = pk2(b[k].x, b[k].y); o.w = pk2(b[k].z, b[k].w); pd[i] = o; } } } }
    for (int i = (F.vcu * NWAVES * 64) + F.tid; i < T * 32; i += F.G * NWAVES * 64) { const int t = i >> 5, f = i & 31;
        const float inv = exp2f(-(float)f * (13.287712379549449f / 32.0f));
        const float ang = (float)pos[t] * inv;
        P_ROPE[(size_t)t * 64 + f] = cosf(ang); P_ROPE[(size_t)t * 64 + 32 + f] = sinf(ang); }
    P0_SPLIT();
    __syncthreads();
    constexpr int NITEMS = 768 + 256 + 2 * 1536 + 2 * 768 + 2 * 256 + 2 * 64 + 384 + 256 + 16;
    for (int it = gw; it < NITEMS; it += NGW) {
        int r = it; const float* W = nullptr; const float* scale = nullptr; bf16* WT = nullptr; int ldw = 0, K = 0, Nd = 0, mode = 0; bool found = false;
#define TRM(W_, ldw_, K_, Nd_, mode_, scale_, WT_) if (!found) { const int items_ = ((K_) / 64) * ((Nd_) / 64); if (r < items_) { W = (W_); ldw = (ldw_); K = (K_); Nd = (Nd_); mode = (mode_); scale = (scale_); WT = (bf16*)(ws + (WT_)); found = true; } else r -= items_; }
        TRM(hy_w_in, HYIN, 1024, 3072, 2, norm_mix, WS_WIN)
        TRM(hy_w_out, 1024, 1024, 1024, 2, nullptr, WS_WOUT0)
        TRM(ff_w_up, 6144, 1024, 6144, 1, norm_ffn, WS_WUP0)
        TRM(ff_w_up + (size_t)1024 * 6144, 6144, 1024, 6144, 1, norm_ffn + 1024, WS_WUP1)
        TRM(ff_w_down, 1024, 3072, 1024, 2, nullptr, WS_WDN0)
        TRM(ff_w_down + (size_t)3072 * 1024, 1024, 3072, 1024, 2, nullptr, WS_WDN1)
        TRM(ple_w_gate, 1024, 1024, 1024, 2, norm_ple, WS_WGT0)
        TRM(ple_w_gate + (size_t)1024 * 1024, 1024, 1024, 1024, 2, norm_ple + 1024, WS_WGT1)
        TRM(ple_w_proj, 1024, 256, 1024, 2, nullptr, WS_WPJ0)
        TRM(ple_w_proj + (size_t)256 * 1024, 1024, 256, 1024, 2, nullptr, WS_WPJ1)
        TRM(at_w_qkv, 1536, 1024, 1536, 2, norm_mix + 1024, WS_WQKV)
        TRM(at_w_out, 1024, 1024, 1024, 2, nullptr, WS_WO1)
#undef TRM
        if (found) { const int nblk = Nd / 64, kb = r / nblk, sb = r - kb * nblk; tr_item<true>(W, ldw, 64 * sb, mode, scale, WT, K, 64 * kb, scr, F.lane); }
        else { const int g = r >> 3, n = r & 7;
          tr_item<false>((g ? rg_wx : rg_wa) + (size_t)n * 4096, 64, 0, 0, nullptr, P_RGW + (size_t)r * 4096, 64, 0, scr, F.lane); }
    }
}

__device__ __forceinline__ void ld8f(const bf16* p, float (&o)[8]) { const v4u v = *(const v4u*)p; o[0] = bflo(v.x); o[1] = bfhi(v.x); o[2] = bflo(v.y); o[3] = bfhi(v.y); o[4] = bflo(v.z); o[5] = bfhi(v.z); o[6] = bflo(v.w); o[7] = bfhi(v.w); }
__device__ __forceinline__ void conv4x8(const bf16* zp, int s, const float* cw, int ldw, const float* cb, float (&out)[8]) {
    { const f32x4 b0 = *(const f32x4*)cb, b1 = *(const f32x4*)(cb + 4); out[0] = b0[0]; out[1] = b0[1]; out[2] = b0[2]; out[3] = b0[3]; out[4] = b1[0]; out[5] = b1[1]; out[6] = b1[2]; out[7] = b1[3]; }
#pragma unroll
    for (int j = 0; j < 4; ++j) if (s - 3 + j >= 0) { float xv[8]; ld8f(zp + (ptrdiff_t)(j - 3) * ZW, xv);
        const f32x4 w0 = *(const f32x4*)(cw + j * ldw), w1 = *(const f32x4*)(cw + j * ldw + 4);
        out[0] += w0[0] * xv[0]; out[1] += w0[1] * xv[1]; out[2] += w0[2] * xv[2]; out[3] += w0[3] * xv[3]; out[4] += w1[0] * xv[4]; out[5] += w1[1] * xv[5]; out[6] += w1[2] * xv[6]; out[7] += w1[3] * xv[7]; }
}
__device__ __forceinline__ v4u pk8f(const float (&a)[8]) { v4u o; o.x = pk2(a[0], a[1]); o.y = pk2(a[2], a[3]); o.z = pk2(a[4], a[5]); o.w = pk2(a[6], a[7]); return o; }
__device__ __forceinline__ float logsig(float f) { return fminf(f, 0.f) - __logf(1.0f + __expf(-fabsf(f))); }

template <int CTRL, int ROWMASK> __device__ __forceinline__ float dpp_f(float idv, float v) { return __int_as_float(__builtin_amdgcn_update_dpp(__float_as_int(idv), __float_as_int(v), CTRL, ROWMASK, 0xF, false)); }
__device__ __forceinline__ float scan_add(float v) {
    v += dpp_f<0x111, 0xF>(0.f, v); v += dpp_f<0x112, 0xF>(0.f, v); v += dpp_f<0x114, 0xF>(0.f, v); v += dpp_f<0x118, 0xF>(0.f, v);
    v += dpp_f<0x142, 0xA>(0.f, v); v += dpp_f<0x143, 0xC>(0.f, v); return v; }
__device__ __forceinline__ float scan_max(float v) {
    v = fmaxf(v, dpp_f<0x111, 0xF>(-INFINITY, v)); v = fmaxf(v, dpp_f<0x112, 0xF>(-INFINITY, v)); v = fmaxf(v, dpp_f<0x114, 0xF>(-INFINITY, v)); v = fmaxf(v, dpp_f<0x118, 0xF>(-INFINITY, v));
    v = fmaxf(v, dpp_f<0x142, 0xA>(-INFINITY, v)); v = fmaxf(v, dpp_f<0x143, 0xC>(-INFINITY, v)); return v; }
__device__ __forceinline__ float lane63(float v) { return __int_as_float(__builtin_amdgcn_readlane(__float_as_int(v), 63)); }
struct MlPre { v4u q[3], k[3], v[2]; float ip, fp, np, mp; };
template <bool PC> __device__ __forceinline__ void ml_prefetch(Frame& F, int u, MlPre& R) {
    const int c = u & 63, bh = u >> 6, h = bh & 3, b = bh >> 2, tok0 = b * SEQ + c * 64;
    const bf16* z = P_Z;
    int tid = F.tid; asm volatile("" : "+v"(tid));
#pragma unroll
    for (int s = 0; s < 3; ++s) { const int i = tid + 512 * s, row = s < 2 ? 3 + (i & 63) : (tid >> 4), ch = s < 2 ? (i >> 6) : (tid & 15); const bool ok = s < 2 || (tid < 48 && c > 0);
        const bf16* zp = z + (size_t)(tok0 - 3 + row) * ZW + 128 * h + 8 * ch;
        R.k[s] = ok ? *(const v4u*)(zp + 1536) : (v4u){0u, 0u, 0u, 0u};
        if (PC) R.q[s] = ok ? *(const v4u*)(zp + 1024) : (v4u){0u, 0u, 0u, 0u}; }
#pragma unroll
    for (int s = 0; s < 2; ++s) { const int i = tid + 512 * s, l = i & 63, ch = i >> 6; R.v[s] = *(const v4u*)(z + (size_t)(tok0 + l) * ZW + 2048 + 128 * h + 8 * ch); }
    if (tid < 64) { R.ip = P_GATES[(size_t)(tok0 + tid) * 8 + h]; R.fp = P_GATES[(size_t)(tok0 + tid) * 8 + 4 + h]; }
    if (PC) {
        if (tid >= 128 && tid < 256) R.np = P_NPREV[(size_t)u * 128 + tid - 128];
        R.mp = P_MPREV[u];
    }
}
__device__ __forceinline__ void vt_scatter(LAS unsigned short* VT, int stride, int ch, int l, const v4u& vv) {
    VT[(8 * ch + 0) * stride + l] = (unsigned short)(vv.x & 0xffffu); VT[(8 * ch + 1) * stride + l] = (unsigned short)(vv.x >> 16);
    VT[(8 * ch + 2) * stride + l] = (unsigned short)(vv.y & 0xffffu); VT[(8 * ch + 3) * stride + l] = (unsigned short)(vv.y >> 16);
    VT[(8 * ch + 4) * stride + l] = (unsigned short)(vv.z & 0xffffu); VT[(8 * ch + 5) * stride + l] = (unsigned short)(vv.z >> 16);
    VT[(8 * ch + 6) * stride + l] = (unsigned short)(vv.w & 0xffffu); VT[(8 * ch + 7) * stride + l] = (unsigned short)(vv.w >> 16);
}
__device__ __forceinline__ void conv4_lds(ldsp raw, int l, int ch, const LAS float* cw, const LAS float* cb, float (&out)[8]) {
    { const f32x4 b0 = *(const LAS f32x4*)(cb + 8 * ch), b1 = *(const LAS f32x4*)(cb + 8 * ch + 4); out[0] = b0[0]; out[1] = b0[1]; out[2] = b0[2]; out[3] = b0[3]; out[4] = b1[0]; out[5] = b1[1]; out[6] = b1[2]; out[7] = b1[3]; }
#pragma unroll
    for (int j = 0; j < 4; ++j) { const v4u v = *(const LAS v4u*)(raw + (l + j) * 272 + 16 * ch); const f32x4 w0 = *(const LAS f32x4*)(cw + j * 128 + 8 * ch), w1 = *(const LAS f32x4*)(cw + j * 128 + 8 * ch + 4);
        out[0] += w0[0] * bflo(v.x); out[1] += w0[1] * bfhi(v.x); out[2] += w0[2] * bflo(v.y); out[3] += w0[3] * bfhi(v.y); out[4] += w1[0] * bflo(v.z); out[5] += w1[1] * bfhi(v.z); out[6] += w1[2] * bflo(v.w); out[7] += w1[3] * bfhi(v.w); }
}

__device__ __forceinline__ void mlA_phase(Frame& F) {
    PHASE_FENCE(F);
    const float* ml_cw = karg(F, 15); const float* ml_cb = karg(F, 16);
    ldsp L = F.lds;
    constexpr int RAWK = 0, KTO = 18432, VTO = 36864, WLO = 57600, CWO = 57856;
    LAS unsigned short* KT = (LAS unsigned short*)(L + KTO); LAS unsigned short* VT = (LAS unsigned short*)(L + VTO); LAS float* WL = (LAS float*)(L + WLO); LAS float* CW = (LAS float*)(L + CWO);
    int u = F.vcu; if (u >= 2048) return;
    int hcw = -1;
    MlPre R; ml_prefetch<false>(F, u, R);
    for (; u < 2048; u += F.G) {
        { const int h = (u >> 6) & 3; if (h != hcw) { hcw = h; for (int i = F.tid; i < 640; i += NWAVES * 64) CW[i] = (i < 512) ? ml_cw[(i >> 7) * 1024 + 512 + 128 * h + (i & 127)] : ml_cb[512 + 128 * h + (i - 512)]; } }
#pragma unroll
        for (int s = 0; s < 3; ++s) { const int i = F.tid + 512 * s, row = s < 2 ? 3 + (i & 63) : (F.tid >> 4), ch = s < 2 ? (i >> 6) : (F.tid & 15); if (s < 2 || F.tid < 48) *(LAS v4u*)(L + RAWK + row * 272 + 16 * ch) = R.k[s]; }
#pragma unroll
        for (int s = 0; s < 2; ++s) { const int i = F.tid + 512 * s; vt_scatter(VT, 72, i >> 6, i & 63, R.v[s]); }
        for (int i = F.tid; i < 16 * 64; i += NWAVES * 64) { const int r = i >> 6, l = i & 63; VT[(128 + r) * 72 + l] = (r == 0) ? (unsigned short)0x3F80 : (unsigned short)0; }
        if (F.wave == 0) {
            const int l = F.lane; const float bc = scan_add(logsig(R.fp));
            const float bl = lane63(bc); const float g = bl - bc + R.ip; const float mx = lane63(scan_max(g));
            WL[l] = __expf(g - mx);
            if (l == 0) { P_MLOC[u] = mx; P_BLAST[u] = bl; }
        }
        __syncthreads();
        if (u + F.G < 2048) ml_prefetch<false>(F, u + F.G, R);
        { const int l = F.tid & 63;
#pragma unroll
          for (int it = 0; it < 2; ++it) { const int ch = (F.tid >> 6) + 8 * it; float kc[8]; conv4_lds(L + RAWK, l, ch, CW, CW + 512, kc);
            const float wl = WL[l] * 0.08838834764831845f;
#pragma unroll
            for (int i = 0; i < 8; ++i) KT[(8 * ch + i) * 72 + l] = f2bf1(fsilu(kc[i]) * wl); } }
        __syncthreads();
        { const int fr = F.lane & 15, fq = F.lane >> 4, w = F.wave;
          bf16x8 a[2];
#pragma unroll
          for (int ks = 0; ks < 2; ++ks) a[ks] = *(const LAS bf16x8*)(L + KTO + (16 * w + fr) * 144 + (32 * ks + 8 * fq) * 2);
#pragma unroll
          for (int nt = 0; nt < 9; ++nt) { f32x4 acc = {0.f, 0.f, 0.f, 0.f};
#pragma unroll
            for (int ks = 0; ks < 2; ++ks) { const bf16x8 bb = *(const LAS bf16x8*)(L + VTO + (16 * nt + fr) * 144 + (32 * ks + 8 * fq) * 2); acc = MFMA16(a[ks], bb, acc); }
            if (nt < 8) { v2u o; o.x = pk2(acc[0], acc[1]); o.y = pk2(acc[2], acc[3]); *(v2u*)(P_CST + (size_t)u * 16384 + (16 * nt + fr) * 128 + 16 * w + 4 * fq) = o; }
            else if (fr == 0) { *(f32x4*)(P_NLOC + (size_t)u * 128 + 16 * w + 4 * fq) = acc; } } }
        __syncthreads();
    }
}

__device__ __forceinline__ void mlC_phase(Frame& F) {
    PHASE_FENCE(F);
    const float* ml_cw = karg(F, 15); const float* ml_cb = karg(F, 16); const float* ml_norm = karg(F, 17);
    ldsp L = F.lds;
    constexpr int RAWQ = 0, RAWK = 18432, QI = 36864, KI = 54272, VTO = 71680, SQO = 90112, CTO = 99328, ARR = 134144  , CWO = 136704  , HFO = 0;
    static_assert(ARR + 576 * 4 <= CWO && CWO + 1408 * 4 <= LDSCTL_OFF, "mlC LDS map");
    LAS unsigned short* VT = (LAS unsigned short*)(L + VTO); LAS unsigned short* SQ = (LAS unsigned short*)(L + SQO); LAS float* HF = (LAS float*)(L + HFO); LAS float* CW = (LAS float*)(L + CWO);
    LAS float* DV = (LAS float*)(L + ARR); LAS float* MU = DV + 64; LAS float* AI = DV + 128; LAS float* EM = DV + 192; LAS float* DENP = DV + 256  ; LAS float* DNI = DV + 384; LAS float* NP = DV + 448  ;
    int u = F.vcu; if (u >= 2048) return;
    int hcw = -1;
    MlPre R; ml_prefetch<true>(F, u, R);
    for (; u < 2048; u += F.G) {
        const int c = u & 63, bh = u >> 6, h = bh & 3, b = bh >> 2, tok0 = b * SEQ + c * 64;
        if (h != hcw) { hcw = h;
            for (int i = F.tid; i < 1280; i += NWAVES * 64) { const int qk = i / 640, r = i % 640; CW[i] = (r < 512) ? ml_cw[(r >> 7) * 1024 + 512 * qk + 128 * h + (r & 127)] : ml_cb[512 * qk + 128 * h + (r - 512)]; }
            if (F.tid < 128) CW[1280 + F.tid] = ml_norm[128 * h + F.tid]; }
#pragma unroll
        for (int s = 0; s < 3; ++s) { const int i = F.tid + 512 * s, row = s < 2 ? 3 + (i & 63) : (F.tid >> 4), ch = s < 2 ? (i >> 6) : (F.tid & 15); if (s < 2 || F.tid < 48) { *(LAS v4u*)(L + RAWQ + row * 272 + 16 * ch) = R.q[s]; *(LAS v4u*)(L + RAWK + row * 272 + 16 * ch) = R.k[s]; } }
#pragma unroll
        for (int s = 0; s < 2; ++s) { const int i = F.tid + 512 * s; vt_scatter(VT, 72, i >> 6, i & 63, R.v[s]); }
        if (F.wave == 0) {
            const int l = F.lane; const float bc = scan_add(logsig(R.fp));
            const float dv = R.ip - bc; const float cm = scan_max(dv);
            const float bm = bc + R.mp, mt = fmaxf(bm, bc + cm);
            AI[l] = __expf(bm - mt); MU[l] = mt - bc; DV[l] = dv; EM[l] = __expf(-mt);
        }
        if (F.tid >= 128 && F.tid < 256) NP[F.tid - 128] = R.np;
        __syncthreads();
        v4u ct[4];
#pragma unroll
        for (int s = 0; s < 4; ++s) ct[s] = *(const v4u*)(P_CST + (size_t)u * 16384 + (size_t)(F.tid + 512 * s) * 8);
        if (u + F.G < 2048) ml_prefetch<true>(F, u + F.G, R);
        { const int l = F.tid & 63;
#pragma unroll
          for (int it = 0; it < 2; ++it) { const int ch = (F.tid >> 6) + 8 * it; float qc[8], kc[8];
            conv4_lds(L + RAWQ, l, ch, CW, CW + 512, qc); conv4_lds(L + RAWK, l, ch, CW + 640, CW + 1152, kc);
#pragma unroll
            for (int i = 0; i < 8; ++i) { qc[i] = fsilu(qc[i]); kc[i] = fsilu(kc[i]) * 0.08838834764831845f; }
            *(LAS v4u*)(L + QI + l * 272 + 16 * ch) = pk8f(qc); *(LAS v4u*)(L + KI + l * 272 + 16 * ch) = pk8f(kc); } }
        __syncthreads();
        const int fr = F.lane & 15, fq = F.lane >> 4, w = F.wave, tt = w >> 1;
        {
          float rs[4] = {0.f, 0.f, 0.f, 0.f};
#pragma unroll 1
          for (int si = 0; si < 2; ++si) { const int st = 2 * (w & 1) + si; f32x4 acc = {0.f, 0.f, 0.f, 0.f};
#pragma unroll
            for (int ks = 0; ks < 4; ++ks) { const bf16x8 a = *(const LAS bf16x8*)(L + QI + (16 * tt + fr) * 272 + (32 * ks + 8 * fq) * 2), bb = *(const LAS bf16x8*)(L + KI + (16 * st + fr) * 272 + (32 * ks + 8 * fq) * 2); acc = MFMA16(a, bb, acc); }
            const int s = 16 * st + fr; const float dvs = DV[s];
#pragma unroll
            for (int r = 0; r < 4; ++r) { const int t = 16 * tt + 4 * fq + r; const float wgt = (s <= t) ? __expf(dvs - MU[t]) : 0.f; const float v = acc[r] * wgt; rs[r] += v; SQ[t * 72 + s] = f2bf1(v); } }
#pragma unroll
          for (int r = 0; r < 4; ++r) { float v = rs[r]; v += __shfl_xor(v, 1); v += __shfl_xor(v, 2); v += __shfl_xor(v, 4); v += __shfl_xor(v, 8); if (fr == 0) DENP[(w & 1) * 64 + 16 * tt + 4 * fq + r] = v; }
          const int t = F.tid >> 3, part = F.tid & 7; float acc = 0.f;
          { const v4u v0 = *(const LAS v4u*)(L + QI + t * 272 + 32 * part), v1 = *(const LAS v4u*)(L + QI + t * 272 + 32 * part + 16);
            const float q0[8] = {bflo(v0.x), bfhi(v0.x), bflo(v0.y), bfhi(v0.y), bflo(v0.z), bfhi(v0.z), bflo(v0.w), bfhi(v0.w)};
            const float q1[8] = {bflo(v1.x), bfhi(v1.x), bflo(v1.y), bfhi(v1.y), bflo(v1.z), bfhi(v1.z), bflo(v1.w), bfhi(v1.w)};
#pragma unroll
            for (int i = 0; i < 8; ++i) acc += q0[i] * NP[16 * part + i] + q1[i] * NP[16 * part + 8 + i]; }
          acc += __shfl_xor(acc, 1); acc += __shfl_xor(acc, 2); acc += __shfl_xor(acc, 4);
          if (part == 0) DNI[t] = acc; }
#pragma unroll
        for (int s = 0; s < 4; ++s) { const int i = F.tid + 512 * s; *(LAS v4u*)(L + CTO + (i >> 4) * 272 + 16 * (i & 15)) = ct[s]; }
        __syncthreads();
        v4u o0, o1; { const bf16* op = P_Z + (size_t)(tok0 + (F.tid >> 3)) * ZW + 2560 + 128 * h + 16 * (F.tid & 7); o0 = *(const v4u*)op; o1 = *(const v4u*)(op + 8); }
        {
#pragma unroll 1
          for (int ei = 0; ei < 4; ++ei) { const int et = 4 * (w & 1) + ei; f32x4 ai_ = {0.f, 0.f, 0.f, 0.f}, ax = {0.f, 0.f, 0.f, 0.f};
#pragma unroll
            for (int ks = 0; ks < 2; ++ks) { const bf16x8 a = *(const LAS bf16x8*)(L + SQO + (16 * tt + fr) * 144 + (32 * ks + 8 * fq) * 2), bb = *(const LAS bf16x8*)(L + VTO + (16 * et + fr) * 144 + (32 * ks + 8 * fq) * 2); ai_ = MFMA16(a, bb, ai_); }
#pragma unroll
            for (int ks = 0; ks < 4; ++ks) { const bf16x8 a = *(const LAS bf16x8*)(L + QI + (16 * tt + fr) * 272 + (32 * ks + 8 * fq) * 2), bb = *(const LAS bf16x8*)(L + CTO + (16 * et + fr) * 272 + (32 * ks + 8 * fq) * 2); ax = MFMA16(a, bb, ax); }
#pragma unroll
            for (int r = 0; r < 4; ++r) { const int t = 16 * tt + 4 * fq + r; const float aint = AI[t]; const float den = DENP[t] + DENP[64 + t] + aint * DNI[t]; const float dd = fmaxf(fabsf(den), EM[t]);
                HF[t * 132 + 16 * et + fr] = (ai_[r] + aint * ax[r]) / dd; } } }
        __syncthreads();
        {
          const int t = F.tid >> 3, part = F.tid & 7; f32x4 hv[4]; float ss = 0.f;
#pragma unroll
          for (int i = 0; i < 4; ++i) { hv[i] = *(const LAS f32x4*)(HF + t * 132 + 16 * part + 4 * i); ss += pg8::dot4(hv[i]); }
          ss += __shfl_xor(ss, 1); ss += __shfl_xor(ss, 2); ss += __shfl_xor(ss, 4);
          const float rstd = rsqrtf(ss * (1.0f / 128.0f) + 1e-6f);
          const float og0[8] = {bflo(o0.x), bfhi(o0.x), bflo(o0.y), bfhi(o0.y), bflo(o0.z), bfhi(o0.z), bflo(o0.w), bfhi(o0.w)};
          const float og1[8] = {bflo(o1.x), bfhi(o1.x), bflo(o1.y), bfhi(o1.y), bflo(o1.z), bfhi(o1.z), bflo(o1.w), bfhi(o1.w)};
          float y0[8], y1[8]; const LAS float* gn = CW + 1280 + 16 * part;
#pragma unroll
          for (int i = 0; i < 8; ++i) { y0[i] = hv[i >> 2][i & 3] * rstd * gn[i] * fsigmoid(og0[i]); y1[i] = hv[2 + (i >> 2)][i & 3] * rstd * gn[8 + i] * fsigmoid(og1[i]); }
          bf16* yp = P_YBUF + (size_t)(tok0 + t) * DM + 512 + 128 * h + 16 * part; *(v4u*)yp = pk8f(y0); *(v4u*)(yp + 8) = pk8f(y1); }
        __syncthreads();
    }
}

struct RgPre { v4u raw[11]; float carry[4]; };
template <bool FINAL> __device__ __forceinline__ void rg_prefetch(Frame& F, int u, RgPre& R) {
    const int b = u >> 6, c = u & 63, tok0 = b * SEQ + c * 64;
    int tid = F.tid; asm volatile("" : "+v"(tid));
    const int chunk = tid & 63, run = tid >> 6, col0 = 8 * chunk;
#pragma unroll
    for (int k = 0; k < 11; ++k) { const int s = c * 64 + 8 * run - 3 + k; R.raw[k] = (s >= 0) ? *(const v4u*)(P_Z + (size_t)(tok0 + 8 * run - 3 + k) * ZW + col0) : (v4u){0u, 0u, 0u, 0u}; }
    if (FINAL) {
        const int fr = tid & 15, w = tid >> 6;
#pragma unroll
        for (int jt = 0; jt < 4; ++jt) R.carry[jt] = P_RGC[(size_t)u * 512 + 64 * w + 16 * jt + fr];
    }
}
template <bool FINAL> __device__ __forceinline__ void rg_phase(Frame& F) {
    PHASE_FENCE(F);
    const float* rg_cw = karg(F, 8); const float* rg_cb = karg(F, 9); const float* rg_ba = karg(F, 11); const float* rg_bx = karg(F, 13); const float* rg_lam = karg(F, 14);
    ldsp L = F.lds;
    constexpr int XCO = 0, GRO = 66560;
    LAS unsigned short* XC = (LAS unsigned short*)(L + XCO); LAS unsigned short* GR = (LAS unsigned short*)(L + GRO);
    const int fr = F.lane & 15, fq = F.lane >> 4, w = F.wave;
    int u = F.vcu; if (u >= 512) return;
    RgPre R; rg_prefetch<FINAL>(F, u, R);
    bf16x8 bfr[2][4][2]; float ba[4], bx[4], sp8[4];
#pragma unroll
    for (int g = 0; g < 2; ++g)
#pragma unroll
        for (int jt = 0; jt < 4; ++jt)
#pragma unroll
            for (int ks = 0; ks < 2; ++ks) bfr[g][jt][ks] = *(const bf16x8*)(P_RGW + (size_t)(g * 8 + w) * 4096 + (16 * jt + fr) * 64 + 32 * ks + 8 * fq);
#pragma unroll
    for (int jt = 0; jt < 4; ++jt) { const int chn = 64 * w + 16 * jt + fr; ba[jt] = rg_ba[chn]; bx[jt] = rg_bx[chn]; sp8[jt] = 8.0f * 1.4426950408889634f * log1pf(__expf(-rg_lam[chn]));     }
    const int chunk = F.tid & 63, run = F.tid >> 6, col0 = 8 * chunk;
    LAS float* CWL = (LAS float*)(L + 132096);
    for (int i = F.tid; i < 2560; i += NWAVES * 64) CWL[i] = (i < 2048) ? rg_cw[i] : rg_cb[i - 2048];
    __syncthreads();
    for (; u < 512; u += F.G) {
        const int b = u >> 6, c = u & 63, tok0 = b * SEQ + c * 64;
        f32x4 wa[4], wb[4];
#pragma unroll
        for (int j = 0; j < 4; ++j) { wa[j] = *(const LAS f32x4*)(CWL + j * 512 + col0); wb[j] = *(const LAS f32x4*)(CWL + j * 512 + col0 + 4); }
        const f32x4 b0 = *(const LAS f32x4*)(CWL + 2048 + col0), b1 = *(const LAS f32x4*)(CWL + 2048 + col0 + 4);
#pragma unroll
        for (int t = 0; t < 8; ++t) { f32x4 oa = b0, ob = b1;
#pragma unroll
            for (int j = 0; j < 4; ++j) { f32x4 xa, xb2; pg8::unpack8(R.raw[t + j], xa, xb2); oa += wa[j] * xa; ob += wb[j] * xb2; }
            *(LAS v4u*)(L + XCO + (8 * run + t) * 1040 + 16 * chunk) = pg8::pk8(oa, ob); }
        float carry[4], ptot[4]; v4u gk[8];
#pragma unroll
        for (int jt = 0; jt < 4; ++jt) { carry[jt] = FINAL ? R.carry[jt] : 0.f; ptot[jt] = 1.f; }
        __syncthreads();
        if (u + F.G < 512) rg_prefetch<FINAL>(F, u + F.G, R);
        if (FINAL) {
#pragma unroll
            for (int k = 0; k < 8; ++k) gk[k] = *(const v4u*)(P_Z + (size_t)(tok0 + run + 8 * k) * ZW + 512 + col0); }
#pragma unroll 1
        for (int tt = 0; tt < 4; ++tt) {
            bf16x8 a[2];
#pragma unroll
            for (int ks = 0; ks < 2; ++ks) a[ks] = *(const LAS bf16x8*)(L + XCO + (16 * tt + fr) * 1040 + (64 * w + 32 * ks + 8 * fq) * 2);
#pragma unroll
            for (int jt = 0; jt < 4; ++jt) { f32x4 ga = {0.f, 0.f, 0.f, 0.f}, gx = {0.f, 0.f, 0.f, 0.f};
#pragma unroll
                for (int ks = 0; ks < 2; ++ks) { ga = MFMA16(a[ks], bfr[0][jt][ks], ga); gx = MFMA16(a[ks], bfr[1][jt][ks], gx); }
                const int chn = 64 * w + 16 * jt + fr; float av[4], uv[4];
#pragma unroll
                for (int r = 0; r < 4; ++r) { const int t = 16 * tt + 4 * fq + r; const float xcv = bf2f(XC[t * 520 + chn]);
                    const float la = -fsigmoid(ga[r] + ba[jt]) * sp8[jt]; const float aa = __builtin_amdgcn_exp2f(la); av[r] = aa; uv[r] = sqrtf(fmaxf(1.0f - aa * aa, 0.f)) * fsigmoid(gx[r] + bx[jt]) * xcv; }
                float Pi = av[0] * av[1] * av[2] * av[3], hi = ((uv[0] * av[1] + uv[1]) * av[2] + uv[2]) * av[3] + uv[3];
                { const float tP = __shfl_up(Pi, 16), th = __shfl_up(hi, 16); if (fq >= 1) { hi = Pi * th + hi; Pi = Pi * tP; } }
                { const float tP = __shfl_up(Pi, 32), th = __shfl_up(hi, 32); if (fq >= 2) { hi = Pi * th + hi; Pi = Pi * tP; } }
                float Pe = __shfl_up(Pi, 16), he = __shfl_up(hi, 16); if (fq == 0) { Pe = 1.f; he = 0.f; }
                const float P3 = __shfl(Pi, 48 + fr), h3 = __shfl(hi, 48 + fr);
                if (FINAL) { float hc = Pe * carry[jt] + he;
#pragma unroll
                    for (int r = 0; r < 4; ++r) { const int t = 16 * tt + 4 * fq + r; hc = av[r] * hc + uv[r]; GR[t * 512 + chn] = f2bf1(hc); } }
                carry[jt] = P3 * carry[jt] + h3; ptot[jt] *= P3; }
        }
        if (!FINAL) { if (fq == 0) {
#pragma unroll
            for (int jt = 0; jt < 4; ++jt) { P_RGA[(size_t)u * 512 + 64 * w + 16 * jt + fr] = ptot[jt]; P_RGH[(size_t)u * 512 + 64 * w + 16 * jt + fr] = carry[jt]; } } }
        else { __syncthreads();
#pragma unroll
            for (int k = 0; k < 8; ++k) { const int t = run + 8 * k; f32x4 h0, h1, g0, g1; const v4u hw = *(const LAS v4u*)(L + GRO + t * 1024 + 16 * chunk); pg8::unpack8(hw, h0, h1); pg8::unpack8(gk[k], g0, g1);
#pragma unroll
                for (int e = 0; e < 4; ++e) { h0[e] *= gelu_tanh(g0[e]); h1[e] *= gelu_tanh(g1[e]); }
                *(v4u*)(P_YBUF + (size_t)(tok0 + t) * DM + 8 * chunk) = pg8::pk8(h0, h1); } }
        __syncthreads();
    }
}

__device__ __forceinline__ void mixB_unit(Frame& F, int unit) {
    PHASE_FENCE(F);
    const int bh = unit >> 3, sl = unit & 7; ldsp L = F.lds;
    LAS float* AP = (LAS float*)L; LAS float* AL = AP + 64;
    bf16* base = P_CST + (size_t)bh * 64 * 16384 + sl * 2048 + F.tid * 4; v2u cl[64];
#pragma unroll
    for (int c = 0; c < 64; ++c) cl[c] = *(const v2u*)(base + (size_t)c * 16384);
    if (F.wave == 0) {
        const float mlv = P_MLOC[bh * 64 + F.lane], blv = P_BLAST[bh * 64 + F.lane]; float mst = -INFINITY, mp = 0.f, mn_ = 0.f;
#pragma unroll
        for (int c = 0; c < 64; ++c) { const float ml = __int_as_float(__builtin_amdgcn_readlane(__float_as_int(mlv), c));
            const float bl = __int_as_float(__builtin_amdgcn_readlane(__float_as_int(blv), c)); const float mn = fmaxf(bl + mst, ml);
            if (F.lane == c) { mp = mst; mn_ = mn; }
            mst = mn; }
        AP[F.lane] = __expf(blv + mp - mn_); AL[F.lane] = __expf(mlv - mn_); if (sl == 0) P_MPREV[bh * 64 + F.lane] = mp; }
    __syncthreads();
    { float st[4] = {0.f, 0.f, 0.f, 0.f};
#pragma unroll
      for (int c = 0; c < 64; ++c) { v2u o; o.x = pk2(st[0], st[1]); o.y = pk2(st[2], st[3]); *(v2u*)(base + (size_t)c * 16384) = o;
          const float ap = AP[c], al = AL[c];
          st[0] = ap * st[0] + al * bflo(cl[c].x); st[1] = ap * st[1] + al * bfhi(cl[c].x); st[2] = ap * st[2] + al * bflo(cl[c].y); st[3] = ap * st[3] + al * bfhi(cl[c].y); } }
    if (sl == 0 && F.tid < 128) { float ns = 0.f;
        for (int c0 = 0; c0 < 64; c0 += 16) { float nl[16];
#pragma unroll
            for (int k = 0; k < 16; ++k) nl[k] = P_NLOC[(size_t)(bh * 64 + c0 + k) * 128 + F.tid];
#pragma unroll
            for (int k = 0; k < 16; ++k) { P_NPREV[(size_t)(bh * 64 + c0 + k) * 128 + F.tid] = ns; ns = AP[c0 + k] * ns + AL[c0 + k] * nl[k]; } } }
#pragma unroll
    for (int j = 0; j < 2; ++j) { const int idx = unit * 16 + 2 * F.wave + j, b = idx >> 9, chn = idx & 511; const size_t o = (size_t)(b * 64 + F.lane) * 512 + chn;
        float Pi = P_RGA[o], hi = P_RGH[o];
#pragma unroll
        for (int off = 1; off < 64; off <<= 1) { const float tP = __shfl_up(Pi, off), th = __shfl_up(hi, off); if (F.lane >= off) { hi = Pi * th + hi; Pi = Pi * tP; } }
        float he = __shfl_up(hi, 1); if (F.lane == 0) he = 0.f;
        P_RGC[o] = he; }
    __syncthreads();
}

__device__ __forceinline__ void attn_unit(Frame& F, int u, const bf16* Qb, const bf16* Kb, const bf16* Vb, bf16* Ob) { const float* at_sinks = karg(F, 22);
    const int qb = u & 31, kvh = (u >> 5) & 3, b = u >> 7; const int row0 = b * SEQ + 128 * qb;
    ldsp L = F.lds;
    constexpr int KI = 0, VTO = 36864;
    LAS unsigned short* VT = (LAS unsigned short*)(L + VTO);
#pragma unroll
    for (int it = 0; it < 4; ++it) { const int idx = F.tid + 512 * it, kr = idx & 255, chk = idx >> 8; const bool ok = (qb > 0) || (kr >= 128);
        v4u kv = {0u, 0u, 0u, 0u}, vv = {0u, 0u, 0u, 0u};
        if (ok) { const size_t o = (size_t)(row0 - 128 + kr) * 256 + 64 * kvh + 8 * chk; kv = *(const v4u*)(Kb + o); vv = *(const v4u*)(Vb + o); }
        *(LAS v4u*)(L + KI + kr * 144 + 16 * chk) = kv;
        VT[(8 * chk + 0) * 260 + kr] = (unsigned short)(vv.x & 0xffffu); VT[(8 * chk + 1) * 260 + kr] = (unsigned short)(vv.x >> 16);
        VT[(8 * chk + 2) * 260 + kr] = (unsigned short)(vv.y & 0xffffu); VT[(8 * chk + 3) * 260 + kr] = (unsigned short)(vv.y >> 16);
        VT[(8 * chk + 4) * 260 + kr] = (unsigned short)(vv.z & 0xffffu); VT[(8 * chk + 5) * 260 + kr] = (unsigned short)(vv.z >> 16);
        VT[(8 * chk + 6) * 260 + kr] = (unsigned short)(vv.w & 0xffffu); VT[(8 * chk + 7) * 260 + kr] = (unsigned short)(vv.w >> 16); }
    __syncthreads();
    const int r = F.lane & 31, hh = F.lane >> 5, w = F.wave, head = 4 * kvh + (w >> 1);
    const float sink = at_sinks[head] * 1.4426950408889634f;
#pragma unroll 1
    for (int qt = 0; qt < 2; ++qt) {
        const int q0 = 64 * (w & 1) + 32 * qt, kt0 = q0 >> 5; const size_t qrow = (size_t)(row0 + q0 + r);
        bf16x8 qf[4];
#pragma unroll
        for (int ks = 0; ks < 4; ++ks) qf[ks] = *(const bf16x8*)(Qb + qrow * 1024 + 64 * head + 16 * ks + 8 * hh);
        f32x16 S[5];
#pragma unroll
        for (int i = 0; i < 5; ++i) {
#pragma unroll
            for (int e = 0; e < 16; ++e) S[i][e] = 0.f;
#pragma unroll
            for (int ks = 0; ks < 4; ++ks) { const bf16x8 kf = *(const LAS bf16x8*)(L + KI + (32 * (kt0 + i) + r) * 144 + (16 * ks + 8 * hh) * 2); S[i] = MFMA32(kf, qf[ks], S[i]); } }
        float mx = sink;
#pragma unroll
        for (int i = 0; i < 5; ++i) { const bool whole = (qb == 0) && (kt0 + i < 4);
#pragma unroll
            for (int e = 0; e < 16; ++e) { const int cr = (e & 3) + 8 * (e >> 2) + 4 * hh; float v = S[i][e];
                if (i == 0) v = (cr > r) ? v : -INFINITY;
                if (i == 4) v = (cr <= r) ? v : -INFINITY;
                v = whole ? -INFINITY : v;
                S[i][e] = v; mx = fmaxf(mx, v); } }
        mx = fmaxf(mx, __shfl_xor(mx, 32));
        float sum = 0.f;
#pragma unroll
        for (int i = 0; i < 5; ++i)
#pragma unroll
            for (int e = 0; e < 16; ++e) { const float p = __builtin_amdgcn_exp2f(S[i][e] - mx); S[i][e] = p; sum += p; }
        sum += __shfl_xor(sum, 32); sum += __builtin_amdgcn_exp2f(sink - mx);
        const float inv = 1.0f / sum;
        f32x16 O[2];
#pragma unroll
        for (int e = 0; e < 16; ++e) { O[0][e] = 0.f; O[1][e] = 0.f; }
#pragma unroll
        for (int i = 0; i < 5; ++i)
#pragma unroll
            for (int s = 0; s < 2; ++s) {
                v4u pw; pw.x = pk2(S[i][8 * s + 0], S[i][8 * s + 1]); pw.y = pk2(S[i][8 * s + 2], S[i][8 * s + 3]); pw.z = pk2(S[i][8 * s + 4], S[i][8 * s + 5]); pw.w = pk2(S[i][8 * s + 6], S[i][8 * s + 7]);
                const bf16x8 pf = __builtin_bit_cast(bf16x8, pw);
#pragma unroll
                for (int dt = 0; dt < 2; ++dt) { const int ko = (32 * dt + r) * 520 + (32 * (kt0 + i) + 16 * s + 4 * hh) * 2;
                    const s16x4 lo = *(const LAS s16x4*)(L + VTO + ko), hi = *(const LAS s16x4*)(L + VTO + ko + 16);
                    const bf16x8 vf = __builtin_shufflevector(lo, hi, 0, 1, 2, 3, 4, 5, 6, 7);
                    O[dt] = MFMA32(vf, pf, O[dt]); } }
        bf16* op = Ob + qrow * 1024 + 64 * head + 4 * hh;
#pragma unroll
        for (int dt = 0; dt < 2; ++dt)
#pragma unroll
            for (int g4 = 0; g4 < 4; ++g4) { v2u o; o.x = pk2(O[dt][4 * g4] * inv, O[dt][4 * g4 + 1] * inv); o.y = pk2(O[dt][4 * g4 + 2] * inv, O[dt][4 * g4 + 3] * inv); *(v2u*)(op + 32 * dt + 8 * g4) = o; }
    }
    __syncthreads();
}

__device__ __forceinline__ void fixup_panel(Frame& F, int pm, const float* cw, const float* cb, bf16* A2, const bf16* GH, const bf16* UH, const bf16* GT) {
    for (int idx = F.tid; idx < 8 * 384; idx += NWAVES * 64) {
        const int chk = idx % 384, rg = idx / 384, rr = rg & 1, grp = 4 * pm + (rg >> 1), ch0 = 8 * chk; const bool first = (grp & 63) == 0;
        float g0[8], u0[8], p1[8], p2[8];
        ld8f(GH + ((size_t)grp * 2 + rr) * 3072 + ch0, g0); ld8f(UH + ((size_t)grp * 2 + rr) * 3072 + ch0, u0);
#pragma unroll
        for (int i = 0; i < 8; ++i) { p1[i] = 0.f; p2[i] = 0.f; }
        if (rr == 1) { ld8f(GH + ((size_t)grp * 2) * 3072 + ch0, p1); if (!first) ld8f(GT + ((size_t)(grp - 1) * 2 + 1) * 3072 + ch0, p2); }
        else if (!first) { ld8f(GT + ((size_t)(grp - 1) * 2 + 1) * 3072 + ch0, p1); ld8f(GT + ((size_t)(grp - 1) * 2) * 3072 + ch0, p2); }
        float o[8];
#pragma unroll
        for (int i = 0; i < 8; ++i) { const float y = cw[ch0 + i] * p2[i] + cw[3072 + ch0 + i] * p1[i] + cw[6144 + ch0 + i] * g0[i] + cb[ch0 + i]; o[i] = gelu_tanh(y) * u0[i]; }
        *(v4u*)(A2 + (size_t)grp * 32 * 6144 + ((ch0 >> 6) * 128 + ((ch0 >> 5) & 1) * 64 + rr * 32 + (ch0 & 31))) = pk8f(o);
    }
}

#define GRID_BAR() do { xcd_barrier(bar); TSTAMP(); } while (0)
template <int L> __device__ __forceinline__ bool layer_part(Frame& F, const XcdBarrier& bar, int& ts_n) {
    constexpr int l = L;
    unsigned char* ws = F.ws; const int bx = (int)blockIdx.x;
    bf16* const XBA = (bf16*)(ws + WS_XBA); bf16* const XBB = (bf16*)(ws + WS_XBB);
    float* const SSA = (float*)(ws + WS_SSA); float* const SSB = (float*)(ws + WS_SSB);
    bf16* const PP = (bf16*)(ws + WS_CST); bf16* const A2 = (bf16*)(ws + WS_BIG);

        if (l == 1) {
            bf16* const Qb = (bf16*)(ws + WS_BIG); bf16* const Kb = (bf16*)(ws + WS_BIG + 64 * MiB); bf16* const Vb = (bf16*)(ws + WS_BIG + 80 * MiB); bf16* const Ob = (bf16*)(ws + WS_BIG + 96 * MiB);
PREP(7) {
            { pg8::Gemm g{XBB, (const bf16*)(ws + WS_WQKV), T, 1536, DM}; pg8::StaticOrder S; S.init(T, 1536, F.G, bx);
              pg8::EpiQkv E{SSB, P_ROPE, karg(F, 20), karg(F, 21), Qb, Kb, Vb};
              pg8::gemm_phase<pg8::EpiQkv, pg8::StaticOrder, true, true>(F.lds, g, S, E, F.wave); }
            { pg8::Gemm g{(const bf16*)(ws + WS_PB) + (size_t)T * 256, (const bf16*)(ws + WS_WPJ1), T, DM, 256}; pg8::StaticOrder S; S.init(T, DM, F.G, bx);
              pg8::EpiZ<true> E{PP, DM, nullptr, nullptr};
              pg8::gemm_phase<pg8::EpiZ<true>, pg8::StaticOrder, true, true>(F.lds, g, S, E, F.wave); }
            GRID_BAR();
    }

            PREP(8) {
            PHASE_FENCE(F); for (int u = F.vcu; u < 1024; u += F.G) attn_unit(F, u, Qb, Kb, Vb, Ob);
            GRID_BAR();
            }
            { pg8::Gemm g{Ob, (const bf16*)(ws + WS_WO1), T, DM, DM}; pg8::StaticOrder S; S.init(T, DM, F.G, bx);
              pg8::EpiRes<false, false> E{XBB, XBA, SSA};
              pg8::gemm_phase<pg8::EpiRes<false, false>, pg8::StaticOrder, true, true>(F.lds, g, S, E, F.wave); }
            GRID_BAR();
            if (DBG_STOP == 9) return true;
        } else {
PREP(3) {
            { pg8::Gemm g{P_YBUF, (const bf16*)(ws + WS_WOUT0), T, DM, DM}; pg8::StaticOrder S; S.init(T, DM, F.G, bx);
              pg8::EpiRes<true, false> E{karg(F, 0), XBB, SSB};
              pg8::gemm_phase<pg8::EpiRes<true, false>, pg8::StaticOrder, true, true>(F.lds, g, S, E, F.wave); }
            { pg8::Gemm g{(const bf16*)(ws + WS_PB), (const bf16*)(ws + WS_WPJ0), T, DM, 256}; pg8::StaticOrder S; S.init(T, DM, F.G, bx);
              pg8::EpiZ<true> E{PP, DM, nullptr, nullptr};
              pg8::gemm_phase<pg8::EpiZ<true>, pg8::StaticOrder, true, true>(F.lds, g, S, E, F.wave); }
            GRID_BAR();
    }

            if (DBG_STOP == 3) return true;
        }
        const bf16* xin = l ? XBA : XBB; const float* ssin = l ? SSA : SSB; bf16* side = l ? XBB : XBA;
        bf16* const GH = side; bf16* const UH = side + (size_t)3 * MiB; bf16* const GT = side + (size_t)6 * MiB;
        const float* cw = karg(F, 25) + (size_t)l * 3 * 3072; const float* cb = karg(F, 26) + (size_t)l * 3072;
        PREP(10 + 10 * l) {
        { pg8::Gemm g{xin, (const bf16*)(ws + (l ? WS_WUP1 : WS_WUP0)), T, 2 * FFD, DM}; pg8::StaticOrder S; S.init(T, 2 * FFD, F.G, bx);
          pg8::EpiUp E{ssin, cw, cb, A2, GH, UH, GT};
          pg8::gemm_phase<pg8::EpiUp, pg8::StaticOrder, true, true>(F.lds, g, S, E, F.wave); }
        GRID_BAR();
        }
        PHASE_FENCE(F); for (int pm = F.vcu; pm < T / 256; pm += F.G) fixup_panel(F, pm, cw, cb, A2, GH, UH, GT);
        GRID_BAR();
        bf16* const xdn = l ? XBB : XBA; float* const ssdn = l ? SSB : SSA;
        { pg8::Gemm g{A2, (const bf16*)(ws + (l ? WS_WDN1 : WS_WDN0)), T, DM, FFD}; pg8::StaticOrder S; S.init(T, DM, F.G, bx);
          pg8::EpiRes<false, true> E{xin, xdn, ssdn};
          pg8::gemm_phase<pg8::EpiRes<false, true>, pg8::StaticOrder, true, true>(F.lds, g, S, E, F.wave); }
        GRID_BAR();
        if ((l == 0 && DBG_STOP == 5) || (l == 1 && DBG_STOP == 11)) return true;
#ifdef PROBE_P6MODE
        if (L == 0) { pg8::Gemm g{xdn, (const bf16*)(ws + (l ? WS_WGT1 : WS_WGT0)), T, DM, DM}; pg8::StaticOrder S; S.init(T, DM, F.G, bx);
#if PROBE_P6MODE == 0
          pg8::EpiNone E0{}; pg8::gemm_phase<pg8::EpiNone, pg8::StaticOrder, true, true>(F.lds, g, S, E0, F.wave);
#else
          pg8::EpiPleProbe<PROBE_P6MODE> E0{ssdn, PP, xdn, A2, (float*)(ws + WS_BIG + 100 * MiB)}; pg8::gemm_phase<pg8::EpiPleProbe<PROBE_P6MODE>, pg8::StaticOrder, true, true>(F.lds, g, S, E0, F.wave);
#endif
          GRID_BAR(); }
#endif
        { pg8::Gemm g{xdn, (const bf16*)(ws + (l ? WS_WGT1 : WS_WGT0)), T, DM, DM}; pg8::StaticOrder S; S.init(T, DM, F.G, bx);
          pg8::EpiPle<(L == 1)> E{ssdn, PP, xdn, XBB, SSB, F.out};
          pg8::gemm_phase<pg8::EpiPle<(L == 1)>, pg8::StaticOrder, true, true>(F.lds, g, S, E, F.wave); }
        if (l == 0) GRID_BAR();
        if (l == 0 && DBG_STOP == 6) return true;

    return false;
}
struct Args { const void* in[30]; float* out; unsigned char* ws; };
__global__ void __launch_bounds__(NWAVES * 64, 2) hy_fwd(Args args) {
    extern __shared__ __attribute__((aligned(16))) unsigned char lds[];
    Frame F;
    F.lds = (ldsp)lds; F.MISC = (volatile LAS unsigned*)(F.lds + MISC_OFF);
    F.tid = threadIdx.x; F.lane = F.tid & 63; F.wave = __builtin_amdgcn_readfirstlane(F.tid >> 6);
    F.G = gridDim.x; { const int bx = blockIdx.x; F.vcu = (F.G % 8 == 0) ? (bx % 8) * (F.G / 8) + bx / 8 : bx; }
    unsigned char* ws = args.ws; F.ws = ws; F.out = args.out;
    F.kb = (unsigned long long)__builtin_amdgcn_kernarg_segment_ptr();
    for (int i = F.tid; i < (LDS_BYTES - LDSCTL_OFF) / 4; i += NWAVES * 64) ((LAS unsigned*)(F.lds + LDSCTL_OFF))[i] = 0u;
    __syncthreads();
    XcdBarrier bar = xcd_barrier_post((unsigned*)(ws + WS_CTL) + CW_BAR, F.MISC + 8, F.wave);
    bf16* const XBA = (bf16*)(ws + WS_XBA); bf16* const XBB = (bf16*)(ws + WS_XBB);
    float* const SSA = (float*)(ws + WS_SSA); float* const SSB = (float*)(ws + WS_SSB);
    bf16* const PP = (bf16*)(ws + WS_CST); bf16* const A2 = (bf16*)(ws + WS_BIG);
    const int bx = (int)blockIdx.x; int ts_n = 0; (void)ts_n;
    TSTAMP();

    PREP(100) {
    p0_prologue(F, bar, ts_n);
    GRID_BAR();
    }
#if DBG_STOP >= 1
PREP(1) {
    { pg8::Gemm g{XBA, (const bf16*)(ws + WS_WIN), T, ZW, DM}; pg8::StaticOrder S; S.init(T, ZW, F.G, bx);
#if PROBE_PHASE == 1 && defined(PROBE_VARIANT)
      if (rep_ < PROBE_N) {
#if PROBE_VARIANT == 1
        pg8::EpiNone E0{}; pg8::gemm_phase<pg8::EpiNone, pg8::StaticOrder, true, true>(F.lds, g, S, E0, F.wave);
#elif PROBE_VARIANT == 4
        pg8::EpiNone E0{}; pg8::gemm_phase<pg8::EpiNone, pg8::StaticOrder, false, true>(F.lds, g, S, E0, F.wave);
#elif PROBE_VARIANT == 5
        pg8::EpiNone E0{}; pg8::gemm_phase<pg8::EpiNone, pg8::StaticOrder, true, false>(F.lds, g, S, E0, F.wave);
#elif PROBE_VARIANT == 3
        pg8::EpiZLine E0{P_Z, ZW}; pg8::gemm_phase<pg8::EpiZLine, pg8::StaticOrder, true, true>(F.lds, g, S, E0, F.wave);
#else
        pg8::EpiZ<false> E0{P_Z, ZW, nullptr, nullptr}; pg8::gemm_phase<pg8::EpiZ<false>, pg8::StaticOrder, true, true>(F.lds, g, S, E0, F.wave);
#endif
      } else
#endif
      { pg8::EpiZ<false> E{P_Z, ZW, karg(F, 7), SSA};
      pg8::gemm_phase<pg8::EpiZ<false>, pg8::StaticOrder, true, true>(F.lds, g, S, E, F.wave); } }
    GRID_BAR();
    }

    PREP(21) { mlA_phase(F); }
#ifdef PROBE_P2CSPLIT
    GRID_BAR();
#endif
    PREP(22) { rg_phase<false>(F); }
    GRID_BAR();
    for (int u = F.vcu; u < 256; u += F.G) mixB_unit(F, u);
    GRID_BAR();
    PREP(41) { mlC_phase(F); }
#ifdef PROBE_P2CSPLIT
    GRID_BAR();
#endif
    PREP(42) { rg_phase<true>(F); }
    GRID_BAR();
#endif
    PREP(99) { if (rep_ > 0) GRID_BAR(); }
#if DBG_STOP >= 3
    if (layer_part<0>(F, bar, ts_n)) return;
    if (layer_part<1>(F, bar, ts_n)) return;
#ifdef PROBE_TA
    GRID_BAR();
    if (blockIdx.x == 0 && threadIdx.x == 0) { const unsigned dt = F.MISC[16 + PROBE_TB] - F.MISC[16 + PROBE_TA]; F.out[0] += floorf((float)dt * (float)(PROBE_TSCALE) * 0.5f) * 2.0f; }
#endif
#endif
}

extern "C" void kernel_launch(void* const* d_in, const int* in_sizes, int n_in, void* d_out, int out_size, void* d_ws, size_t ws_size, hipStream_t stream) {
    static int grid = 0;
    if (grid == 0) {
        if (n_in != 30 || in_sizes[0] != T * DM || out_size != T * DM || ws_size < WS_END) { fprintf(stderr, "kernel_launch: unexpected shapes (n_in %d, in0 %d, out %d, ws %zu < %zu); nothing launched\n", n_in, n_in > 0 ? in_sizes[0] : -1, out_size, ws_size, (size_t)WS_END); grid = -1; return; }
        int dev = 0, cus = 0, per_cu = 0;
        if (hipGetDevice(&dev) != hipSuccess || hipDeviceGetAttribute(&cus, hipDeviceAttributeMultiprocessorCount, dev) != hipSuccess) { fprintf(stderr, "kernel_launch: device query failed\n"); grid = -1; return; }
        if (hipFuncSetAttribute((const void*)hy_fwd, hipFuncAttributeMaxDynamicSharedMemorySize, LDS_BYTES) != hipSuccess) { fprintf(stderr, "kernel_launch: hipFuncSetAttribute failed\n"); grid = -1; return; }
        if (hipOccupancyMaxActiveBlocksPerMultiprocessor(&per_cu, (const void*)hy_fwd, NWAVES * 64, LDS_BYTES) != hipSuccess || per_cu < 1) { fprintf(stderr, "kernel_launch: occupancy query says %d workgroups per CU; nothing launched\n", per_cu); (void)hipGetLastError(); grid = -1; return; }
        grid = cus;
    }
    if (grid < 0) return;
    if (hipMemsetAsync((char*)d_ws + WS_CTL, 0, CTL_ZERO_BYTES, stream) != hipSuccess) { fprintf(stderr, "kernel_launch: hipMemsetAsync failed\n"); return; }
    Args a{};
    for (int i = 0; i < 30; ++i) a.in[i] = d_in[i];
    a.out = (float*)d_out; a.ws = (unsigned char*)d_ws;
    hipLaunchKernelGGL(hy_fwd, dim3(grid), dim3(NWAVES * 64), LDS_BYTES, stream, a);
    const hipError_t le = hipPeekAtLastError();
    if (le != hipSuccess) fprintf(stderr, "kernel_launch: launch failed: %s\n", hipGetErrorName(le));
}
```

```cpp
#include <hip/hip_runtime.h>
#include <cstdio>
#include <cstdint>
#include <cmath>
namespace pg8 {
#define PG8_LAS __attribute__((address_space(3)))
typedef unsigned short bf16_t;
typedef short bf16x8 __attribute__((ext_vector_type(8)));
typedef float f32x4 __attribute__((ext_vector_type(4)));
typedef unsigned u32x4 __attribute__((ext_vector_type(4)));
constexpr int BM = 256, BK = 64, HALF = 128, HTB = HALF * BK * 2  , STAGE_BYTES = 8 * HTB, NXCD = 8, WGM = 8;

__host__ __device__ __forceinline__ int lds_byte(int r, int c) { const int st = (r >> 4) * 2 + (c >> 5), rr = r & 15, cc = c & 31, ob = rr * 64 + cc * 2; return st * 1024 + (ob ^ (((ob >> 9) & 1) << 5)); }
__host__ __device__ __forceinline__ void stage_rc(int b, int& R, int& C) { const int st = b / 1024, sb = b % 1024, swz = sb ^ (((sb >> 9) & 1) << 5); R = (st >> 1) * 16 + swz / 64; C = (st & 1) * 32 + (swz % 64) / 2; }
__host__ __device__ __forceinline__ int perm32(int rho) { const int n = rho >> 4, i = rho & 15; return 8 * (i >> 2) + 4 * n + (i & 3); }

__device__ __forceinline__ int lane_now() { int l; asm volatile("v_mbcnt_lo_u32_b32 %0, -1, 0\n\tv_mbcnt_hi_u32_b32 %0, -1, %0" : "=v"(l)); return l; }

struct Unit { int pm, pn; };
struct Gemm { const bf16_t* A; const bf16_t* Bt; int M, N, K; };

struct StaticOrder {
    int nM, nN, nwg, G, c;
    __host__ __device__ void init(int M, int N, int G_, int c_) { nM = M / BM; nN = N / BM; nwg = nM * nN; G = G_; c = c_; }
    __host__ __device__ bool next(int i, Unit& u) const {
        const long L = (long)i * G + c; if (L >= nwg) return false;
        int wgid = (int)L; { const int q = nwg / NXCD, r = nwg % NXCD, xcd = wgid % NXCD, off = wgid / NXCD; wgid = (xcd < r ? xcd * (q + 1) : r * (q + 1) + (xcd - r) * q) + off; }
        const int nig = WGM * nN, gid = wgid / nig, fm = gid * WGM, gsz = (nM - fm) < WGM ? (nM - fm) : WGM;
        u.pm = fm + ((wgid % nig) % gsz); u.pn = (wgid % nig) / gsz; return true;
    }
    __device__ __forceinline__ void a_ready(const Unit&) const {}
    __device__ __forceinline__ void done(const Unit&) const {}
};

typedef float f32x2_t __attribute__((ext_vector_type(2))); typedef __bf16 bf16x2_t __attribute__((ext_vector_type(2)));
__device__ __forceinline__ unsigned pk2(float lo, float hi) { f32x2_t v = {lo, hi}; bf16x2_t b = __builtin_convertvector(v, bf16x2_t); return __builtin_bit_cast(unsigned, b); }
__device__ __forceinline__ float bflo(unsigned w) { return __uint_as_float(w << 16); }
__device__ __forceinline__ float bfhi(unsigned w) { return __uint_as_float(w & 0xffff0000u); }
__device__ __forceinline__ float fsigmoid(float x) { return __builtin_amdgcn_rcpf(1.0f + __expf(-x)); }
__device__ __forceinline__ float gelu_tanh(float x) { const float t2 = x * (2.3022082f + 0.10294324f * x * x); return x * __builtin_amdgcn_rcpf(1.0f + __builtin_amdgcn_exp2f(-t2)); }
__device__ __forceinline__ u32x4 pk8(const f32x4& a, const f32x4& b) { u32x4 w; w.x = pk2(a[0], a[1]); w.y = pk2(a[2], a[3]); w.z = pk2(b[0], b[1]); w.w = pk2(b[2], b[3]); return w; }
__device__ __forceinline__ float dot4(const f32x4& a) { return (a[0] * a[0] + a[1] * a[1]) + (a[2] * a[2] + a[3] * a[3]); }
__device__ __forceinline__ float sum_fq(float s) {
    { const auto r = __builtin_amdgcn_permlane16_swap(__float_as_uint(s), __float_as_uint(s), false, false); s = __uint_as_float(r[0]) + __uint_as_float(r[1]); }
    { const auto r = __builtin_amdgcn_permlane32_swap(__float_as_uint(s), __float_as_uint(s), false, false); s = __uint_as_float(r[0]) + __uint_as_float(r[1]); }
    return s;
}
__device__ __forceinline__ float row_rstd(const float* ss, int row) {
    const f32x4* p = (const f32x4*)(ss + (size_t)row * 16);
    const f32x4 a = p[0], b = p[1], c = p[2], d = p[3];
    const float s = (((a[0] + a[1]) + (a[2] + a[3])) + ((b[0] + b[1]) + (b[2] + b[3]))) + (((c[0] + c[1]) + (c[2] + c[3])) + ((d[0] + d[1]) + (d[2] + d[3])));
    return rsqrtf(s * (1.0f / 1024.0f) + 1e-6f);
}

__device__ __forceinline__ unsigned dpp_xor1(unsigned v) { return (unsigned)__builtin_amdgcn_update_dpp(0, (int)v, 0xB1, 0xF, 0xF, true); }
template <int N> __device__ __forceinline__ unsigned dpp_ror(unsigned v) { return (unsigned)__builtin_amdgcn_update_dpp(0, (int)v, 0x120 + N, 0xF, 0xF, true); }
__device__ __forceinline__ u32x4 shfl1(const u32x4& v) { u32x4 r; r.x = dpp_xor1(v.x); r.y = dpp_xor1(v.y); r.z = dpp_xor1(v.z); r.w = dpp_xor1(v.w); return r; }
__device__ __forceinline__ void xchg_out(const u32x4& X0, const u32x4& X1, bool odd, u32x4& PA, u32x4& PB) { const u32x4 recv = shfl1(odd ? X0 : X1); PA = odd ? recv : X0; PB = odd ? X1 : recv; }
__device__ __forceinline__ void xchg_in(const u32x4& LA, const u32x4& LB, bool odd, u32x4& X0, u32x4& X1) { const u32x4 recv = shfl1(odd ? LA : LB); X0 = odd ? recv : LA; X1 = odd ? LB : recv; }
__device__ __forceinline__ u32x4 f2u(const f32x4& v) { return __builtin_bit_cast(u32x4, v); }
__device__ __forceinline__ f32x4 u2f(const u32x4& v) { return __builtin_bit_cast(f32x4, v); }
__device__ __forceinline__ void unpack8(const u32x4& w, f32x4& a, f32x4& b) { a[0] = bflo(w.x); a[1] = bfhi(w.x); a[2] = bflo(w.y); a[3] = bfhi(w.y); b[0] = bflo(w.z); b[1] = bfhi(w.z); b[2] = bflo(w.w); b[3] = bfhi(w.w); }
__device__ __forceinline__ void store_bf16_lines(bf16_t* base, int ld, int rowE, int fr, int fq, const u32x4& X0, const u32x4& X1) {
    const bool odd = fr & 1; u32x4 PA, PB; xchg_out(X0, X1, odd, PA, PB); const int c8 = ((fr & 1) * 4 + fq) * 8;
    *(u32x4*)(base + (size_t)rowE * ld + c8) = PA; *(u32x4*)(base + (size_t)(rowE + 1) * ld + c8) = PB;
}
__device__ __forceinline__ void load_bf16_lines(const bf16_t* base, int ld, int rowE, int fr, int fq, u32x4& X0, u32x4& X1) {
    const bool odd = fr & 1; const int c8 = ((fr & 1) * 4 + fq) * 8;
    const u32x4 LA = *(const u32x4*)(base + (size_t)rowE * ld + c8), LB = *(const u32x4*)(base + (size_t)(rowE + 1) * ld + c8); xchg_in(LA, LB, odd, X0, X1);
}
__device__ __forceinline__ void store_f32_lines(float* base, int ld, int rowE, int fr, int fq, const f32x4& N0, const f32x4& N1) {
    const bool odd = fr & 1; u32x4 PA, PB; xchg_out(f2u(N0), f2u(N1), odd, PA, PB); const int c4 = (2 * fq + (fr & 1)) * 4;
    *(u32x4*)(base + (size_t)rowE * ld + c4) = PA; *(u32x4*)(base + (size_t)(rowE + 1) * ld + c4) = PB;
}
__device__ __forceinline__ void load_f32_lines(const float* base, int ld, int rowE, int fr, int fq, f32x4& N0, f32x4& N1) {
    const bool odd = fr & 1; const int c4 = (2 * fq + (fr & 1)) * 4;
    const u32x4 LA = *(const u32x4*)(base + (size_t)rowE * ld + c4), LB = *(const u32x4*)(base + (size_t)(rowE + 1) * ld + c4); u32x4 X0, X1; xchg_in(LA, LB, odd, X0, X1); N0 = u2f(X0); N1 = u2f(X1);
}
__device__ __forceinline__ size_t pair_off(int LD, int row, int colw, int fq) { return (size_t)(row >> 1) * (size_t)(2 * LD) + (size_t)((colw >> 6) * 128 + (row & 1) * 32 + 8 * fq); }

__device__ __forceinline__ f32x4 rstd_ld(const float* ss, int row, int fq) { return *(const f32x4*)(ss + (size_t)row * 16 + 4 * fq); }
__device__ __forceinline__ float rstd_fin(const f32x4& p) { float s = (p[0] + p[1]) + (p[2] + p[3]); s = sum_fq(s); return rsqrtf(s * (1.0f / 1024.0f) + 1e-6f); }

template <bool OPAIR> struct EpiZ {
    static constexpr bool PERM = true, AFTER_DRAIN = false, APERM = false;
    bf16_t* O; int ldc; const float* bias;
    __device__ __forceinline__ void operator()(const f32x4 (&acc)[2][2][4][2], const Unit& u, int wr, int wc, int fr, int fq) const {
        const int colw = u.pn * BM + 64 * wc;
        f32x4 bv[2][2];
#pragma unroll
        for (int bj = 0; bj < 2; ++bj)
#pragma unroll
            for (int n = 0; n < 2; ++n) bv[bj][n] = bias ? *(const f32x4*)(bias + colw + 32 * bj + 8 * fq + 4 * n) : (f32x4){0.f, 0.f, 0.f, 0.f};
#pragma unroll
        for (int ai = 0; ai < 2; ++ai) {
#pragma unroll
            for (int m = 0; m < 4; ++m) { const int rowE = u.pm * BM + ai * HALF + wr * 64 + m * 16 + (fr & ~1);
                const u32x4 X0 = pk8(acc[ai][0][m][0] + bv[0][0], acc[ai][0][m][1] + bv[0][1]), X1 = pk8(acc[ai][1][m][0] + bv[1][0], acc[ai][1][m][1] + bv[1][1]);
                if (OPAIR) { bf16_t* o = O + pair_off(ldc, rowE + (fr & 1), colw, fq); *(u32x4*)o = X0; *(u32x4*)(o + 64) = X1; }
                else store_bf16_lines(O + colw, ldc, rowE, fr, fq, X0, X1); } }
    }
};

template <bool SRCF32, bool AP> struct EpiRes {
    static constexpr bool PERM = true, AFTER_DRAIN = false, APERM = AP;
    const void* src; bf16_t* xb; float* sso;
    __device__ __forceinline__ void operator()(const f32x4 (&acc)[2][2][4][2], const Unit& u, int wr, int wc, int fr, int fq) const {
        const int colw = u.pn * BM + 64 * wc; const bool odd = fr & 1;
#pragma unroll
        for (int ah = 0; ah < (SRCF32 ? 4 : 2); ++ah) { const int ai = SRCF32 ? (ah >> 1) : ah, m0 = SRCF32 ? (ah & 1) * 2 : 0, m1 = SRCF32 ? m0 + 2 : 4;
            u32x4 LA[4][2], LB[4][2];
#pragma unroll
            for (int m = m0; m < m1; ++m) { const int rowE = u.pm * BM + ai * HALF + wr * 64 + m * 16 + (fr & ~1);
                if (SRCF32) { const int c4 = (2 * fq + (fr & 1)) * 4;
#pragma unroll
                    for (int bj = 0; bj < 2; ++bj) { const float* b = (const float*)src + colw + 32 * bj + c4; LA[m][bj] = *(const u32x4*)(b + (size_t)rowE * 1024); LB[m][bj] = *(const u32x4*)(b + (size_t)(rowE + 1) * 1024); } }
                else { const bf16_t* b = (const bf16_t*)src + pair_off(1024, rowE + (fr & 1), colw, fq); LA[m][0] = *(const u32x4*)b; LB[m][0] = *(const u32x4*)(b + 64); } }
#pragma unroll
            for (int m = m0; m < m1; ++m) { const int rowE = u.pm * BM + ai * HALF + wr * 64 + m * 16 + (fr & ~1), row = rowE + (fr & 1);
                f32x4 r[2][2];
                if (SRCF32) {
#pragma unroll
                    for (int bj = 0; bj < 2; ++bj) { u32x4 X0, X1; xchg_in(LA[m][bj], LB[m][bj], odd, X0, X1); r[bj][0] = u2f(X0); r[bj][1] = u2f(X1); } }
                else { unpack8(LA[m][0], r[0][0], r[0][1]); unpack8(LB[m][0], r[1][0], r[1][1]); }
                float sq = 0.f; f32x4 v[2][2];
#pragma unroll
                for (int bj = 0; bj < 2; ++bj)
#pragma unroll
                    for (int n = 0; n < 2; ++n) { v[bj][n] = r[bj][n] + acc[ai][bj][m][n]; sq += dot4(v[bj][n]); }
                { bf16_t* o = xb + pair_off(1024, row, colw, fq); *(u32x4*)o = pk8(v[0][0], v[0][1]); *(u32x4*)(o + 64) = pk8(v[1][0], v[1][1]); }
                sq = sum_fq(sq);
                sso[(size_t)row * 16 + 4 * u.pn + wc] = sq; } }
    }
};

template <bool FINAL> struct EpiPle {
    static constexpr bool PERM = true, AFTER_DRAIN = false, APERM = true;
    const float* ss; const bf16_t* pp; const bf16_t* xin; bf16_t* xb; float* sso; float* out;
    __device__ __forceinline__ void operator()(const f32x4 (&acc)[2][2][4][2], const Unit& u, int wr, int wc, int fr, int fq) const {
        const int colw = u.pn * BM + 64 * wc;
#pragma unroll
        for (int ah = 0; ah < 4; ++ah) { const int ai = ah >> 1, m0 = (ah & 1) * 2;
            u32x4 XA[4], XB[4], PA[4], PB[4]; f32x4 rp[4];
#pragma unroll
            for (int m = m0; m < m0 + 2; ++m) { const int rowE = u.pm * BM + ai * HALF + wr * 64 + m * 16 + (fr & ~1); const size_t o = pair_off(1024, rowE + (fr & 1), colw, fq);
                rp[m] = rstd_ld(ss, rowE + (fr & 1), fq);
                XA[m] = *(const u32x4*)(xin + o); XB[m] = *(const u32x4*)(xin + o + 64); PA[m] = *(const u32x4*)(pp + o); PB[m] = *(const u32x4*)(pp + o + 64); }
#pragma unroll
            for (int m = m0; m < m0 + 2; ++m) { const int rowE = u.pm * BM + ai * HALF + wr * 64 + m * 16 + (fr & ~1), row = rowE + (fr & 1); const float rs = rstd_fin(rp[m]);
                f32x4 r[2][2], p[2][2];
                unpack8(XA[m], r[0][0], r[0][1]); unpack8(XB[m], r[1][0], r[1][1]);
                unpack8(PA[m], p[0][0], p[0][1]); unpack8(PB[m], p[1][0], p[1][1]);
                float sq = 0.f; f32x4 v[2][2];
#pragma unroll
                for (int bj = 0; bj < 2; ++bj)
#pragma unroll
                    for (int n = 0; n < 2; ++n) { const f32x4 a = acc[ai][bj][m][n] * rs;
#pragma unroll
                        for (int e = 0; e < 4; ++e) v[bj][n][e] = r[bj][n][e] + fsigmoid(a[e]) * p[bj][n][e];
                        sq += dot4(v[bj][n]); }
                if (FINAL) { store_f32_lines(out + colw, 1024, rowE, fr, fq, v[0][0], v[0][1]); store_f32_lines(out + colw + 32, 1024, rowE, fr, fq, v[1][0], v[1][1]); }
                else { { bf16_t* o = xb + pair_off(1024, row, colw, fq); *(u32x4*)o = pk8(v[0][0], v[0][1]); *(u32x4*)(o + 64) = pk8(v[1][0], v[1][1]); }
                    sq = sum_fq(sq);
                    sso[(size_t)row * 16 + 4 * u.pn + wc] = sq; } } }
    }
};

struct EpiQkv {
    static constexpr bool PERM = true, AFTER_DRAIN = false, APERM = true;
    const float* ss; const float* rope; const float* qn; const float* kn; bf16_t* Q; bf16_t* K; bf16_t* V;
    __device__ __forceinline__ void operator()(const f32x4 (&acc)[2][2][4][2], const Unit& u, int wr, int wc, int fr, int fq) const {
        if (u.pn == 5) {
#pragma unroll
            for (int ai = 0; ai < 2; ++ai)
#pragma unroll
                for (int m = 0; m < 4; ++m) { const int rowE = u.pm * BM + ai * HALF + wr * 64 + m * 16 + (fr & ~1), row = rowE + (fr & 1); const float rs = rstd_fin(rstd_ld(ss, row, fq));
                    store_bf16_lines(V + 64 * wc, 256, rowE, fr, fq, pk8(acc[ai][0][m][0] * rs, acc[ai][0][m][1] * rs), pk8(acc[ai][1][m][0] * rs, acc[ai][1][m][1] * rs)); }
            return;
        }
        const bool isq = u.pn < 4; const float* gn = isq ? qn : kn; const float osc = isq ? 0.125f * 1.4426950408889634f : 1.0f;
        bf16_t* dst = isq ? Q + (size_t)(64 * (4 * u.pn + wc)) : K + (size_t)(64 * wc); const int ldd = isq ? 1024 : 256;
        f32x4 g[2][2];
#pragma unroll
        for (int bj = 0; bj < 2; ++bj)
#pragma unroll
            for (int n = 0; n < 2; ++n) g[bj][n] = *(const f32x4*)(gn + 32 * bj + 8 * fq + 4 * n);
#pragma unroll
        for (int ah = 0; ah < 4; ++ah) { const int ai = ah >> 1, m0 = (ah & 1) * 2;
          f32x4 rp[4], csn[4][4];
#pragma unroll
          for (int m = m0; m < m0 + 2; ++m) { const int row = u.pm * BM + ai * HALF + wr * 64 + m * 16 + fr; rp[m] = rstd_ld(ss, row, fq); const float* rq = rope + (size_t)row * 64 + 8 * fq;
              csn[m][0] = *(const f32x4*)rq; csn[m][1] = *(const f32x4*)(rq + 4); csn[m][2] = *(const f32x4*)(rq + 32); csn[m][3] = *(const f32x4*)(rq + 36); }
#pragma unroll
            for (int m = m0; m < m0 + 2; ++m) { const int rowE = u.pm * BM + ai * HALF + wr * 64 + m * 16 + (fr & ~1); const float rs = rstd_fin(rp[m]);
                f32x4 v[2][2]; float sq = 0.f;
#pragma unroll
                for (int bj = 0; bj < 2; ++bj)
#pragma unroll
                    for (int n = 0; n < 2; ++n) { v[bj][n] = acc[ai][bj][m][n] * rs; sq += dot4(v[bj][n]); }
                sq = sum_fq(sq);
                const float hr = rsqrtf(sq * (1.0f / 64.0f) + 1e-6f);
#pragma unroll
                for (int bj = 0; bj < 2; ++bj)
#pragma unroll
                    for (int n = 0; n < 2; ++n) v[bj][n] = v[bj][n] * hr * g[bj][n];
                f32x4 o[2][2];
#pragma unroll
                for (int n = 0; n < 2; ++n) { const f32x4 cs = csn[m][n], sn = csn[m][2 + n];
                    o[0][n] = (v[0][n] * cs - v[1][n] * sn) * osc; o[1][n] = (v[1][n] * cs + v[0][n] * sn) * osc; }
                store_bf16_lines(dst, ldd, rowE, fr, fq, pk8(o[0][0], o[0][1]), pk8(o[1][0], o[1][1])); } }
    }
};

struct EpiUp {
    static constexpr bool PERM = true, AFTER_DRAIN = false, APERM = true;
    const float* ss; const float* cw; const float* cb; bf16_t* A2; bf16_t* GH; bf16_t* UH; bf16_t* GT;
    template <int N> static __device__ __forceinline__ f32x4 ror4(const f32x4& v) { f32x4 r; r[0] = __uint_as_float(dpp_ror<N>(__float_as_uint(v[0]))); r[1] = __uint_as_float(dpp_ror<N>(__float_as_uint(v[1]))); r[2] = __uint_as_float(dpp_ror<N>(__float_as_uint(v[2]))); r[3] = __uint_as_float(dpp_ror<N>(__float_as_uint(v[3]))); return r; }
    __device__ __forceinline__ void operator()(const f32x4 (&acc)[2][2][4][2], const Unit& u, int wr, int wc, int fr, int fq) const {
        const int ch0 = u.pn * 128 + wc * 32 + 8 * fq;
        f32x4 w2[2], bb[2], w1o[2], w0o[2], w1m[2], w0m[2];
#pragma unroll
        for (int n = 0; n < 2; ++n) { const f32x4 w0 = *(const f32x4*)(cw + ch0 + 4 * n), w1 = *(const f32x4*)(cw + 3072 + ch0 + 4 * n); const f32x4 z4 = {0.f, 0.f, 0.f, 0.f};
            w2[n] = *(const f32x4*)(cw + 6144 + ch0 + 4 * n); bb[n] = *(const f32x4*)(cb + ch0 + 4 * n);
            w1o[n] = fr >= 1 ? w1 : z4; w1m[n] = fr >= 1 ? z4 : w1; w0o[n] = fr >= 2 ? w0 : z4; w0m[n] = fr >= 2 ? z4 : w0; }
#pragma unroll
        for (int ai = 0; ai < 2; ++ai) {
            const int grp = 4 * u.pm + 2 * ai + wr;
            f32x4 gp[2] = {{0.f, 0.f, 0.f, 0.f}, {0.f, 0.f, 0.f, 0.f}};
            f32x4 rpu[4];
#pragma unroll
            for (int m = 0; m < 4; ++m) rpu[m] = rstd_ld(ss, u.pm * BM + ai * HALF + wr * 64 + m * 16 + fr, fq);
#pragma unroll
            for (int m = 0; m < 4; ++m) { const int row = u.pm * BM + ai * HALF + wr * 64 + m * 16 + fr; const float rs = rstd_fin(rpu[m]);
                f32x4 g[2], uu[2], o[2];
#pragma unroll
                for (int n = 0; n < 2; ++n) { g[n] = acc[ai][0][m][n] * rs; uu[n] = acc[ai][1][m][n] * rs;
                    f32x4 y = bb[n] + w2[n] * g[n] + w1o[n] * ror4<1>(g[n]) + w0o[n] * ror4<2>(g[n]);
                    if (m > 0) y += w1m[n] * ror4<1>(gp[n]) + w0m[n] * ror4<2>(gp[n]);
#pragma unroll
                    for (int e = 0; e < 4; ++e) { const float yy = y[e]; const float t2 = yy * (2.3022082f + 0.10294324f * yy * yy);
                        o[n][e] = yy * __builtin_amdgcn_rcpf(1.0f + __builtin_amdgcn_exp2f(-t2)) * uu[n][e]; } }
                const bool head = (m == 0) && (fr < 2);
                if (!head) *(u32x4*)(A2 + (size_t)(row >> 1) * 6144 + ((ch0 >> 6) * 128 + ((ch0 >> 5) & 1) * 64 + (row & 1) * 32 + (ch0 & 31))) = pk8(o[0], o[1]);
                else { const size_t so = ((size_t)grp * 2 + fr) * 3072 + ch0; *(u32x4*)(GH + so) = pk8(g[0], g[1]); *(u32x4*)(UH + so) = pk8(uu[0], uu[1]); }
                if (m == 3 && fr >= 14) { const size_t so = ((size_t)grp * 2 + (fr - 14)) * 3072 + ch0; *(u32x4*)(GT + so) = pk8(g[0], g[1]); }
                gp[0] = g[0]; gp[1] = g[1]; }
        }
    }
};

struct EpiNone {
    static constexpr bool PERM = true, AFTER_DRAIN = false, APERM = false;
    __device__ __forceinline__ void operator()(const f32x4 (&acc)[2][2][4][2], const Unit& u, int wr, int wc, int fr, int fq) const {
#pragma unroll
        for (int ai = 0; ai < 2; ++ai)
#pragma unroll
            for (int m = 0; m < 4; ++m)
#pragma unroll
                for (int bj = 0; bj < 2; ++bj) { asm volatile("" :: "v"(acc[ai][bj][m][0]), "v"(acc[ai][bj][m][1])); }
    }
};

struct EpiZLine {
    static constexpr bool PERM = true, AFTER_DRAIN = false, APERM = false;
    bf16_t* O; int ldc;
    __device__ __forceinline__ void operator()(const f32x4 (&acc)[2][2][4][2], const Unit& u, int wr, int wc, int fr, int fq) const {
        const int col0 = u.pn * BM + 64 * wc + ((fr & 1) * 4 + fq) * 8;
#pragma unroll
        for (int ai = 0; ai < 2; ++ai)
#pragma unroll
            for (int m = 0; m < 4; ++m) {
#pragma unroll
                for (int bj = 0; bj < 2; ++bj) { const int row = u.pm * BM + ai * HALF + wr * 64 + m * 16 + (fr & ~1) + bj;
                    *(u32x4*)(O + (size_t)row * ldc + col0) = pk8(acc[ai][bj][m][0], acc[ai][bj][m][1]); } }
    }
};
template <class Epi, class Sched, bool ALIGN_EPI = false, bool SP2 = false>
__device__ __forceinline__ void gemm_phase(PG8_LAS unsigned char* lds, const Gemm g, const Sched& S, const Epi& E, int wave_id) {
    int tid_ = lane_now() + 64 * wave_id;
    const int tid = tid_, wid = __builtin_amdgcn_readfirstlane(tid >> 6), lane = tid & 63, wr = wid >> 2, wc = wid & 3, fr = lane & 15, fq = lane >> 4;
    const int K = g.K, nt = K / BK;
    unsigned voffA[2], voffB[2];
#pragma unroll
    for (int i = 0; i < 2; ++i) { int R, C; stage_rc(tid * 16 + i * 8192, R, C); const int Rb = Epi::PERM ? ((R & ~31) + perm32(R & 31)) : R;
        voffA[i] = Epi::APERM ? (unsigned)((R >> 1) * (4 * K) + ((C >> 5) & 1) * 128 + (R & 1) * 64 + (C & 31) * 2) : (unsigned)(R * K + C) * 2u;
        voffB[i] = (unsigned)((Rb >> 1) * (4 * K) + ((C >> 5) & 1) * 128 + (Rb & 1) * 64 + (C & 31) * 2); }
    const size_t kstepA = Epi::APERM ? (size_t)(BK * 4) : (size_t)(BK * 2), kstepB = (size_t)(BK * 4);
    const size_t hstep = (size_t)HALF * K * 2;
    const size_t tstep = 2 * hstep;
    const unsigned ldsw = (unsigned)wid * 1024u;
    const int aoff = lds_byte(wr * 64 + fr, fq * 8), boff = lds_byte(wc * 32 + fr, fq * 8);
#define PG8_SA(b, h) (((b) * 2 + (h)) * HTB)
#define PG8_SB(b, h) ((4 + (b) * 2 + (h)) * HTB)
#define PG8_STAGE(bufoff, gbase, voff) do { _Pragma("unroll") for (int _i = 0; _i < 2; ++_i) \
        __builtin_amdgcn_global_load_lds((const unsigned*)((const char*)(gbase) + (voff)[_i]), (PG8_LAS unsigned*)(lds + (bufoff) + ldsw + _i * 8192), 16, 0, 0); } while (0)
#define PG8_LDA(dst, b, h) do { _Pragma("unroll") for (int m = 0; m < 4; ++m) _Pragma("unroll") for (int k = 0; k < 2; ++k) dst[m][k] = *(const PG8_LAS bf16x8*)(lds + PG8_SA(b, h) + aoff + m * 2048 + k * 1024); } while (0)
#define PG8_LDB(dst, b, h) do { _Pragma("unroll") for (int n = 0; n < 2; ++n) _Pragma("unroll") for (int k = 0; k < 2; ++k) dst[n][k] = *(const PG8_LAS bf16x8*)(lds + PG8_SB(b, h) + boff + n * 2048 + k * 1024); } while (0)
#define PG8_MMA(ai, bj, At, Bt) do { __builtin_amdgcn_s_setprio(1); _Pragma("unroll") for (int m = 0; m < 4; ++m) _Pragma("unroll") for (int n = 0; n < 2; ++n) _Pragma("unroll") for (int k = 0; k < 2; ++k) \
        acc[ai][bj][m][n] = __builtin_amdgcn_mfma_f32_16x16x32_bf16(Bt[n][k], At[m][k], acc[ai][bj][m][n], 0, 0, 0); __builtin_amdgcn_s_setprio(0); } while (0)
#define PG8_WAIT_V(n) asm volatile("s_waitcnt vmcnt(" #n ")" ::: "memory")
#define PG8_WAIT_L(n) asm volatile("s_waitcnt lgkmcnt(" #n ")" ::: "memory")
#define PG8_BAR __builtin_amdgcn_s_barrier()
#define PG8_SCHED __builtin_amdgcn_sched_barrier(0)
    Unit cur, nxt; int ui = 0;
    if (!S.next(0, cur)) return;
    f32x4 acc[2][2][4][2];
#pragma unroll
    for (int a = 0; a < 2; ++a)
#pragma unroll
        for (int b = 0; b < 2; ++b)
#pragma unroll
            for (int m = 0; m < 4; ++m)
#pragma unroll
                for (int n = 0; n < 2; ++n) acc[a][b][m][n] = (f32x4){0.f, 0.f, 0.f, 0.f};
    bf16x8 At[4][2], B0[2][2], B1[2][2];
    const char* cA = (const char*)g.A + (size_t)cur.pm * tstep; const char* cB = (const char*)g.Bt + (size_t)cur.pn * tstep;
    S.a_ready(cur);
    if constexpr (SP2) {
        PG8_STAGE(PG8_SB(0, 0), cB, voffB); PG8_STAGE(PG8_SB(0, 1), cB + hstep, voffB); PG8_STAGE(PG8_SA(0, 0), cA, voffA); PG8_STAGE(PG8_SA(0, 1), cA + hstep, voffA);
        if (wr == 1) PG8_BAR;
        PG8_WAIT_V(2); PG8_BAR;
        PG8_STAGE(PG8_SB(1, 0), cB + kstepB, voffB); PG8_STAGE(PG8_SA(1, 0), cA + kstepA, voffA); PG8_STAGE(PG8_SB(1, 1), cB + hstep + kstepB, voffB);
        PG8_WAIT_V(6); PG8_BAR;
    } else {
        PG8_STAGE(PG8_SB(0, 0), cB, voffB); PG8_STAGE(PG8_SA(0, 0), cA, voffA); PG8_STAGE(PG8_SB(0, 1), cB + hstep, voffB); PG8_STAGE(PG8_SA(0, 1), cA + hstep, voffA);
        if (wr == 1) PG8_BAR;
        PG8_WAIT_V(4); PG8_BAR;
        PG8_STAGE(PG8_SB(1, 0), cB + kstepB, voffB); PG8_STAGE(PG8_SA(1, 0), cA + kstepA, voffA); PG8_STAGE(PG8_SB(1, 1), cB + hstep + kstepB, voffB);
        PG8_WAIT_V(6); PG8_BAR;
    }
    for (;;) {
        const bool has_next = S.next(ui + 1, nxt);
        const char* nA = has_next ? (const char*)g.A + (size_t)nxt.pm * tstep : cA; const char* nB = has_next ? (const char*)g.Bt + (size_t)nxt.pn * tstep : cB;
        for (int t = 0; t < nt; t += 2) {
            const bool last = (t == nt - 2);
            const char* a1 = cA + (size_t)(t + 1) * kstepA;
            const char* a2 = last ? nA : cA + (size_t)(t + 2) * kstepA; const char* b2 = last ? nB : cB + (size_t)(t + 2) * kstepB;
            const char* a3 = a2 + kstepA; const char* b3 = b2 + kstepB;
            if (last && has_next) S.a_ready(nxt);
            if constexpr (SP2) {
            PG8_LDB(B0, 0, 0); PG8_LDB(B1, 0, 1); PG8_SCHED; PG8_LDA(At, 0, 0); PG8_STAGE(PG8_SA(1, 1), a1 + hstep, voffA);
            PG8_WAIT_V(8); PG8_WAIT_L(0); PG8_BAR; PG8_MMA(0, 0, At, B0); PG8_MMA(0, 1, At, B1); PG8_BAR; PG8_SCHED;
            PG8_LDA(At, 0, 1); PG8_STAGE(PG8_SB(0, 0), b2, voffB); PG8_STAGE(PG8_SB(0, 1), b2 + hstep, voffB); PG8_STAGE(PG8_SA(0, 0), a2, voffA);
            PG8_WAIT_V(8); PG8_WAIT_L(0); PG8_BAR; PG8_MMA(1, 0, At, B0); PG8_MMA(1, 1, At, B1); PG8_BAR; PG8_SCHED;
            PG8_LDB(B0, 1, 0); PG8_LDB(B1, 1, 1); PG8_SCHED; PG8_LDA(At, 1, 0); PG8_STAGE(PG8_SA(0, 1), a2 + hstep, voffA);
            PG8_WAIT_V(8); PG8_WAIT_L(0); PG8_BAR; PG8_MMA(0, 0, At, B0); PG8_MMA(0, 1, At, B1); PG8_BAR; PG8_SCHED;
            PG8_LDA(At, 1, 1); PG8_STAGE(PG8_SB(1, 0), b3, voffB); PG8_STAGE(PG8_SB(1, 1), b3 + hstep, voffB); PG8_STAGE(PG8_SA(1, 0), a3, voffA);
            PG8_WAIT_V(8); PG8_WAIT_L(0); PG8_BAR; PG8_MMA(1, 0, At, B0); PG8_MMA(1, 1, At, B1); PG8_BAR; PG8_SCHED;
            } else {
            PG8_LDB(B0, 0, 0); PG8_SCHED; PG8_LDA(At, 0, 0); PG8_STAGE(PG8_SA(1, 1), a1 + hstep, voffA);
            PG8_WAIT_L(8); PG8_BAR; PG8_WAIT_L(0); PG8_MMA(0, 0, At, B0); PG8_BAR; PG8_SCHED;
            PG8_LDB(B1, 0, 1); PG8_STAGE(PG8_SB(0, 0), b2, voffB);
            PG8_BAR; PG8_WAIT_L(0); PG8_MMA(0, 1, At, B1); PG8_BAR;
            PG8_LDA(At, 0, 1); PG8_STAGE(PG8_SA(0, 0), a2, voffA);
            PG8_BAR; PG8_WAIT_L(0); PG8_MMA(1, 0, At, B0); PG8_BAR; PG8_SCHED;
            PG8_STAGE(PG8_SB(0, 1), b2 + hstep, voffB);
            PG8_WAIT_V(6); PG8_BAR; PG8_MMA(1, 1, At, B1); PG8_BAR;
            PG8_LDB(B0, 1, 0); PG8_SCHED; PG8_LDA(At, 1, 0); PG8_STAGE(PG8_SA(0, 1), a2 + hstep, voffA);
            PG8_WAIT_L(8); PG8_BAR; PG8_WAIT_L(0); PG8_MMA(0, 0, At, B0); PG8_BAR; PG8_SCHED;
            PG8_LDB(B1, 1, 1); PG8_STAGE(PG8_SB(1, 0), b3, voffB);
            PG8_BAR; PG8_WAIT_L(0); PG8_MMA(0, 1, At, B1); PG8_BAR;
            PG8_LDA(At, 1, 1); PG8_STAGE(PG8_SA(1, 0), a3, voffA);
            PG8_BAR; PG8_WAIT_L(0); PG8_MMA(1, 0, At, B0); PG8_BAR; PG8_SCHED;
            PG8_STAGE(PG8_SB(1, 1), b3 + hstep, voffB);
            PG8_WAIT_V(6); PG8_BAR; PG8_MMA(1, 1, At, B1); PG8_BAR;
            }
        }
        if constexpr (ALIGN_EPI) { if (wr == 0) PG8_BAR; }
        if constexpr (!Epi::AFTER_DRAIN) { E(acc, cur, wr, wc, fr, fq); S.done(cur); }
        if (!has_next) break;
#pragma unroll
        for (int a = 0; a < 2; ++a)
#pragma unroll
            for (int b = 0; b < 2; ++b)
#pragma unroll
                for (int m = 0; m < 4; ++m)
#pragma unroll
                    for (int n = 0; n < 2; ++n) acc[a][b][m][n] = (f32x4){0.f, 0.f, 0.f, 0.f};
        cur = nxt; cA = nA; cB = nB; ++ui;
        if constexpr (ALIGN_EPI) { if (wr == 1) PG8_BAR; }
    }
    PG8_WAIT_V(0);
    if constexpr (!ALIGN_EPI) { if (wr == 0) PG8_BAR; }
    PG8_BAR;
    if constexpr (Epi::AFTER_DRAIN) { E.fused(acc, cur, wr, wc, fr, fq, lds, wid, lane); S.done(cur); }
#undef PG8_SA
#undef PG8_SB
#undef PG8_STAGE
#undef PG8_LDA
#undef PG8_LDB
#undef PG8_MMA
#undef PG8_WAIT_V
#undef PG8_WAIT_L
#undef PG8_BAR
#undef PG8_SCHED
}
}

constexpr int NWAVES = 8;
constexpr int NB = 8, SEQ = 4096, T = NB * SEQ, DM = 1024, ZW = 3072, FFD = 3072, HYIN = 3080;
#ifndef PROBE_PHASE
#define PROBE_PHASE 0
#define PROBE_N 0
#endif
#define PREP(id) for (int rep_ = 0; rep_ < 1 + ((PROBE_PHASE == (id)) ? PROBE_N : 0); ++rep_)
#ifdef PROBE_TA
#define TSTAMP() do { if (blockIdx.x == 0 && threadIdx.x == 0) { F.MISC[16 + ts_n] = (unsigned)__builtin_amdgcn_s_memrealtime(); } ++ts_n; } while (0)
#else
#define TSTAMP() do { } while (0)
#endif
#ifndef DBG_STOP
#define DBG_STOP 99
#endif

constexpr size_t MiB = 1u << 20;
constexpr size_t WS_CTL = 0, CTL_ZERO_BYTES = 1 * MiB;
constexpr size_t WS_WIN = 2 * MiB, WS_WOUT0 = 8 * MiB, WS_WUP0 = 10 * MiB, WS_WDN0 = 22 * MiB, WS_WGT0 = 28 * MiB, WS_WPJ0 = 30 * MiB,
                 WS_WQKV = 31 * MiB, WS_WO1 = 34 * MiB, WS_WUP1 = 36 * MiB, WS_WDN1 = 48 * MiB, WS_WGT1 = 54 * MiB, WS_WPJ1 = 56 * MiB, WS_RGW = 57 * MiB;
constexpr size_t WS_GATES = 58 * MiB, WS_SSA = 59 * MiB, WS_SSB = 61 * MiB, WS_ROPE = 63 * MiB, WS_NLOC = 71 * MiB, WS_NPREV = 72 * MiB, WS_MSC = 73 * MiB,
                 WS_RGA = 74 * MiB, WS_RGH = 75 * MiB, WS_RGC = 76 * MiB;
constexpr size_t WS_PB = 78 * MiB, WS_XBA = 110 * MiB, WS_XBB = 174 * MiB, WS_CST = 238 * MiB, WS_BIG = 302 * MiB, WS_END = 494 * MiB;
constexpr int CW_BAR = 4096;

constexpr int RING_BYTES = 131072;
constexpr int LDSCTL_OFF = 163328, MISC_OFF = LDSCTL_OFF + 320;
constexpr int LDS_BYTES = 163840;

#define GAS __attribute__((address_space(1)))
#define LAS __attribute__((address_space(3)))
typedef unsigned short bf16;
typedef unsigned v4u __attribute__((ext_vector_type(4)));
typedef unsigned v2u __attribute__((ext_vector_type(2)));
typedef float f32x4 __attribute__((ext_vector_type(4)));
typedef float f32x16 __attribute__((ext_vector_type(16)));
typedef short bf16x8 __attribute__((ext_vector_type(8)));
typedef short s16x4 __attribute__((ext_vector_type(4)));
typedef GAS unsigned gu32;
typedef LAS unsigned char* ldsp;
#define LDS_WAIT() asm volatile("s_waitcnt lgkmcnt(0)" ::: "memory")
using pg8::pk2; using pg8::bflo; using pg8::bfhi; using pg8::fsigmoid; using pg8::gelu_tanh;
__device__ __forceinline__ unsigned short f2bf1(float x) { return (unsigned short)(pk2(x, 0.f) & 0xffffu); }
__device__ __forceinline__ float bf2f(unsigned short b) { return __uint_as_float(((unsigned)b) << 16); }
__device__ __forceinline__ float fsilu(float x) { return x * __builtin_amdgcn_rcpf(1.0f + __expf(-x)); }
#define MFMA16(a, b, c) __builtin_amdgcn_mfma_f32_16x16x32_bf16((a), (b), (c), 0, 0, 0)
#define MFMA32(a, b, c) __builtin_amdgcn_mfma_f32_32x32x16_bf16((a), (b), (c), 0, 0, 0)

#define PHASE_FENCE(F) do { asm volatile("" ::: "memory"); const int l_ = pg8::lane_now(); (F).lane = l_; (F).tid = l_ + 64 * (F).wave; } while (0)
#define XB_TMO      128
#define XB_XCNT(j)  (256  + 64 * (j))
#define XB_XSUB(j)  (1280 + 64 * (j))
#define XB_XGEN(j)  (2304 + 64 * (j))
#define XB_TOP      3328
#define XB_TOPGEN   3392
#define XCD_BAR_WORDS 3456
#define XB_SPIN_CAP (1u << 18)

__device__ __forceinline__ unsigned xb_ld(unsigned* p)              { return __hip_atomic_load(p, __ATOMIC_RELAXED, __HIP_MEMORY_SCOPE_AGENT); }
__device__ __forceinline__ unsigned xb_add(unsigned* p, unsigned v) { return __hip_atomic_fetch_add(p, v, __ATOMIC_RELAXED, __HIP_MEMORY_SCOPE_AGENT); }
__device__ __forceinline__ unsigned xb_xcc_id() { return (unsigned)__builtin_amdgcn_s_getreg((3 << 11) | 20) & 0xFu; }
#define XB_SPIN(cond, bar) do { unsigned _sp = 0; while (cond) { __builtin_amdgcn_s_sleep(1); \
    if ((++_sp & 255u) == 0u) { if (xb_ld(&(bar)[XB_TMO])) break; if (_sp > XB_SPIN_CAP) { atomicAdd(&(bar)[XB_TMO], 1u); break; } } } } while (0)

struct XcdBarrier {
    unsigned* bar; unsigned x; int w;
    volatile LAS unsigned* st;
};

__device__ __forceinline__ XcdBarrier xcd_barrier_post(unsigned* bar, volatile LAS unsigned* st, int wave) {
    XcdBarrier b; b.bar = bar; b.x = xb_xcc_id(); b.st = st; b.w = wave;
    if (threadIdx.x == 0) (void)xb_add(&bar[XB_XCNT(b.x)], 1u);
    return b;
}
__device__ __forceinline__ void xcd_barrier_complete(unsigned* bar, unsigned x, unsigned& nloc, unsigned& nx) {
    const unsigned G = gridDim.x * gridDim.y * gridDim.z;
    unsigned sum, cnt, mine, sp = 0u;
    for (;;) {
        sum = 0u; cnt = 0u; mine = 0u;
#pragma unroll
        for (unsigned j = 0; j < 16; ++j) { const unsigned c = xb_ld(&bar[XB_XCNT(j)]); sum += c; cnt += (c > 0u) ? 1u : 0u; mine = (j == x) ? c : mine; }
        if (sum == G) break;
        __builtin_amdgcn_s_sleep(1);
        if ((++sp & 255u) == 0u) { if (xb_ld(&bar[XB_TMO])) break; if (sp > XB_SPIN_CAP) { atomicAdd(&bar[XB_TMO], 1u); break; } }
    }
    nloc = mine > 0u ? mine : 1u; nx = cnt > 0u ? cnt : 1u;
}

__device__ __forceinline__ void xcd_barrier(const XcdBarrier& b) {
    asm volatile("s_waitcnt vmcnt(0)" ::: "memory");
    __syncthreads();
    if (b.w == 0 && pg8::lane_now() == 0) {
        unsigned* bar = b.bar;
        __builtin_amdgcn_s_waitcnt(0);
        unsigned nloc = b.st[0], nx = b.st[1];
        if (nloc == 0u) { xcd_barrier_complete(bar, b.x, nloc, nx); b.st[0] = nloc; b.st[1] = nx; }
        const unsigned old = xb_add(&bar[XB_XSUB(b.x)], 1u);
        const unsigned gen = old / nloc;
        if (old + 1u == (gen + 1u) * nloc) {
            __builtin_amdgcn_fence(__ATOMIC_RELEASE, "agent");
            asm volatile("s_waitcnt vmcnt(0)" ::: "memory");
            const unsigned og = xb_add(&bar[XB_TOP], 1u);
            const unsigned tg = og / nx;
            if (og + 1u == (tg + 1u) * nx) xb_add(&bar[XB_TOPGEN], 1u);
            else XB_SPIN(xb_ld(&bar[XB_TOPGEN]) == tg, bar);
            __builtin_amdgcn_fence(__ATOMIC_ACQUIRE, "agent");
            xb_add(&bar[XB_XGEN(b.x)], 1u);
            asm volatile("s_waitcnt vmcnt(0)" ::: "memory");
        } else {
            XB_SPIN(xb_ld(&bar[XB_XGEN(b.x)]) == gen, bar);
            __builtin_amdgcn_fence(__ATOMIC_ACQUIRE, "agent");
            asm volatile("s_waitcnt vmcnt(0)" ::: "memory");
        }
    }
    __syncthreads();
}

struct Frame {
    ldsp lds; volatile LAS unsigned* MISC;
    int tid, lane, wave, vcu, G;
    unsigned char* ws; unsigned long long kb; float* out;
};
__device__ __forceinline__ const float* karg(const Frame& F, int i) { unsigned long long a = F.kb; asm volatile("" : "+s"(a) :: "memory"); return (const float*)(((const __attribute__((address_space(4))) unsigned long long*)a)[i]); }
#define P_Z     ((bf16*)(F.ws + WS_BIG))
#define P_YBUF  ((bf16*)(F.ws + WS_XBA))
#define P_CST   ((bf16*)(F.ws + WS_CST))
#define P_RGW   ((bf16*)(F.ws + WS_RGW))
#define P_GATES ((float*)(F.ws + WS_GATES))
#define P_NLOC  ((float*)(F.ws + WS_NLOC))
#define P_NPREV ((float*)(F.ws + WS_NPREV))
#define P_MLOC  ((float*)(F.ws + WS_MSC))
#define P_BLAST ((float*)(F.ws + WS_MSC) + 2048)
#define P_MPREV ((float*)(F.ws + WS_MSC) + 4096)
#define P_RGA   ((float*)(F.ws + WS_RGA))
#define P_RGH   ((float*)(F.ws + WS_RGH))
#define P_RGC   ((float*)(F.ws + WS_RGC))
#define P_ROPE  ((float*)(F.ws + WS_ROPE))

__device__ __forceinline__ int tr_dst_row(int mode, int src) {
    if (mode == 1) { const int s2 = src < 3072 ? src : src - 3072; return 256 * (s2 >> 7) + (src < 3072 ? 0 : 128) + (s2 & 127); }
    if (mode == 2) return (src & ~255) + 128 * ((src >> 5) & 1) + 32 * ((src >> 6) & 3);
    return src;
}
template <bool PAIRED> __device__ __forceinline__ void tr_item(const float* W, int ldw, int srcc, int mode, const float* scale, bf16* WT, int K, int k0, LAS float* scr, int lane) {
#pragma unroll
    for (int i = 0; i < 16; ++i) { const int kk = 4 * i + (lane >> 4), n4 = (lane & 15) * 4; const float s = scale ? scale[k0 + kk] : 1.0f;
        const f32x4 v = *(const f32x4*)(W + (size_t)(k0 + kk) * ldw + srcc + n4);
        scr[kk * 65 + n4] = v[0] * s; scr[kk * 65 + n4 + 1] = v[1] * s; scr[kk * 65 + n4 + 2] = v[2] * s; scr[kk * 65 + n4 + 3] = v[3] * s; }
    LDS_WAIT(); asm volatile("" ::: "memory");
    const int c = lane & 7, d0 = tr_dst_row(mode, srcc), d1 = tr_dst_row(mode, srcc + 32);
#pragma unroll
    for (int j = 0; j < 8; ++j) { const int n = (lane >> 3) + 8 * j; const LAS float* s = scr + (8 * c) * 65 + n;
        v4u o; o.x = pk2(s[0 * 65], s[1 * 65]); o.y = pk2(s[2 * 65], s[3 * 65]); o.z = pk2(s[4 * 65], s[5 * 65]); o.w = pk2(s[6 * 65], s[7 * 65]);
        const int drow = (n < 32 ? d0 : d1) + (n & 31);
        if (PAIRED) *(GAS v4u*)(WT + (size_t)(drow >> 1) * (2 * K) + 2 * k0 + (c >> 2) * 64 + (drow & 1) * 32 + (c & 3) * 8) = o;
        else *(GAS v4u*)(WT + (size_t)drow * K + k0 + 8 * c) = o; }
    LDS_WAIT(); asm volatile("" ::: "memory");
}
__device__ __forceinline__ bool tr_matrix(int& r, const float* W, int ldw, int K, int Nd, int mode, const float* scale, bf16* WT, LAS float* scr, int lane) {
    const int nblk = Nd / 64, items = (K / 64) * nblk;
    if (r >= items) { r -= items; return false; }
    const int kb = r / nblk, sb = r % nblk;
    tr_item<true>(W, ldw, 64 * sb, mode, scale, WT, K, 64 * kb, scr, lane);
    return true;
}
__device__ __forceinline__ float wave_sum(float v) {
#pragma unroll
    for (int o = 1; o < 64; o <<= 1) v += __shfl_xor(v, o);
    return v;
}
#ifdef PROBE_P0SPLIT
#define P0_SPLIT() do { xcd_barrier(bar); TSTAMP(); } while (0)
#else
#define P0_SPLIT() do { } while (0)
#endif
__device__ __forceinline__ void p0_prologue(Frame& F, const XcdBarrier& bar, int& ts_n) {
    PHASE_FENCE(F); const float* x = karg(F, 0); const float* p = karg(F, 1); const int* pos = (const int*)karg(F, 2); const float* norm_mix = karg(F, 3); const float* norm_ffn = karg(F, 4); const float* norm_ple = karg(F, 5); const float* hy_w_in = karg(F, 6); const float* hy_b_in = karg(F, 7); const float* rg_wa = karg(F, 10); const float* rg_wx = karg(F, 12); const float* hy_w_out = karg(F, 18); const float* at_w_qkv = karg(F, 19); const float* at_w_out = karg(F, 23); const float* ff_w_up = karg(F, 24); const float* ff_w_down = karg(F, 27); const float* ple_w_gate = karg(F, 28); const float* ple_w_proj = karg(F, 29);
    LAS float* scr = (LAS float*)(F.lds + F.wave * 16640);
    const int gw = F.vcu * NWAVES + F.wave, NGW = F.G * NWAVES;
    unsigned char* ws = F.ws;
    LAS float* GW = (LAS float*)(F.lds);
    for (int i = F.tid; i < 8192; i += NWAVES * 64) { const int k = i >> 3, g = i & 7; GW[i] = hy_w_in[(size_t)k * HYIN + 3072 + g] * norm_mix[k]; }
    __syncthreads();
    P0_SPLIT();
    bf16* xb = (bf16*)(ws + WS_XBA);
    const float bgate = (F.lane < 64) ? hy_b_in[3072 + (F.lane >> 3)] : 0.f;
    for (int row0 = 2 * gw; row0 < T; row0 += 2 * NGW) {
        f32x4 v[2][4];
#pragma unroll
        for (int rr = 0; rr < 2; ++rr) { const GAS f32x4* xr = (const GAS f32x4*)(x + (size_t)(row0 + rr) * DM) + F.lane;
#pragma unroll
            for (int j = 0; j < 4; ++j) v[rr][j] = xr[64 * j]; }
#pragma unroll
        for (int rr = 0; rr < 2; ++rr) { const int row = row0 + rr; float s = 0.f; float d[8];
#pragma unroll
            for (int g = 0; g < 8; ++g) d[g] = 0.f;
#pragma unroll
            for (int j = 0; j < 4; ++j) { s += (v[rr][j].x * v[rr][j].x + v[rr][j].y * v[rr][j].y) + (v[rr][j].z * v[rr][j].z + v[rr][j].w * v[rr][j].w);
#pragma unroll
                for (int e = 0; e < 4; ++e) { const int k = 4 * (F.lane + 64 * j) + e; const f32x4 w0 = *(const LAS f32x4*)(GW + k * 8), w1 = *(const LAS f32x4*)(GW + k * 8 + 4);
                    const float xv = v[rr][j][e];
                    d[0] += xv * w0[0]; d[1] += xv * w0[1]; d[2] += xv * w0[2]; d[3] += xv * w0[3]; d[4] += xv * w1[0]; d[5] += xv * w1[1]; d[6] += xv * w1[2]; d[7] += xv * w1[3]; } }
            s = wave_sum(s);
            const bool b5 = F.lane & 32, b4 = F.lane & 16, b3 = F.lane & 8; float r4[4], r2[2];
#pragma unroll
            for (int i = 0; i < 4; ++i) { const float recv = __shfl_xor(b5 ? d[i] : d[i + 4], 32); r4[i] = (b5 ? d[i + 4] : d[i]) + recv; }
#pragma unroll
            for (int i = 0; i < 2; ++i) { const float recv = __shfl_xor(b4 ? r4[i] : r4[i + 2], 16); r2[i] = (b4 ? r4[i + 2] : r4[i]) + recv; }
            float dg; { const float recv = __shfl_xor(b3 ? r2[0] : r2[1], 8); dg = (b3 ? r2[1] : r2[0]) + recv; }
            dg += __shfl_xor(dg, 1); dg += __shfl_xor(dg, 2); dg += __shfl_xor(dg, 4);
            const float rstd = rsqrtf(s * (1.0f / DM) + 1e-6f);
            if ((F.lane & 7) == 0) P_GATES[(size_t)row * 8 + (F.lane >> 3)] = rstd * dg + bgate;
            GAS unsigned long long* o8 = (GAS unsigned long long*)(xb + (size_t)row * DM) + F.lane;
#pragma unroll
            for (int j = 0; j < 4; ++j) o8[64 * j] = (unsigned long long)pk2(v[rr][j].x * rstd, v[rr][j].y * rstd) | ((unsigned long long)pk2(v[rr][j].z * rstd, v[rr][j].w * rstd) << 32);
#if DBG_STOP < 3
            { GAS f32x4* oo = (GAS f32x4*)(F.out + (size_t)row * DM) + F.lane;
#pragma unroll
              for (int j = 0; j < 4; ++j) oo[64 * j] = v[rr][j]; }
#endif
        }
    }
    P0_SPLIT();
    { const GAS f32x4* ps = (const GAS f32x4*)p; GAS v4u* pd = (GAS v4u*)(ws + WS_PB); const int n8 = 2 * T * 256 / 8;
      for (int i0 = gw * 64 + F.lane; i0 < n8; i0 += 4 * NGW * 64) { f32x4 a[4], b[4];
#pragma unroll
          for (int k = 0; k < 4; ++k) { const int i = i0 + k * NGW * 64; if (i < n8) { a[k] = ps[2 * i]; b[k] = ps[2 * i + 1]; } }
#pragma unroll
          for (int k = 0; k < 4; ++k) { const int i = i0 + k * NGW * 64; if (i < n8) { v4u o; o.x = pk2(a[k].x, a[k].y); o.y = pk2(a[k].z, a[k].w); o.z = pk2(b[k].x, b[k].y); o.w = pk2(b[k].z, b[k].w); pd[i] = o; } } } }
    for (int i = (F.vcu * NWAVES * 64) + F.tid; i < T * 32; i += F.G * NWAVES * 64) { const int t = i >> 5, f = i & 31;
        const float inv = exp2f(-(float)f * (13.287712379549449f / 32.0f));
        const float ang = (float)pos[t] * inv;
        P_ROPE[(size_t)t * 64 + f] = cosf(ang); P_ROPE[(size_t)t * 64 + 32 + f] = sinf(ang); }
    P0_SPLIT();
    __syncthreads();
    constexpr int NITEMS = 768 + 256 + 2 * 1536 + 2 * 768 + 2 * 256 + 2 * 64 + 384 + 256 + 16;
    for (int it = gw; it < NITEMS; it += NGW) {
        int r = it; const float* W = nullptr; const float* scale = nullptr; bf16* WT = nullptr; int ldw = 0, K = 0, Nd = 0, mode = 0; bool found = false;
#define TRM(W_, ldw_, K_, Nd_, mode_, scale_, WT_) if (!found) { const int items_ = ((K_) / 64) * ((Nd_) / 64); if (r < items_) { W = (W_); ldw = (ldw_); K = (K_); Nd = (Nd_); mode = (mode_); scale = (scale_); WT = (bf16*)(ws + (WT_)); found = true; } else r -= items_; }
        TRM(hy_w_in, HYIN, 1024, 3072, 2, norm_mix, WS_WIN)
        TRM(hy_w_out, 1024, 1024, 1024, 2, nullptr, WS_WOUT0)
        TRM(ff_w_up, 6144, 1024, 6144, 1, norm_ffn, WS_WUP0)
        TRM(ff_w_up + (size_t)1024 * 6144, 6144, 1024, 6144, 1, norm_ffn + 1024, WS_WUP1)
        TRM(ff_w_down, 1024, 3072, 1024, 2, nullptr, WS_WDN0)
        TRM(ff_w_down + (size_t)3072 * 1024, 1024, 3072, 1024, 2, nullptr, WS_WDN1)
        TRM(ple_w_gate, 1024, 1024, 1024, 2, norm_ple, WS_WGT0)
        TRM(ple_w_gate + (size_t)1024 * 1024, 1024, 1024, 1024, 2, norm_ple + 1024, WS_WGT1)
        TRM(ple_w_proj, 1024, 256, 1024, 2, nullptr, WS_WPJ0)
        TRM(ple_w_proj + (size_t)256 * 1024, 1024, 256, 1024, 2, nullptr, WS_WPJ1)
        TRM(at_w_qkv, 1536, 1024, 1536, 2, norm_mix + 1024, WS_WQKV)
        TRM(at_w_out, 1024, 1024, 1024, 2, nullptr, WS_WO1)
#undef TRM
        if (found) { const int nblk = Nd / 64, kb = r / nblk, sb = r - kb * nblk; tr_item<true>(W, ldw, 64 * sb, mode, scale, WT, K, 64 * kb, scr, F.lane); }
        else { const int g = r >> 3, n = r & 7;
          tr_item<false>((g ? rg_wx : rg_wa) + (size_t)n * 4096, 64, 0, 0, nullptr, P_RGW + (size_t)r * 4096, 64, 0, scr, F.lane); }
    }
}

__device__ __forceinline__ void ld8f(const bf16* p, float (&o)[8]) { const v4u v = *(const v4u*)p; o[0] = bflo(v.x); o[1] = bfhi(v.x); o[2] = bflo(v.y); o[3] = bfhi(v.y); o[4] = bflo(v.z); o[5] = bfhi(v.z); o[6] = bflo(v.w); o[7] = bfhi(v.w); }
__device__ __forceinline__ void conv4x8(const bf16* zp, int s, const float* cw, int ldw, const float* cb, float (&out)[8]) {
    { const f32x4 b0 = *(const f32x4*)cb, b1 = *(const f32x4*)(cb + 4); out[0] = b0[0]; out[1] = b0[1]; out[2] = b0[2]; out[3] = b0[3]; out[4] = b1[0]; out[5] = b1[1]; out[6] = b1[2]; out[7] = b1[3]; }
#pragma unroll
    for (int j = 0; j < 4; ++j) if (s - 3 + j >= 0) { float xv[8]; ld8f(zp + (ptrdiff_t)(j - 3) * ZW, xv);
        const f32x4 w0 = *(const f32x4*)(cw + j * ldw), w1 = *(const f32x4*)(cw + j * ldw + 4);
        out[0] += w0[0] * xv[0]; out[1] += w0[1] * xv[1]; out[2] += w0[2] * xv[2]; out[3] += w0[3] * xv[3]; out[4] += w1[0] * xv[4]; out[5] += w1[1] * xv[5]; out[6] += w1[2] * xv[6]; out[7] += w1[3] * xv[7]; }
}
__device__ __forceinline__ v4u pk8f(const float (&a)[8]) { v4u o; o.x = pk2(a[0], a[1]); o.y = pk2(a[2], a[3]); o.z = pk2(a[4], a[5]); o.w = pk2(a[6], a[7]); return o; }
__device__ __forceinline__ float logsig(float f) { return fminf(f, 0.f) - __logf(1.0f + __expf(-fabsf(f))); }

template <int CTRL, int ROWMASK> __device__ __forceinline__ float dpp_f(float idv, float v) { return __int_as_float(__builtin_amdgcn_update_dpp(__float_as_int(idv), __float_as_int(v), CTRL, ROWMASK, 0xF, false)); }
__device__ __forceinline__ float scan_add(float v) {
    v += dpp_f<0x111, 0xF>(0.f, v); v += dpp_f<0x112, 0xF>(0.f, v); v += dpp_f<0x114, 0xF>(0.f, v); v += dpp_f<0x118, 0xF>(0.f, v);
    v += dpp_f<0x142, 0xA>(0.f, v); v += dpp_f<0x143, 0xC>(0.f, v); return v; }
__device__ __forceinline__ float scan_max(float v) {
    v = fmaxf(v, dpp_f<0x111, 0xF>(-INFINITY, v)); v = fmaxf(v, dpp_f<0x112, 0xF>(-INFINITY, v)); v = fmaxf(v, dpp_f<0x114, 0xF>(-INFINITY, v)); v = fmaxf(v, dpp_f<0x118, 0xF>(-INFINITY, v));
    v = fmaxf(v, dpp_f<0x142, 0xA>(-INFINITY, v)); v = fmaxf(v, dpp_f<0x143, 0xC>(-INFINITY, v)); return v; }
__device__ __forceinline__ float lane63(float v) { return __int_as_float(__builtin_amdgcn_readlane(__float_as_int(v), 63)); }
struct MlPre { v4u q[3], k[3], v[2]; float ip, fp, np, mp; };
template <bool PC> __device__ __forceinline__ void ml_prefetch(Frame& F, int u, MlPre& R) {
    const int c = u & 63, bh = u >> 6, h = bh & 3, b = bh >> 2, tok0 = b * SEQ + c * 64;
    const bf16* z = P_Z;
    int tid = F.tid; asm volatile("" : "+v"(tid));
#pragma unroll
    for (int s = 0; s < 3; ++s) { const int i = tid + 512 * s, row = s < 2 ? 3 + (i & 63) : (tid >> 4), ch = s < 2 ? (i >> 6) : (tid & 15); const bool ok = s < 2 || (tid < 48 && c > 0);
        const bf16* zp = z + (size_t)(tok0 - 3 + row) * ZW + 128 * h + 8 * ch;
        R.k[s] = ok ? *(const v4u*)(zp + 1536) : (v4u){0u, 0u, 0u, 0u};
        if (PC) R.q[s] = ok ? *(const v4u*)(zp + 1024) : (v4u){0u, 0u, 0u, 0u}; }
#pragma unroll
    for (int s = 0; s < 2; ++s) { const int i = tid + 512 * s, l = i & 63, ch = i >> 6; R.v[s] = *(const v4u*)(z + (size_t)(tok0 + l) * ZW + 2048 + 128 * h + 8 * ch); }
    if (tid < 64) { R.ip = P_GATES[(size_t)(tok0 + tid) * 8 + h]; R.fp = P_GATES[(size_t)(tok0 + tid) * 8 + 4 + h]; }
    if (PC) {
        if (tid >= 128 && tid < 256) R.np = P_NPREV[(size_t)u * 128 + tid - 128];
        R.mp = P_MPREV[u];
    }
}
__device__ __forceinline__ void vt_scatter(LAS unsigned short* VT, int stride, int ch, int l, const v4u& vv) {
    VT[(8 * ch + 0) * stride + l] = (unsigned short)(vv.x & 0xffffu); VT[(8 * ch + 1) * stride + l] = (unsigned short)(vv.x >> 16);
    VT[(8 * ch + 2) * stride + l] = (unsigned short)(vv.y & 0xffffu); VT[(8 * ch + 3) * stride + l] = (unsigned short)(vv.y >> 16);
    VT[(8 * ch + 4) * stride + l] = (unsigned short)(vv.z & 0xffffu); VT[(8 * ch + 5) * stride + l] = (unsigned short)(vv.z >> 16);
    VT[(8 * ch + 6) * stride + l] = (unsigned short)(vv.w & 0xffffu); VT[(8 * ch + 7) * stride + l] = (unsigned short)(vv.w >> 16);
}
__device__ __forceinline__ void conv4_lds(ldsp raw, int l, int ch, const LAS float* cw, const LAS float* cb, float (&out)[8]) {
    { const f32x4 b0 = *(const LAS f32x4*)(cb + 8 * ch), b1 = *(const LAS f32x4*)(cb + 8 * ch + 4); out[0] = b0[0]; out[1] = b0[1]; out[2] = b0[2]; out[3] = b0[3]; out[4] = b1[0]; out[5] = b1[1]; out[6] = b1[2]; out[7] = b1[3]; }
#pragma unroll
    for (int j = 0; j < 4; ++j) { const v4u v = *(const LAS v4u*)(raw + (l + j) * 272 + 16 * ch); const f32x4 w0 = *(const LAS f32x4*)(cw + j * 128 + 8 * ch), w1 = *(const LAS f32x4*)(cw + j * 128 + 8 * ch + 4);
        out[0] += w0[0] * bflo(v.x); out[1] += w0[1] * bfhi(v.x); out[2] += w0[2] * bflo(v.y); out[3] += w0[3] * bfhi(v.y); out[4] += w1[0] * bflo(v.z); out[5] += w1[1] * bfhi(v.z); out[6] += w1[2] * bflo(v.w); out[7] += w1[3] * bfhi(v.w); }
}

__device__ __forceinline__ void mlA_phase(Frame& F) {
    PHASE_FENCE(F);
    const float* ml_cw = karg(F, 15); const float* ml_cb = karg(F, 16);
    ldsp L = F.lds;
    constexpr int RAWK = 0, KTO = 18432, VTO = 36864, WLO = 57600, CWO = 57856;
    LAS unsigned short* KT = (LAS unsigned short*)(L + KTO); LAS unsigned short* VT = (LAS unsigned short*)(L + VTO); LAS float* WL = (LAS float*)(L + WLO); LAS float* CW = (LAS float*)(L + CWO);
    int u = F.vcu; if (u >= 2048) return;
    int hcw = -1;
    MlPre R; ml_prefetch<false>(F, u, R);
    for (; u < 2048; u += F.G) {
        { const int h = (u >> 6) & 3; if (h != hcw) { hcw = h; for (int i = F.tid; i < 640; i += NWAVES * 64) CW[i] = (i < 512) ? ml_cw[(i >> 7) * 1024 + 512 + 128 * h + (i & 127)] : ml_cb[512 + 128 * h + (i - 512)]; } }
#pragma unroll
        for (int s = 0; s < 3; ++s) { const int i = F.tid + 512 * s, row = s < 2 ? 3 + (i & 63) : (F.tid >> 4), ch = s < 2 ? (i >> 6) : (F.tid & 15); if (s < 2 || F.tid < 48) *(LAS v4u*)(L + RAWK + row * 272 + 16 * ch) = R.k[s]; }
#pragma unroll
        for (int s = 0; s < 2; ++s) { const int i = F.tid + 512 * s; vt_scatter(VT, 72, i >> 6, i & 63, R.v[s]); }
        for (int i = F.tid; i < 16 * 64; i += NWAVES * 64) { const int r = i >> 6, l = i & 63; VT[(128 + r) * 72 + l] = (r == 0) ? (unsigned short)0x3F80 : (unsigned short)0; }
        if (F.wave == 0) {
            const int l = F.lane; const float bc = scan_add(logsig(R.fp));
            const float bl = lane63(bc); const float g = bl - bc + R.ip; const float mx = lane63(scan_max(g));
            WL[l] = __expf(g - mx);
            if (l == 0) { P_MLOC[u] = mx; P_BLAST[u] = bl; }
        }
        __syncthreads();
        if (u + F.G < 2048) ml_prefetch<false>(F, u + F.G, R);
        { const int l = F.tid & 63;
#pragma unroll
          for (int it = 0; it < 2; ++it) { const int ch = (F.tid >> 6) + 8 * it; float kc[8]; conv4_lds(L + RAWK, l, ch, CW, CW + 512, kc);
            const float wl = WL[l] * 0.08838834764831845f;
#pragma unroll
            for (int i = 0; i < 8; ++i) KT[(8 * ch + i) * 72 + l] = f2bf1(fsilu(kc[i]) * wl); } }
        __syncthreads();
        { const int fr = F.lane & 15, fq = F.lane >> 4, w = F.wave;
          bf16x8 a[2];
#pragma unroll
          for (int ks = 0; ks < 2; ++ks) a[ks] = *(const LAS bf16x8*)(L + KTO + (16 * w + fr) * 144 + (32 * ks + 8 * fq) * 2);
#pragma unroll
          for (int nt = 0; nt < 9; ++nt) { f32x4 acc = {0.f, 0.f, 0.f, 0.f};
#pragma unroll
            for (int ks = 0; ks < 2; ++ks) { const bf16x8 bb = *(const LAS bf16x8*)(L + VTO + (16 * nt + fr) * 144 + (32 * ks + 8 * fq) * 2); acc = MFMA16(a[ks], bb, acc); }
            if (nt < 8) { v2u o; o.x = pk2(acc[0], acc[1]); o.y = pk2(acc[2], acc[3]); *(v2u*)(P_CST + (size_t)u * 16384 + (16 * nt + fr) * 128 + 16 * w + 4 * fq) = o; }
            else if (fr == 0) { *(f32x4*)(P_NLOC + (size_t)u * 128 + 16 * w + 4 * fq) = acc; } } }
        __syncthreads();
    }
}

__device__ __forceinline__ void mlC_phase(Frame& F) {
    PHASE_FENCE(F);
    const float* ml_cw = karg(F, 15); const float* ml_cb = karg(F, 16); const float* ml_norm = karg(F, 17);
    ldsp L = F.lds;
    constexpr int RAWQ = 0, RAWK = 18432, QI = 36864, KI = 54272, VTO = 71680, SQO = 90112, CTO = 99328, ARR = 134144  , CWO = 136704  , HFO = 0;
    static_assert(ARR + 576 * 4 <= CWO && CWO + 1408 * 4 <= LDSCTL_OFF, "mlC LDS map");
    LAS unsigned short* VT = (LAS unsigned short*)(L + VTO); LAS unsigned short* SQ = (LAS unsigned short*)(L + SQO); LAS float* HF = (LAS float*)(L + HFO); LAS float* CW = (LAS float*)(L + CWO);
    LAS float* DV = (LAS float*)(L + ARR); LAS float* MU = DV + 64; LAS float* AI = DV + 128; LAS float* EM = DV + 192; LAS float* DENP = DV + 256  ; LAS float* DNI = DV + 384; LAS float* NP = DV + 448  ;
    int u = F.vcu; if (u >= 2048) return;
    int hcw = -1;
    MlPre R; ml_prefetch<true>(F, u, R);
    for (; u < 2048; u += F.G) {
        const int c = u & 63, bh = u >> 6, h = bh & 3, b = bh >> 2, tok0 = b * SEQ + c * 64;
        if (h != hcw) { hcw = h;
            for (int i = F.tid; i < 1280; i += NWAVES * 64) { const int qk = i / 640, r = i % 640; CW[i] = (r < 512) ? ml_cw[(r >> 7) * 1024 + 512 * qk + 128 * h + (r & 127)] : ml_cb[512 * qk + 128 * h + (r - 512)]; }
            if (F.tid < 128) CW[1280 + F.tid] = ml_norm[128 * h + F.tid]; }
#pragma unroll
        for (int s = 0; s < 3; ++s) { const int i = F.tid + 512 * s, row = s < 2 ? 3 + (i & 63) : (F.tid >> 4), ch = s < 2 ? (i >> 6) : (F.tid & 15); if (s < 2 || F.tid < 48) { *(LAS v4u*)(L + RAWQ + row * 272 + 16 * ch) = R.q[s]; *(LAS v4u*)(L + RAWK + row * 272 + 16 * ch) = R.k[s]; } }
#pragma unroll
        for (int s = 0; s < 2; ++s) { const int i = F.tid + 512 * s; vt_scatter(VT, 72, i >> 6, i & 63, R.v[s]); }
        if (F.wave == 0) {
            const int l = F.lane; const float bc = scan_add(logsig(R.fp));
            const float dv = R.ip - bc; const float cm = scan_max(dv);
            const float bm = bc + R.mp, mt = fmaxf(bm, bc + cm);
            AI[l] = __expf(bm - mt); MU[l] = mt - bc; DV[l] = dv; EM[l] = __expf(-mt);
        }
        if (F.tid >= 128 && F.tid < 256) NP[F.tid - 128] = R.np;
        __syncthreads();
        v4u ct[4];
#pragma unroll
        for (int s = 0; s < 4; ++s) ct[s] = *(const v4u*)(P_CST + (size_t)u * 16384 + (size_t)(F.tid + 512 * s) * 8);
        if (u + F.G < 2048) ml_prefetch<true>(F, u + F.G, R);
        { const int l = F.tid & 63;
#pragma unroll
          for (int it = 0; it < 2; ++it) { const int ch = (F.tid >> 6) + 8 * it; float qc[8], kc[8];
            conv4_lds(L + RAWQ, l, ch, CW, CW + 512, qc); conv4_lds(L + RAWK, l, ch, CW + 640, CW + 1152, kc);
#pragma unroll
            for (int i = 0; i < 8; ++i) { qc[i] = fsilu(qc[i]); kc[i] = fsilu(kc[i]) * 0.08838834764831845f; }
            *(LAS v4u*)(L + QI + l * 272 + 16 * ch) = pk8f(qc); *(LAS v4u*)(L + KI + l * 272 + 16 * ch) = pk8f(kc); } }
        __syncthreads();
        const int fr = F.lane & 15, fq = F.lane >> 4, w = F.wave, tt = w >> 1;
        {
          float rs[4] = {0.f, 0.f, 0.f, 0.f};
#pragma unroll 1
          for (int si = 0; si < 2; ++si) { const int st = 2 * (w & 1) + si; f32x4 acc = {0.f, 0.f, 0.f, 0.f};
#pragma unroll
            for (int ks = 0; ks < 4; ++ks) { const bf16x8 a = *(const LAS bf16x8*)(L + QI + (16 * tt + fr) * 272 + (32 * ks + 8 * fq) * 2), bb = *(const LAS bf16x8*)(L + KI + (16 * st + fr) * 272 + (32 * ks + 8 * fq) * 2); acc = MFMA16(a, bb, acc); }
            const int s = 16 * st + fr; const float dvs = DV[s];
#pragma unroll
            for (int r = 0; r < 4; ++r) { const int t = 16 * tt + 4 * fq + r; const float wgt = (s <= t) ? __expf(dvs - MU[t]) : 0.f; const float v = acc[r] * wgt; rs[r] += v; SQ[t * 72 + s] = f2bf1(v); } }
#pragma unroll
          for (int r = 0; r < 4; ++r) { float v = rs[r]; v += __shfl_xor(v, 1); v += __shfl_xor(v, 2); v += __shfl_xor(v, 4); v += __shfl_xor(v, 8); if (fr == 0) DENP[(w & 1) * 64 + 16 * tt + 4 * fq + r] = v; }
          const int t = F.tid >> 3, part = F.tid & 7; float acc = 0.f;
          { const v4u v0 = *(const LAS v4u*)(L + QI + t * 272 + 32 * part), v1 = *(const LAS v4u*)(L + QI + t * 272 + 32 * part + 16);
            const float q0[8] = {bflo(v0.x), bfhi(v0.x), bflo(v0.y), bfhi(v0.y), bflo(v0.z), bfhi(v0.z), bflo(v0.w), bfhi(v0.w)};
            const float q1[8] = {bflo(v1.x), bfhi(v1.x), bflo(v1.y), bfhi(v1.y), bflo(v1.z), bfhi(v1.z), bflo(v1.w), bfhi(v1.w)};
#pragma unroll
            for (int i = 0; i < 8; ++i) acc += q0[i] * NP[16 * part + i] + q1[i] * NP[16 * part + 8 + i]; }
          acc += __shfl_xor(acc, 1); acc += __shfl_xor(acc, 2); acc += __shfl_xor(acc, 4);
          if (part == 0) DNI[t] = acc; }
#pragma unroll
        for (int s = 0; s < 4; ++s) { const int i = F.tid + 512 * s; *(LAS v4u*)(L + CTO + (i >> 4) * 272 + 16 * (i & 15)) = ct[s]; }
        __syncthreads();
        v4u o0, o1; { const bf16* op = P_Z + (size_t)(tok0 + (F.tid >> 3)) * ZW + 2560 + 128 * h + 16 * (F.tid & 7); o0 = *(const v4u*)op; o1 = *(const v4u*)(op + 8); }
        {
#pragma unroll 1
          for (int ei = 0; ei < 4; ++ei) { const int et = 4 * (w & 1) + ei; f32x4 ai_ = {0.f, 0.f, 0.f, 0.f}, ax = {0.f, 0.f, 0.f, 0.f};
#pragma unroll
            for (int ks = 0; ks < 2; ++ks) { const bf16x8 a = *(const LAS bf16x8*)(L + SQO + (16 * tt + fr) * 144 + (32 * ks + 8 * fq) * 2), bb = *(const LAS bf16x8*)(L + VTO + (16 * et + fr) * 144 + (32 * ks + 8 * fq) * 2); ai_ = MFMA16(a, bb, ai_); }
#pragma unroll
            for (int ks = 0; ks < 4; ++ks) { const bf16x8 a = *(const LAS bf16x8*)(L + QI + (16 * tt + fr) * 272 + (32 * ks + 8 * fq) * 2), bb = *(const LAS bf16x8*)(L + CTO + (16 * et + fr) * 272 + (32 * ks + 8 * fq) * 2); ax = MFMA16(a, bb, ax); }
#pragma unroll
            for (int r = 0; r < 4; ++r) { const int t = 16 * tt + 4 * fq + r; const float aint = AI[t]; const float den = DENP[t] + DENP[64 + t] + aint * DNI[t]; const float dd = fmaxf(fabsf(den), EM[t]);
                HF[t * 132 + 16 * et + fr] = (ai_[r] + aint * ax[r]) / dd; } } }
        __syncthreads();
        {
          const int t = F.tid >> 3, part = F.tid & 7; f32x4 hv[4]; float ss = 0.f;
#pragma unroll
          for (int i = 0; i < 4; ++i) { hv[i] = *(const LAS f32x4*)(HF + t * 132 + 16 * part + 4 * i); ss += pg8::dot4(hv[i]); }
          ss += __shfl_xor(ss, 1); ss += __shfl_xor(ss, 2); ss += __shfl_xor(ss, 4);
          const float rstd = rsqrtf(ss * (1.0f / 128.0f) + 1e-6f);
          const float og0[8] = {bflo(o0.x), bfhi(o0.x), bflo(o0.y), bfhi(o0.y), bflo(o0.z), bfhi(o0.z), bflo(o0.w), bfhi(o0.w)};
          const float og1[8] = {bflo(o1.x), bfhi(o1.x), bflo(o1.y), bfhi(o1.y), bflo(o1.z), bfhi(o1.z), bflo(o1.w), bfhi(o1.w)};
          float y0[8], y1[8]; const LAS float* gn = CW + 1280 + 16 * part;
#pragma unroll
          for (int i = 0; i < 8; ++i) { y0[i] = hv[i >> 2][i & 3] * rstd * gn[i] * fsigmoid(og0[i]); y1[i] = hv[2 + (i >> 2)][i & 3] * rstd * gn[8 + i] * fsigmoid(og1[i]); }
          bf16* yp = P_YBUF + (size_t)(tok0 + t) * DM + 512 + 128 * h + 16 * part; *(v4u*)yp = pk8f(y0); *(v4u*)(yp + 8) = pk8f(y1); }
        __syncthreads();
    }
}

struct RgPre { v4u raw[11]; float carry[4]; };
template <bool FINAL> __device__ __forceinline__ void rg_prefetch(Frame& F, int u, RgPre& R) {
    const int b = u >> 6, c = u & 63, tok0 = b * SEQ + c * 64;
    int tid = F.tid; asm volatile("" : "+v"(tid));
    const int chunk = tid & 63, run = tid >> 6, col0 = 8 * chunk;
#pragma unroll
    for (int k = 0; k < 11; ++k) { const int s = c * 64 + 8 * run - 3 + k; R.raw[k] = (s >= 0) ? *(const v4u*)(P_Z + (size_t)(tok0 + 8 * run - 3 + k) * ZW + col0) : (v4u){0u, 0u, 0u, 0u}; }
    if (FINAL) {
        const int fr = tid & 15, w = tid >> 6;
#pragma unroll
        for (int jt = 0; jt < 4; ++jt) R.carry[jt] = P_RGC[(size_t)u * 512 + 64 * w + 16 * jt + fr];
    }
}
template <bool FINAL> __device__ __forceinline__ void rg_phase(Frame& F) {
    PHASE_FENCE(F);
    const float* rg_cw = karg(F, 8); const float* rg_cb = karg(F, 9); const float* rg_ba = karg(F, 11); const float* rg_bx = karg(F, 13); const float* rg_lam = karg(F, 14);
    ldsp L = F.lds;
    constexpr int XCO = 0, GRO = 66560;
    LAS unsigned short* XC = (LAS unsigned short*)(L + XCO); LAS unsigned short* GR = (LAS unsigned short*)(L + GRO);
    const int fr = F.lane & 15, fq = F.lane >> 4, w = F.wave;
    int u = F.vcu; if (u >= 512) return;
    RgPre R; rg_prefetch<FINAL>(F, u, R);
    bf16x8 bfr[2][4][2]; float ba[4], bx[4], sp8[4];
#pragma unroll
    for (int g = 0; g < 2; ++g)
#pragma unroll
        for (int jt = 0; jt < 4; ++jt)
#pragma unroll
            for (int ks = 0; ks < 2; ++ks) bfr[g][jt][ks] = *(const bf16x8*)(P_RGW + (size_t)(g * 8 + w) * 4096 + (16 * jt + fr) * 64 + 32 * ks + 8 * fq);
#pragma unroll
    for (int jt = 0; jt < 4; ++jt) { const int chn = 64 * w + 16 * jt + fr; ba[jt] = rg_ba[chn]; bx[jt] = rg_bx[chn]; sp8[jt] = 8.0f * 1.4426950408889634f * log1pf(__expf(-rg_lam[chn]));     }
    const int chunk = F.tid & 63, run = F.tid >> 6, col0 = 8 * chunk;
    LAS float* CWL = (LAS float*)(L + 132096);
    for (int i = F.tid; i < 2560; i += NWAVES * 64) CWL[i] = (i < 2048) ? rg_cw[i] : rg_cb[i - 2048];
    __syncthreads();
    for (; u < 512; u += F.G) {
        const int b = u >> 6, c = u & 63, tok0 = b * SEQ + c * 64;
        f32x4 wa[4], wb[4];
#pragma unroll
        for (int j = 0; j < 4; ++j) { wa[j] = *(const LAS f32x4*)(CWL + j * 512 + col0); wb[j] = *(const LAS f32x4*)(CWL + j * 512 + col0 + 4); }
        const f32x4 b0 = *(const LAS f32x4*)(CWL + 2048 + col0), b1 = *(const LAS f32x4*)(CWL + 2048 + col0 + 4);
#pragma unroll
        for (int t = 0; t < 8; ++t) { f32x4 oa = b0, ob = b1;
#pragma unroll
            for (int j = 0; j < 4; ++j) { f32x4 xa, xb2; pg8::unpack8(R.raw[t + j], xa, xb2); oa += wa[j] * xa; ob += wb[j] * xb2; }
            *(LAS v4u*)(L + XCO + (8 * run + t) * 1040 + 16 * chunk) = pg8::pk8(oa, ob); }
        float carry[4], ptot[4]; v4u gk[8];
#pragma unroll
        for (int jt = 0; jt < 4; ++jt) { carry[jt] = FINAL ? R.carry[jt] : 0.f; ptot[jt] = 1.f; }
        __syncthreads();
        if (u + F.G < 512) rg_prefetch<FINAL>(F, u + F.G, R);
        if (FINAL) {
#pragma unroll
            for (int k = 0; k < 8; ++k) gk[k] = *(const v4u*)(P_Z + (size_t)(tok0 + run + 8 * k) * ZW + 512 + col0); }
#pragma unroll 1
        for (int tt = 0; tt < 4; ++tt) {
            bf16x8 a[2];
#pragma unroll
            for (int ks = 0; ks < 2; ++ks) a[ks] = *(const LAS bf16x8*)(L + XCO + (16 * tt + fr) * 1040 + (64 * w + 32 * ks + 8 * fq) * 2);
#pragma unroll
            for (int jt = 0; jt < 4; ++jt) { f32x4 ga = {0.f, 0.f, 0.f, 0.f}, gx = {0.f, 0.f, 0.f, 0.f};
#pragma unroll
                for (int ks = 0; ks < 2; ++ks) { ga = MFMA16(a[ks], bfr[0][jt][ks], ga); gx = MFMA16(a[ks], bfr[1][jt][ks], gx); }
                const int chn = 64 * w + 16 * jt + fr; float av[4], uv[4];
#pragma unroll
                for (int r = 0; r < 4; ++r) { const int t = 16 * tt + 4 * fq + r; const float xcv = bf2f(XC[t * 520 + chn]);
                    const float la = -fsigmoid(ga[r] + ba[jt]) * sp8[jt]; const float aa = __builtin_amdgcn_exp2f(la); av[r] = aa; uv[r] = sqrtf(fmaxf(1.0f - aa * aa, 0.f)) * fsigmoid(gx[r] + bx[jt]) * xcv; }
                float Pi = av[0] * av[1] * av[2] * av[3], hi = ((uv[0] * av[1] + uv[1]) * av[2] + uv[2]) * av[3] + uv[3];
                { const float tP = __shfl_up(Pi, 16), th = __shfl_up(hi, 16); if (fq >= 1) { hi = Pi * th + hi; Pi = Pi * tP; } }
                { const float tP = __shfl_up(Pi, 32), th = __shfl_up(hi, 32); if (fq >= 2) { hi = Pi * th + hi; Pi = Pi * tP; } }
                float Pe = __shfl_up(Pi, 16), he = __shfl_up(hi, 16); if (fq == 0) { Pe = 1.f; he = 0.f; }
                const float P3 = __shfl(Pi, 48 + fr), h3 = __shfl(hi, 48 + fr);
                if (FINAL) { float hc = Pe * carry[jt] + he;
#pragma unroll
                    for (int r = 0; r < 4; ++r) { const int t = 16 * tt + 4 * fq + r; hc = av[r] * hc + uv[r]; GR[t * 512 + chn] = f2bf1(hc); } }
                carry[jt] = P3 * carry[jt] + h3; ptot[jt] *= P3; }
        }
        if (!FINAL) { if (fq == 0) {
#pragma unroll
            for (int jt = 0; jt < 4; ++jt) { P_RGA[(size_t)u * 512 + 64 * w + 16 * jt + fr] = ptot[jt]; P_RGH[(size_t)u * 512 + 64 * w + 16 * jt + fr] = carry[jt]; } } }
        else { __syncthreads();
#pragma unroll
            for (int k = 0; k < 8; ++k) { const int t = run + 8 * k; f32x4 h0, h1, g0, g1; const v4u hw = *(const LAS v4u*)(L + GRO + t * 1024 + 16 * chunk); pg8::unpack8(hw, h0, h1); pg8::unpack8(gk[k], g0, g1);
#pragma unroll
                for (int e = 0; e < 4; ++e) { h0[e] *= gelu_tanh(g0[e]); h1[e] *= gelu_tanh(g1[e]); }
                *(v4u*)(P_YBUF + (size_t)(tok0 + t) * DM + 8 * chunk) = pg8::pk8(h0, h1); } }
        __syncthreads();
    }
}

__device__ __forceinline__ void mixB_unit(Frame& F, int unit) {
    PHASE_FENCE(F);
    const int bh = unit >> 3, sl = unit & 7; ldsp L = F.lds;
    LAS float* AP = (LAS float*)L; LAS float* AL = AP + 64;
    bf16* base = P_CST + (size_t)bh * 64 * 16384 + sl * 2048 + F.tid * 4; v2u cl[64];
#pragma unroll
    for (int c = 0; c < 64; ++c) cl[c] = *(const v2u*)(base + (size_t)c * 16384);
    if (F.wave == 0) {
        const float mlv = P_MLOC[bh * 64 + F.lane], blv = P_BLAST[bh * 64 + F.lane]; float mst = -INFINITY, mp = 0.f, mn_ = 0.f;
#pragma unroll
        for (int c = 0; c < 64; ++c) { const float ml = __int_as_float(__builtin_amdgcn_readlane(__float_as_int(mlv), c));
            const float bl = __int_as_float(__builtin_amdgcn_readlane(__float_as_int(blv), c)); const float mn = fmaxf(bl + mst, ml);
            if (F.lane == c) { mp = mst; mn_ = mn; }
            mst = mn; }
        AP[F.lane] = __expf(blv + mp - mn_); AL[F.lane] = __expf(mlv - mn_); if (sl == 0) P_MPREV[bh * 64 + F.lane] = mp; }
    __syncthreads();
    { float st[4] = {0.f, 0.f, 0.f, 0.f};
#pragma unroll
      for (int c = 0; c < 64; ++c) { v2u o; o.x = pk2(st[0], st[1]); o.y = pk2(st[2], st[3]); *(v2u*)(base + (size_t)c * 16384) = o;
          const float ap = AP[c], al = AL[c];
          st[0] = ap * st[0] + al * bflo(cl[c].x); st[1] = ap * st[1] + al * bfhi(cl[c].x); st[2] = ap * st[2] + al * bflo(cl[c].y); st[3] = ap * st[3] + al * bfhi(cl[c].y); } }
    if (sl == 0 && F.tid < 128) { float ns = 0.f;
        for (int c0 = 0; c0 < 64; c0 += 16) { float nl[16];
#pragma unroll
            for (int k = 0; k < 16; ++k) nl[k] = P_NLOC[(size_t)(bh * 64 + c0 + k) * 128 + F.tid];
#pragma unroll
            for (int k = 0; k < 16; ++k) { P_NPREV[(size_t)(bh * 64 + c0 + k) * 128 + F.tid] = ns; ns = AP[c0 + k] * ns + AL[c0 + k] * nl[k]; } } }
#pragma unroll
    for (int j = 0; j < 2; ++j) { const int idx = unit * 16 + 2 * F.wave + j, b = idx >> 9, chn = idx & 511; const size_t o = (size_t)(b * 64 + F.lane) * 512 + chn;
        float Pi = P_RGA[o], hi = P_RGH[o];
#pragma unroll
        for (int off = 1; off < 64; off <<= 1) { const float tP = __shfl_up(Pi, off), th = __shfl_up(hi, off); if (F.lane >= off) { hi = Pi * th + hi; Pi = Pi * tP; } }
        float he = __shfl_up(hi, 1); if (F.lane == 0) he = 0.f;
        P_RGC[o] = he; }
    __syncthreads();
}

__device__ __forceinline__ void attn_unit(Frame& F, int u, const bf16* Qb, const bf16* Kb, const bf16* Vb, bf16* Ob) { const float* at_sinks = karg(F, 22);
    const int qb = u & 31, kvh = (u >> 5) & 3, b = u >> 7; const int row0 = b * SEQ + 128 * qb;
    ldsp L = F.lds;
    constexpr int KI = 0, VTO = 36864;
    LAS unsigned short* VT = (LAS unsigned short*)(L + VTO);
#pragma unroll
    for (int it = 0; it < 4; ++it) { const int idx = F.tid + 512 * it, kr = idx & 255, chk = idx >> 8; const bool ok = (qb > 0) || (kr >= 128);
        v4u kv = {0u, 0u, 0u, 0u}, vv = {0u, 0u, 0u, 0u};
        if (ok) { const size_t o = (size_t)(row0 - 128 + kr) * 256 + 64 * kvh + 8 * chk; kv = *(const v4u*)(Kb + o); vv = *(const v4u*)(Vb + o); }
        *(LAS v4u*)(L + KI + kr * 144 + 16 * chk) = kv;
        VT[(8 * chk + 0) * 260 + kr] = (unsigned short)(vv.x & 0xffffu); VT[(8 * chk + 1) * 260 + kr] = (unsigned short)(vv.x >> 16);
        VT[(8 * chk + 2) * 260 + kr] = (unsigned short)(vv.y & 0xffffu); VT[(8 * chk + 3) * 260 + kr] = (unsigned short)(vv.y >> 16);
        VT[(8 * chk + 4) * 260 + kr] = (unsigned short)(vv.z & 0xffffu); VT[(8 * chk + 5) * 260 + kr] = (unsigned short)(vv.z >> 16);
        VT[(8 * chk + 6) * 260 + kr] = (unsigned short)(vv.w & 0xffffu); VT[(8 * chk + 7) * 260 + kr] = (unsigned short)(vv.w >> 16); }
    __syncthreads();
    const int r = F.lane & 31, hh = F.lane >> 5, w = F.wave, head = 4 * kvh + (w >> 1);
    const float sink = at_sinks[head] * 1.4426950408889634f;
#pragma unroll 1
    for (int qt = 0; qt < 2; ++qt) {
        const int q0 = 64 * (w & 1) + 32 * qt, kt0 = q0 >> 5; const size_t qrow = (size_t)(row0 + q0 + r);
        bf16x8 qf[4];
#pragma unroll
        for (int ks = 0; ks < 4; ++ks) qf[ks] = *(const bf16x8*)(Qb + qrow * 1024 + 64 * head + 16 * ks + 8 * hh);
        f32x16 S[5];
#pragma unroll
        for (int i = 0; i < 5; ++i) {
#pragma unroll
            for (int e = 0; e < 16; ++e) S[i][e] = 0.f;
#pragma unroll
            for (int ks = 0; ks < 4; ++ks) { const bf16x8 kf = *(const LAS bf16x8*)(L + KI + (32 * (kt0 + i) + r) * 144 + (16 * ks + 8 * hh) * 2); S[i] = MFMA32(kf, qf[ks], S[i]); } }
        float mx = sink;
#pragma unroll
        for (int i = 0; i < 5; ++i) { const bool whole = (qb == 0) && (kt0 + i < 4);
#pragma unroll
            for (int e = 0; e < 16; ++e) { const int cr = (e & 3) + 8 * (e >> 2) + 4 * hh; float v = S[i][e];
                if (i == 0) v = (cr > r) ? v : -INFINITY;
                if (i == 4) v = (cr <= r) ? v : -INFINITY;
                v = whole ? -INFINITY : v;
                S[i][e] = v; mx = fmaxf(mx, v); } }
        mx = fmaxf(mx, __shfl_xor(mx, 32));
        float sum = 0.f;
#pragma unroll
        for (int i = 0; i < 5; ++i)
#pragma unroll
            for (int e = 0; e < 16; ++e) { const float p = __builtin_amdgcn_exp2f(S[i][e] - mx); S[i][e] = p; sum += p; }
        sum += __shfl_xor(sum, 32); sum += __builtin_amdgcn_exp2f(sink - mx);
        const float inv = 1.0f / sum;
        f32x16 O[2];
#pragma unroll
        for (int e = 0; e < 16; ++e) { O[0][e] = 0.f; O[1][e] = 0.f; }
#pragma unroll
        for (int i = 0; i < 5; ++i)
#pragma unroll
            for (int s = 0; s < 2; ++s) {
                v4u pw; pw.x = pk2(S[i][8 * s + 0], S[i][8 * s + 1]); pw.y = pk2(S[i][8 * s + 2], S[i][8 * s + 3]); pw.z = pk2(S[i][8 * s + 4], S[i][8 * s + 5]); pw.w = pk2(S[i][8 * s + 6], S[i][8 * s + 7]);
                const bf16x8 pf = __builtin_bit_cast(bf16x8, pw);
#pragma unroll
                for (int dt = 0; dt < 2; ++dt) { const int ko = (32 * dt + r) * 520 + (32 * (kt0 + i) + 16 * s + 4 * hh) * 2;
                    const s16x4 lo = *(const LAS s16x4*)(L + VTO + ko), hi = *(const LAS s16x4*)(L + VTO + ko + 16);
                    const bf16x8 vf = __builtin_shufflevector(lo, hi, 0, 1, 2, 3, 4, 5, 6, 7);
                    O[dt] = MFMA32(vf, pf, O[dt]); } }
        bf16* op = Ob + qrow * 1024 + 64 * head + 4 * hh;
#pragma unroll
        for (int dt = 0; dt < 2; ++dt)
#pragma unroll
            for (int g4 = 0; g4 < 4; ++g4) { v2u o; o.x = pk2(O[dt][4 * g4] * inv, O[dt][4 * g4 + 1] * inv); o.y = pk2(O[dt][4 * g4 + 2] * inv, O[dt][4 * g4 + 3] * inv); *(v2u*)(op + 32 * dt + 8 * g4) = o; }
    }
    __syncthreads();
}

__device__ __forceinline__ void fixup_panel(Frame& F, int pm, const float* cw, const float* cb, bf16* A2, const bf16* GH, const bf16* UH, const bf16* GT) {
    for (int idx = F.tid; idx < 8 * 384; idx += NWAVES * 64) {
        const int chk = idx % 384, rg = idx / 384, rr = rg & 1, grp = 4 * pm + (rg >> 1), ch0 = 8 * chk; const bool first = (grp & 63) == 0;
        float g0[8], u0[8], p1[8], p2[8];
        ld8f(GH + ((size_t)grp * 2 + rr) * 3072 + ch0, g0); ld8f(UH + ((size_t)grp * 2 + rr) * 3072 + ch0, u0);
#pragma unroll
        for (int i = 0; i < 8; ++i) { p1[i] = 0.f; p2[i] = 0.f; }
        if (rr == 1) { ld8f(GH + ((size_t)grp * 2) * 3072 + ch0, p1); if (!first) ld8f(GT + ((size_t)(grp - 1) * 2 + 1) * 3072 + ch0, p2); }
        else if (!first) { ld8f(GT + ((size_t)(grp - 1) * 2 + 1) * 3072 + ch0, p1); ld8f(GT + ((size_t)(grp - 1) * 2) * 3072 + ch0, p2); }
        float o[8];
#pragma unroll
        for (int i = 0; i < 8; ++i) { const float y = cw[ch0 + i] * p2[i] + cw[3072 + ch0 + i] * p1[i] + cw[6144 + ch0 + i] * g0[i] + cb[ch0 + i]; o[i] = gelu_tanh(y) * u0[i]; }
        *(v4u*)(A2 + (size_t)grp * 32 * 6144 + ((ch0 >> 6) * 128 + ((ch0 >> 5) & 1) * 64 + rr * 32 + (ch0 & 31))) = pk8f(o);
    }
}

#define GRID_BAR() do { xcd_barrier(bar); TSTAMP(); } while (0)
template <int L> __device__ __forceinline__ bool layer_part(Frame& F, const XcdBarrier& bar, int& ts_n) {
    constexpr int l = L;
    unsigned char* ws = F.ws; const int bx = (int)blockIdx.x;
    bf16* const XBA = (bf16*)(ws + WS_XBA); bf16* const XBB = (bf16*)(ws + WS_XBB);
    float* const SSA = (float*)(ws + WS_SSA); float* const SSB = (float*)(ws + WS_SSB);
    bf16* const PP = (bf16*)(ws + WS_CST); bf16* const A2 = (bf16*)(ws + WS_BIG);

        if (l == 1) {
            bf16* const Qb = (bf16*)(ws + WS_BIG); bf16* const Kb = (bf16*)(ws + WS_BIG + 64 * MiB); bf16* const Vb = (bf16*)(ws + WS_BIG + 80 * MiB); bf16* const Ob = (bf16*)(ws + WS_BIG + 96 * MiB);
PREP(7) {
            { pg8::Gemm g{XBB, (const bf16*)(ws + WS_WQKV), T, 1536, DM}; pg8::StaticOrder S; S.init(T, 1536, F.G, bx);
              pg8::EpiQkv E{SSB, P_ROPE, karg(F, 20), karg(F, 21), Qb, Kb, Vb};
              pg8::gemm_phase<pg8::EpiQkv, pg8::StaticOrder, true, true>(F.lds, g, S, E, F.wave); }
            { pg8::Gemm g{(const bf16*)(ws + WS_PB) + (size_t)T * 256, (const bf16*)(ws + WS_WPJ1), T, DM, 256}; pg8::StaticOrder S; S.init(T, DM, F.G, bx);
              pg8::EpiZ<true> E{PP, DM, nullptr};
              pg8::gemm_phase<pg8::EpiZ<true>, pg8::StaticOrder, true, true>(F.lds, g, S, E, F.wave); }
            GRID_BAR();
    }

            PREP(8) {
            PHASE_FENCE(F); for (int u = F.vcu; u < 1024; u += F.G) attn_unit(F, u, Qb, Kb, Vb, Ob);
            GRID_BAR();
            }
            { pg8::Gemm g{Ob, (const bf16*)(ws + WS_WO1), T, DM, DM}; pg8::StaticOrder S; S.init(T, DM, F.G, bx);
              pg8::EpiRes<false, false> E{XBB, XBA, SSA};
              pg8::gemm_phase<pg8::EpiRes<false, false>, pg8::StaticOrder, true, true>(F.lds, g, S, E, F.wave); }
            GRID_BAR();
            if (DBG_STOP == 9) return true;
        } else {
PREP(3) {
            { pg8::Gemm g{P_YBUF, (const bf16*)(ws + WS_WOUT0), T, DM, DM}; pg8::StaticOrder S; S.init(T, DM, F.G, bx);
              pg8::EpiRes<true, false> E{karg(F, 0), XBB, SSB};
              pg8::gemm_phase<pg8::EpiRes<true, false>, pg8::StaticOrder, true, true>(F.lds, g, S, E, F.wave); }
            { pg8::Gemm g{(const bf16*)(ws + WS_PB), (const bf16*)(ws + WS_WPJ0), T, DM, 256}; pg8::StaticOrder S; S.init(T, DM, F.G, bx);
              pg8::EpiZ<true> E{PP, DM, nullptr};
              pg8::gemm_phase<pg8::EpiZ<true>, pg8::StaticOrder, true, true>(F.lds, g, S, E, F.wave); }
            GRID_BAR();
    }

            if (DBG_STOP == 3) return true;
        }
        const bf16* xin = l ? XBA : XBB; const float* ssin = l ? SSA : SSB; bf16* side = l ? XBB : XBA;
        bf16* const GH = side; bf16* const UH = side + (size_t)3 * MiB; bf16* const GT = side + (size_t)6 * MiB;
        const float* cw = karg(F, 25) + (size_t)l * 3 * 3072; const float* cb = karg(F, 26) + (size_t)l * 3072;
        PREP(10 + 10 * l) {
        { pg8::Gemm g{xin, (const bf16*)(ws + (l ? WS_WUP1 : WS_WUP0)), T, 2 * FFD, DM}; pg8::StaticOrder S; S.init(T, 2 * FFD, F.G, bx);
          pg8::EpiUp E{ssin, cw, cb, A2, GH, UH, GT};
          pg8::gemm_phase<pg8::EpiUp, pg8::StaticOrder, true, true>(F.lds, g, S, E, F.wave); }
        GRID_BAR();
        }
        PHASE_FENCE(F); for (int pm = F.vcu; pm < T / 256; pm += F.G) fixup_panel(F, pm, cw, cb, A2, GH, UH, GT);
        GRID_BAR();
        bf16* const xdn = l ? XBB : XBA; float* const ssdn = l ? SSB : SSA;
        { pg8::Gemm g{A2, (const bf16*)(ws + (l ? WS_WDN1 : WS_WDN0)), T, DM, FFD}; pg8::StaticOrder S; S.init(T, DM, F.G, bx);
          pg8::EpiRes<false, true> E{xin, xdn, ssdn};
          pg8::gemm_phase<pg8::EpiRes<false, true>, pg8::StaticOrder, true, true>(F.lds, g, S, E, F.wave); }
        GRID_BAR();
        if ((l == 0 && DBG_STOP == 5) || (l == 1 && DBG_STOP == 11)) return true;
#ifdef PROBE_P6MODE
        if (L == 0) { pg8::Gemm g{xdn, (const bf16*)(ws + (l ? WS_WGT1 : WS_WGT0)), T, DM, DM}; pg8::StaticOrder S; S.init(T, DM, F.G, bx);
#if PROBE_P6MODE == 0
          pg8::EpiNone E0{}; pg8::gemm_phase<pg8::EpiNone, pg8::StaticOrder, true, true>(F.lds, g, S, E0, F.wave);
#else
          pg8::EpiPleProbe<PROBE_P6MODE> E0{ssdn, PP, xdn, A2, (float*)(ws + WS_BIG + 100 * MiB)}; pg8::gemm_phase<pg8::EpiPleProbe<PROBE_P6MODE>, pg8::StaticOrder, true, true>(F.lds, g, S, E0, F.wave);
#endif
          GRID_BAR(); }
#endif
        { pg8::Gemm g{xdn, (const bf16*)(ws + (l ? WS_WGT1 : WS_WGT0)), T, DM, DM}; pg8::StaticOrder S; S.init(T, DM, F.G, bx);
          pg8::EpiPle<(L == 1)> E{ssdn, PP, xdn, XBB, SSB, F.out};
          pg8::gemm_phase<pg8::EpiPle<(L == 1)>, pg8::StaticOrder, true, true>(F.lds, g, S, E, F.wave); }
        if (l == 0) GRID_BAR();
        if (l == 0 && DBG_STOP == 6) return true;

    return false;
}
struct Args { const void* in[30]; float* out; unsigned char* ws; };
__global__ void __launch_bounds__(NWAVES * 64, 2) hy_fwd(Args args) {
    extern __shared__ __attribute__((aligned(16))) unsigned char lds[];
    Frame F;
    F.lds = (ldsp)lds; F.MISC = (volatile LAS unsigned*)(F.lds + MISC_OFF);
    F.tid = threadIdx.x; F.lane = F.tid & 63; F.wave = __builtin_amdgcn_readfirstlane(F.tid >> 6);
    F.G = gridDim.x; { const int bx = blockIdx.x; F.vcu = (F.G % 8 == 0) ? (bx % 8) * (F.G / 8) + bx / 8 : bx; }
    unsigned char* ws = args.ws; F.ws = ws; F.out = args.out;
    F.kb = (unsigned long long)__builtin_amdgcn_kernarg_segment_ptr();
    for (int i = F.tid; i < (LDS_BYTES - LDSCTL_OFF) / 4; i += NWAVES * 64) ((LAS unsigned*)(F.lds + LDSCTL_OFF))[i] = 0u;
    __syncthreads();
    XcdBarrier bar = xcd_barrier_post((unsigned*)(ws + WS_CTL) + CW_BAR, F.MISC + 8, F.wave);
    bf16* const XBA = (bf16*)(ws + WS_XBA); bf16* const XBB = (bf16*)(ws + WS_XBB);
    float* const SSA = (float*)(ws + WS_SSA); float* const SSB = (float*)(ws + WS_SSB);
    bf16* const PP = (bf16*)(ws + WS_CST); bf16* const A2 = (bf16*)(ws + WS_BIG);
    const int bx = (int)blockIdx.x; int ts_n = 0; (void)ts_n;
    TSTAMP();

    PREP(100) {
    p0_prologue(F, bar, ts_n);
    GRID_BAR();
    }
#if DBG_STOP >= 1
PREP(1) {
    { pg8::Gemm g{XBA, (const bf16*)(ws + WS_WIN), T, ZW, DM}; pg8::StaticOrder S; S.init(T, ZW, F.G, bx);
#if PROBE_PHASE == 1 && defined(PROBE_VARIANT)
      if (rep_ < PROBE_N) {
#if PROBE_VARIANT == 1
        pg8::EpiNone E0{}; pg8::gemm_phase<pg8::EpiNone, pg8::StaticOrder, true, true>(F.lds, g, S, E0, F.wave);
#elif PROBE_VARIANT == 4
        pg8::EpiNone E0{}; pg8::gemm_phase<pg8::EpiNone, pg8::StaticOrder, false, true>(F.lds, g, S, E0, F.wave);
#elif PROBE_VARIANT == 5
        pg8::EpiNone E0{}; pg8::gemm_phase<pg8::EpiNone, pg8::StaticOrder, true, false>(F.lds, g, S, E0, F.wave);
#elif PROBE_VARIANT == 3
        pg8::EpiZLine E0{P_Z, ZW}; pg8::gemm_phase<pg8::EpiZLine, pg8::StaticOrder, true, true>(F.lds, g, S, E0, F.wave);
#else
        pg8::EpiZ<false> E0{P_Z, ZW, nullptr}; pg8::gemm_phase<pg8::EpiZ<false>, pg8::StaticOrder, true, true>(F.lds, g, S, E0, F.wave);
#endif
      } else
#endif
      { pg8::EpiZ<false> E{P_Z, ZW, karg(F, 7)};
      pg8::gemm_phase<pg8::EpiZ<false>, pg8::StaticOrder, true, true>(F.lds, g, S, E, F.wave); } }
    GRID_BAR();
    }

    PREP(21) { mlA_phase(F); }
#ifdef PROBE_P2CSPLIT
    GRID_BAR();
#endif
    PREP(22) { rg_phase<false>(F); }
    GRID_BAR();
    for (int u = F.vcu; u < 256; u += F.G) mixB_unit(F, u);
    GRID_BAR();
    PREP(41) { mlC_phase(F); }
#ifdef PROBE_P2CSPLIT
    GRID_BAR();
#endif
    PREP(42) { rg_phase<true>(F); }
    GRID_BAR();
#endif
    PREP(99) { if (rep_ > 0) GRID_BAR(); }
#if DBG_STOP >= 3
    if (layer_part<0>(F, bar, ts_n)) return;
    if (layer_part<1>(F, bar, ts_n)) return;
#ifdef PROBE_TA
    GRID_BAR();
    if (blockIdx.x == 0 && threadIdx.x == 0) { const unsigned dt = F.MISC[16 + PROBE_TB] - F.MISC[16 + PROBE_TA]; F.out[0] += floorf((float)dt * (float)(PROBE_TSCALE) * 0.5f) * 2.0f; }
#endif
#endif
}

extern "C" void kernel_launch(void* const* d_in, const int* in_sizes, int n_in, void* d_out, int out_size, void* d_ws, size_t ws_size, hipStream_t stream) {
    static int grid = 0;
    if (grid == 0) {
        if (n_in != 30 || in_sizes[0] != T * DM || out_size != T * DM || ws_size < WS_END) { fprintf(stderr, "kernel_launch: unexpected shapes (n_in %d, in0 %d, out %d, ws %zu < %zu); nothing launched\n", n_in, n_in > 0 ? in_sizes[0] : -1, out_size, ws_size, (size_t)WS_END); grid = -1; return; }
        int dev = 0, cus = 0, per_cu = 0;
        if (hipGetDevice(&dev) != hipSuccess || hipDeviceGetAttribute(&cus, hipDeviceAttributeMultiprocessorCount, dev) != hipSuccess) { fprintf(stderr, "kernel_launch: device query failed\n"); grid = -1; return; }
        if (hipFuncSetAttribute((const void*)hy_fwd, hipFuncAttributeMaxDynamicSharedMemorySize, LDS_BYTES) != hipSuccess) { fprintf(stderr, "kernel_launch: hipFuncSetAttribute failed\n"); grid = -1; return; }
        if (hipOccupancyMaxActiveBlocksPerMultiprocessor(&per_cu, (const void*)hy_fwd, NWAVES * 64, LDS_BYTES) != hipSuccess || per_cu < 1) { fprintf(stderr, "kernel_launch: occupancy query says %d workgroups per CU; nothing launched\n", per_cu); (void)hipGetLastError(); grid = -1; return; }
        grid = cus;
    }
    if (grid < 0) return;
    if (hipMemsetAsync((char*)d_ws + WS_CTL, 0, CTL_ZERO_BYTES, stream) != hipSuccess) { fprintf(stderr, "kernel_launch: hipMemsetAsync failed\n"); return; }
    Args a{};
    for (int i = 0; i < 30; ++i) a.in[i] = d_in[i];
    a.out = (float*)d_out; a.ws = (unsigned char*)d_ws;
    hipLaunchKernelGGL(hy_fwd, dim3(grid), dim3(NWAVES * 64), LDS_BYTES, stream, a);
    const hipError_t le = hipPeekAtLastError();
    if (le != hipSuccess) fprintf(stderr, "kernel_launch: launch failed: %s\n", hipGetErrorName(le));
}
```

```cpp
#include <hip/hip_runtime.h>
#include <cstdio>
#include <cstdint>
#include <cmath>
namespace pg8 {
#define PG8_LAS __attribute__((address_space(3)))
typedef unsigned short bf16_t;
typedef short bf16x8 __attribute__((ext_vector_type(8)));
typedef float f32x4 __attribute__((ext_vector_type(4)));
typedef unsigned u32x4 __attribute__((ext_vector_type(4)));
constexpr int BM = 256, BK = 64, HALF = 128, HTB = HALF * BK * 2  , STAGE_BYTES = 8 * HTB, NXCD = 8, WGM = 8;

__host__ __device__ __forceinline__ int lds_byte(int r, int c) { const int st = (r >> 4) * 2 + (c >> 5), rr = r & 15, cc = c & 31, ob = rr * 64 + cc * 2; return st * 1024 + (ob ^ (((ob >> 9) & 1) << 5)); }
__host__ __device__ __forceinline__ void stage_rc(int b, int& R, int& C) { const int st = b / 1024, sb = b % 1024, swz = sb ^ (((sb >> 9) & 1) << 5); R = (st >> 1) * 16 + swz / 64; C = (st & 1) * 32 + (swz % 64) / 2; }
__host__ __device__ __forceinline__ int perm32(int rho) { const int n = rho >> 4, i = rho & 15; return 8 * (i >> 2) + 4 * n + (i & 3); }

__device__ __forceinline__ int lane_now() { int l; asm volatile("v_mbcnt_lo_u32_b32 %0, -1, 0\n\tv_mbcnt_hi_u32_b32 %0, -1, %0" : "=v"(l)); return l; }

struct Unit { int pm, pn; };
struct Gemm { const bf16_t* A; const bf16_t* Bt; int M, N, K; };

struct StaticOrder {
    int nM, nN, nwg, G, c;
    __host__ __device__ void init(int M, int N, int G_, int c_) { nM = M / BM; nN = N / BM; nwg = nM * nN; G = G_; c = c_; }
    __host__ __device__ bool next(int i, Unit& u) const {
        const long L = (long)i * G + c; if (L >= nwg) return false;
        int wgid = (int)L; { const int q = nwg / NXCD, r = nwg % NXCD, xcd = wgid % NXCD, off = wgid / NXCD; wgid = (xcd < r ? xcd * (q + 1) : r * (q + 1) + (xcd - r) * q) + off; }
        const int nig = WGM * nN, gid = wgid / nig, fm = gid * WGM, gsz = (nM - fm) < WGM ? (nM - fm) : WGM;
        u.pm = fm + ((wgid % nig) % gsz); u.pn = (wgid % nig) / gsz; return true;
    }
    __device__ __forceinline__ void a_ready(const Unit&) const {}
    __device__ __forceinline__ void done(const Unit&) const {}
};

typedef float f32x2_t __attribute__((ext_vector_type(2))); typedef __bf16 bf16x2_t __attribute__((ext_vector_type(2)));
__device__ __forceinline__ unsigned pk2(float lo, float hi) { f32x2_t v = {lo, hi}; bf16x2_t b = __builtin_convertvector(v, bf16x2_t); return __builtin_bit_cast(unsigned, b); }
__device__ __forceinline__ float bflo(unsigned w) { return __uint_as_float(w << 16); }
__device__ __forceinline__ float bfhi(unsigned w) { return __uint_as_float(w & 0xffff0000u); }
__device__ __forceinline__ float fsigmoid(float x) { return __builtin_amdgcn_rcpf(1.0f + __expf(-x)); }
__device__ __forceinline__ float gelu_tanh(float x) { const float t2 = x * (2.3022082f + 0.10294324f * x * x); return x * __builtin_amdgcn_rcpf(1.0f + __builtin_amdgcn_exp2f(-t2)); }
__device__ __forceinline__ u32x4 pk8(const f32x4& a, const f32x4& b) { u32x4 w; w.x = pk2(a[0], a[1]); w.y = pk2(a[2], a[3]); w.z = pk2(b[0], b[1]); w.w = pk2(b[2], b[3]); return w; }
__device__ __forceinline__ float dot4(const f32x4& a) { return (a[0] * a[0] + a[1] * a[1]) + (a[2] * a[2] + a[3] * a[3]); }
__device__ __forceinline__ float sum_fq(float s) {
    { const auto r = __builtin_amdgcn_permlane16_swap(__float_as_uint(s), __float_as_uint(s), false, false); s = __uint_as_float(r[0]) + __uint_as_float(r[1]); }
    { const auto r = __builtin_amdgcn_permlane32_swap(__float_as_uint(s), __float_as_uint(s), false, false); s = __uint_as_float(r[0]) + __uint_as_float(r[1]); }
    return s;
}
__device__ __forceinline__ float row_rstd(const float* ss, int row) {
    const f32x4* p = (const f32x4*)(ss + (size_t)row * 16);
    const f32x4 a = p[0], b = p[1], c = p[2], d = p[3];
    const float s = (((a[0] + a[1]) + (a[2] + a[3])) + ((b[0] + b[1]) + (b[2] + b[3]))) + (((c[0] + c[1]) + (c[2] + c[3])) + ((d[0] + d[1]) + (d[2] + d[3])));
    return rsqrtf(s * (1.0f / 1024.0f) + 1e-6f);
}

__device__ __forceinline__ unsigned dpp_xor1(unsigned v) { return (unsigned)__builtin_amdgcn_update_dpp(0, (int)v, 0xB1, 0xF, 0xF, true); }
template <int N> __device__ __forceinline__ unsigned dpp_ror(unsigned v) { return (unsigned)__builtin_amdgcn_update_dpp(0, (int)v, 0x120 + N, 0xF, 0xF, true); }
__device__ __forceinline__ u32x4 shfl1(const u32x4& v) { u32x4 r; r.x = dpp_xor1(v.x); r.y = dpp_xor1(v.y); r.z = dpp_xor1(v.z); r.w = dpp_xor1(v.w); return r; }
__device__ __forceinline__ void xchg_out(const u32x4& X0, const u32x4& X1, bool odd, u32x4& PA, u32x4& PB) { const u32x4 recv = shfl1(odd ? X0 : X1); PA = odd ? recv : X0; PB = odd ? X1 : recv; }
__device__ __forceinline__ void xchg_in(const u32x4& LA, const u32x4& LB, bool odd, u32x4& X0, u32x4& X1) { const u32x4 recv = shfl1(odd ? LA : LB); X0 = odd ? recv : LA; X1 = odd ? LB : recv; }
__device__ __forceinline__ void st16(void* p, const u32x4& v) { __builtin_nontemporal_store(v, (u32x4*)p); }
__device__ __forceinline__ u32x4 f2u(const f32x4& v) { return __builtin_bit_cast(u32x4, v); }
__device__ __forceinline__ f32x4 u2f(const u32x4& v) { return __builtin_bit_cast(f32x4, v); }
__device__ __forceinline__ void unpack8(const u32x4& w, f32x4& a, f32x4& b) { a[0] = bflo(w.x); a[1] = bfhi(w.x); a[2] = bflo(w.y); a[3] = bfhi(w.y); b[0] = bflo(w.z); b[1] = bfhi(w.z); b[2] = bflo(w.w); b[3] = bfhi(w.w); }
__device__ __forceinline__ void store_bf16_lines(bf16_t* base, int ld, int rowE, int fr, int fq, const u32x4& X0, const u32x4& X1) {
    const bool odd = fr & 1; u32x4 PA, PB; xchg_out(X0, X1, odd, PA, PB); const int c8 = ((fr & 1) * 4 + fq) * 8;
    st16(base + (size_t)rowE * ld + c8, PA); st16(base + (size_t)(rowE + 1) * ld + c8, PB);
}
__device__ __forceinline__ void load_bf16_lines(const bf16_t* base, int ld, int rowE, int fr, int fq, u32x4& X0, u32x4& X1) {
    const bool odd = fr & 1; const int c8 = ((fr & 1) * 4 + fq) * 8;
    const u32x4 LA = *(const u32x4*)(base + (size_t)rowE * ld + c8), LB = *(const u32x4*)(base + (size_t)(rowE + 1) * ld + c8); xchg_in(LA, LB, odd, X0, X1);
}
__device__ __forceinline__ void store_f32_lines(float* base, int ld, int rowE, int fr, int fq, const f32x4& N0, const f32x4& N1) {
    const bool odd = fr & 1; u32x4 PA, PB; xchg_out(f2u(N0), f2u(N1), odd, PA, PB); const int c4 = (2 * fq + (fr & 1)) * 4;
    st16(base + (size_t)rowE * ld + c4, PA); st16(base + (size_t)(rowE + 1) * ld + c4, PB);
}
__device__ __forceinline__ void load_f32_lines(const float* base, int ld, int rowE, int fr, int fq, f32x4& N0, f32x4& N1) {
    const bool odd = fr & 1; const int c4 = (2 * fq + (fr & 1)) * 4;
    const u32x4 LA = *(const u32x4*)(base + (size_t)rowE * ld + c4), LB = *(const u32x4*)(base + (size_t)(rowE + 1) * ld + c4); u32x4 X0, X1; xchg_in(LA, LB, odd, X0, X1); N0 = u2f(X0); N1 = u2f(X1);
}
__device__ __forceinline__ size_t pair_off(int LD, int row, int colw, int fq) { return (size_t)(row >> 1) * (size_t)(2 * LD) + (size_t)((colw >> 6) * 128 + (row & 1) * 32 + 8 * fq); }

__device__ __forceinline__ f32x4 rstd_ld(const float* ss, int row, int fq) { return *(const f32x4*)(ss + (size_t)row * 16 + 4 * fq); }
__device__ __forceinline__ float rstd_fin(const f32x4& p) { float s = (p[0] + p[1]) + (p[2] + p[3]); s = sum_fq(s); return rsqrtf(s * (1.0f / 1024.0f) + 1e-6f); }

template <bool OPAIR> struct EpiZ {
    static constexpr bool PERM = true, AFTER_DRAIN = false, APERM = false;
    bf16_t* O; int ldc; const float* bias;
    __device__ __forceinline__ void operator()(const f32x4 (&acc)[2][2][4][2], const Unit& u, int wr, int wc, int fr, int fq) const {
        const int colw = u.pn * BM + 64 * wc;
        f32x4 bv[2][2];
#pragma unroll
        for (int bj = 0; bj < 2; ++bj)
#pragma unroll
            for (int n = 0; n < 2; ++n) bv[bj][n] = bias ? *(const f32x4*)(bias + colw + 32 * bj + 8 * fq + 4 * n) : (f32x4){0.f, 0.f, 0.f, 0.f};
#pragma unroll
        for (int ai = 0; ai < 2; ++ai) {
#pragma unroll
            for (int m = 0; m < 4; ++m) { const int rowE = u.pm * BM + ai * HALF + wr * 64 + m * 16 + (fr & ~1);
                const u32x4 X0 = pk8(acc[ai][0][m][0] + bv[0][0], acc[ai][0][m][1] + bv[0][1]), X1 = pk8(acc[ai][1][m][0] + bv[1][0], acc[ai][1][m][1] + bv[1][1]);
                if (OPAIR) { bf16_t* o = O + pair_off(ldc, rowE + (fr & 1), colw, fq); st16(o, X0); st16(o + 64, X1); }
                else store_bf16_lines(O + colw, ldc, rowE, fr, fq, X0, X1); } }
    }
};

template <bool SRCF32, bool AP> struct EpiRes {
    static constexpr bool PERM = true, AFTER_DRAIN = false, APERM = AP;
    const void* src; bf16_t* xb; float* sso;
    __device__ __forceinline__ void operator()(const f32x4 (&acc)[2][2][4][2], const Unit& u, int wr, int wc, int fr, int fq) const {
        const int colw = u.pn * BM + 64 * wc; const bool odd = fr & 1;
#pragma unroll
        for (int ah = 0; ah < (SRCF32 ? 4 : 2); ++ah) { const int ai = SRCF32 ? (ah >> 1) : ah, m0 = SRCF32 ? (ah & 1) * 2 : 0, m1 = SRCF32 ? m0 + 2 : 4;
            u32x4 LA[4][2], LB[4][2];
#pragma unroll
            for (int m = m0; m < m1; ++m) { const int rowE = u.pm * BM + ai * HALF + wr * 64 + m * 16 + (fr & ~1);
                if (SRCF32) { const int c4 = (2 * fq + (fr & 1)) * 4;
#pragma unroll
                    for (int bj = 0; bj < 2; ++bj) { const float* b = (const float*)src + colw + 32 * bj + c4; LA[m][bj] = *(const u32x4*)(b + (size_t)rowE * 1024); LB[m][bj] = *(const u32x4*)(b + (size_t)(rowE + 1) * 1024); } }
                else { const bf16_t* b = (const bf16_t*)src + pair_off(1024, rowE + (fr & 1), colw, fq); LA[m][0] = *(const u32x4*)b; LB[m][0] = *(const u32x4*)(b + 64); } }
#pragma unroll
            for (int m = m0; m < m1; ++m) { const int rowE = u.pm * BM + ai * HALF + wr * 64 + m * 16 + (fr & ~1), row = rowE + (fr & 1);
                f32x4 r[2][2];
                if (SRCF32) {
#pragma unroll
                    for (int bj = 0; bj < 2; ++bj) { u32x4 X0, X1; xchg_in(LA[m][bj], LB[m][bj], odd, X0, X1); r[bj][0] = u2f(X0); r[bj][1] = u2f(X1); } }
                else { unpack8(LA[m][0], r[0][0], r[0][1]); unpack8(LB[m][0], r[1][0], r[1][1]); }
                float sq = 0.f; f32x4 v[2][2];
#pragma unroll
                for (int bj = 0; bj < 2; ++bj)
#pragma unroll
                    for (int n = 0; n < 2; ++n) { v[bj][n] = r[bj][n] + acc[ai][bj][m][n]; sq += dot4(v[bj][n]); }
                { bf16_t* o = xb + pair_off(1024, row, colw, fq); st16(o, pk8(v[0][0], v[0][1])); st16(o + 64, pk8(v[1][0], v[1][1])); }
                sq = sum_fq(sq);
                sso[(size_t)row * 16 + 4 * u.pn + wc] = sq; } }
    }
};

template <bool FINAL> struct EpiPle {
    static constexpr bool PERM = true, AFTER_DRAIN = false, APERM = true;
    const float* ss; const bf16_t* pp; const bf16_t* xin; bf16_t* xb; float* sso; float* out;
    __device__ __forceinline__ void operator()(const f32x4 (&acc)[2][2][4][2], const Unit& u, int wr, int wc, int fr, int fq) const {
        const int colw = u.pn * BM + 64 * wc;
#pragma unroll
        for (int ah = 0; ah < 4; ++ah) { const int ai = ah >> 1, m0 = (ah & 1) * 2;
            u32x4 XA[4], XB[4], PA[4], PB[4]; f32x4 rp[4];
#pragma unroll
            for (int m = m0; m < m0 + 2; ++m) { const int rowE = u.pm * BM + ai * HALF + wr * 64 + m * 16 + (fr & ~1); const size_t o = pair_off(1024, rowE + (fr & 1), colw, fq);
                rp[m] = rstd_ld(ss, rowE + (fr & 1), fq);
                XA[m] = *(const u32x4*)(xin + o); XB[m] = *(const u32x4*)(xin + o + 64); PA[m] = *(const u32x4*)(pp + o); PB[m] = *(const u32x4*)(pp + o + 64); }
#pragma unroll
            for (int m = m0; m < m0 + 2; ++m) { const int rowE = u.pm * BM + ai * HALF + wr * 64 + m * 16 + (fr & ~1), row = rowE + (fr & 1); const float rs = rstd_fin(rp[m]);
                f32x4 r[2][2], p[2][2];
                unpack8(XA[m], r[0][0], r[0][1]); unpack8(XB[m], r[1][0], r[1][1]);
                unpack8(PA[m], p[0][0], p[0][1]); unpack8(PB[m], p[1][0], p[1][1]);
                float sq = 0.f; f32x4 v[2][2];
#pragma unroll
                for (int bj = 0; bj < 2; ++bj)
#pragma unroll
                    for (int n = 0; n < 2; ++n) { const f32x4 a = acc[ai][bj][m][n] * rs;
#pragma unroll
                        for (int e = 0; e < 4; ++e) v[bj][n][e] = r[bj][n][e] + fsigmoid(a[e]) * p[bj][n][e];
                        sq += dot4(v[bj][n]); }
                if (FINAL) { store_f32_lines(out + colw, 1024, rowE, fr, fq, v[0][0], v[0][1]); store_f32_lines(out + colw + 32, 1024, rowE, fr, fq, v[1][0], v[1][1]); }
                else { { bf16_t* o = xb + pair_off(1024, row, colw, fq); st16(o, pk8(v[0][0], v[0][1])); st16(o + 64, pk8(v[1][0], v[1][1])); }
                    sq = sum_fq(sq);
                    sso[(size_t)row * 16 + 4 * u.pn + wc] = sq; } } }
    }
};

struct EpiQkv {
    static constexpr bool PERM = true, AFTER_DRAIN = false, APERM = true;
    const float* ss; const float* rope; const float* qn; const float* kn; bf16_t* Q; bf16_t* K; bf16_t* V;
    __device__ __forceinline__ void operator()(const f32x4 (&acc)[2][2][4][2], const Unit& u, int wr, int wc, int fr, int fq) const {
        if (u.pn == 5) {
#pragma unroll
            for (int ai = 0; ai < 2; ++ai)
#pragma unroll
                for (int m = 0; m < 4; ++m) { const int rowE = u.pm * BM + ai * HALF + wr * 64 + m * 16 + (fr & ~1), row = rowE + (fr & 1); const float rs = rstd_fin(rstd_ld(ss, row, fq));
                    store_bf16_lines(V + 64 * wc, 256, rowE, fr, fq, pk8(acc[ai][0][m][0] * rs, acc[ai][0][m][1] * rs), pk8(acc[ai][1][m][0] * rs, acc[ai][1][m][1] * rs)); }
            return;
        }
        const bool isq = u.pn < 4; const float* gn = isq ? qn : kn; const float osc = isq ? 0.125f * 1.4426950408889634f : 1.0f;
        bf16_t* dst = isq ? Q + (size_t)(64 * (4 * u.pn + wc)) : K + (size_t)(64 * wc); const int ldd = isq ? 1024 : 256;
        f32x4 g[2][2];
#pragma unroll
        for (int bj = 0; bj < 2; ++bj)
#pragma unroll
            for (int n = 0; n < 2; ++n) g[bj][n] = *(const f32x4*)(gn + 32 * bj + 8 * fq + 4 * n);
#pragma unroll
        for (int ah = 0; ah < 4; ++ah) { const int ai = ah >> 1, m0 = (ah & 1) * 2;
          f32x4 rp[4], csn[4][4];
#pragma unroll
          for (int m = m0; m < m0 + 2; ++m) { const int row = u.pm * BM + ai * HALF + wr * 64 + m * 16 + fr; rp[m] = rstd_ld(ss, row, fq); const float* rq = rope + (size_t)row * 64 + 8 * fq;
              csn[m][0] = *(const f32x4*)rq; csn[m][1] = *(const f32x4*)(rq + 4); csn[m][2] = *(const f32x4*)(rq + 32); csn[m][3] = *(const f32x4*)(rq + 36); }
#pragma unroll
            for (int m = m0; m < m0 + 2; ++m) { const int rowE = u.pm * BM + ai * HALF + wr * 64 + m * 16 + (fr & ~1); const float rs = rstd_fin(rp[m]);
                f32x4 v[2][2]; float sq = 0.f;
#pragma unroll
                for (int bj = 0; bj < 2; ++bj)
#pragma unroll
                    for (int n = 0; n < 2; ++n) { v[bj][n] = acc[ai][bj][m][n] * rs; sq += dot4(v[bj][n]); }
                sq = sum_fq(sq);
                const float hr = rsqrtf(sq * (1.0f / 64.0f) + 1e-6f);
#pragma unroll
                for (int bj = 0; bj < 2; ++bj)
#pragma unroll
                    for (int n = 0; n < 2; ++n) v[bj][n] = v[bj][n] * hr * g[bj][n];
                f32x4 o[2][2];
#pragma unroll
                for (int n = 0; n < 2; ++n) { const f32x4 cs = csn[m][n], sn = csn[m][2 + n];
                    o[0][n] = (v[0][n] * cs - v[1][n] * sn) * osc; o[1][n] = (v[1][n] * cs + v[0][n] * sn) * osc; }
                store_bf16_lines(dst, ldd, rowE, fr, fq, pk8(o[0][0], o[0][1]), pk8(o[1][0], o[1][1])); } }
    }
};

__device__ __forceinline__ void conv_taps_shr(f32x4& y, const f32x4& g, const f32x4& w1, const f32x4& w0) {
    float y0 = y[0], y1 = y[1], y2 = y[2], y3 = y[3];
    asm("s_nop 1\n\t"
        "v_fmac_f32_dpp %0, %4, %8 row_shr:1 row_mask:0xf bank_mask:0xf\n\t"
        "v_fmac_f32_dpp %1, %5, %9 row_shr:1 row_mask:0xf bank_mask:0xf\n\t"
        "v_fmac_f32_dpp %2, %6, %10 row_shr:1 row_mask:0xf bank_mask:0xf\n\t"
        "v_fmac_f32_dpp %3, %7, %11 row_shr:1 row_mask:0xf bank_mask:0xf\n\t"
        "v_fmac_f32_dpp %0, %4, %12 row_shr:2 row_mask:0xf bank_mask:0xf\n\t"
        "v_fmac_f32_dpp %1, %5, %13 row_shr:2 row_mask:0xf bank_mask:0xf\n\t"
        "v_fmac_f32_dpp %2, %6, %14 row_shr:2 row_mask:0xf bank_mask:0xf\n\t"
        "v_fmac_f32_dpp %3, %7, %15 row_shr:2 row_mask:0xf bank_mask:0xf"
        : "+v"(y0), "+v"(y1), "+v"(y2), "+v"(y3)
        : "v"(g[0]), "v"(g[1]), "v"(g[2]), "v"(g[3]), "v"(w1[0]), "v"(w1[1]), "v"(w1[2]), "v"(w1[3]), "v"(w0[0]), "v"(w0[1]), "v"(w0[2]), "v"(w0[3]));
    y[0] = y0; y[1] = y1; y[2] = y2; y[3] = y3;
}
__device__ __forceinline__ void conv_taps_ror(f32x4& y, const f32x4& gp, const f32x4& w1m, const f32x4& w0m) {
    float y0 = y[0], y1 = y[1], y2 = y[2], y3 = y[3];
    asm("s_nop 1\n\t"
        "v_fmac_f32_dpp %0, %4, %8 row_ror:1 row_mask:0xf bank_mask:0xf\n\t"
        "v_fmac_f32_dpp %1, %5, %9 row_ror:1 row_mask:0xf bank_mask:0xf\n\t"
        "v_fmac_f32_dpp %2, %6, %10 row_ror:1 row_mask:0xf bank_mask:0xf\n\t"
        "v_fmac_f32_dpp %3, %7, %11 row_ror:1 row_mask:0xf bank_mask:0xf\n\t"
        "v_fmac_f32_dpp %0, %4, %12 row_ror:2 row_mask:0xf bank_mask:0xf\n\t"
        "v_fmac_f32_dpp %1, %5, %13 row_ror:2 row_mask:0xf bank_mask:0xf\n\t"
        "v_fmac_f32_dpp %2, %6, %14 row_ror:2 row_mask:0xf bank_mask:0xf\n\t"
        "v_fmac_f32_dpp %3, %7, %15 row_ror:2 row_mask:0xf bank_mask:0xf"
        : "+v"(y0), "+v"(y1), "+v"(y2), "+v"(y3)
        : "v"(gp[0]), "v"(gp[1]), "v"(gp[2]), "v"(gp[3]), "v"(w1m[0]), "v"(w1m[1]), "v"(w1m[2]), "v"(w1m[3]), "v"(w0m[0]), "v"(w0m[1]), "v"(w0m[2]), "v"(w0m[3]));
    y[0] = y0; y[1] = y1; y[2] = y2; y[3] = y3;
}
template <int PV> struct EpiUpT {
    static constexpr bool PERM = true, AFTER_DRAIN = false, APERM = true;
    const float* ss; const float* cw; const float* cb; bf16_t* A2; bf16_t* GH; bf16_t* UH; bf16_t* GT;
    __device__ __forceinline__ void operator()(const f32x4 (&acc)[2][2][4][2], const Unit& u, int wr, int wc, int fr, int fq) const {
        const int ch0 = u.pn * 128 + wc * 32 + 8 * fq;
        f32x4 w2[2], bb[2], w1[2], w0[2], w1m[2], w0m[2];
#pragma unroll
        for (int n = 0; n < 2; ++n) { const f32x4 z4 = {0.f, 0.f, 0.f, 0.f};
            w0[n] = *(const f32x4*)(cw + ch0 + 4 * n); w1[n] = *(const f32x4*)(cw + 3072 + ch0 + 4 * n); w2[n] = *(const f32x4*)(cw + 6144 + ch0 + 4 * n); bb[n] = *(const f32x4*)(cb + ch0 + 4 * n);
            w1m[n] = fr >= 1 ? z4 : w1[n]; w0m[n] = fr >= 2 ? z4 : w0[n]; }
        float c1 = 0.10294324f, c0 = 2.3022082f, c_one = 1.0f; asm("" : "+s"(c1), "+s"(c0), "+s"(c_one));
        const f32x4 C1 = {c1, c1, c1, c1}, C0 = {c0, c0, c0, c0}, ONE = {c_one, c_one, c_one, c_one};
        f32x4 rpu[2][4];
#pragma unroll
        for (int ai = 0; ai < 2; ++ai)
#pragma unroll
            for (int m = 0; m < 4; ++m) rpu[ai][m] = (PV == 3 || PV == 5) ? (f32x4){1.f, 1.f, 1.f, 1.f} : rstd_ld(ss, u.pm * BM + ai * HALF + wr * 64 + m * 16 + fr, fq);
#pragma unroll
        for (int ai = 0; ai < 2; ++ai) {
            const int grp = 4 * u.pm + 2 * ai + wr;
            f32x4 gp[2] = {{0.f, 0.f, 0.f, 0.f}, {0.f, 0.f, 0.f, 0.f}};
#pragma unroll
            for (int m = 0; m < 4; ++m) { const int row = u.pm * BM + ai * HALF + wr * 64 + m * 16 + fr; const float rs = (PV == 3 || PV == 5) ? rpu[ai][m][0] : rstd_fin(rpu[ai][m]);
                f32x4 g[2], uu[2], o[2];
#pragma unroll
                for (int n = 0; n < 2; ++n) { g[n] = acc[ai][0][m][n] * rs; uu[n] = acc[ai][1][m][n] * rs;
                    f32x4 y = bb[n] + w2[n] * g[n];
                    conv_taps_shr(y, g[n], w1[n], w0[n]);
                    if (m > 0) conv_taps_ror(y, gp[n], w1m[n], w0m[n]);
                    const f32x4 t2 = y * (y * y * C1 + C0); f32x4 ex;
#pragma unroll
                    for (int e = 0; e < 4; ++e) ex[e] = (PV == 2 || PV == 5) ? -t2[e] : __builtin_amdgcn_exp2f(-t2[e]);
                    const f32x4 den = ex + ONE; f32x4 rc;
#pragma unroll
                    for (int e = 0; e < 4; ++e) rc[e] = (PV == 2 || PV == 5) ? den[e] : __builtin_amdgcn_rcpf(den[e]);
                    o[n] = y * rc * uu[n]; }
                const bool head = (m == 0) && (fr < 2);
                if (PV == 1 || PV == 5) { const u32x4 q0 = pk8(o[0], o[1]), q1 = pk8(g[0], g[1]), q2 = pk8(uu[0], uu[1]); asm volatile("" :: "v"(q0), "v"(q1), "v"(q2)); } else {
                if (!head) { u32x4* dst = (u32x4*)(A2 + (size_t)(row >> 1) * 6144 + ((ch0 >> 6) * 128 + ((ch0 >> 5) & 1) * 64 + (row & 1) * 32 + (ch0 & 31))); if (PV == 6) *dst = pk8(o[0], o[1]); else st16(dst, pk8(o[0], o[1])); }
                else { const size_t so = ((size_t)grp * 2 + fr) * 3072 + ch0; *(u32x4*)(GH + so) = pk8(g[0], g[1]); *(u32x4*)(UH + so) = pk8(uu[0], uu[1]); }
                if (m == 3 && fr >= 14) { const size_t so = ((size_t)grp * 2 + (fr - 14)) * 3072 + ch0; *(u32x4*)(GT + so) = pk8(g[0], g[1]); } }
                gp[0] = g[0]; gp[1] = g[1]; }
        }
    }
};

typedef EpiUpT<0> EpiUp;

struct EpiNone {
    static constexpr bool PERM = true, AFTER_DRAIN = false, APERM = false;
    __device__ __forceinline__ void operator()(const f32x4 (&acc)[2][2][4][2], const Unit& u, int wr, int wc, int fr, int fq) const {
#pragma unroll
        for (int ai = 0; ai < 2; ++ai)
#pragma unroll
            for (int m = 0; m < 4; ++m)
#pragma unroll
                for (int bj = 0; bj < 2; ++bj) { asm volatile("" :: "v"(acc[ai][bj][m][0]), "v"(acc[ai][bj][m][1])); }
    }
};

struct EpiZLine {
    static constexpr bool PERM = true, AFTER_DRAIN = false, APERM = false;
    bf16_t* O; int ldc;
    __device__ __forceinline__ void operator()(const f32x4 (&acc)[2][2][4][2], const Unit& u, int wr, int wc, int fr, int fq) const {
        const int col0 = u.pn * BM + 64 * wc + ((fr & 1) * 4 + fq) * 8;
#pragma unroll
        for (int ai = 0; ai < 2; ++ai)
#pragma unroll
            for (int m = 0; m < 4; ++m) {
#pragma unroll
                for (int bj = 0; bj < 2; ++bj) { const int row = u.pm * BM + ai * HALF + wr * 64 + m * 16 + (fr & ~1) + bj;
                    *(u32x4*)(O + (size_t)row * ldc + col0) = pk8(acc[ai][bj][m][0], acc[ai][bj][m][1]); } }
    }
};
template <class Epi, class Sched, bool ALIGN_EPI = false, bool SP2 = false>
__device__ __forceinline__ void gemm_phase(PG8_LAS unsigned char* lds, const Gemm g, const Sched& S, const Epi& E, int wave_id) {
    int tid_ = lane_now() + 64 * wave_id;
    const int tid = tid_, wid = __builtin_amdgcn_readfirstlane(tid >> 6), lane = tid & 63, wr = wid >> 2, wc = wid & 3, fr = lane & 15, fq = lane >> 4;
    const int K = g.K, nt = K / BK;
    unsigned voffA[2], voffB[2];
#pragma unroll
    for (int i = 0; i < 2; ++i) { int R, C; stage_rc(tid * 16 + i * 8192, R, C); const int Rb = Epi::PERM ? ((R & ~31) + perm32(R & 31)) : R;
        voffA[i] = Epi::APERM ? (unsigned)((R >> 1) * (4 * K) + ((C >> 5) & 1) * 128 + (R & 1) * 64 + (C & 31) * 2) : (unsigned)(R * K + C) * 2u;
        voffB[i] = (unsigned)((Rb >> 1) * (4 * K) + ((C >> 5) & 1) * 128 + (Rb & 1) * 64 + (C & 31) * 2); }
    const size_t kstepA = Epi::APERM ? (size_t)(BK * 4) : (size_t)(BK * 2), kstepB = (size_t)(BK * 4);
    const size_t hstep = (size_t)HALF * K * 2;
    const size_t tstep = 2 * hstep;
    const unsigned ldsw = (unsigned)wid * 1024u;
    const int aoff = lds_byte(wr * 64 + fr, fq * 8), boff = lds_byte(wc * 32 + fr, fq * 8);
#define PG8_SA(b, h) (((b) * 2 + (h)) * HTB)
#define PG8_SB(b, h) ((4 + (b) * 2 + (h)) * HTB)
#define PG8_STAGE(bufoff, gbase, voff) do { _Pragma("unroll") for (int _i = 0; _i < 2; ++_i) \
        __builtin_amdgcn_global_load_lds((const unsigned*)((const char*)(gbase) + (voff)[_i]), (PG8_LAS unsigned*)(lds + (bufoff) + ldsw + _i * 8192), 16, 0, 0); } while (0)
#define PG8_LDA(dst, b, h) do { _Pragma("unroll") for (int m = 0; m < 4; ++m) _Pragma("unroll") for (int k = 0; k < 2; ++k) dst[m][k] = *(const PG8_LAS bf16x8*)(lds + PG8_SA(b, h) + aoff + m * 2048 + k * 1024); } while (0)
#define PG8_LDB(dst, b, h) do { _Pragma("unroll") for (int n = 0; n < 2; ++n) _Pragma("unroll") for (int k = 0; k < 2; ++k) dst[n][k] = *(const PG8_LAS bf16x8*)(lds + PG8_SB(b, h) + boff + n * 2048 + k * 1024); } while (0)
#define PG8_MMA(ai, bj, At, Bt) do { __builtin_amdgcn_s_setprio(1); _Pragma("unroll") for (int m = 0; m < 4; ++m) _Pragma("unroll") for (int n = 0; n < 2; ++n) _Pragma("unroll") for (int k = 0; k < 2; ++k) \
        acc[ai][bj][m][n] = __builtin_amdgcn_mfma_f32_16x16x32_bf16(Bt[n][k], At[m][k], acc[ai][bj][m][n], 0, 0, 0); __builtin_amdgcn_s_setprio(0); } while (0)
#define PG8_WAIT_V(n) asm volatile("s_waitcnt vmcnt(" #n ")" ::: "memory")
#define PG8_WAIT_L(n) asm volatile("s_waitcnt lgkmcnt(" #n ")" ::: "memory")
#define PG8_BAR __builtin_amdgcn_s_barrier()
#define PG8_SCHED __builtin_amdgcn_sched_barrier(0)
    Unit cur, nxt; int ui = 0;
    if (!S.next(0, cur)) return;
    f32x4 acc[2][2][4][2];
#pragma unroll
    for (int a = 0; a < 2; ++a)
#pragma unroll
        for (int b = 0; b < 2; ++b)
#pragma unroll
            for (int m = 0; m < 4; ++m)
#pragma unroll
                for (int n = 0; n < 2; ++n) acc[a][b][m][n] = (f32x4){0.f, 0.f, 0.f, 0.f};
    bf16x8 At[4][2], B0[2][2], B1[2][2];
    const char* cA = (const char*)g.A + (size_t)cur.pm * tstep; const char* cB = (const char*)g.Bt + (size_t)cur.pn * tstep;
    S.a_ready(cur);
    if constexpr (SP2) {
        PG8_STAGE(PG8_SB(0, 0), cB, voffB); PG8_STAGE(PG8_SB(0, 1), cB + hstep, voffB); PG8_STAGE(PG8_SA(0, 0), cA, voffA); PG8_STAGE(PG8_SA(0, 1), cA + hstep, voffA);
        if (wr == 1) PG8_BAR;
        PG8_WAIT_V(2); PG8_BAR;
        PG8_STAGE(PG8_SB(1, 0), cB + kstepB, voffB); PG8_STAGE(PG8_SA(1, 0), cA + kstepA, voffA); PG8_STAGE(PG8_SB(1, 1), cB + hstep + kstepB, voffB);
        PG8_WAIT_V(6); PG8_BAR;
    } else {
        PG8_STAGE(PG8_SB(0, 0), cB, voffB); PG8_STAGE(PG8_SA(0, 0), cA, voffA); PG8_STAGE(PG8_SB(0, 1), cB + hstep, voffB); PG8_STAGE(PG8_SA(0, 1), cA + hstep, voffA);
        if (wr == 1) PG8_BAR;
        PG8_WAIT_V(4); PG8_BAR;
        PG8_STAGE(PG8_SB(1, 0), cB + kstepB, voffB); PG8_STAGE(PG8_SA(1, 0), cA + kstepA, voffA); PG8_STAGE(PG8_SB(1, 1), cB + hstep + kstepB, voffB);
        PG8_WAIT_V(6); PG8_BAR;
    }
    for (;;) {
        const bool has_next = S.next(ui + 1, nxt);
        const char* nA = has_next ? (const char*)g.A + (size_t)nxt.pm * tstep : cA; const char* nB = has_next ? (const char*)g.Bt + (size_t)nxt.pn * tstep : cB;
        for (int t = 0; t < nt; t += 2) {
            const bool last = (t == nt - 2);
            const char* a1 = cA + (size_t)(t + 1) * kstepA;
            const char* a2 = last ? nA : cA + (size_t)(t + 2) * kstepA; const char* b2 = last ? nB : cB + (size_t)(t + 2) * kstepB;
            const char* a3 = a2 + kstepA; const char* b3 = b2 + kstepB;
            if (last && has_next) S.a_ready(nxt);
            if constexpr (SP2) {
            PG8_LDB(B0, 0, 0); PG8_LDB(B1, 0, 1); PG8_SCHED; PG8_LDA(At, 0, 0); PG8_STAGE(PG8_SA(1, 1), a1 + hstep, voffA);
            PG8_WAIT_V(8); PG8_WAIT_L(0); PG8_BAR; PG8_MMA(0, 0, At, B0); PG8_MMA(0, 1, At, B1); PG8_BAR; PG8_SCHED;
            PG8_LDA(At, 0, 1); PG8_STAGE(PG8_SB(0, 0), b2, voffB); PG8_STAGE(PG8_SB(0, 1), b2 + hstep, voffB); PG8_STAGE(PG8_SA(0, 0), a2, voffA);
            PG8_WAIT_V(8); PG8_WAIT_L(0); PG8_BAR; PG8_MMA(1, 0, At, B0); PG8_MMA(1, 1, At, B1); PG8_BAR; PG8_SCHED;
            PG8_LDB(B0, 1, 0); PG8_LDB(B1, 1, 1); PG8_SCHED; PG8_LDA(At, 1, 0); PG8_STAGE(PG8_SA(0, 1), a2 + hstep, voffA);
            PG8_WAIT_V(8); PG8_WAIT_L(0); PG8_BAR; PG8_MMA(0, 0, At, B0); PG8_MMA(0, 1, At, B1); PG8_BAR; PG8_SCHED;
            PG8_LDA(At, 1, 1); PG8_STAGE(PG8_SB(1, 0), b3, voffB); PG8_STAGE(PG8_SB(1, 1), b3 + hstep, voffB); PG8_STAGE(PG8_SA(1, 0), a3, voffA);
            PG8_WAIT_V(8); PG8_WAIT_L(0); PG8_BAR; PG8_MMA(1, 0, At, B0); PG8_MMA(1, 1, At, B1); PG8_BAR; PG8_SCHED;
            } else {
            PG8_LDB(B0, 0, 0); PG8_SCHED; PG8_LDA(At, 0, 0); PG8_STAGE(PG8_SA(1, 1), a1 + hstep, voffA);
            PG8_WAIT_L(8); PG8_BAR; PG8_WAIT_L(0); PG8_MMA(0, 0, At, B0); PG8_BAR; PG8_SCHED;
            PG8_LDB(B1, 0, 1); PG8_STAGE(PG8_SB(0, 0), b2, voffB);
            PG8_BAR; PG8_WAIT_L(0); PG8_MMA(0, 1, At, B1); PG8_BAR;
            PG8_LDA(At, 0, 1); PG8_STAGE(PG8_SA(0, 0), a2, voffA);
            PG8_BAR; PG8_WAIT_L(0); PG8_MMA(1, 0, At, B0); PG8_BAR; PG8_SCHED;
            PG8_STAGE(PG8_SB(0, 1), b2 + hstep, voffB);
            PG8_WAIT_V(6); PG8_BAR; PG8_MMA(1, 1, At, B1); PG8_BAR;
            PG8_LDB(B0, 1, 0); PG8_SCHED; PG8_LDA(At, 1, 0); PG8_STAGE(PG8_SA(0, 1), a2 + hstep, voffA);
            PG8_WAIT_L(8); PG8_BAR; PG8_WAIT_L(0); PG8_MMA(0, 0, At, B0); PG8_BAR; PG8_SCHED;
            PG8_LDB(B1, 1, 1); PG8_STAGE(PG8_SB(1, 0), b3, voffB);
            PG8_BAR; PG8_WAIT_L(0); PG8_MMA(0, 1, At, B1); PG8_BAR;
            PG8_LDA(At, 1, 1); PG8_STAGE(PG8_SA(1, 0), a3, voffA);
            PG8_BAR; PG8_WAIT_L(0); PG8_MMA(1, 0, At, B0); PG8_BAR; PG8_SCHED;
            PG8_STAGE(PG8_SB(1, 1), b3 + hstep, voffB);
            PG8_WAIT_V(6); PG8_BAR; PG8_MMA(1, 1, At, B1); PG8_BAR;
            }
        }
        if constexpr (ALIGN_EPI) { if (wr == 0) PG8_BAR; }
        if constexpr (!Epi::AFTER_DRAIN) { E(acc, cur, wr, wc, fr, fq); S.done(cur); }
        if (!has_next) break;
#pragma unroll
        for (int a = 0; a < 2; ++a)
#pragma unroll
            for (int b = 0; b < 2; ++b)
#pragma unroll
                for (int m = 0; m < 4; ++m)
#pragma unroll
                    for (int n = 0; n < 2; ++n) acc[a][b][m][n] = (f32x4){0.f, 0.f, 0.f, 0.f};
        cur = nxt; cA = nA; cB = nB; ++ui;
        if constexpr (ALIGN_EPI) { if (wr == 1) PG8_BAR; }
    }
    PG8_WAIT_V(0);
    if constexpr (!ALIGN_EPI) { if (wr == 0) PG8_BAR; }
    PG8_BAR;
    if constexpr (Epi::AFTER_DRAIN) { E.fused(acc, cur, wr, wc, fr, fq, lds, wid, lane); S.done(cur); }
#undef PG8_SA
#undef PG8_SB
#undef PG8_STAGE
#undef PG8_LDA
#undef PG8_LDB
#undef PG8_MMA
#undef PG8_WAIT_V
#undef PG8_WAIT_L
#undef PG8_BAR
#undef PG8_SCHED
}
}

constexpr int NWAVES = 8;
constexpr int NB = 8, SEQ = 4096, T = NB * SEQ, DM = 1024, ZW = 3072, FFD = 3072, HYIN = 3080;
#ifndef PROBE_PHASE
#define PROBE_PHASE 0
#define PROBE_N 0
#endif
#define PREP(id) for (int rep_ = 0; rep_ < 1 + ((PROBE_PHASE == (id)) ? PROBE_N : 0); ++rep_)
#ifdef PROBE_TA
#ifndef PROBE_TOFF
#define PROBE_TOFF 0
#endif
#define TSTAMP() do { if (blockIdx.x == 0 && threadIdx.x == 0) { F.MISC[16 + ts_n] = (unsigned)__builtin_amdgcn_s_memrealtime(); } ++ts_n; } while (0)
#else
#define TSTAMP() do { } while (0)
#endif
#ifndef DBG_STOP
#define DBG_STOP 99
#endif

constexpr size_t MiB = 1u << 20;
constexpr size_t WS_CTL = 0, CTL_ZERO_BYTES = 1 * MiB;
constexpr size_t WS_WIN = 2 * MiB, WS_WOUT0 = 8 * MiB, WS_WUP0 = 10 * MiB, WS_WDN0 = 22 * MiB, WS_WGT0 = 28 * MiB, WS_WPJ0 = 30 * MiB,
                 WS_WQKV = 31 * MiB, WS_WO1 = 34 * MiB, WS_WUP1 = 36 * MiB, WS_WDN1 = 48 * MiB, WS_WGT1 = 54 * MiB, WS_WPJ1 = 56 * MiB, WS_RGW = 57 * MiB;
constexpr size_t WS_GATES = 58 * MiB, WS_SSA = 59 * MiB, WS_SSB = 61 * MiB, WS_ROPE = 63 * MiB, WS_NLOC = 71 * MiB, WS_NPREV = 72 * MiB, WS_MSC = 73 * MiB,
                 WS_RGA = 74 * MiB, WS_RGH = 75 * MiB, WS_RGC = 76 * MiB;
constexpr size_t WS_PB = 78 * MiB, WS_XBA = 110 * MiB, WS_XBB = 174 * MiB, WS_CST = 238 * MiB, WS_BIG = 302 * MiB, WS_END = 494 * MiB;
constexpr int CW_BAR = 4096;

constexpr int RING_BYTES = 131072;
constexpr int LDSCTL_OFF = 163328, MISC_OFF = LDSCTL_OFF + 320;
constexpr int LDS_BYTES = 163840;

#define GAS __attribute__((address_space(1)))
#define LAS __attribute__((address_space(3)))
typedef unsigned short bf16;
typedef unsigned v4u __attribute__((ext_vector_type(4)));
typedef unsigned v2u __attribute__((ext_vector_type(2)));
typedef float f32x4 __attribute__((ext_vector_type(4)));
typedef float f32x16 __attribute__((ext_vector_type(16)));
typedef short bf16x8 __attribute__((ext_vector_type(8)));
typedef short s16x4 __attribute__((ext_vector_type(4)));
typedef GAS unsigned gu32;
typedef LAS unsigned char* ldsp;
#define LDS_WAIT() asm volatile("s_waitcnt lgkmcnt(0)" ::: "memory")
using pg8::pk2; using pg8::bflo; using pg8::bfhi; using pg8::fsigmoid; using pg8::gelu_tanh;
__device__ __forceinline__ unsigned short f2bf1(float x) { return (unsigned short)(pk2(x, 0.f) & 0xffffu); }
__device__ __forceinline__ float bf2f(unsigned short b) { return __uint_as_float(((unsigned)b) << 16); }
__device__ __forceinline__ float fsilu(float x) { return x * __builtin_amdgcn_rcpf(1.0f + __expf(-x)); }
#define MFMA16(a, b, c) __builtin_amdgcn_mfma_f32_16x16x32_bf16((a), (b), (c), 0, 0, 0)
#define MFMA32(a, b, c) __builtin_amdgcn_mfma_f32_32x32x16_bf16((a), (b), (c), 0, 0, 0)

#define PHASE_FENCE(F) do { asm volatile("" ::: "memory"); const int l_ = pg8::lane_now(); (F).lane = l_; (F).tid = l_ + 64 * (F).wave; } while (0)
#define XB_TMO      128
#define XB_XCNT(j)  (256  + 64 * (j))
#define XB_XSUB(j)  (1280 + 64 * (j))
#define XB_XGEN(j)  (2304 + 64 * (j))
#define XB_TOP      3328
#define XB_TOPGEN   3392
#define XCD_BAR_WORDS 3456
#define XB_SPIN_CAP (1u << 18)

__device__ __forceinline__ unsigned xb_ld(unsigned* p)              { return __hip_atomic_load(p, __ATOMIC_RELAXED, __HIP_MEMORY_SCOPE_AGENT); }
__device__ __forceinline__ unsigned xb_add(unsigned* p, unsigned v) { return __hip_atomic_fetch_add(p, v, __ATOMIC_RELAXED, __HIP_MEMORY_SCOPE_AGENT); }
__device__ __forceinline__ unsigned xb_xcc_id() { return (unsigned)__builtin_amdgcn_s_getreg((3 << 11) | 20) & 0xFu; }
#define XB_SPIN(cond, bar) do { unsigned _sp = 0; while (cond) { __builtin_amdgcn_s_sleep(1); \
    if ((++_sp & 255u) == 0u) { if (xb_ld(&(bar)[XB_TMO])) break; if (_sp > XB_SPIN_CAP) { atomicAdd(&(bar)[XB_TMO], 1u); break; } } } } while (0)

struct XcdBarrier {
    unsigned* bar; unsigned x; int w;
    volatile LAS unsigned* st;
};

__device__ __forceinline__ XcdBarrier xcd_barrier_post(unsigned* bar, volatile LAS unsigned* st, int wave) {
    XcdBarrier b; b.bar = bar; b.x = xb_xcc_id(); b.st = st; b.w = wave;
    if (threadIdx.x == 0) (void)xb_add(&bar[XB_XCNT(b.x)], 1u);
    return b;
}
__device__ __forceinline__ void xcd_barrier_complete(unsigned* bar, unsigned x, unsigned& nloc, unsigned& nx) {
    const unsigned G = gridDim.x * gridDim.y * gridDim.z;
    unsigned sum, cnt, mine, sp = 0u;
    for (;;) {
        sum = 0u; cnt = 0u; mine = 0u;
#pragma unroll
        for (unsigned j = 0; j < 16; ++j) { const unsigned c = xb_ld(&bar[XB_XCNT(j)]); sum += c; cnt += (c > 0u) ? 1u : 0u; mine = (j == x) ? c : mine; }
        if (sum == G) break;
        __builtin_amdgcn_s_sleep(1);
        if ((++sp & 255u) == 0u) { if (xb_ld(&bar[XB_TMO])) break; if (sp > XB_SPIN_CAP) { atomicAdd(&bar[XB_TMO], 1u); break; } }
    }
    nloc = mine > 0u ? mine : 1u; nx = cnt > 0u ? cnt : 1u;
}

__device__ __forceinline__ void xcd_barrier(const XcdBarrier& b) {
    asm volatile("s_waitcnt vmcnt(0)" ::: "memory");
    __syncthreads();
    if (b.w == 0 && pg8::lane_now() == 0) {
        unsigned* bar = b.bar;
        __builtin_amdgcn_s_waitcnt(0);
        unsigned nloc = b.st[0], nx = b.st[1];
        if (nloc == 0u) { xcd_barrier_complete(bar, b.x, nloc, nx); b.st[0] = nloc; b.st[1] = nx; }
        const unsigned old = xb_add(&bar[XB_XSUB(b.x)], 1u);
        const unsigned gen = old / nloc;
        if (old + 1u == (gen + 1u) * nloc) {
            __builtin_amdgcn_fence(__ATOMIC_RELEASE, "agent");
            asm volatile("s_waitcnt vmcnt(0)" ::: "memory");
            const unsigned og = xb_add(&bar[XB_TOP], 1u);
            const unsigned tg = og / nx;
            if (og + 1u == (tg + 1u) * nx) xb_add(&bar[XB_TOPGEN], 1u);
            else XB_SPIN(xb_ld(&bar[XB_TOPGEN]) == tg, bar);
            __builtin_amdgcn_fence(__ATOMIC_ACQUIRE, "agent");
            xb_add(&bar[XB_XGEN(b.x)], 1u);
            asm volatile("s_waitcnt vmcnt(0)" ::: "memory");
        } else {
            XB_SPIN(xb_ld(&bar[XB_XGEN(b.x)]) == gen, bar);
            __builtin_amdgcn_fence(__ATOMIC_ACQUIRE, "agent");
            asm volatile("s_waitcnt vmcnt(0)" ::: "memory");
        }
    }
    __syncthreads();
}

struct Frame {
    ldsp lds; volatile LAS unsigned* MISC;
    int tid, lane, wave, vcu, G;
    unsigned char* ws; unsigned long long kb; float* out;
};
__device__ __forceinline__ const float* karg(const Frame& F, int i) { unsigned long long a = F.kb; asm volatile("" : "+s"(a) :: "memory"); return (const float*)(((const __attribute__((address_space(4))) unsigned long long*)a)[i]); }
#define P_Z     ((bf16*)(F.ws + WS_BIG))
#define P_YBUF  ((bf16*)(F.ws + WS_XBA))
#define P_CST   ((bf16*)(F.ws + WS_CST))
#define P_RGW   ((bf16*)(F.ws + WS_RGW))
#define P_GATES ((float*)(F.ws + WS_GATES))
#define P_NLOC  ((float*)(F.ws + WS_NLOC))
#define P_NPREV ((float*)(F.ws + WS_NPREV))
#define P_MLOC  ((float*)(F.ws + WS_MSC))
#define P_BLAST ((float*)(F.ws + WS_MSC) + 2048)
#define P_MPREV ((float*)(F.ws + WS_MSC) + 4096)
#define P_RGA   ((float*)(F.ws + WS_RGA))
#define P_RGH   ((float*)(F.ws + WS_RGH))
#define P_RGC   ((float*)(F.ws + WS_RGC))
#define P_ROPE  ((float*)(F.ws + WS_ROPE))

__device__ __forceinline__ int tr_dst_row(int mode, int src) {
    if (mode == 1) { const int s2 = src < 3072 ? src : src - 3072; return 256 * (s2 >> 7) + (src < 3072 ? 0 : 128) + (s2 & 127); }
    if (mode == 2) return (src & ~255) + 128 * ((src >> 5) & 1) + 32 * ((src >> 6) & 3);
    return src;
}
template <bool PAIRED> __device__ __forceinline__ void tr_item(const float* W, int ldw, int srcc, int mode, const float* scale, bf16* WT, int K, int k0, LAS float* scr, int lane) {
#pragma unroll
    for (int i = 0; i < 16; ++i) { const int kk = 4 * i + (lane >> 4), n4 = (lane & 15) * 4; const float s = scale ? scale[k0 + kk] : 1.0f;
        const f32x4 v = *(const f32x4*)(W + (size_t)(k0 + kk) * ldw + srcc + n4);
        scr[kk * 65 + n4] = v[0] * s; scr[kk * 65 + n4 + 1] = v[1] * s; scr[kk * 65 + n4 + 2] = v[2] * s; scr[kk * 65 + n4 + 3] = v[3] * s; }
    LDS_WAIT(); asm volatile("" ::: "memory");
    const int c = lane & 7, d0 = tr_dst_row(mode, srcc), d1 = tr_dst_row(mode, srcc + 32);
#pragma unroll
    for (int j = 0; j < 8; ++j) { const int n = (lane >> 3) + 8 * j; const LAS float* s = scr + (8 * c) * 65 + n;
        v4u o; o.x = pk2(s[0 * 65], s[1 * 65]); o.y = pk2(s[2 * 65], s[3 * 65]); o.z = pk2(s[4 * 65], s[5 * 65]); o.w = pk2(s[6 * 65], s[7 * 65]);
        const int drow = (n < 32 ? d0 : d1) + (n & 31);
        if (PAIRED) *(GAS v4u*)(WT + (size_t)(drow >> 1) * (2 * K) + 2 * k0 + (c >> 2) * 64 + (drow & 1) * 32 + (c & 3) * 8) = o;
        else *(GAS v4u*)(WT + (size_t)drow * K + k0 + 8 * c) = o; }
    LDS_WAIT(); asm volatile("" ::: "memory");
}
__device__ __forceinline__ bool tr_matrix(int& r, const float* W, int ldw, int K, int Nd, int mode, const float* scale, bf16* WT, LAS float* scr, int lane) {
    const int nblk = Nd / 64, items = (K / 64) * nblk;
    if (r >= items) { r -= items; return false; }
    const int kb = r / nblk, sb = r % nblk;
    tr_item<true>(W, ldw, 64 * sb, mode, scale, WT, K, 64 * kb, scr, lane);
    return true;
}
__device__ __forceinline__ float wave_sum(float v) {
#pragma unroll
    for (int o = 1; o < 64; o <<= 1) v += __shfl_xor(v, o);
    return v;
}
#ifdef PROBE_P0SPLIT
#define P0_SPLIT() do { xcd_barrier(bar); TSTAMP(); } while (0)
#else
#define P0_SPLIT() do { } while (0)
#endif
__device__ __forceinline__ void p0_prologue(Frame& F, const XcdBarrier& bar, int& ts_n) {
    PHASE_FENCE(F); const float* x = karg(F, 0); const float* p = karg(F, 1); const int* pos = (const int*)karg(F, 2); const float* norm_mix = karg(F, 3); const float* norm_ffn = karg(F, 4); const float* norm_ple = karg(F, 5); const float* hy_w_in = karg(F, 6); const float* hy_b_in = karg(F, 7); const float* rg_wa = karg(F, 10); const float* rg_wx = karg(F, 12); const float* hy_w_out = karg(F, 18); const float* at_w_qkv = karg(F, 19); const float* at_w_out = karg(F, 23); const float* ff_w_up = karg(F, 24); const float* ff_w_down = karg(F, 27); const float* ple_w_gate = karg(F, 28); const float* ple_w_proj = karg(F, 29);
    LAS float* scr = (LAS float*)(F.lds + F.wave * 16640);
    const int gw = F.vcu * NWAVES + F.wave, NGW = F.G * NWAVES;
    unsigned char* ws = F.ws;
    LAS float* GW = (LAS float*)(F.lds);
    for (int i = F.tid; i < 8192; i += NWAVES * 64) { const int k = i >> 3, g = i & 7; GW[i] = hy_w_in[(size_t)k * HYIN + 3072 + g] * norm_mix[k]; }
    __syncthreads();
    P0_SPLIT();
    bf16* xb = (bf16*)(ws + WS_XBA);
    const float bgate = (F.lane < 64) ? hy_b_in[3072 + (F.lane >> 3)] : 0.f;
    for (int row0 = 2 * gw; row0 < T; row0 += 2 * NGW) {
        f32x4 v[2][4];
#pragma unroll
        for (int rr = 0; rr < 2; ++rr) { const GAS f32x4* xr = (const GAS f32x4*)(x + (size_t)(row0 + rr) * DM) + F.lane;
#pragma unroll
            for (int j = 0; j < 4; ++j) v[rr][j] = xr[64 * j]; }
#pragma unroll
        for (int rr = 0; rr < 2; ++rr) { const int row = row0 + rr; float s = 0.f; float d[8];
#pragma unroll
            for (int g = 0; g < 8; ++g) d[g] = 0.f;
#pragma unroll
            for (int j = 0; j < 4; ++j) { s += (v[rr][j].x * v[rr][j].x + v[rr][j].y * v[rr][j].y) + (v[rr][j].z * v[rr][j].z + v[rr][j].w * v[rr][j].w);
#pragma unroll
                for (int e = 0; e < 4; ++e) { const int k = 4 * (F.lane + 64 * j) + e; const f32x4 w0 = *(const LAS f32x4*)(GW + k * 8), w1 = *(const LAS f32x4*)(GW + k * 8 + 4);
                    const float xv = v[rr][j][e];
                    d[0] += xv * w0[0]; d[1] += xv * w0[1]; d[2] += xv * w0[2]; d[3] += xv * w0[3]; d[4] += xv * w1[0]; d[5] += xv * w1[1]; d[6] += xv * w1[2]; d[7] += xv * w1[3]; } }
            s = wave_sum(s);
            const bool b5 = F.lane & 32, b4 = F.lane & 16, b3 = F.lane & 8; float r4[4], r2[2];
#pragma unroll
            for (int i = 0; i < 4; ++i) { const float recv = __shfl_xor(b5 ? d[i] : d[i + 4], 32); r4[i] = (b5 ? d[i + 4] : d[i]) + recv; }
#pragma unroll
            for (int i = 0; i < 2; ++i) { const float recv = __shfl_xor(b4 ? r4[i] : r4[i + 2], 16); r2[i] = (b4 ? r4[i + 2] : r4[i]) + recv; }
            float dg; { const float recv = __shfl_xor(b3 ? r2[0] : r2[1], 8); dg = (b3 ? r2[1] : r2[0]) + recv; }
            dg += __shfl_xor(dg, 1); dg += __shfl_xor(dg, 2); dg += __shfl_xor(dg, 4);
            const float rstd = rsqrtf(s * (1.0f / DM) + 1e-6f);
            if ((F.lane & 7) == 0) P_GATES[(size_t)row * 8 + (F.lane >> 3)] = rstd * dg + bgate;
            GAS unsigned long long* o8 = (GAS unsigned long long*)(xb + (size_t)row * DM) + F.lane;
#pragma unroll
            for (int j = 0; j < 4; ++j) o8[64 * j] = (unsigned long long)pk2(v[rr][j].x * rstd, v[rr][j].y * rstd) | ((unsigned long long)pk2(v[rr][j].z * rstd, v[rr][j].w * rstd) << 32);
#if DBG_STOP < 3
            { GAS f32x4* oo = (GAS f32x4*)(F.out + (size_t)row * DM) + F.lane;
#pragma unroll
              for (int j = 0; j < 4; ++j) oo[64 * j] = v[rr][j]; }
#endif
        }
    }
    P0_SPLIT();
    { const GAS f32x4* ps = (const GAS f32x4*)p; GAS v4u* pd = (GAS v4u*)(ws + WS_PB); const int n8 = 2 * T * 256 / 8;
      for (int i0 = gw * 64 + F.lane; i0 < n8; i0 += 4 * NGW * 64) { f32x4 a[4], b[4];
#pragma unroll
          for (int k = 0; k < 4; ++k) { const int i = i0 + k * NGW * 64; if (i < n8) { a[k] = ps[2 * i]; b[k] = ps[2 * i + 1]; } }
#pragma unroll
          for (int k = 0; k < 4; ++k) { const int i = i0 + k * NGW * 64; if (i < n8) { v4u o; o.x = pk2(a[k].x, a[k].y); o.y = pk2(a[k].z, a[k].w); o.z = pk2(b[k].x, b[k].y); o.w = pk2(b[k].z, b[k].w); pd[i] = o; } } } }
    for (int i = (F.vcu * NWAVES * 64) + F.tid; i < T * 32; i += F.G * NWAVES * 64) { const int t = i >> 5, f = i & 31;
        const float inv = exp2f(-(float)f * (13.287712379549449f / 32.0f));
        const float ang = (float)pos[t] * inv;
        P_ROPE[(size_t)t * 64 + f] = cosf(ang); P_ROPE[(size_t)t * 64 + 32 + f] = sinf(ang); }
    P0_SPLIT();
    __syncthreads();
    constexpr int NITEMS = 768 + 256 + 2 * 1536 + 2 * 768 + 2 * 256 + 2 * 64 + 384 + 256 + 16;
    for (int it = gw; it < NITEMS; it += NGW) {
        int r = it; const float* W = nullptr; const float* scale = nullptr; bf16* WT = nullptr; int ldw = 0, K = 0, Nd = 0, mode = 0; bool found = false;
#define TRM(W_, ldw_, K_, Nd_, mode_, scale_, WT_) if (!found) { const int items_ = ((K_) / 64) * ((Nd_) / 64); if (r < items_) { W = (W_); ldw = (ldw_); K = (K_); Nd = (Nd_); mode = (mode_); scale = (scale_); WT = (bf16*)(ws + (WT_)); found = true; } else r -= items_; }
        TRM(hy_w_in, HYIN, 1024, 3072, 2, norm_mix, WS_WIN)
        TRM(hy_w_out, 1024, 1024, 1024, 2, nullptr, WS_WOUT0)
        TRM(ff_w_up, 6144, 1024, 6144, 1, norm_ffn, WS_WUP0)
        TRM(ff_w_up + (size_t)1024 * 6144, 6144, 1024, 6144, 1, norm_ffn + 1024, WS_WUP1)
        TRM(ff_w_down, 1024, 3072, 1024, 2, nullptr, WS_WDN0)
        TRM(ff_w_down + (size_t)3072 * 1024, 1024, 3072, 1024, 2, nullptr, WS_WDN1)
        TRM(ple_w_gate, 1024, 1024, 1024, 2, norm_ple, WS_WGT0)
        TRM(ple_w_gate + (size_t)1024 * 1024, 1024, 1024, 1024, 2, norm_ple + 1024, WS_WGT1)
        TRM(ple_w_proj, 1024, 256, 1024, 2, nullptr, WS_WPJ0)
        TRM(ple_w_proj + (size_t)256 * 1024, 1024, 256, 1024, 2, nullptr, WS_WPJ1)
        TRM(at_w_qkv, 1536, 1024, 1536, 2, norm_mix + 1024, WS_WQKV)
        TRM(at_w_out, 1024, 1024, 1024, 2, nullptr, WS_WO1)
#undef TRM
        if (found) { const int nblk = Nd / 64, kb = r / nblk, sb = r - kb * nblk; tr_item<true>(W, ldw, 64 * sb, mode, scale, WT, K, 64 * kb, scr, F.lane); }
        else { const int g = r >> 3, n = r & 7;
          tr_item<false>((g ? rg_wx : rg_wa) + (size_t)n * 4096, 64, 0, 0, nullptr, P_RGW + (size_t)r * 4096, 64, 0, scr, F.lane); }
    }
}

__device__ __forceinline__ void ld8f(const bf16* p, float (&o)[8]) { const v4u v = *(const v4u*)p; o[0] = bflo(v.x); o[1] = bfhi(v.x); o[2] = bflo(v.y); o[3] = bfhi(v.y); o[4] = bflo(v.z); o[5] = bfhi(v.z); o[6] = bflo(v.w); o[7] = bfhi(v.w); }
__device__ __forceinline__ void conv4x8(const bf16* zp, int s, const float* cw, int ldw, const float* cb, float (&out)[8]) {
    { const f32x4 b0 = *(const f32x4*)cb, b1 = *(const f32x4*)(cb + 4); out[0] = b0[0]; out[1] = b0[1]; out[2] = b0[2]; out[3] = b0[3]; out[4] = b1[0]; out[5] = b1[1]; out[6] = b1[2]; out[7] = b1[3]; }
#pragma unroll
    for (int j = 0; j < 4; ++j) if (s - 3 + j >= 0) { float xv[8]; ld8f(zp + (ptrdiff_t)(j - 3) * ZW, xv);
        const f32x4 w0 = *(const f32x4*)(cw + j * ldw), w1 = *(const f32x4*)(cw + j * ldw + 4);
        out[0] += w0[0] * xv[0]; out[1] += w0[1] * xv[1]; out[2] += w0[2] * xv[2]; out[3] += w0[3] * xv[3]; out[4] += w1[0] * xv[4]; out[5] += w1[1] * xv[5]; out[6] += w1[2] * xv[6]; out[7] += w1[3] * xv[7]; }
}
__device__ __forceinline__ v4u pk8f(const float (&a)[8]) { v4u o; o.x = pk2(a[0], a[1]); o.y = pk2(a[2], a[3]); o.z = pk2(a[4], a[5]); o.w = pk2(a[6], a[7]); return o; }
__device__ __forceinline__ float logsig(float f) { return fminf(f, 0.f) - __logf(1.0f + __expf(-fabsf(f))); }

template <int CTRL, int ROWMASK> __device__ __forceinline__ float dpp_f(float idv, float v) { return __int_as_float(__builtin_amdgcn_update_dpp(__float_as_int(idv), __float_as_int(v), CTRL, ROWMASK, 0xF, false)); }
__device__ __forceinline__ float scan_add(float v) {
    v += dpp_f<0x111, 0xF>(0.f, v); v += dpp_f<0x112, 0xF>(0.f, v); v += dpp_f<0x114, 0xF>(0.f, v); v += dpp_f<0x118, 0xF>(0.f, v);
    v += dpp_f<0x142, 0xA>(0.f, v); v += dpp_f<0x143, 0xC>(0.f, v); return v; }
__device__ __forceinline__ float scan_max(float v) {
    v = fmaxf(v, dpp_f<0x111, 0xF>(-INFINITY, v)); v = fmaxf(v, dpp_f<0x112, 0xF>(-INFINITY, v)); v = fmaxf(v, dpp_f<0x114, 0xF>(-INFINITY, v)); v = fmaxf(v, dpp_f<0x118, 0xF>(-INFINITY, v));
    v = fmaxf(v, dpp_f<0x142, 0xA>(-INFINITY, v)); v = fmaxf(v, dpp_f<0x143, 0xC>(-INFINITY, v)); return v; }
__device__ __forceinline__ float lane63(float v) { return __int_as_float(__builtin_amdgcn_readlane(__float_as_int(v), 63)); }
struct MlPre { v4u q[3], k[3], v[2]; float ip, fp, np, mp; };
template <bool PC> __device__ __forceinline__ void ml_prefetch(Frame& F, int u, MlPre& R) {
    const int c = u & 63, bh = u >> 6, h = bh & 3, b = bh >> 2, tok0 = b * SEQ + c * 64;
    const bf16* z = P_Z;
    int tid = F.tid; asm volatile("" : "+v"(tid));
#pragma unroll
    for (int s = 0; s < 3; ++s) { const int i = tid + 512 * s, row = s < 2 ? 3 + (i & 63) : (tid >> 4), ch = s < 2 ? (i >> 6) : (tid & 15); const bool ok = s < 2 || (tid < 48 && c > 0);
        const bf16* zp = z + (size_t)(tok0 - 3 + row) * ZW + 128 * h + 8 * ch;
        R.k[s] = ok ? *(const v4u*)(zp + 1536) : (v4u){0u, 0u, 0u, 0u};
        if (PC) R.q[s] = ok ? *(const v4u*)(zp + 1024) : (v4u){0u, 0u, 0u, 0u}; }
#pragma unroll
    for (int s = 0; s < 2; ++s) { const int i = tid + 512 * s, l = i & 63, ch = i >> 6; R.v[s] = *(const v4u*)(z + (size_t)(tok0 + l) * ZW + 2048 + 128 * h + 8 * ch); }
    if (tid < 64) { R.ip = P_GATES[(size_t)(tok0 + tid) * 8 + h]; R.fp = P_GATES[(size_t)(tok0 + tid) * 8 + 4 + h]; }
    if (PC) {
        if (tid >= 128 && tid < 256) R.np = P_NPREV[(size_t)u * 128 + tid - 128];
        R.mp = P_MPREV[u];
    }
}
__device__ __forceinline__ void vt_scatter(LAS unsigned short* VT, int stride, int ch, int l, const v4u& vv) {
    VT[(8 * ch + 0) * stride + l] = (unsigned short)(vv.x & 0xffffu); VT[(8 * ch + 1) * stride + l] = (unsigned short)(vv.x >> 16);
    VT[(8 * ch + 2) * stride + l] = (unsigned short)(vv.y & 0xffffu); VT[(8 * ch + 3) * stride + l] = (unsigned short)(vv.y >> 16);
    VT[(8 * ch + 4) * stride + l] = (unsigned short)(vv.z & 0xffffu); VT[(8 * ch + 5) * stride + l] = (unsigned short)(vv.z >> 16);
    VT[(8 * ch + 6) * stride + l] = (unsigned short)(vv.w & 0xffffu); VT[(8 * ch + 7) * stride + l] = (unsigned short)(vv.w >> 16);
}
__device__ __forceinline__ void conv4_lds(ldsp raw, int l, int ch, const LAS float* cw, const LAS float* cb, float (&out)[8]) {
    { const f32x4 b0 = *(const LAS f32x4*)(cb + 8 * ch), b1 = *(const LAS f32x4*)(cb + 8 * ch + 4); out[0] = b0[0]; out[1] = b0[1]; out[2] = b0[2]; out[3] = b0[3]; out[4] = b1[0]; out[5] = b1[1]; out[6] = b1[2]; out[7] = b1[3]; }
#pragma unroll
    for (int j = 0; j < 4; ++j) { const v4u v = *(const LAS v4u*)(raw + (l + j) * 272 + 16 * ch); const f32x4 w0 = *(const LAS f32x4*)(cw + j * 128 + 8 * ch), w1 = *(const LAS f32x4*)(cw + j * 128 + 8 * ch + 4);
        out[0] += w0[0] * bflo(v.x); out[1] += w0[1] * bfhi(v.x); out[2] += w0[2] * bflo(v.y); out[3] += w0[3] * bfhi(v.y); out[4] += w1[0] * bflo(v.z); out[5] += w1[1] * bfhi(v.z); out[6] += w1[2] * bflo(v.w); out[7] += w1[3] * bfhi(v.w); }
}

__device__ __forceinline__ void mlA_phase(Frame& F) {
    PHASE_FENCE(F);
    const float* ml_cw = karg(F, 15); const float* ml_cb = karg(F, 16);
    ldsp L = F.lds;
    constexpr int RAWK = 0, KTO = 18432, VTO = 36864, WLO = 57600, CWO = 57856;
    LAS unsigned short* KT = (LAS unsigned short*)(L + KTO); LAS unsigned short* VT = (LAS unsigned short*)(L + VTO); LAS float* WL = (LAS float*)(L + WLO); LAS float* CW = (LAS float*)(L + CWO);
    int u = F.vcu; if (u >= 2048) return;
    int hcw = -1;
    MlPre R; ml_prefetch<false>(F, u, R);
    for (; u < 2048; u += F.G) {
        { const int h = (u >> 6) & 3; if (h != hcw) { hcw = h; for (int i = F.tid; i < 640; i += NWAVES * 64) CW[i] = (i < 512) ? ml_cw[(i >> 7) * 1024 + 512 + 128 * h + (i & 127)] : ml_cb[512 + 128 * h + (i - 512)]; } }
#pragma unroll
        for (int s = 0; s < 3; ++s) { const int i = F.tid + 512 * s, row = s < 2 ? 3 + (i & 63) : (F.tid >> 4), ch = s < 2 ? (i >> 6) : (F.tid & 15); if (s < 2 || F.tid < 48) *(LAS v4u*)(L + RAWK + row * 272 + 16 * ch) = R.k[s]; }
#pragma unroll
        for (int s = 0; s < 2; ++s) { const int i = F.tid + 512 * s; vt_scatter(VT, 72, i >> 6, i & 63, R.v[s]); }
        for (int i = F.tid; i < 16 * 64; i += NWAVES * 64) { const int r = i >> 6, l = i & 63; VT[(128 + r) * 72 + l] = (r == 0) ? (unsigned short)0x3F80 : (unsigned short)0; }
        if (F.wave == 0) {
            const int l = F.lane; const float bc = scan_add(logsig(R.fp));
            const float bl = lane63(bc); const float g = bl - bc + R.ip; const float mx = lane63(scan_max(g));
            WL[l] = __expf(g - mx);
            if (l == 0) { P_MLOC[u] = mx; P_BLAST[u] = bl; }
        }
        __syncthreads();
        if (u + F.G < 2048) ml_prefetch<false>(F, u + F.G, R);
        { const int l = F.tid & 63;
#pragma unroll
          for (int it = 0; it < 2; ++it) { const int ch = (F.tid >> 6) + 8 * it; float kc[8]; conv4_lds(L + RAWK, l, ch, CW, CW + 512, kc);
            const float wl = WL[l] * 0.08838834764831845f;
#pragma unroll
            for (int i = 0; i < 8; ++i) KT[(8 * ch + i) * 72 + l] = f2bf1(fsilu(kc[i]) * wl); } }
        __syncthreads();
        { const int fr = F.lane & 15, fq = F.lane >> 4, w = F.wave;
          bf16x8 a[2];
#pragma unroll
          for (int ks = 0; ks < 2; ++ks) a[ks] = *(const LAS bf16x8*)(L + KTO + (16 * w + fr) * 144 + (32 * ks + 8 * fq) * 2);
#pragma unroll
          for (int nt = 0; nt < 9; ++nt) { f32x4 acc = {0.f, 0.f, 0.f, 0.f};
#pragma unroll
            for (int ks = 0; ks < 2; ++ks) { const bf16x8 bb = *(const LAS bf16x8*)(L + VTO + (16 * nt + fr) * 144 + (32 * ks + 8 * fq) * 2); acc = MFMA16(a[ks], bb, acc); }
            if (nt < 8) { v2u o; o.x = pk2(acc[0], acc[1]); o.y = pk2(acc[2], acc[3]); *(v2u*)(P_CST + (size_t)u * 16384 + (16 * nt + fr) * 128 + 16 * w + 4 * fq) = o; }
            else if (fr == 0) { *(f32x4*)(P_NLOC + (size_t)u * 128 + 16 * w + 4 * fq) = acc; } } }
        __syncthreads();
    }
}

__device__ __forceinline__ void mlC_phase(Frame& F) {
    PHASE_FENCE(F);
    const float* ml_cw = karg(F, 15); const float* ml_cb = karg(F, 16); const float* ml_norm = karg(F, 17);
    ldsp L = F.lds;
    constexpr int RAWQ = 0, RAWK = 18432, QI = 36864, KI = 54272, VTO = 71680, SQO = 90112, CTO = 99328, ARR = 134144  , CWO = 136704  , HFO = 0;
    static_assert(ARR + 576 * 4 <= CWO && CWO + 1408 * 4 <= LDSCTL_OFF, "mlC LDS map");
    LAS unsigned short* VT = (LAS unsigned short*)(L + VTO); LAS unsigned short* SQ = (LAS unsigned short*)(L + SQO); LAS float* HF = (LAS float*)(L + HFO); LAS float* CW = (LAS float*)(L + CWO);
    LAS float* DV = (LAS float*)(L + ARR); LAS float* MU = DV + 64; LAS float* AI = DV + 128; LAS float* EM = DV + 192; LAS float* DENP = DV + 256  ; LAS float* DNI = DV + 384; LAS float* NP = DV + 448  ;
    int u = F.vcu; if (u >= 2048) return;
    int hcw = -1;
    MlPre R; ml_prefetch<true>(F, u, R);
    for (; u < 2048; u += F.G) {
        const int c = u & 63, bh = u >> 6, h = bh & 3, b = bh >> 2, tok0 = b * SEQ + c * 64;
        if (h != hcw) { hcw = h;
            for (int i = F.tid; i < 1280; i += NWAVES * 64) { const int qk = i / 640, r = i % 640; CW[i] = (r < 512) ? ml_cw[(r >> 7) * 1024 + 512 * qk + 128 * h + (r & 127)] : ml_cb[512 * qk + 128 * h + (r - 512)]; }
            if (F.tid < 128) CW[1280 + F.tid] = ml_norm[128 * h + F.tid]; }
#pragma unroll
        for (int s = 0; s < 3; ++s) { const int i = F.tid + 512 * s, row = s < 2 ? 3 + (i & 63) : (F.tid >> 4), ch = s < 2 ? (i >> 6) : (F.tid & 15); if (s < 2 || F.tid < 48) { *(LAS v4u*)(L + RAWQ + row * 272 + 16 * ch) = R.q[s]; *(LAS v4u*)(L + RAWK + row * 272 + 16 * ch) = R.k[s]; } }
#pragma unroll
        for (int s = 0; s < 2; ++s) { const int i = F.tid + 512 * s; vt_scatter(VT, 72, i >> 6, i & 63, R.v[s]); }
        if (F.wave == 0) {
            const int l = F.lane; const float bc = scan_add(logsig(R.fp));
            const float dv = R.ip - bc; const float cm = scan_max(dv);
            const float bm = bc + R.mp, mt = fmaxf(bm, bc + cm);
            AI[l] = __expf(bm - mt); MU[l] = mt - bc; DV[l] = dv; EM[l] = __expf(-mt);
        }
        if (F.tid >= 128 && F.tid < 256) NP[F.tid - 128] = R.np;
        __syncthreads();
        v4u ct[4];
#pragma unroll
        for (int s = 0; s < 4; ++s) ct[s] = *(const v4u*)(P_CST + (size_t)u * 16384 + (size_t)(F.tid + 512 * s) * 8);
        if (u + F.G < 2048) ml_prefetch<true>(F, u + F.G, R);
        { const int l = F.tid & 63;
#pragma unroll
          for (int it = 0; it < 2; ++it) { const int ch = (F.tid >> 6) + 8 * it; float qc[8], kc[8];
            conv4_lds(L + RAWQ, l, ch, CW, CW + 512, qc); conv4_lds(L + RAWK, l, ch, CW + 640, CW + 1152, kc);
#pragma unroll
            for (int i = 0; i < 8; ++i) { qc[i] = fsilu(qc[i]); kc[i] = fsilu(kc[i]) * 0.08838834764831845f; }
            *(LAS v4u*)(L + QI + l * 272 + 16 * ch) = pk8f(qc); *(LAS v4u*)(L + KI + l * 272 + 16 * ch) = pk8f(kc); } }
        __syncthreads();
        const int fr = F.lane & 15, fq = F.lane >> 4, w = F.wave, tt = w >> 1;
        {
          float rs[4] = {0.f, 0.f, 0.f, 0.f};
#pragma unroll 1
          for (int si = 0; si < 2; ++si) { const int st = 2 * (w & 1) + si; f32x4 acc = {0.f, 0.f, 0.f, 0.f};
#pragma unroll
            for (int ks = 0; ks < 4; ++ks) { const bf16x8 a = *(const LAS bf16x8*)(L + QI + (16 * tt + fr) * 272 + (32 * ks + 8 * fq) * 2), bb = *(const LAS bf16x8*)(L + KI + (16 * st + fr) * 272 + (32 * ks + 8 * fq) * 2); acc = MFMA16(a, bb, acc); }
            const int s = 16 * st + fr; const float dvs = DV[s];
#pragma unroll
            for (int r = 0; r < 4; ++r) { const int t = 16 * tt + 4 * fq + r; const float wgt = (s <= t) ? __expf(dvs - MU[t]) : 0.f; const float v = acc[r] * wgt; rs[r] += v; SQ[t * 72 + s] = f2bf1(v); } }
#pragma unroll
          for (int r = 0; r < 4; ++r) { float v = rs[r]; v += __shfl_xor(v, 1); v += __shfl_xor(v, 2); v += __shfl_xor(v, 4); v += __shfl_xor(v, 8); if (fr == 0) DENP[(w & 1) * 64 + 16 * tt + 4 * fq + r] = v; }
          const int t = F.tid >> 3, part = F.tid & 7; float acc = 0.f;
          { const v4u v0 = *(const LAS v4u*)(L + QI + t * 272 + 32 * part), v1 = *(const LAS v4u*)(L + QI + t * 272 + 32 * part + 16);
            const float q0[8] = {bflo(v0.x), bfhi(v0.x), bflo(v0.y), bfhi(v0.y), bflo(v0.z), bfhi(v0.z), bflo(v0.w), bfhi(v0.w)};
            const float q1[8] = {bflo(v1.x), bfhi(v1.x), bflo(v1.y), bfhi(v1.y), bflo(v1.z), bfhi(v1.z), bflo(v1.w), bfhi(v1.w)};
#pragma unroll
            for (int i = 0; i < 8; ++i) acc += q0[i] * NP[16 * part + i] + q1[i] * NP[16 * part + 8 + i]; }
          acc += __shfl_xor(acc, 1); acc += __shfl_xor(acc, 2); acc += __shfl_xor(acc, 4);
          if (part == 0) DNI[t] = acc; }
#pragma unroll
        for (int s = 0; s < 4; ++s) { const int i = F.tid + 512 * s; *(LAS v4u*)(L + CTO + (i >> 4) * 272 + 16 * (i & 15)) = ct[s]; }
        __syncthreads();
        v4u o0, o1; { const bf16* op = P_Z + (size_t)(tok0 + (F.tid >> 3)) * ZW + 2560 + 128 * h + 16 * (F.tid & 7); o0 = *(const v4u*)op; o1 = *(const v4u*)(op + 8); }
        {
#pragma unroll 1
          for (int ei = 0; ei < 4; ++ei) { const int et = 4 * (w & 1) + ei; f32x4 ai_ = {0.f, 0.f, 0.f, 0.f}, ax = {0.f, 0.f, 0.f, 0.f};
#pragma unroll
            for (int ks = 0; ks < 2; ++ks) { const bf16x8 a = *(const LAS bf16x8*)(L + SQO + (16 * tt + fr) * 144 + (32 * ks + 8 * fq) * 2), bb = *(const LAS bf16x8*)(L + VTO + (16 * et + fr) * 144 + (32 * ks + 8 * fq) * 2); ai_ = MFMA16(a, bb, ai_); }
#pragma unroll
            for (int ks = 0; ks < 4; ++ks) { const bf16x8 a = *(const LAS bf16x8*)(L + QI + (16 * tt + fr) * 272 + (32 * ks + 8 * fq) * 2), bb = *(const LAS bf16x8*)(L + CTO + (16 * et + fr) * 272 + (32 * ks + 8 * fq) * 2); ax = MFMA16(a, bb, ax); }
#pragma unroll
            for (int r = 0; r < 4; ++r) { const int t = 16 * tt + 4 * fq + r; const float aint = AI[t]; const float den = DENP[t] + DENP[64 + t] + aint * DNI[t]; const float dd = fmaxf(fabsf(den), EM[t]);
                HF[t * 132 + 16 * et + fr] = (ai_[r] + aint * ax[r]) / dd; } } }
        __syncthreads();
        {
          const int t = F.tid >> 3, part = F.tid & 7; f32x4 hv[4]; float ss = 0.f;
#pragma unroll
          for (int i = 0; i < 4; ++i) { hv[i] = *(const LAS f32x4*)(HF + t * 132 + 16 * part + 4 * i); ss += pg8::dot4(hv[i]); }
          ss += __shfl_xor(ss, 1); ss += __shfl_xor(ss, 2); ss += __shfl_xor(ss, 4);
          const float rstd = rsqrtf(ss * (1.0f / 128.0f) + 1e-6f);
          const float og0[8] = {bflo(o0.x), bfhi(o0.x), bflo(o0.y), bfhi(o0.y), bflo(o0.z), bfhi(o0.z), bflo(o0.w), bfhi(o0.w)};
          const float og1[8] = {bflo(o1.x), bfhi(o1.x), bflo(o1.y), bfhi(o1.y), bflo(o1.z), bfhi(o1.z), bflo(o1.w), bfhi(o1.w)};
          float y0[8], y1[8]; const LAS float* gn = CW + 1280 + 16 * part;
#pragma unroll
          for (int i = 0; i < 8; ++i) { y0[i] = hv[i >> 2][i & 3] * rstd * gn[i] * fsigmoid(og0[i]); y1[i] = hv[2 + (i >> 2)][i & 3] * rstd * gn[8 + i] * fsigmoid(og1[i]); }
          bf16* yp = P_YBUF + (size_t)(tok0 + t) * DM + 512 + 128 * h + 16 * part; *(v4u*)yp = pk8f(y0); *(v4u*)(yp + 8) = pk8f(y1); }
        __syncthreads();
    }
}

struct RgPre { v4u raw[11]; float carry[4]; };
template <bool FINAL> __device__ __forceinline__ void rg_prefetch(Frame& F, int u, RgPre& R) {
    const int b = u >> 6, c = u & 63, tok0 = b * SEQ + c * 64;
    int tid = F.tid; asm volatile("" : "+v"(tid));
    const int chunk = tid & 63, run = tid >> 6, col0 = 8 * chunk;
#pragma unroll
    for (int k = 0; k < 11; ++k) { const int s = c * 64 + 8 * run - 3 + k; R.raw[k] = (s >= 0) ? *(const v4u*)(P_Z + (size_t)(tok0 + 8 * run - 3 + k) * ZW + col0) : (v4u){0u, 0u, 0u, 0u}; }
    if (FINAL) {
        const int fr = tid & 15, w = tid >> 6;
#pragma unroll
        for (int jt = 0; jt < 4; ++jt) R.carry[jt] = P_RGC[(size_t)u * 512 + 64 * w + 16 * jt + fr];
    }
}
template <bool FINAL> __device__ __forceinline__ void rg_phase(Frame& F) {
    PHASE_FENCE(F);
    const float* rg_cw = karg(F, 8); const float* rg_cb = karg(F, 9); const float* rg_ba = karg(F, 11); const float* rg_bx = karg(F, 13); const float* rg_lam = karg(F, 14);
    ldsp L = F.lds;
    constexpr int XCO = 0, GRO = 66560;
    LAS unsigned short* XC = (LAS unsigned short*)(L + XCO); LAS unsigned short* GR = (LAS unsigned short*)(L + GRO);
    const int fr = F.lane & 15, fq = F.lane >> 4, w = F.wave;
    int u = F.vcu; if (u >= 512) return;
    RgPre R; rg_prefetch<FINAL>(F, u, R);
    bf16x8 bfr[2][4][2]; float ba[4], bx[4], sp8[4];
#pragma unroll
    for (int g = 0; g < 2; ++g)
#pragma unroll
        for (int jt = 0; jt < 4; ++jt)
#pragma unroll
            for (int ks = 0; ks < 2; ++ks) bfr[g][jt][ks] = *(const bf16x8*)(P_RGW + (size_t)(g * 8 + w) * 4096 + (16 * jt + fr) * 64 + 32 * ks + 8 * fq);
#pragma unroll
    for (int jt = 0; jt < 4; ++jt) { const int chn = 64 * w + 16 * jt + fr; ba[jt] = rg_ba[chn]; bx[jt] = rg_bx[chn]; sp8[jt] = 8.0f * 1.4426950408889634f * log1pf(__expf(-rg_lam[chn]));     }
    const int chunk = F.tid & 63, run = F.tid >> 6, col0 = 8 * chunk;
    LAS float* CWL = (LAS float*)(L + 132096);
    for (int i = F.tid; i < 2560; i += NWAVES * 64) CWL[i] = (i < 2048) ? rg_cw[i] : rg_cb[i - 2048];
    __syncthreads();
    for (; u < 512; u += F.G) {
        const int b = u >> 6, c = u & 63, tok0 = b * SEQ + c * 64;
        f32x4 wa[4], wb[4];
#pragma unroll
        for (int j = 0; j < 4; ++j) { wa[j] = *(const LAS f32x4*)(CWL + j * 512 + col0); wb[j] = *(const LAS f32x4*)(CWL + j * 512 + col0 + 4); }
        const f32x4 b0 = *(const LAS f32x4*)(CWL + 2048 + col0), b1 = *(const LAS f32x4*)(CWL + 2048 + col0 + 4);
#pragma unroll
        for (int t = 0; t < 8; ++t) { f32x4 oa = b0, ob = b1;
#pragma unroll
            for (int j = 0; j < 4; ++j) { f32x4 xa, xb2; pg8::unpack8(R.raw[t + j], xa, xb2); oa += wa[j] * xa; ob += wb[j] * xb2; }
            *(LAS v4u*)(L + XCO + (8 * run + t) * 1040 + 16 * chunk) = pg8::pk8(oa, ob); }
        float carry[4], ptot[4]; v4u gk[8];
#pragma unroll
        for (int jt = 0; jt < 4; ++jt) { carry[jt] = FINAL ? R.carry[jt] : 0.f; ptot[jt] = 1.f; }
        __syncthreads();
        if (u + F.G < 512) rg_prefetch<FINAL>(F, u + F.G, R);
        if (FINAL) {
#pragma unroll
            for (int k = 0; k < 8; ++k) gk[k] = *(const v4u*)(P_Z + (size_t)(tok0 + run + 8 * k) * ZW + 512 + col0); }
#pragma unroll 1
        for (int tt = 0; tt < 4; ++tt) {
            bf16x8 a[2];
#pragma unroll
            for (int ks = 0; ks < 2; ++ks) a[ks] = *(const LAS bf16x8*)(L + XCO + (16 * tt + fr) * 1040 + (64 * w + 32 * ks + 8 * fq) * 2);
#pragma unroll
            for (int jt = 0; jt < 4; ++jt) { f32x4 ga = {0.f, 0.f, 0.f, 0.f}, gx = {0.f, 0.f, 0.f, 0.f};
#pragma unroll
                for (int ks = 0; ks < 2; ++ks) { ga = MFMA16(a[ks], bfr[0][jt][ks], ga); gx = MFMA16(a[ks], bfr[1][jt][ks], gx); }
                const int chn = 64 * w + 16 * jt + fr; float av[4], uv[4];
#pragma unroll
                for (int r = 0; r < 4; ++r) { const int t = 16 * tt + 4 * fq + r; const float xcv = bf2f(XC[t * 520 + chn]);
                    const float la = -fsigmoid(ga[r] + ba[jt]) * sp8[jt]; const float aa = __builtin_amdgcn_exp2f(la); av[r] = aa; uv[r] = sqrtf(fmaxf(1.0f - aa * aa, 0.f)) * fsigmoid(gx[r] + bx[jt]) * xcv; }
                float Pi = av[0] * av[1] * av[2] * av[3], hi = ((uv[0] * av[1] + uv[1]) * av[2] + uv[2]) * av[3] + uv[3];
                { const float tP = __shfl_up(Pi, 16), th = __shfl_up(hi, 16); if (fq >= 1) { hi = Pi * th + hi; Pi = Pi * tP; } }
                { const float tP = __shfl_up(Pi, 32), th = __shfl_up(hi, 32); if (fq >= 2) { hi = Pi * th + hi; Pi = Pi * tP; } }
                float Pe = __shfl_up(Pi, 16), he = __shfl_up(hi, 16); if (fq == 0) { Pe = 1.f; he = 0.f; }
                const float P3 = __shfl(Pi, 48 + fr), h3 = __shfl(hi, 48 + fr);
                if (FINAL) { float hc = Pe * carry[jt] + he;
#pragma unroll
                    for (int r = 0; r < 4; ++r) { const int t = 16 * tt + 4 * fq + r; hc = av[r] * hc + uv[r]; GR[t * 512 + chn] = f2bf1(hc); } }
                carry[jt] = P3 * carry[jt] + h3; ptot[jt] *= P3; }
        }
        if (!FINAL) { if (fq == 0) {
#pragma unroll
            for (int jt = 0; jt < 4; ++jt) { P_RGA[(size_t)u * 512 + 64 * w + 16 * jt + fr] = ptot[jt]; P_RGH[(size_t)u * 512 + 64 * w + 16 * jt + fr] = carry[jt]; } } }
        else { __syncthreads();
#pragma unroll
            for (int k = 0; k < 8; ++k) { const int t = run + 8 * k; f32x4 h0, h1, g0, g1; const v4u hw = *(const LAS v4u*)(L + GRO + t * 1024 + 16 * chunk); pg8::unpack8(hw, h0, h1); pg8::unpack8(gk[k], g0, g1);
#pragma unroll
                for (int e = 0; e < 4; ++e) { h0[e] *= gelu_tanh(g0[e]); h1[e] *= gelu_tanh(g1[e]); }
                *(v4u*)(P_YBUF + (size_t)(tok0 + t) * DM + 8 * chunk) = pg8::pk8(h0, h1); } }
        __syncthreads();
    }
}

__device__ __forceinline__ void mixB_unit(Frame& F, int unit) {
    PHASE_FENCE(F);
    const int bh = unit >> 3, sl = unit & 7; ldsp L = F.lds;
    LAS float* AP = (LAS float*)L; LAS float* AL = AP + 64;
    bf16* base = P_CST + (size_t)bh * 64 * 16384 + sl * 2048 + F.tid * 4; v2u cl[64];
#pragma unroll
    for (int c = 0; c < 64; ++c) cl[c] = *(const v2u*)(base + (size_t)c * 16384);
    if (F.wave == 0) {
        const float mlv = P_MLOC[bh * 64 + F.lane], blv = P_BLAST[bh * 64 + F.lane]; float mst = -INFINITY, mp = 0.f, mn_ = 0.f;
#pragma unroll
        for (int c = 0; c < 64; ++c) { const float ml = __int_as_float(__builtin_amdgcn_readlane(__float_as_int(mlv), c));
            const float bl = __int_as_float(__builtin_amdgcn_readlane(__float_as_int(blv), c)); const float mn = fmaxf(bl + mst, ml);
            if (F.lane == c) { mp = mst; mn_ = mn; }
            mst = mn; }
        AP[F.lane] = __expf(blv + mp - mn_); AL[F.lane] = __expf(mlv - mn_); if (sl == 0) P_MPREV[bh * 64 + F.lane] = mp; }
    __syncthreads();
    { float st[4] = {0.f, 0.f, 0.f, 0.f};
#pragma unroll
      for (int c = 0; c < 64; ++c) { v2u o; o.x = pk2(st[0], st[1]); o.y = pk2(st[2], st[3]); *(v2u*)(base + (size_t)c * 16384) = o;
          const float ap = AP[c], al = AL[c];
          st[0] = ap * st[0] + al * bflo(cl[c].x); st[1] = ap * st[1] + al * bfhi(cl[c].x); st[2] = ap * st[2] + al * bflo(cl[c].y); st[3] = ap * st[3] + al * bfhi(cl[c].y); } }
    if (sl == 0 && F.tid < 128) { float ns = 0.f;
        for (int c0 = 0; c0 < 64; c0 += 16) { float nl[16];
#pragma unroll
            for (int k = 0; k < 16; ++k) nl[k] = P_NLOC[(size_t)(bh * 64 + c0 + k) * 128 + F.tid];
#pragma unroll
            for (int k = 0; k < 16; ++k) { P_NPREV[(size_t)(bh * 64 + c0 + k) * 128 + F.tid] = ns; ns = AP[c0 + k] * ns + AL[c0 + k] * nl[k]; } } }
#pragma unroll
    for (int j = 0; j < 2; ++j) { const int idx = unit * 16 + 2 * F.wave + j, b = idx >> 9, chn = idx & 511; const size_t o = (size_t)(b * 64 + F.lane) * 512 + chn;
        float Pi = P_RGA[o], hi = P_RGH[o];
#pragma unroll
        for (int off = 1; off < 64; off <<= 1) { const float tP = __shfl_up(Pi, off), th = __shfl_up(hi, off); if (F.lane >= off) { hi = Pi * th + hi; Pi = Pi * tP; } }
        float he = __shfl_up(hi, 1); if (F.lane == 0) he = 0.f;
        P_RGC[o] = he; }
    __syncthreads();
}

__device__ __forceinline__ void attn_unit(Frame& F, int u, const bf16* Qb, const bf16* Kb, const bf16* Vb, bf16* Ob) { const float* at_sinks = karg(F, 22);
    const int qb = u & 31, kvh = (u >> 5) & 3, b = u >> 7; const int row0 = b * SEQ + 128 * qb;
    ldsp L = F.lds;
    constexpr int KI = 0, VTO = 36864;
    LAS unsigned short* VT = (LAS unsigned short*)(L + VTO);
#pragma unroll
    for (int it = 0; it < 4; ++it) { const int idx = F.tid + 512 * it, kr = idx & 255, chk = idx >> 8; const bool ok = (qb > 0) || (kr >= 128);
        v4u kv = {0u, 0u, 0u, 0u}, vv = {0u, 0u, 0u, 0u};
        if (ok) { const size_t o = (size_t)(row0 - 128 + kr) * 256 + 64 * kvh + 8 * chk; kv = *(const v4u*)(Kb + o); vv = *(const v4u*)(Vb + o); }
        *(LAS v4u*)(L + KI + kr * 144 + 16 * chk) = kv;
        VT[(8 * chk + 0) * 260 + kr] = (unsigned short)(vv.x & 0xffffu); VT[(8 * chk + 1) * 260 + kr] = (unsigned short)(vv.x >> 16);
        VT[(8 * chk + 2) * 260 + kr] = (unsigned short)(vv.y & 0xffffu); VT[(8 * chk + 3) * 260 + kr] = (unsigned short)(vv.y >> 16);
        VT[(8 * chk + 4) * 260 + kr] = (unsigned short)(vv.z & 0xffffu); VT[(8 * chk + 5) * 260 + kr] = (unsigned short)(vv.z >> 16);
        VT[(8 * chk + 6) * 260 + kr] = (unsigned short)(vv.w & 0xffffu); VT[(8 * chk + 7) * 260 + kr] = (unsigned short)(vv.w >> 16); }
    __syncthreads();
    const int r = F.lane & 31, hh = F.lane >> 5, w = F.wave, head = 4 * kvh + (w >> 1);
    const float sink = at_sinks[head] * 1.4426950408889634f;
#pragma unroll 1
    for (int qt = 0; qt < 2; ++qt) {
        const int q0 = 64 * (w & 1) + 32 * qt, kt0 = q0 >> 5; const size_t qrow = (size_t)(row0 + q0 + r);
        bf16x8 qf[4];
#pragma unroll
        for (int ks = 0; ks < 4; ++ks) qf[ks] = *(const bf16x8*)(Qb + qrow * 1024 + 64 * head + 16 * ks + 8 * hh);
        f32x16 S[5];
#pragma unroll
        for (int i = 0; i < 5; ++i) {
#pragma unroll
            for (int e = 0; e < 16; ++e) S[i][e] = 0.f;
#pragma unroll
            for (int ks = 0; ks < 4; ++ks) { const bf16x8 kf = *(const LAS bf16x8*)(L + KI + (32 * (kt0 + i) + r) * 144 + (16 * ks + 8 * hh) * 2); S[i] = MFMA32(kf, qf[ks], S[i]); } }
        float mx = sink;
#pragma unroll
        for (int i = 0; i < 5; ++i) { const bool whole = (qb == 0) && (kt0 + i < 4);
#pragma unroll
            for (int e = 0; e < 16; ++e) { const int cr = (e & 3) + 8 * (e >> 2) + 4 * hh; float v = S[i][e];
                if (i == 0) v = (cr > r) ? v : -INFINITY;
                if (i == 4) v = (cr <= r) ? v : -INFINITY;
                v = whole ? -INFINITY : v;
                S[i][e] = v; mx = fmaxf(mx, v); } }
        mx = fmaxf(mx, __shfl_xor(mx, 32));
        float sum = 0.f;
#pragma unroll
        for (int i = 0; i < 5; ++i)
#pragma unroll
            for (int e = 0; e < 16; ++e) { const float p = __builtin_amdgcn_exp2f(S[i][e] - mx); S[i][e] = p; sum += p; }
        sum += __shfl_xor(sum, 32); sum += __builtin_amdgcn_exp2f(sink - mx);
        const float inv = 1.0f / sum;
        f32x16 O[2];
#pragma unroll
        for (int e = 0; e < 16; ++e) { O[0][e] = 0.f; O[1][e] = 0.f; }
#pragma unroll
        for (int i = 0; i < 5; ++i)
#pragma unroll
            for (int s = 0; s < 2; ++s) {
                v4u pw; pw.x = pk2(S[i][8 * s + 0], S[i][8 * s + 1]); pw.y = pk2(S[i][8 * s + 2], S[i][8 * s + 3]); pw.z = pk2(S[i][8 * s + 4], S[i][8 * s + 5]); pw.w = pk2(S[i][8 * s + 6], S[i][8 * s + 7]);
                const bf16x8 pf = __builtin_bit_cast(bf16x8, pw);
#pragma unroll
                for (int dt = 0; dt < 2; ++dt) { const int ko = (32 * dt + r) * 520 + (32 * (kt0 + i) + 16 * s + 4 * hh) * 2;
                    const s16x4 lo = *(const LAS s16x4*)(L + VTO + ko), hi = *(const LAS s16x4*)(L + VTO + ko + 16);
                    const bf16x8 vf = __builtin_shufflevector(lo, hi, 0, 1, 2, 3, 4, 5, 6, 7);
                    O[dt] = MFMA32(vf, pf, O[dt]); } }
        bf16* op = Ob + qrow * 1024 + 64 * head + 4 * hh;
#pragma unroll
        for (int dt = 0; dt < 2; ++dt)
#pragma unroll
            for (int g4 = 0; g4 < 4; ++g4) { v2u o; o.x = pk2(O[dt][4 * g4] * inv, O[dt][4 * g4 + 1] * inv); o.y = pk2(O[dt][4 * g4 + 2] * inv, O[dt][4 * g4 + 3] * inv); *(v2u*)(op + 32 * dt + 8 * g4) = o; }
    }
    __syncthreads();
}

__device__ __forceinline__ void fixup_panel(Frame& F, int pm, const float* cw, const float* cb, bf16* A2, const bf16* GH, const bf16* UH, const bf16* GT) {
    for (int idx = F.tid; idx < 8 * 384; idx += NWAVES * 64) {
        const int chk = idx % 384, rg = idx / 384, rr = rg & 1, grp = 4 * pm + (rg >> 1), ch0 = 8 * chk; const bool first = (grp & 63) == 0;
        float g0[8], u0[8], p1[8], p2[8];
        ld8f(GH + ((size_t)grp * 2 + rr) * 3072 + ch0, g0); ld8f(UH + ((size_t)grp * 2 + rr) * 3072 + ch0, u0);
#pragma unroll
        for (int i = 0; i < 8; ++i) { p1[i] = 0.f; p2[i] = 0.f; }
        if (rr == 1) { ld8f(GH + ((size_t)grp * 2) * 3072 + ch0, p1); if (!first) ld8f(GT + ((size_t)(grp - 1) * 2 + 1) * 3072 + ch0, p2); }
        else if (!first) { ld8f(GT + ((size_t)(grp - 1) * 2 + 1) * 3072 + ch0, p1); ld8f(GT + ((size_t)(grp - 1) * 2) * 3072 + ch0, p2); }
        float o[8];
#pragma unroll
        for (int i = 0; i < 8; ++i) { const float y = cw[ch0 + i] * p2[i] + cw[3072 + ch0 + i] * p1[i] + cw[6144 + ch0 + i] * g0[i] + cb[ch0 + i]; o[i] = gelu_tanh(y) * u0[i]; }
        *(v4u*)(A2 + (size_t)grp * 32 * 6144 + ((ch0 >> 6) * 128 + ((ch0 >> 5) & 1) * 64 + rr * 32 + (ch0 & 31))) = pk8f(o);
    }
}

#define GRID_BAR() do { xcd_barrier(bar); TSTAMP(); } while (0)
template <int L> __device__ __forceinline__ bool layer_part(Frame& F, const XcdBarrier& bar, int& ts_n) {
    constexpr int l = L;
    unsigned char* ws = F.ws; const int bx = (int)blockIdx.x;
    bf16* const XBA = (bf16*)(ws + WS_XBA); bf16* const XBB = (bf16*)(ws + WS_XBB);
    float* const SSA = (float*)(ws + WS_SSA); float* const SSB = (float*)(ws + WS_SSB);
    bf16* const PP = (bf16*)(ws + WS_CST); bf16* const A2 = (bf16*)(ws + WS_BIG);

        if (l == 1) {
            bf16* const Qb = (bf16*)(ws + WS_BIG); bf16* const Kb = (bf16*)(ws + WS_BIG + 64 * MiB); bf16* const Vb = (bf16*)(ws + WS_BIG + 80 * MiB); bf16* const Ob = (bf16*)(ws + WS_BIG + 96 * MiB);
PREP(7) {
            { pg8::Gemm g{XBB, (const bf16*)(ws + WS_WQKV), T, 1536, DM}; pg8::StaticOrder S; S.init(T, 1536, F.G, bx);
              pg8::EpiQkv E{SSB, P_ROPE, karg(F, 20), karg(F, 21), Qb, Kb, Vb};
              pg8::gemm_phase<pg8::EpiQkv, pg8::StaticOrder, true, true>(F.lds, g, S, E, F.wave); }
            { pg8::Gemm g{(const bf16*)(ws + WS_PB) + (size_t)T * 256, (const bf16*)(ws + WS_WPJ1), T, DM, 256}; pg8::StaticOrder S; S.init(T, DM, F.G, bx);
              pg8::EpiZ<true> E{PP, DM, nullptr};
              pg8::gemm_phase<pg8::EpiZ<true>, pg8::StaticOrder, true, true>(F.lds, g, S, E, F.wave); }
            GRID_BAR();
    }

            PREP(8) {
            PHASE_FENCE(F); for (int u = F.vcu; u < 1024; u += F.G) attn_unit(F, u, Qb, Kb, Vb, Ob);
            GRID_BAR();
            }
            { pg8::Gemm g{Ob, (const bf16*)(ws + WS_WO1), T, DM, DM}; pg8::StaticOrder S; S.init(T, DM, F.G, bx);
              pg8::EpiRes<false, false> E{XBB, XBA, SSA};
              pg8::gemm_phase<pg8::EpiRes<false, false>, pg8::StaticOrder, true, true>(F.lds, g, S, E, F.wave); }
            GRID_BAR();
            if (DBG_STOP == 9) return true;
        } else {
PREP(3) {
            { pg8::Gemm g{P_YBUF, (const bf16*)(ws + WS_WOUT0), T, DM, DM}; pg8::StaticOrder S; S.init(T, DM, F.G, bx);
              pg8::EpiRes<true, false> E{karg(F, 0), XBB, SSB};
              pg8::gemm_phase<pg8::EpiRes<true, false>, pg8::StaticOrder, true, true>(F.lds, g, S, E, F.wave); }
            { pg8::Gemm g{(const bf16*)(ws + WS_PB), (const bf16*)(ws + WS_WPJ0), T, DM, 256}; pg8::StaticOrder S; S.init(T, DM, F.G, bx);
              pg8::EpiZ<true> E{PP, DM, nullptr};
              pg8::gemm_phase<pg8::EpiZ<true>, pg8::StaticOrder, true, true>(F.lds, g, S, E, F.wave); }
            GRID_BAR();
    }

            if (DBG_STOP == 3) return true;
        }
        const bf16* xin = l ? XBA : XBB; const float* ssin = l ? SSA : SSB; bf16* side = l ? XBB : XBA;
        bf16* const GH = side; bf16* const UH = side + (size_t)3 * MiB; bf16* const GT = side + (size_t)6 * MiB;
        const float* cw = karg(F, 25) + (size_t)l * 3 * 3072; const float* cb = karg(F, 26) + (size_t)l * 3072;
#ifdef PROBE_UP
        if (L == 0) { pg8::Gemm g{xin, (const bf16*)(ws + (l ? WS_WUP1 : WS_WUP0)), T, 2 * FFD, DM}; pg8::StaticOrder S; S.init(T, 2 * FFD, F.G, bx);
#if PROBE_UP == 4
          pg8::EpiNone E0{}; pg8::gemm_phase<pg8::EpiNone, pg8::StaticOrder, true, true>(F.lds, g, S, E0, F.wave);
#else
          pg8::EpiUpT<PROBE_UP> E0{ssin, cw, cb, A2, GH, UH, GT}; pg8::gemm_phase<pg8::EpiUpT<PROBE_UP>, pg8::StaticOrder, true, true>(F.lds, g, S, E0, F.wave);
#endif
          GRID_BAR(); }
#endif
        PREP(10 + 10 * l) {
        { pg8::Gemm g{xin, (const bf16*)(ws + (l ? WS_WUP1 : WS_WUP0)), T, 2 * FFD, DM}; pg8::StaticOrder S; S.init(T, 2 * FFD, F.G, bx);
          pg8::EpiUp E{ssin, cw, cb, A2, GH, UH, GT};
          pg8::gemm_phase<pg8::EpiUp, pg8::StaticOrder, true, true>(F.lds, g, S, E, F.wave); }
        GRID_BAR();
        }
        PHASE_FENCE(F); for (int pm = F.vcu; pm < T / 256; pm += F.G) fixup_panel(F, pm, cw, cb, A2, GH, UH, GT);
        GRID_BAR();
        bf16* const xdn = l ? XBB : XBA; float* const ssdn = l ? SSB : SSA;
        { pg8::Gemm g{A2, (const bf16*)(ws + (l ? WS_WDN1 : WS_WDN0)), T, DM, FFD}; pg8::StaticOrder S; S.init(T, DM, F.G, bx);
          pg8::EpiRes<false, true> E{xin, xdn, ssdn};
          pg8::gemm_phase<pg8::EpiRes<false, true>, pg8::StaticOrder, true, true>(F.lds, g, S, E, F.wave); }
        GRID_BAR();
        if ((l == 0 && DBG_STOP == 5) || (l == 1 && DBG_STOP == 11)) return true;
#ifdef PROBE_P6MODE
        if (L == 0) { pg8::Gemm g{xdn, (const bf16*)(ws + (l ? WS_WGT1 : WS_WGT0)), T, DM, DM}; pg8::StaticOrder S; S.init(T, DM, F.G, bx);
#if PROBE_P6MODE == 0
          pg8::EpiNone E0{}; pg8::gemm_phase<pg8::EpiNone, pg8::StaticOrder, true, true>(F.lds, g, S, E0, F.wave);
#else
          pg8::EpiPleProbe<PROBE_P6MODE> E0{ssdn, PP, xdn, A2, (float*)(ws + WS_BIG + 100 * MiB)}; pg8::gemm_phase<pg8::EpiPleProbe<PROBE_P6MODE>, pg8::StaticOrder, true, true>(F.lds, g, S, E0, F.wave);
#endif
          GRID_BAR(); }
#endif
        { pg8::Gemm g{xdn, (const bf16*)(ws + (l ? WS_WGT1 : WS_WGT0)), T, DM, DM}; pg8::StaticOrder S; S.init(T, DM, F.G, bx);
          pg8::EpiPle<(L == 1)> E{ssdn, PP, xdn, XBB, SSB, F.out};
          pg8::gemm_phase<pg8::EpiPle<(L == 1)>, pg8::StaticOrder, true, true>(F.lds, g, S, E, F.wave); }
        if (l == 0) GRID_BAR();
        if (l == 0 && DBG_STOP == 6) return true;

    return false;
}
struct Args { const void* in[30]; float* out; unsigned char* ws; };
__global__ void __launch_bounds__(NWAVES * 64, 2) hy_fwd(Args args) {
    extern __shared__ __attribute__((aligned(16))) unsigned char lds[];
    Frame F;
    F.lds = (ldsp)lds; F.MISC = (volatile LAS unsigned*)(F.lds + MISC_OFF);
    F.tid = threadIdx.x; F.lane = F.tid & 63; F.wave = __builtin_amdgcn_readfirstlane(F.tid >> 6);
    F.G = gridDim.x; { const int bx = blockIdx.x; F.vcu = (F.G % 8 == 0) ? (bx % 8) * (F.G / 8) + bx / 8 : bx; }
    unsigned char* ws = args.ws; F.ws = ws; F.out = args.out;
    F.kb = (unsigned long long)__builtin_amdgcn_kernarg_segment_ptr();
    for (int i = F.tid; i < (LDS_BYTES - LDSCTL_OFF) / 4; i += NWAVES * 64) ((LAS unsigned*)(F.lds + LDSCTL_OFF))[i] = 0u;
    __syncthreads();
    XcdBarrier bar = xcd_barrier_post((unsigned*)(ws + WS_CTL) + CW_BAR, F.MISC + 8, F.wave);
    bf16* const XBA = (bf16*)(ws + WS_XBA); bf16* const XBB = (bf16*)(ws + WS_XBB);
    float* const SSA = (float*)(ws + WS_SSA); float* const SSB = (float*)(ws + WS_SSB);
    bf16* const PP = (bf16*)(ws + WS_CST); bf16* const A2 = (bf16*)(ws + WS_BIG);
    const int bx = (int)blockIdx.x; int ts_n = 0; (void)ts_n;
    TSTAMP();

    PREP(100) {
    p0_prologue(F, bar, ts_n);
    GRID_BAR();
    }
#if DBG_STOP >= 1
PREP(1) {
    { pg8::Gemm g{XBA, (const bf16*)(ws + WS_WIN), T, ZW, DM}; pg8::StaticOrder S; S.init(T, ZW, F.G, bx);
#if PROBE_PHASE == 1 && defined(PROBE_VARIANT)
      if (rep_ < PROBE_N) {
#if PROBE_VARIANT == 1
        pg8::EpiNone E0{}; pg8::gemm_phase<pg8::EpiNone, pg8::StaticOrder, true, true>(F.lds, g, S, E0, F.wave);
#elif PROBE_VARIANT == 4
        pg8::EpiNone E0{}; pg8::gemm_phase<pg8::EpiNone, pg8::StaticOrder, false, true>(F.lds, g, S, E0, F.wave);
#elif PROBE_VARIANT == 5
        pg8::EpiNone E0{}; pg8::gemm_phase<pg8::EpiNone, pg8::StaticOrder, true, false>(F.lds, g, S, E0, F.wave);
#elif PROBE_VARIANT == 3
        pg8::EpiZLine E0{P_Z, ZW}; pg8::gemm_phase<pg8::EpiZLine, pg8::StaticOrder, true, true>(F.lds, g, S, E0, F.wave);
#else
        pg8::EpiZ<false> E0{P_Z, ZW, nullptr}; pg8::gemm_phase<pg8::EpiZ<false>, pg8::StaticOrder, true, true>(F.lds, g, S, E0, F.wave);
#endif
      } else
#endif
      { pg8::EpiZ<false> E{P_Z, ZW, karg(F, 7)};
      pg8::gemm_phase<pg8::EpiZ<false>, pg8::StaticOrder, true, true>(F.lds, g, S, E, F.wave); } }
    GRID_BAR();
    }

    PREP(21) { mlA_phase(F); }
#ifdef PROBE_P2CSPLIT
    GRID_BAR();
#endif
    PREP(22) { rg_phase<false>(F); }
    GRID_BAR();
    for (int u = F.vcu; u < 256; u += F.G) mixB_unit(F, u);
    GRID_BAR();
    PREP(41) { mlC_phase(F); }
#ifdef PROBE_P2CSPLIT
    GRID_BAR();
#endif
    PREP(42) { rg_phase<true>(F); }
    GRID_BAR();
#endif
    PREP(99) { if (rep_ > 0) GRID_BAR(); }
#if DBG_STOP >= 3
    if (layer_part<0>(F, bar, ts_n)) return;
    if (layer_part<1>(F, bar, ts_n)) return;
#ifdef PROBE_TA
    GRID_BAR();
    if (blockIdx.x == 0 && threadIdx.x == 0) { const unsigned dt = F.MISC[16 + PROBE_TB] - F.MISC[16 + PROBE_TA] - (unsigned)(PROBE_TOFF); F.out[0] += floorf((float)dt * (float)(PROBE_TSCALE) * 0.5f) * 2.0f; }
#endif
#endif
}

extern "C" void kernel_launch(void* const* d_in, const int* in_sizes, int n_in, void* d_out, int out_size, void* d_ws, size_t ws_size, hipStream_t stream) {
    static int grid = 0;
    if (grid == 0) {
        if (n_in != 30 || in_sizes[0] != T * DM || out_size != T * DM || ws_size < WS_END) { fprintf(stderr, "kernel_launch: unexpected shapes (n_in %d, in0 %d, out %d, ws %zu < %zu); nothing launched\n", n_in, n_in > 0 ? in_sizes[0] : -1, out_size, ws_size, (size_t)WS_END); grid = -1; return; }
        int dev = 0, cus = 0, per_cu = 0;
        if (hipGetDevice(&dev) != hipSuccess || hipDeviceGetAttribute(&cus, hipDeviceAttributeMultiprocessorCount, dev) != hipSuccess) { fprintf(stderr, "kernel_launch: device query failed\n"); grid = -1; return; }
        if (hipFuncSetAttribute((const void*)hy_fwd, hipFuncAttributeMaxDynamicSharedMemorySize, LDS_BYTES) != hipSuccess) { fprintf(stderr, "kernel_launch: hipFuncSetAttribute failed\n"); grid = -1; return; }
        if (hipOccupancyMaxActiveBlocksPerMultiprocessor(&per_cu, (const void*)hy_fwd, NWAVES * 64, LDS_BYTES) != hipSuccess || per_cu < 1) { fprintf(stderr, "kernel_launch: occupancy query says %d workgroups per CU; nothing launched\n", per_cu); (void)hipGetLastError(); grid = -1; return; }
        grid = cus;
    }
    if (grid < 0) return;
    if (hipMemsetAsync((char*)d_ws + WS_CTL, 0, CTL_ZERO_BYTES, stream) != hipSuccess) { fprintf(stderr, "kernel_launch: hipMemsetAsync failed\n"); return; }
    Args a{};
    for (int i = 0; i < 30; ++i) a.in[i] = d_in[i];
    a.out = (float*)d_out; a.ws = (unsigned char*)d_ws;
    hipLaunchKernelGGL(hy_fwd, dim3(grid), dim3(NWAVES * 64), LDS_BYTES, stream, a);
    const hipError_t le = hipPeekAtLastError();
    if (le != hipSuccess) fprintf(stderr, "kernel_launch: launch failed: %s\n", hipGetErrorName(le));
}
```

```cpp
#include <hip/hip_runtime.h>
#include <cstdio>
#include <cstdint>
#include <cmath>
namespace pg8 {
#define PG8_LAS __attribute__((address_space(3)))
typedef unsigned short bf16_t;
typedef short bf16x8 __attribute__((ext_vector_type(8)));
typedef float f32x4 __attribute__((ext_vector_type(4)));
typedef unsigned u32x4 __attribute__((ext_vector_type(4)));
constexpr int BM = 256, BK = 64, HALF = 128, HTB = HALF * BK * 2  , STAGE_BYTES = 8 * HTB, NXCD = 8, WGM = 8;

__host__ __device__ __forceinline__ int lds_byte(int r, int c) { const int st = (r >> 4) * 2 + (c >> 5), rr = r & 15, cc = c & 31, ob = rr * 64 + cc * 2; return st * 1024 + (ob ^ (((ob >> 9) & 1) << 5)); }
__host__ __device__ __forceinline__ void stage_rc(int b, int& R, int& C) { const int st = b / 1024, sb = b % 1024, swz = sb ^ (((sb >> 9) & 1) << 5); R = (st >> 1) * 16 + swz / 64; C = (st & 1) * 32 + (swz % 64) / 2; }
__host__ __device__ __forceinline__ int perm32(int rho) { const int n = rho >> 4, i = rho & 15; return 8 * (i >> 2) + 4 * n + (i & 3); }

__device__ __forceinline__ int lane_now() { int l; asm volatile("v_mbcnt_lo_u32_b32 %0, -1, 0\n\tv_mbcnt_hi_u32_b32 %0, -1, %0" : "=v"(l)); return l; }

struct Unit { int pm, pn; };
struct Gemm { const bf16_t* A; const bf16_t* Bt; int M, N, K; };

struct StaticOrder {
    int nM, nN, nwg, G, c;
    __host__ __device__ void init(int M, int N, int G_, int c_) { nM = M / BM; nN = N / BM; nwg = nM * nN; G = G_; c = c_; }
    __host__ __device__ bool next(int i, Unit& u) const {
        const long L = (long)i * G + c; if (L >= nwg) return false;
        int wgid = (int)L; { const int q = nwg / NXCD, r = nwg % NXCD, xcd = wgid % NXCD, off = wgid / NXCD; wgid = (xcd < r ? xcd * (q + 1) : r * (q + 1) + (xcd - r) * q) + off; }
        const int nig = WGM * nN, gid = wgid / nig, fm = gid * WGM, gsz = (nM - fm) < WGM ? (nM - fm) : WGM;
        u.pm = fm + ((wgid % nig) % gsz); u.pn = (wgid % nig) / gsz; return true;
    }
    __device__ __forceinline__ void a_ready(const Unit&) const {}
    __device__ __forceinline__ void done(const Unit&) const {}
};

typedef float f32x2_t __attribute__((ext_vector_type(2))); typedef __bf16 bf16x2_t __attribute__((ext_vector_type(2)));
__device__ __forceinline__ unsigned pk2(float lo, float hi) { f32x2_t v = {lo, hi}; bf16x2_t b = __builtin_convertvector(v, bf16x2_t); return __builtin_bit_cast(unsigned, b); }
__device__ __forceinline__ float bflo(unsigned w) { return __uint_as_float(w << 16); }
__device__ __forceinline__ float bfhi(unsigned w) { return __uint_as_float(w & 0xffff0000u); }
__device__ __forceinline__ float fsigmoid(float x) { return __builtin_amdgcn_rcpf(1.0f + __expf(-x)); }
__device__ __forceinline__ float gelu_tanh(float x) { const float t2 = x * (2.3022082f + 0.10294324f * x * x); return x * __builtin_amdgcn_rcpf(1.0f + __builtin_amdgcn_exp2f(-t2)); }
__device__ __forceinline__ u32x4 pk8(const f32x4& a, const f32x4& b) { u32x4 w; w.x = pk2(a[0], a[1]); w.y = pk2(a[2], a[3]); w.z = pk2(b[0], b[1]); w.w = pk2(b[2], b[3]); return w; }
__device__ __forceinline__ float dot4(const f32x4& a) { return (a[0] * a[0] + a[1] * a[1]) + (a[2] * a[2] + a[3] * a[3]); }
__device__ __forceinline__ float sum_fq(float s) {
    { const auto r = __builtin_amdgcn_permlane16_swap(__float_as_uint(s), __float_as_uint(s), false, false); s = __uint_as_float(r[0]) + __uint_as_float(r[1]); }
    { const auto r = __builtin_amdgcn_permlane32_swap(__float_as_uint(s), __float_as_uint(s), false, false); s = __uint_as_float(r[0]) + __uint_as_float(r[1]); }
    return s;
}
__device__ __forceinline__ float row_rstd(const float* ss, int row) {
    const f32x4* p = (const f32x4*)(ss + (size_t)row * 16);
    const f32x4 a = p[0], b = p[1], c = p[2], d = p[3];
    const float s = (((a[0] + a[1]) + (a[2] + a[3])) + ((b[0] + b[1]) + (b[2] + b[3]))) + (((c[0] + c[1]) + (c[2] + c[3])) + ((d[0] + d[1]) + (d[2] + d[3])));
    return rsqrtf(s * (1.0f / 1024.0f) + 1e-6f);
}

__device__ __forceinline__ unsigned dpp_xor1(unsigned v) { return (unsigned)__builtin_amdgcn_update_dpp(0, (int)v, 0xB1, 0xF, 0xF, true); }
template <int N> __device__ __forceinline__ unsigned dpp_ror(unsigned v) { return (unsigned)__builtin_amdgcn_update_dpp(0, (int)v, 0x120 + N, 0xF, 0xF, true); }
__device__ __forceinline__ u32x4 shfl1(const u32x4& v) { u32x4 r; r.x = dpp_xor1(v.x); r.y = dpp_xor1(v.y); r.z = dpp_xor1(v.z); r.w = dpp_xor1(v.w); return r; }
__device__ __forceinline__ void xchg_out(const u32x4& X0, const u32x4& X1, bool odd, u32x4& PA, u32x4& PB) { const u32x4 recv = shfl1(odd ? X0 : X1); PA = odd ? recv : X0; PB = odd ? X1 : recv; }
__device__ __forceinline__ void xchg_in(const u32x4& LA, const u32x4& LB, bool odd, u32x4& X0, u32x4& X1) { const u32x4 recv = shfl1(odd ? LA : LB); X0 = odd ? recv : LA; X1 = odd ? LB : recv; }
__device__ __forceinline__ void st16(void* p, const u32x4& v) { __builtin_nontemporal_store(v, (u32x4*)p); }
__device__ __forceinline__ u32x4 f2u(const f32x4& v) { return __builtin_bit_cast(u32x4, v); }
__device__ __forceinline__ f32x4 u2f(const u32x4& v) { return __builtin_bit_cast(f32x4, v); }
__device__ __forceinline__ void unpack8(const u32x4& w, f32x4& a, f32x4& b) { a[0] = bflo(w.x); a[1] = bfhi(w.x); a[2] = bflo(w.y); a[3] = bfhi(w.y); b[0] = bflo(w.z); b[1] = bfhi(w.z); b[2] = bflo(w.w); b[3] = bfhi(w.w); }
__device__ __forceinline__ void store_bf16_lines(bf16_t* base, int ld, int rowE, int fr, int fq, const u32x4& X0, const u32x4& X1) {
    const bool odd = fr & 1; u32x4 PA, PB; xchg_out(X0, X1, odd, PA, PB); const int c8 = ((fr & 1) * 4 + fq) * 8;
    st16(base + (size_t)rowE * ld + c8, PA); st16(base + (size_t)(rowE + 1) * ld + c8, PB);
}
__device__ __forceinline__ void load_bf16_lines(const bf16_t* base, int ld, int rowE, int fr, int fq, u32x4& X0, u32x4& X1) {
    const bool odd = fr & 1; const int c8 = ((fr & 1) * 4 + fq) * 8;
    const u32x4 LA = *(const u32x4*)(base + (size_t)rowE * ld + c8), LB = *(const u32x4*)(base + (size_t)(rowE + 1) * ld + c8); xchg_in(LA, LB, odd, X0, X1);
}
__device__ __forceinline__ void store_f32_lines(float* base, int ld, int rowE, int fr, int fq, const f32x4& N0, const f32x4& N1) {
    const bool odd = fr & 1; u32x4 PA, PB; xchg_out(f2u(N0), f2u(N1), odd, PA, PB); const int c4 = (2 * fq + (fr & 1)) * 4;
    st16(base + (size_t)rowE * ld + c4, PA); st16(base + (size_t)(rowE + 1) * ld + c4, PB);
}
__device__ __forceinline__ void load_f32_lines(const float* base, int ld, int rowE, int fr, int fq, f32x4& N0, f32x4& N1) {
    const bool odd = fr & 1; const int c4 = (2 * fq + (fr & 1)) * 4;
    const u32x4 LA = *(const u32x4*)(base + (size_t)rowE * ld + c4), LB = *(const u32x4*)(base + (size_t)(rowE + 1) * ld + c4); u32x4 X0, X1; xchg_in(LA, LB, odd, X0, X1); N0 = u2f(X0); N1 = u2f(X1);
}
__device__ __forceinline__ size_t pair_off(int LD, int row, int colw, int fq) { return (size_t)(row >> 1) * (size_t)(2 * LD) + (size_t)((colw >> 6) * 128 + (row & 1) * 32 + 8 * fq); }

__device__ __forceinline__ f32x4 rstd_ld(const float* ss, int row, int fq) { return *(const f32x4*)(ss + (size_t)row * 16 + 4 * fq); }
__device__ __forceinline__ float rstd_fin(const f32x4& p) { float s = (p[0] + p[1]) + (p[2] + p[3]); s = sum_fq(s); return rsqrtf(s * (1.0f / 1024.0f) + 1e-6f); }

template <bool OPAIR> struct EpiZ {
    static constexpr bool PERM = true, AFTER_DRAIN = false, APERM = false, PRE = false;
    bf16_t* O; int ldc; const float* bias;
    __device__ __forceinline__ void operator()(const f32x4 (&acc)[2][2][4][2], const Unit& u, int wr, int wc, int fr, int fq) const {
        const int colw = u.pn * BM + 64 * wc;
        f32x4 bv[2][2];
#pragma unroll
        for (int bj = 0; bj < 2; ++bj)
#pragma unroll
            for (int n = 0; n < 2; ++n) bv[bj][n] = bias ? *(const f32x4*)(bias + colw + 32 * bj + 8 * fq + 4 * n) : (f32x4){0.f, 0.f, 0.f, 0.f};
#pragma unroll
        for (int ai = 0; ai < 2; ++ai) {
#pragma unroll
            for (int m = 0; m < 4; ++m) { const int rowE = u.pm * BM + ai * HALF + wr * 64 + m * 16 + (fr & ~1);
                const u32x4 X0 = pk8(acc[ai][0][m][0] + bv[0][0], acc[ai][0][m][1] + bv[0][1]), X1 = pk8(acc[ai][1][m][0] + bv[1][0], acc[ai][1][m][1] + bv[1][1]);
                if (OPAIR) { bf16_t* o = O + pair_off(ldc, rowE + (fr & 1), colw, fq); st16(o, X0); st16(o + 64, X1); }
                else store_bf16_lines(O + colw, ldc, rowE, fr, fq, X0, X1); } }
    }
};

template <bool SRCF32, bool AP> struct EpiRes {
    static constexpr bool PERM = true, AFTER_DRAIN = false, APERM = AP, PRE = false;
    const void* src; bf16_t* xb; float* sso;
    __device__ __forceinline__ void operator()(const f32x4 (&acc)[2][2][4][2], const Unit& u, int wr, int wc, int fr, int fq) const {
        const int colw = u.pn * BM + 64 * wc; const bool odd = fr & 1;
#pragma unroll
        for (int ah = 0; ah < (SRCF32 ? 4 : 2); ++ah) { const int ai = SRCF32 ? (ah >> 1) : ah, m0 = SRCF32 ? (ah & 1) * 2 : 0, m1 = SRCF32 ? m0 + 2 : 4;
            u32x4 LA[4][2], LB[4][2];
#pragma unroll
            for (int m = m0; m < m1; ++m) { const int rowE = u.pm * BM + ai * HALF + wr * 64 + m * 16 + (fr & ~1);
                if (SRCF32) { const int c4 = (2 * fq + (fr & 1)) * 4;
#pragma unroll
                    for (int bj = 0; bj < 2; ++bj) { const float* b = (const float*)src + colw + 32 * bj + c4; LA[m][bj] = *(const u32x4*)(b + (size_t)rowE * 1024); LB[m][bj] = *(const u32x4*)(b + (size_t)(rowE + 1) * 1024); } }
                else { const bf16_t* b = (const bf16_t*)src + pair_off(1024, rowE + (fr & 1), colw, fq); LA[m][0] = *(const u32x4*)b; LB[m][0] = *(const u32x4*)(b + 64); } }
#pragma unroll
            for (int m = m0; m < m1; ++m) { const int rowE = u.pm * BM + ai * HALF + wr * 64 + m * 16 + (fr & ~1), row = rowE + (fr & 1);
                f32x4 r[2][2];
                if (SRCF32) {
#pragma unroll
                    for (int bj = 0; bj < 2; ++bj) { u32x4 X0, X1; xchg_in(LA[m][bj], LB[m][bj], odd, X0, X1); r[bj][0] = u2f(X0); r[bj][1] = u2f(X1); } }
                else { unpack8(LA[m][0], r[0][0], r[0][1]); unpack8(LB[m][0], r[1][0], r[1][1]); }
                float sq = 0.f; f32x4 v[2][2];
#pragma unroll
                for (int bj = 0; bj < 2; ++bj)
#pragma unroll
                    for (int n = 0; n < 2; ++n) { v[bj][n] = r[bj][n] + acc[ai][bj][m][n]; sq += dot4(v[bj][n]); }
                { bf16_t* o = xb + pair_off(1024, row, colw, fq); st16(o, pk8(v[0][0], v[0][1])); st16(o + 64, pk8(v[1][0], v[1][1])); }
                sq = sum_fq(sq);
                sso[(size_t)row * 16 + 4 * u.pn + wc] = sq; } }
    }
};

template <bool FINAL> struct EpiPle {
    static constexpr bool PERM = true, AFTER_DRAIN = false, APERM = true, PRE = false;
    const float* ss; const bf16_t* pp; const bf16_t* xin; bf16_t* xb; float* sso; float* out;
    __device__ __forceinline__ void operator()(const f32x4 (&acc)[2][2][4][2], const Unit& u, int wr, int wc, int fr, int fq) const {
        const int colw = u.pn * BM + 64 * wc;
        float c_one = 1.0f; asm("" : "+s"(c_one)); const f32x4 ONE = {c_one, c_one, c_one, c_one};
#pragma unroll
        for (int ah = 0; ah < 4; ++ah) { const int ai = ah >> 1, m0 = (ah & 1) * 2;
            u32x4 XA[4], XB[4], PA[4], PB[4]; f32x4 rp[4];
#pragma unroll
            for (int m = m0; m < m0 + 2; ++m) { const int rowE = u.pm * BM + ai * HALF + wr * 64 + m * 16 + (fr & ~1); const size_t o = pair_off(1024, rowE + (fr & 1), colw, fq);
                rp[m] = rstd_ld(ss, rowE + (fr & 1), fq);
                XA[m] = *(const u32x4*)(xin + o); XB[m] = *(const u32x4*)(xin + o + 64); PA[m] = *(const u32x4*)(pp + o); PB[m] = *(const u32x4*)(pp + o + 64); }
#pragma unroll
            for (int m = m0; m < m0 + 2; ++m) { const int rowE = u.pm * BM + ai * HALF + wr * 64 + m * 16 + (fr & ~1), row = rowE + (fr & 1); const float rsl = rstd_fin(rp[m]) * -1.4426950408889634f;
                f32x4 r[2][2], p[2][2];
                unpack8(XA[m], r[0][0], r[0][1]); unpack8(XB[m], r[1][0], r[1][1]);
                unpack8(PA[m], p[0][0], p[0][1]); unpack8(PB[m], p[1][0], p[1][1]);
                float sq = 0.f; f32x4 v[2][2];
#pragma unroll
                for (int bj = 0; bj < 2; ++bj)
#pragma unroll
                    for (int n = 0; n < 2; ++n) { const f32x4 a = acc[ai][bj][m][n] * rsl; f32x4 ex, sg;
#pragma unroll
                        for (int e = 0; e < 4; ++e) ex[e] = __builtin_amdgcn_exp2f(a[e]);
                        const f32x4 den = ex + ONE;
#pragma unroll
                        for (int e = 0; e < 4; ++e) sg[e] = __builtin_amdgcn_rcpf(den[e]);
                        v[bj][n] = r[bj][n] + sg * p[bj][n];
                        sq += dot4(v[bj][n]); }
                if (FINAL) { store_f32_lines(out + colw, 1024, rowE, fr, fq, v[0][0], v[0][1]); store_f32_lines(out + colw + 32, 1024, rowE, fr, fq, v[1][0], v[1][1]); }
                else { { bf16_t* o = xb + pair_off(1024, row, colw, fq); st16(o, pk8(v[0][0], v[0][1])); st16(o + 64, pk8(v[1][0], v[1][1])); }
                    sq = sum_fq(sq);
                    sso[(size_t)row * 16 + 4 * u.pn + wc] = sq; } } }
    }
};

constexpr int ROPE_LDS_OFF = STAGE_BYTES;
struct EpiQkv {
    static constexpr bool PERM = true, AFTER_DRAIN = false, APERM = true, PRE = true;
    const float* ss; const unsigned short* rope; const float* qn; const float* kn; bf16_t* Q; bf16_t* K; bf16_t* V; PG8_LAS unsigned char* lds;
    __device__ __forceinline__ void pre(const Unit& u, int wid, int lane) const {
        if (u.pn == 5) return;
#pragma unroll
        for (int j = 0; j < 4; ++j) { const int q = wid + 8 * j;
            if (q < 28) { const int sl = 8 * q + (lane >> 3), t = sl - 128, w1 = (t >= 48) ? 1 : 0; const int row = (sl < 128) ? sl : 128 + 64 * w1 + (t - 48 * w1);
                const char* src = (const char*)rope + (size_t)(u.pm * BM + row) * 128 + (lane & 7) * 16;
                __builtin_amdgcn_global_load_lds((const unsigned*)src, (PG8_LAS unsigned*)(lds + ROPE_LDS_OFF + q * 1024), 16, 0, 0); } }
    }
    static __device__ __forceinline__ float h_lo(unsigned w) { return (float)__builtin_bit_cast(_Float16, (unsigned short)(w & 0xffffu)); }
    static __device__ __forceinline__ float h_hi(unsigned w) { unsigned hi = w >> 16; asm("" : "+v"(hi)); return (float)__builtin_bit_cast(_Float16, (unsigned short)hi); }
    static __device__ __forceinline__ void h8_to_f32(const u32x4& w, f32x4& a, f32x4& b) {
        a[0] = h_lo(w.x); a[1] = h_hi(w.x); a[2] = h_lo(w.y); a[3] = h_hi(w.y); b[0] = h_lo(w.z); b[1] = h_hi(w.z); b[2] = h_lo(w.w); b[3] = h_hi(w.w);
    }
    __device__ __forceinline__ void operator()(const f32x4 (&acc)[2][2][4][2], const Unit& u, int wr, int wc, int fr, int fq) const {
        if (u.pn == 5) {
#pragma unroll
            for (int ai = 0; ai < 2; ++ai)
#pragma unroll
                for (int m = 0; m < 4; ++m) { const int rowE = u.pm * BM + ai * HALF + wr * 64 + m * 16 + (fr & ~1), row = rowE + (fr & 1); const float rs = rstd_fin(rstd_ld(ss, row, fq));
                    store_bf16_lines(V + 64 * wc, 256, rowE, fr, fq, pk8(acc[ai][0][m][0] * rs, acc[ai][0][m][1] * rs), pk8(acc[ai][1][m][0] * rs, acc[ai][1][m][1] * rs)); }
            return;
        }
        const bool isq = u.pn < 4; const float* gn = isq ? qn : kn; const float osc = isq ? 0.125f * 1.4426950408889634f : 1.0f;
        bf16_t* dst = isq ? Q + (size_t)(64 * (4 * u.pn + wc)) : K + (size_t)(64 * wc); const int ldd = isq ? 1024 : 256;
        f32x4 g[2][2];
#pragma unroll
        for (int bj = 0; bj < 2; ++bj)
#pragma unroll
            for (int n = 0; n < 2; ++n) g[bj][n] = *(const f32x4*)(gn + 32 * bj + 8 * fq + 4 * n);
#pragma unroll
        for (int ai = 0; ai < 2; ++ai) { f32x4 rp[4]; u32x4 gcs[2];
            if (ai == 1) { const unsigned short* rq = rope + (size_t)(u.pm * BM + HALF + wr * 64 + 48 + fr) * 64 + 8 * fq; gcs[0] = *(const u32x4*)rq; gcs[1] = *(const u32x4*)(rq + 32); }
#pragma unroll
            for (int m = 0; m < 4; ++m) rp[m] = rstd_ld(ss, u.pm * BM + ai * HALF + wr * 64 + m * 16 + fr, fq);
#pragma unroll
            for (int m = 0; m < 4; ++m) { const int rowE = u.pm * BM + ai * HALF + wr * 64 + m * 16 + (fr & ~1); const float rs = rstd_fin(rp[m]);
                u32x4 c8, s8;
#ifdef PROBE_ROPEGLOBAL
                if (true) { const unsigned short* rq2 = rope + (size_t)(u.pm * BM + ai * HALF + wr * 64 + m * 16 + fr) * 64 + 8 * fq; c8 = *(const u32x4*)rq2; s8 = *(const u32x4*)(rq2 + 32); (void)gcs; }
#else
                if (ai == 1 && m == 3) { c8 = gcs[0]; s8 = gcs[1]; }
#endif
                else { const int sl = (ai == 0) ? wr * 64 + m * 16 + fr : 128 + wr * 48 + m * 16 + fr; PG8_LAS const unsigned char* lp = lds + ROPE_LDS_OFF + sl * 128 + 16 * fq;
                    c8 = *(PG8_LAS const u32x4*)lp; s8 = *(PG8_LAS const u32x4*)(lp + 64); }
                f32x4 csn[4]; h8_to_f32(c8, csn[0], csn[1]); h8_to_f32(s8, csn[2], csn[3]);
                f32x4 v[2][2]; float sq = 0.f;
#pragma unroll
                for (int bj = 0; bj < 2; ++bj)
#pragma unroll
                    for (int n = 0; n < 2; ++n) { v[bj][n] = acc[ai][bj][m][n] * rs; sq += dot4(v[bj][n]); }
                sq = sum_fq(sq);
                const float hr = rsqrtf(sq * (1.0f / 64.0f) + 1e-6f);
#pragma unroll
                for (int bj = 0; bj < 2; ++bj)
#pragma unroll
                    for (int n = 0; n < 2; ++n) v[bj][n] = v[bj][n] * hr * g[bj][n];
                f32x4 o[2][2];
#pragma unroll
                for (int n = 0; n < 2; ++n) { const f32x4 cs = csn[n], sn = csn[2 + n];
                    o[0][n] = (v[0][n] * cs - v[1][n] * sn) * osc; o[1][n] = (v[1][n] * cs + v[0][n] * sn) * osc; }
                store_bf16_lines(dst, ldd, rowE, fr, fq, pk8(o[0][0], o[0][1]), pk8(o[1][0], o[1][1])); } }
    }
};

__device__ __forceinline__ void conv_taps_shr(f32x4& y, const f32x4& g, const f32x4& w1, const f32x4& w0) {
    float y0 = y[0], y1 = y[1], y2 = y[2], y3 = y[3];
    asm("s_nop 1\n\t"
        "v_fmac_f32_dpp %0, %4, %8 row_shr:1 row_mask:0xf bank_mask:0xf\n\t"
        "v_fmac_f32_dpp %1, %5, %9 row_shr:1 row_mask:0xf bank_mask:0xf\n\t"
        "v_fmac_f32_dpp %2, %6, %10 row_shr:1 row_mask:0xf bank_mask:0xf\n\t"
        "v_fmac_f32_dpp %3, %7, %11 row_shr:1 row_mask:0xf bank_mask:0xf\n\t"
        "v_fmac_f32_dpp %0, %4, %12 row_shr:2 row_mask:0xf bank_mask:0xf\n\t"
        "v_fmac_f32_dpp %1, %5, %13 row_shr:2 row_mask:0xf bank_mask:0xf\n\t"
        "v_fmac_f32_dpp %2, %6, %14 row_shr:2 row_mask:0xf bank_mask:0xf\n\t"
        "v_fmac_f32_dpp %3, %7, %15 row_shr:2 row_mask:0xf bank_mask:0xf"
        : "+v"(y0), "+v"(y1), "+v"(y2), "+v"(y3)
        : "v"(g[0]), "v"(g[1]), "v"(g[2]), "v"(g[3]), "v"(w1[0]), "v"(w1[1]), "v"(w1[2]), "v"(w1[3]), "v"(w0[0]), "v"(w0[1]), "v"(w0[2]), "v"(w0[3]));
    y[0] = y0; y[1] = y1; y[2] = y2; y[3] = y3;
}
__device__ __forceinline__ void conv_taps_ror(f32x4& y, const f32x4& gp, const f32x4& w1m, const f32x4& w0m) {
    float y0 = y[0], y1 = y[1], y2 = y[2], y3 = y[3];
    asm("s_nop 1\n\t"
        "v_fmac_f32_dpp %0, %4, %8 row_ror:1 row_mask:0xf bank_mask:0xf\n\t"
        "v_fmac_f32_dpp %1, %5, %9 row_ror:1 row_mask:0xf bank_mask:0xf\n\t"
        "v_fmac_f32_dpp %2, %6, %10 row_ror:1 row_mask:0xf bank_mask:0xf\n\t"
        "v_fmac_f32_dpp %3, %7, %11 row_ror:1 row_mask:0xf bank_mask:0xf\n\t"
        "v_fmac_f32_dpp %0, %4, %12 row_ror:2 row_mask:0xf bank_mask:0xf\n\t"
        "v_fmac_f32_dpp %1, %5, %13 row_ror:2 row_mask:0xf bank_mask:0xf\n\t"
        "v_fmac_f32_dpp %2, %6, %14 row_ror:2 row_mask:0xf bank_mask:0xf\n\t"
        "v_fmac_f32_dpp %3, %7, %15 row_ror:2 row_mask:0xf bank_mask:0xf"
        : "+v"(y0), "+v"(y1), "+v"(y2), "+v"(y3)
        : "v"(gp[0]), "v"(gp[1]), "v"(gp[2]), "v"(gp[3]), "v"(w1m[0]), "v"(w1m[1]), "v"(w1m[2]), "v"(w1m[3]), "v"(w0m[0]), "v"(w0m[1]), "v"(w0m[2]), "v"(w0m[3]));
    y[0] = y0; y[1] = y1; y[2] = y2; y[3] = y3;
}
template <int PV> struct EpiUpT {
    static constexpr bool PERM = true, AFTER_DRAIN = false, APERM = true, PRE = false;
    const float* ss; const float* cw; const float* cb; bf16_t* A2; bf16_t* GH; bf16_t* UH; bf16_t* GT;
    __device__ __forceinline__ void operator()(const f32x4 (&acc)[2][2][4][2], const Unit& u, int wr, int wc, int fr, int fq) const {
        const int ch0 = u.pn * 128 + wc * 32 + 8 * fq;
        f32x4 w2[2], bb[2], w1[2], w0[2], w1m[2], w0m[2];
#pragma unroll
        for (int n = 0; n < 2; ++n) { const f32x4 z4 = {0.f, 0.f, 0.f, 0.f};
            w0[n] = *(const f32x4*)(cw + ch0 + 4 * n); w1[n] = *(const f32x4*)(cw + 3072 + ch0 + 4 * n); w2[n] = *(const f32x4*)(cw + 6144 + ch0 + 4 * n); bb[n] = *(const f32x4*)(cb + ch0 + 4 * n);
            w1m[n] = fr >= 1 ? z4 : w1[n]; w0m[n] = fr >= 2 ? z4 : w0[n]; }
        float c1 = 0.10294324f, c0 = 2.3022082f, c_one = 1.0f; asm("" : "+s"(c1), "+s"(c0), "+s"(c_one));
        const f32x4 C1 = {c1, c1, c1, c1}, C0 = {c0, c0, c0, c0}, ONE = {c_one, c_one, c_one, c_one};
        f32x4 rpu[2][4];
#pragma unroll
        for (int ai = 0; ai < 2; ++ai)
#pragma unroll
            for (int m = 0; m < 4; ++m) rpu[ai][m] = (PV == 3 || PV == 5) ? (f32x4){1.f, 1.f, 1.f, 1.f} : rstd_ld(ss, u.pm * BM + ai * HALF + wr * 64 + m * 16 + fr, fq);
#pragma unroll
        for (int ai = 0; ai < 2; ++ai) {
            const int grp = 4 * u.pm + 2 * ai + wr;
            f32x4 gp[2] = {{0.f, 0.f, 0.f, 0.f}, {0.f, 0.f, 0.f, 0.f}};
#pragma unroll
            for (int m = 0; m < 4; ++m) { const int row = u.pm * BM + ai * HALF + wr * 64 + m * 16 + fr; const float rs = (PV == 3 || PV == 5) ? rpu[ai][m][0] : rstd_fin(rpu[ai][m]);
                f32x4 g[2], uu[2], o[2];
#pragma unroll
                for (int n = 0; n < 2; ++n) { g[n] = acc[ai][0][m][n] * rs; uu[n] = acc[ai][1][m][n] * rs;
                    f32x4 y = bb[n] + w2[n] * g[n];
                    conv_taps_shr(y, g[n], w1[n], w0[n]);
                    if (m > 0) conv_taps_ror(y, gp[n], w1m[n], w0m[n]);
                    const f32x4 t2 = y * (y * y * C1 + C0); f32x4 ex;
#pragma unroll
                    for (int e = 0; e < 4; ++e) ex[e] = (PV == 2 || PV == 5) ? -t2[e] : __builtin_amdgcn_exp2f(-t2[e]);
                    const f32x4 den = ex + ONE; f32x4 rc;
#pragma unroll
                    for (int e = 0; e < 4; ++e) rc[e] = (PV == 2 || PV == 5) ? den[e] : __builtin_amdgcn_rcpf(den[e]);
                    o[n] = y * rc * uu[n]; }
                const bool head = (m == 0) && (fr < 2);
                if (PV == 1 || PV == 5) { const u32x4 q0 = pk8(o[0], o[1]), q1 = pk8(g[0], g[1]), q2 = pk8(uu[0], uu[1]); asm volatile("" :: "v"(q0), "v"(q1), "v"(q2)); } else {
                if (!head) { u32x4* dst = (u32x4*)(A2 + (size_t)(row >> 1) * 6144 + ((ch0 >> 6) * 128 + ((ch0 >> 5) & 1) * 64 + (row & 1) * 32 + (ch0 & 31))); if (PV == 6) *dst = pk8(o[0], o[1]); else st16(dst, pk8(o[0], o[1])); }
                else { const size_t so = ((size_t)grp * 2 + fr) * 3072 + ch0; *(u32x4*)(GH + so) = pk8(g[0], g[1]); *(u32x4*)(UH + so) = pk8(uu[0], uu[1]); }
                if (m == 3 && fr >= 14) { const size_t so = ((size_t)grp * 2 + (fr - 14)) * 3072 + ch0; *(u32x4*)(GT + so) = pk8(g[0], g[1]); } }
                gp[0] = g[0]; gp[1] = g[1]; }
        }
    }
};

typedef EpiUpT<0> EpiUp;

struct EpiNone {
    static constexpr bool PERM = true, AFTER_DRAIN = false, APERM = false, PRE = false;
    __device__ __forceinline__ void operator()(const f32x4 (&acc)[2][2][4][2], const Unit& u, int wr, int wc, int fr, int fq) const {
#pragma unroll
        for (int ai = 0; ai < 2; ++ai)
#pragma unroll
            for (int m = 0; m < 4; ++m)
#pragma unroll
                for (int bj = 0; bj < 2; ++bj) { asm volatile("" :: "v"(acc[ai][bj][m][0]), "v"(acc[ai][bj][m][1])); }
    }
};

struct EpiZLine {
    static constexpr bool PERM = true, AFTER_DRAIN = false, APERM = false, PRE = false;
    bf16_t* O; int ldc;
    __device__ __forceinline__ void operator()(const f32x4 (&acc)[2][2][4][2], const Unit& u, int wr, int wc, int fr, int fq) const {
        const int col0 = u.pn * BM + 64 * wc + ((fr & 1) * 4 + fq) * 8;
#pragma unroll
        for (int ai = 0; ai < 2; ++ai)
#pragma unroll
            for (int m = 0; m < 4; ++m) {
#pragma unroll
                for (int bj = 0; bj < 2; ++bj) { const int row = u.pm * BM + ai * HALF + wr * 64 + m * 16 + (fr & ~1) + bj;
                    *(u32x4*)(O + (size_t)row * ldc + col0) = pk8(acc[ai][bj][m][0], acc[ai][bj][m][1]); } }
    }
};
template <class Epi, class Sched, bool ALIGN_EPI = false, bool SP2 = false>
__device__ __forceinline__ void gemm_phase(PG8_LAS unsigned char* lds, const Gemm g, const Sched& S, const Epi& E, int wave_id) {
    int tid_ = lane_now() + 64 * wave_id;
    const int tid = tid_, wid = __builtin_amdgcn_readfirstlane(tid >> 6), lane = tid & 63, wr = wid >> 2, wc = wid & 3, fr = lane & 15, fq = lane >> 4;
    const int K = g.K, nt = K / BK;
    unsigned voffA[2], voffB[2];
#pragma unroll
    for (int i = 0; i < 2; ++i) { int R, C; stage_rc(tid * 16 + i * 8192, R, C); const int Rb = Epi::PERM ? ((R & ~31) + perm32(R & 31)) : R;
        voffA[i] = Epi::APERM ? (unsigned)((R >> 1) * (4 * K) + ((C >> 5) & 1) * 128 + (R & 1) * 64 + (C & 31) * 2) : (unsigned)(R * K + C) * 2u;
        voffB[i] = (unsigned)((Rb >> 1) * (4 * K) + ((C >> 5) & 1) * 128 + (Rb & 1) * 64 + (C & 31) * 2); }
    const size_t kstepA = Epi::APERM ? (size_t)(BK * 4) : (size_t)(BK * 2), kstepB = (size_t)(BK * 4);
    const size_t hstep = (size_t)HALF * K * 2;
    const size_t tstep = 2 * hstep;
    const unsigned ldsw = (unsigned)wid * 1024u;
    const int aoff = lds_byte(wr * 64 + fr, fq * 8), boff = lds_byte(wc * 32 + fr, fq * 8);
#define PG8_SA(b, h) (((b) * 2 + (h)) * HTB)
#define PG8_SB(b, h) ((4 + (b) * 2 + (h)) * HTB)
#define PG8_STAGE(bufoff, gbase, voff) do { _Pragma("unroll") for (int _i = 0; _i < 2; ++_i) \
        __builtin_amdgcn_global_load_lds((const unsigned*)((const char*)(gbase) + (voff)[_i]), (PG8_LAS unsigned*)(lds + (bufoff) + ldsw + _i * 8192), 16, 0, 0); } while (0)
#define PG8_LDA(dst, b, h) do { _Pragma("unroll") for (int m = 0; m < 4; ++m) _Pragma("unroll") for (int k = 0; k < 2; ++k) dst[m][k] = *(const PG8_LAS bf16x8*)(lds + PG8_SA(b, h) + aoff + m * 2048 + k * 1024); } while (0)
#define PG8_LDB(dst, b, h) do { _Pragma("unroll") for (int n = 0; n < 2; ++n) _Pragma("unroll") for (int k = 0; k < 2; ++k) dst[n][k] = *(const PG8_LAS bf16x8*)(lds + PG8_SB(b, h) + boff + n * 2048 + k * 1024); } while (0)
#define PG8_MMA(ai, bj, At, Bt) do { __builtin_amdgcn_s_setprio(1); _Pragma("unroll") for (int m = 0; m < 4; ++m) _Pragma("unroll") for (int n = 0; n < 2; ++n) _Pragma("unroll") for (int k = 0; k < 2; ++k) \
        acc[ai][bj][m][n] = __builtin_amdgcn_mfma_f32_16x16x32_bf16(Bt[n][k], At[m][k], acc[ai][bj][m][n], 0, 0, 0); __builtin_amdgcn_s_setprio(0); } while (0)
#define PG8_WAIT_V(n) asm volatile("s_waitcnt vmcnt(" #n ")" ::: "memory")
#define PG8_WAIT_L(n) asm volatile("s_waitcnt lgkmcnt(" #n ")" ::: "memory")
#define PG8_BAR __builtin_amdgcn_s_barrier()
#define PG8_SCHED __builtin_amdgcn_sched_barrier(0)
    Unit cur, nxt; int ui = 0;
    if (!S.next(0, cur)) return;
    f32x4 acc[2][2][4][2];
#pragma unroll
    for (int a = 0; a < 2; ++a)
#pragma unroll
        for (int b = 0; b < 2; ++b)
#pragma unroll
            for (int m = 0; m < 4; ++m)
#pragma unroll
                for (int n = 0; n < 2; ++n) acc[a][b][m][n] = (f32x4){0.f, 0.f, 0.f, 0.f};
    bf16x8 At[4][2], B0[2][2], B1[2][2];
    const char* cA = (const char*)g.A + (size_t)cur.pm * tstep; const char* cB = (const char*)g.Bt + (size_t)cur.pn * tstep;
    S.a_ready(cur);
    if constexpr (SP2) {
        PG8_STAGE(PG8_SB(0, 0), cB, voffB); PG8_STAGE(PG8_SB(0, 1), cB + hstep, voffB); PG8_STAGE(PG8_SA(0, 0), cA, voffA); PG8_STAGE(PG8_SA(0, 1), cA + hstep, voffA);
        if (wr == 1) PG8_BAR;
        PG8_WAIT_V(2); PG8_BAR;
        PG8_STAGE(PG8_SB(1, 0), cB + kstepB, voffB); PG8_STAGE(PG8_SA(1, 0), cA + kstepA, voffA); PG8_STAGE(PG8_SB(1, 1), cB + hstep + kstepB, voffB);
        PG8_WAIT_V(6); PG8_BAR;
    } else {
        PG8_STAGE(PG8_SB(0, 0), cB, voffB); PG8_STAGE(PG8_SA(0, 0), cA, voffA); PG8_STAGE(PG8_SB(0, 1), cB + hstep, voffB); PG8_STAGE(PG8_SA(0, 1), cA + hstep, voffA);
        if (wr == 1) PG8_BAR;
        PG8_WAIT_V(4); PG8_BAR;
        PG8_STAGE(PG8_SB(1, 0), cB + kstepB, voffB); PG8_STAGE(PG8_SA(1, 0), cA + kstepA, voffA); PG8_STAGE(PG8_SB(1, 1), cB + hstep + kstepB, voffB);
        PG8_WAIT_V(6); PG8_BAR;
    }
    for (;;) {
        const bool has_next = S.next(ui + 1, nxt);
        const char* nA = has_next ? (const char*)g.A + (size_t)nxt.pm * tstep : cA; const char* nB = has_next ? (const char*)g.Bt + (size_t)nxt.pn * tstep : cB;
        for (int t = 0; t < nt; t += 2) {
            const bool last = (t == nt - 2);
            const char* a1 = cA + (size_t)(t + 1) * kstepA;
            const char* a2 = last ? nA : cA + (size_t)(t + 2) * kstepA; const char* b2 = last ? nB : cB + (size_t)(t + 2) * kstepB;
            const char* a3 = a2 + kstepA; const char* b3 = b2 + kstepB;
            if (last && has_next) S.a_ready(nxt);
            if constexpr (Epi::PRE) { if (last) E.pre(cur, wid, lane_now()); }
            if constexpr (SP2) {
            PG8_LDB(B0, 0, 0); PG8_LDB(B1, 0, 1); PG8_SCHED; PG8_LDA(At, 0, 0); PG8_STAGE(PG8_SA(1, 1), a1 + hstep, voffA);
            PG8_WAIT_V(8); PG8_WAIT_L(0); PG8_BAR; PG8_MMA(0, 0, At, B0); PG8_MMA(0, 1, At, B1); PG8_BAR; PG8_SCHED;
            PG8_LDA(At, 0, 1); PG8_STAGE(PG8_SB(0, 0), b2, voffB); PG8_STAGE(PG8_SB(0, 1), b2 + hstep, voffB); PG8_STAGE(PG8_SA(0, 0), a2, voffA);
            PG8_WAIT_V(8); PG8_WAIT_L(0); PG8_BAR; PG8_MMA(1, 0, At, B0); PG8_MMA(1, 1, At, B1); PG8_BAR; PG8_SCHED;
            PG8_LDB(B0, 1, 0); PG8_LDB(B1, 1, 1); PG8_SCHED; PG8_LDA(At, 1, 0); PG8_STAGE(PG8_SA(0, 1), a2 + hstep, voffA);
            PG8_WAIT_V(8); PG8_WAIT_L(0); PG8_BAR; PG8_MMA(0, 0, At, B0); PG8_MMA(0, 1, At, B1); PG8_BAR; PG8_SCHED;
            PG8_LDA(At, 1, 1); PG8_STAGE(PG8_SB(1, 0), b3, voffB); PG8_STAGE(PG8_SB(1, 1), b3 + hstep, voffB); PG8_STAGE(PG8_SA(1, 0), a3, voffA);
            PG8_WAIT_V(8); PG8_WAIT_L(0); PG8_BAR; PG8_MMA(1, 0, At, B0); PG8_MMA(1, 1, At, B1); PG8_BAR; PG8_SCHED;
            } else {
            PG8_LDB(B0, 0, 0); PG8_SCHED; PG8_LDA(At, 0, 0); PG8_STAGE(PG8_SA(1, 1), a1 + hstep, voffA);
            PG8_WAIT_L(8); PG8_BAR; PG8_WAIT_L(0); PG8_MMA(0, 0, At, B0); PG8_BAR; PG8_SCHED;
            PG8_LDB(B1, 0, 1); PG8_STAGE(PG8_SB(0, 0), b2, voffB);
            PG8_BAR; PG8_WAIT_L(0); PG8_MMA(0, 1, At, B1); PG8_BAR;
            PG8_LDA(At, 0, 1); PG8_STAGE(PG8_SA(0, 0), a2, voffA);
            PG8_BAR; PG8_WAIT_L(0); PG8_MMA(1, 0, At, B0); PG8_BAR; PG8_SCHED;
            PG8_STAGE(PG8_SB(0, 1), b2 + hstep, voffB);
            PG8_WAIT_V(6); PG8_BAR; PG8_MMA(1, 1, At, B1); PG8_BAR;
            PG8_LDB(B0, 1, 0); PG8_SCHED; PG8_LDA(At, 1, 0); PG8_STAGE(PG8_SA(0, 1), a2 + hstep, voffA);
            PG8_WAIT_L(8); PG8_BAR; PG8_WAIT_L(0); PG8_MMA(0, 0, At, B0); PG8_BAR; PG8_SCHED;
            PG8_LDB(B1, 1, 1); PG8_STAGE(PG8_SB(1, 0), b3, voffB);
            PG8_BAR; PG8_WAIT_L(0); PG8_MMA(0, 1, At, B1); PG8_BAR;
            PG8_LDA(At, 1, 1); PG8_STAGE(PG8_SA(1, 0), a3, voffA);
            PG8_BAR; PG8_WAIT_L(0); PG8_MMA(1, 0, At, B0); PG8_BAR; PG8_SCHED;
            PG8_STAGE(PG8_SB(1, 1), b3 + hstep, voffB);
            PG8_WAIT_V(6); PG8_BAR; PG8_MMA(1, 1, At, B1); PG8_BAR;
            }
        }
        if constexpr (ALIGN_EPI) { if (wr == 0) PG8_BAR; }
        if constexpr (!Epi::AFTER_DRAIN) { const int ln_ = lane_now(); E(acc, cur, wr, wc, ln_ & 15, ln_ >> 4); S.done(cur); }
        if (!has_next) break;
#pragma unroll
        for (int a = 0; a < 2; ++a)
#pragma unroll
            for (int b = 0; b < 2; ++b)
#pragma unroll
                for (int m = 0; m < 4; ++m)
#pragma unroll
                    for (int n = 0; n < 2; ++n) acc[a][b][m][n] = (f32x4){0.f, 0.f, 0.f, 0.f};
        cur = nxt; cA = nA; cB = nB; ++ui;
        if constexpr (ALIGN_EPI) { if (wr == 1) PG8_BAR; }
    }
    PG8_WAIT_V(0);
    if constexpr (!ALIGN_EPI) { if (wr == 0) PG8_BAR; }
    PG8_BAR;
    if constexpr (Epi::AFTER_DRAIN) { E.fused(acc, cur, wr, wc, fr, fq, lds, wid, lane); S.done(cur); }
#undef PG8_SA
#undef PG8_SB
#undef PG8_STAGE
#undef PG8_LDA
#undef PG8_LDB
#undef PG8_MMA
#undef PG8_WAIT_V
#undef PG8_WAIT_L
#undef PG8_BAR
#undef PG8_SCHED
}
}

constexpr int NWAVES = 8;
constexpr int NB = 8, SEQ = 4096, T = NB * SEQ, DM = 1024, ZW = 3072, FFD = 3072, HYIN = 3080;
#ifndef PROBE_PHASE
#define PROBE_PHASE 0
#define PROBE_N 0
#endif
#define PREP(id) for (int rep_ = 0; rep_ < 1 + ((PROBE_PHASE == (id)) ? PROBE_N : 0); ++rep_)
#ifdef PROBE_TA
#ifndef PROBE_TOFF
#define PROBE_TOFF 0
#endif
#define TSTAMP() do { if (blockIdx.x == 0 && threadIdx.x == 0) { F.MISC[16 + ts_n] = (unsigned)__builtin_amdgcn_s_memrealtime(); } ++ts_n; } while (0)
#else
#define TSTAMP() do { } while (0)
#endif
#ifdef PROBE_SA
#define STG(k) do { if ((k) == PROBE_SA) F.stg_t0 = (unsigned)__builtin_amdgcn_s_memrealtime(); if ((k) == PROBE_SB) F.stg_acc += (unsigned)__builtin_amdgcn_s_memrealtime() - F.stg_t0; } while (0)
#define STG_DECL do { } while (0)
#define STG_END(F) do { if (blockIdx.x == 0 && threadIdx.x == 0) (F).MISC[40] = (F).stg_acc; } while (0)
#define STG_END_ALL(F) do { if (threadIdx.x == 0) ((unsigned*)((F).ws + 512 * 1024))[blockIdx.x] = (F).stg_acc; } while (0)
#else
#define STG(k) do { } while (0)
#define STG_DECL do { } while (0)
#define STG_END(F) do { } while (0)
#endif
#ifndef DBG_STOP
#define DBG_STOP 99
#endif

constexpr size_t MiB = 1u << 20;
constexpr size_t WS_CTL = 0, CTL_ZERO_BYTES = 1 * MiB;
constexpr size_t WS_WIN = 2 * MiB, WS_WOUT0 = 8 * MiB, WS_WUP0 = 10 * MiB, WS_WDN0 = 22 * MiB, WS_WGT0 = 28 * MiB, WS_WPJ0 = 30 * MiB,
                 WS_WQKV = 31 * MiB, WS_WO1 = 34 * MiB, WS_WUP1 = 36 * MiB, WS_WDN1 = 48 * MiB, WS_WGT1 = 54 * MiB, WS_WPJ1 = 56 * MiB, WS_RGW = 57 * MiB;
constexpr size_t WS_GATES = 58 * MiB, WS_SSA = 59 * MiB, WS_SSB = 61 * MiB, WS_ROPE = 63 * MiB, WS_NLOC = 71 * MiB, WS_NPREV = 72 * MiB, WS_MSC = 73 * MiB,
                 WS_RGA = 74 * MiB, WS_RGH = 75 * MiB, WS_RGC = 76 * MiB;
constexpr size_t WS_PB = 78 * MiB, WS_XBA = 110 * MiB, WS_XBB = 174 * MiB, WS_CST = 238 * MiB, WS_BIG = 302 * MiB, WS_END = 494 * MiB;
constexpr int CW_BAR = 4096;

constexpr int RING_BYTES = 131072;
constexpr int LDSCTL_OFF = 163328, MISC_OFF = LDSCTL_OFF + 320;
constexpr int LDS_BYTES = 163840;

#define GAS __attribute__((address_space(1)))
#define LAS __attribute__((address_space(3)))
typedef unsigned short bf16;
typedef unsigned v4u __attribute__((ext_vector_type(4)));
typedef unsigned v2u __attribute__((ext_vector_type(2)));
typedef float f32x4 __attribute__((ext_vector_type(4)));
typedef float f32x16 __attribute__((ext_vector_type(16)));
typedef short bf16x8 __attribute__((ext_vector_type(8)));
typedef short s16x4 __attribute__((ext_vector_type(4)));
typedef GAS unsigned gu32;
typedef LAS unsigned char* ldsp;
#define LDS_WAIT() asm volatile("s_waitcnt lgkmcnt(0)" ::: "memory")
using pg8::pk2; using pg8::bflo; using pg8::bfhi; using pg8::fsigmoid; using pg8::gelu_tanh;
__device__ __forceinline__ unsigned short f2bf1(float x) { return (unsigned short)(pk2(x, 0.f) & 0xffffu); }
__device__ __forceinline__ float bf2f(unsigned short b) { return __uint_as_float(((unsigned)b) << 16); }
__device__ __forceinline__ float fsilu(float x) { return x * __builtin_amdgcn_rcpf(1.0f + __expf(-x)); }
#define MFMA16(a, b, c) __builtin_amdgcn_mfma_f32_16x16x32_bf16((a), (b), (c), 0, 0, 0)
#define MFMA32(a, b, c) __builtin_amdgcn_mfma_f32_32x32x16_bf16((a), (b), (c), 0, 0, 0)

#define PHASE_FENCE(F) do { asm volatile("" ::: "memory"); const int l_ = pg8::lane_now(); (F).lane = l_; (F).tid = l_ + 64 * (F).wave; } while (0)
#define XB_TMO      128
#define XB_XCNT(j)  (256  + 64 * (j))
#define XB_XSUB(j)  (1280 + 64 * (j))
#define XB_XGEN(j)  (2304 + 64 * (j))
#define XB_TOP      3328
#define XB_TOPGEN   3392
#define XCD_BAR_WORDS 3456
#define XB_SPIN_CAP (1u << 18)

__device__ __forceinline__ unsigned xb_ld(unsigned* p)              { return __hip_atomic_load(p, __ATOMIC_RELAXED, __HIP_MEMORY_SCOPE_AGENT); }
__device__ __forceinline__ unsigned xb_add(unsigned* p, unsigned v) { return __hip_atomic_fetch_add(p, v, __ATOMIC_RELAXED, __HIP_MEMORY_SCOPE_AGENT); }
__device__ __forceinline__ unsigned xb_xcc_id() { return (unsigned)__builtin_amdgcn_s_getreg((3 << 11) | 20) & 0xFu; }
#define XB_SPIN(cond, bar) do { unsigned _sp = 0; while (cond) { __builtin_amdgcn_s_sleep(1); \
    if ((++_sp & 255u) == 0u) { if (xb_ld(&(bar)[XB_TMO])) break; if (_sp > XB_SPIN_CAP) { atomicAdd(&(bar)[XB_TMO], 1u); break; } } } } while (0)

struct XcdBarrier {
    unsigned* bar; unsigned x; int w;
    volatile LAS unsigned* st;
};

__device__ __forceinline__ XcdBarrier xcd_barrier_post(unsigned* bar, volatile LAS unsigned* st, int wave) {
    XcdBarrier b; b.bar = bar; b.x = xb_xcc_id(); b.st = st; b.w = wave;
    if (threadIdx.x == 0) (void)xb_add(&bar[XB_XCNT(b.x)], 1u);
    return b;
}
__device__ __forceinline__ void xcd_barrier_complete(unsigned* bar, unsigned x, unsigned& nloc, unsigned& nx) {
    const unsigned G = gridDim.x * gridDim.y * gridDim.z;
    unsigned sum, cnt, mine, sp = 0u;
    for (;;) {
        sum = 0u; cnt = 0u; mine = 0u;
#pragma unroll
        for (unsigned j = 0; j < 16; ++j) { const unsigned c = xb_ld(&bar[XB_XCNT(j)]); sum += c; cnt += (c > 0u) ? 1u : 0u; mine = (j == x) ? c : mine; }
        if (sum == G) break;
        __builtin_amdgcn_s_sleep(1);
        if ((++sp & 255u) == 0u) { if (xb_ld(&bar[XB_TMO])) break; if (sp > XB_SPIN_CAP) { atomicAdd(&bar[XB_TMO], 1u); break; } }
    }
    nloc = mine > 0u ? mine : 1u; nx = cnt > 0u ? cnt : 1u;
}

__device__ __forceinline__ void xcd_barrier(const XcdBarrier& b) {
    asm volatile("s_waitcnt vmcnt(0)" ::: "memory");
    __syncthreads();
    if (b.w == 0 && pg8::lane_now() == 0) {
        unsigned* bar = b.bar;
        __builtin_amdgcn_s_waitcnt(0);
        unsigned nloc = b.st[0], nx = b.st[1];
        if (nloc == 0u) { xcd_barrier_complete(bar, b.x, nloc, nx); b.st[0] = nloc; b.st[1] = nx; }
        const unsigned old = xb_add(&bar[XB_XSUB(b.x)], 1u);
        const unsigned gen = old / nloc;
        if (old + 1u == (gen + 1u) * nloc) {
            __builtin_amdgcn_fence(__ATOMIC_RELEASE, "agent");
            asm volatile("s_waitcnt vmcnt(0)" ::: "memory");
            const unsigned og = xb_add(&bar[XB_TOP], 1u);
            const unsigned tg = og / nx;
            if (og + 1u == (tg + 1u) * nx) xb_add(&bar[XB_TOPGEN], 1u);
            else XB_SPIN(xb_ld(&bar[XB_TOPGEN]) == tg, bar);
            __builtin_amdgcn_fence(__ATOMIC_ACQUIRE, "agent");
            xb_add(&bar[XB_XGEN(b.x)], 1u);
            asm volatile("s_waitcnt vmcnt(0)" ::: "memory");
        } else {
            XB_SPIN(xb_ld(&bar[XB_XGEN(b.x)]) == gen, bar);
            __builtin_amdgcn_fence(__ATOMIC_ACQUIRE, "agent");
            asm volatile("s_waitcnt vmcnt(0)" ::: "memory");
        }
    }
    __syncthreads();
}

struct Frame {
    ldsp lds; volatile LAS unsigned* MISC;
    int tid, lane, wave, vcu, G;
    unsigned char* ws; unsigned long long kb; float* out;
#ifdef PROBE_SA
    unsigned stg_t0, stg_acc;
#endif
};
__device__ __forceinline__ const float* karg(const Frame& F, int i) { unsigned long long a = F.kb; asm volatile("" : "+s"(a) :: "memory"); return (const float*)(((const __attribute__((address_space(4))) unsigned long long*)a)[i]); }
#define P_Z     ((bf16*)(F.ws + WS_BIG))
#define P_YBUF  ((bf16*)(F.ws + WS_XBA))
#define P_CST   ((bf16*)(F.ws + WS_CST))
#define P_RGW   ((bf16*)(F.ws + WS_RGW))
#define P_GATES ((float*)(F.ws + WS_GATES))
#define P_NLOC  ((float*)(F.ws + WS_NLOC))
#define P_NPREV ((float*)(F.ws + WS_NPREV))
#define P_MLOC  ((float*)(F.ws + WS_MSC))
#define P_BLAST ((float*)(F.ws + WS_MSC) + 2048)
#define P_MPREV ((float*)(F.ws + WS_MSC) + 4096)
#define P_RGA   ((float*)(F.ws + WS_RGA))
#define P_RGH   ((float*)(F.ws + WS_RGH))
#define P_RGC   ((float*)(F.ws + WS_RGC))
#define P_ROPE16 ((unsigned short*)(F.ws + WS_ROPE))

__device__ __forceinline__ int tr_dst_row(int mode, int src) {
    if (mode == 1) { const int s2 = src < 3072 ? src : src - 3072; return 256 * (s2 >> 7) + (src < 3072 ? 0 : 128) + (s2 & 127); }
    if (mode == 2) return (src & ~255) + 128 * ((src >> 5) & 1) + 32 * ((src >> 6) & 3);
    return src;
}
template <bool PAIRED> __device__ __forceinline__ void tr_item(const float* W, int ldw, int srcc, int mode, const float* scale, bf16* WT, int K, int k0, LAS float* scr, int lane) {
#pragma unroll
    for (int i = 0; i < 16; ++i) { const int kk = 4 * i + (lane >> 4), n4 = (lane & 15) * 4; const float s = scale ? scale[k0 + kk] : 1.0f;
        const f32x4 v = *(const f32x4*)(W + (size_t)(k0 + kk) * ldw + srcc + n4);
        scr[kk * 65 + n4] = v[0] * s; scr[kk * 65 + n4 + 1] = v[1] * s; scr[kk * 65 + n4 + 2] = v[2] * s; scr[kk * 65 + n4 + 3] = v[3] * s; }
    LDS_WAIT(); asm volatile("" ::: "memory");
    const int c = lane & 7, d0 = tr_dst_row(mode, srcc), d1 = tr_dst_row(mode, srcc + 32);
#pragma unroll
    for (int j = 0; j < 8; ++j) { const int n = (lane >> 3) + 8 * j; const LAS float* s = scr + (8 * c) * 65 + n;
        v4u o; o.x = pk2(s[0 * 65], s[1 * 65]); o.y = pk2(s[2 * 65], s[3 * 65]); o.z = pk2(s[4 * 65], s[5 * 65]); o.w = pk2(s[6 * 65], s[7 * 65]);
        const int drow = (n < 32 ? d0 : d1) + (n & 31);
        if (PAIRED) *(GAS v4u*)(WT + (size_t)(drow >> 1) * (2 * K) + 2 * k0 + (c >> 2) * 64 + (drow & 1) * 32 + (c & 3) * 8) = o;
        else *(GAS v4u*)(WT + (size_t)drow * K + k0 + 8 * c) = o; }
    LDS_WAIT(); asm volatile("" ::: "memory");
}
struct TrI { const float* W; const float* scale; bf16* WT; int ldw, K, mode, srcc, k0; bool paired; };
struct TrR { f32x4 v[16]; float s[16]; };
__device__ __forceinline__ void tr_ld(const TrI& I, int lane, TrR& R) {
#pragma unroll
    for (int i = 0; i < 16; ++i) { const int kk = 4 * i + (lane >> 4), n4 = (lane & 15) * 4; R.s[i] = I.scale ? I.scale[I.k0 + kk] : 1.0f;
        R.v[i] = *(const f32x4*)(I.W + (size_t)(I.k0 + kk) * I.ldw + I.srcc + n4); }
}
__device__ __forceinline__ void tr_st(const TrI& I, const TrR& R, LAS float* scr, int lane) {
#pragma unroll
    for (int i = 0; i < 16; ++i) { const int kk = 4 * i + (lane >> 4), n4 = (lane & 15) * 4; const float sc = R.s[i];
        scr[kk * 65 + n4] = R.v[i][0] * sc; scr[kk * 65 + n4 + 1] = R.v[i][1] * sc; scr[kk * 65 + n4 + 2] = R.v[i][2] * sc; scr[kk * 65 + n4 + 3] = R.v[i][3] * sc; }
    LDS_WAIT(); asm volatile("" ::: "memory");
    const int c = lane & 7, d0 = tr_dst_row(I.mode, I.srcc), d1 = tr_dst_row(I.mode, I.srcc + 32);
#pragma unroll
    for (int j = 0; j < 8; ++j) { const int n = (lane >> 3) + 8 * j; const LAS float* sp = scr + (8 * c) * 65 + n;
        v4u o; o.x = pk2(sp[0 * 65], sp[1 * 65]); o.y = pk2(sp[2 * 65], sp[3 * 65]); o.z = pk2(sp[4 * 65], sp[5 * 65]); o.w = pk2(sp[6 * 65], sp[7 * 65]);
        const int drow = (n < 32 ? d0 : d1) + (n & 31);
        if (I.paired) *(GAS v4u*)(I.WT + (size_t)(drow >> 1) * (2 * I.K) + 2 * I.k0 + (c >> 2) * 64 + (drow & 1) * 32 + (c & 3) * 8) = o;
        else *(GAS v4u*)(I.WT + (size_t)drow * I.K + I.k0 + 8 * c) = o; }
    LDS_WAIT(); asm volatile("" ::: "memory");
}
__device__ __forceinline__ bool tr_matrix(int& r, const float* W, int ldw, int K, int Nd, int mode, const float* scale, bf16* WT, LAS float* scr, int lane) {
    const int nblk = Nd / 64, items = (K / 64) * nblk;
    if (r >= items) { r -= items; return false; }
    const int kb = r / nblk, sb = r % nblk;
    tr_item<true>(W, ldw, 64 * sb, mode, scale, WT, K, 64 * kb, scr, lane);
    return true;
}
template <int CTRL> __device__ __forceinline__ float dpp_mov(float v) { return __int_as_float(__builtin_amdgcn_update_dpp(0, __float_as_int(v), CTRL, 0xF, 0xF, true)); }
__device__ __forceinline__ float sum8(float v)  { v += dpp_mov<0xB1>(v); v += dpp_mov<0x4E>(v); v += dpp_mov<0x141>(v); return v; }
__device__ __forceinline__ float sum16(float v) { v = sum8(v); v += dpp_mov<0x140>(v); return v; }
__device__ __forceinline__ float wave_sum(float v) {
#pragma unroll
    for (int o = 1; o < 64; o <<= 1) v += __shfl_xor(v, o);
    return v;
}
#ifdef PROBE_P0SPLIT
#define P0_SPLIT() do { xcd_barrier(bar); TSTAMP(); } while (0)
#else
#define P0_SPLIT() do { } while (0)
#endif
__device__ __forceinline__ void p0_prologue(Frame& F, const XcdBarrier& bar, int& ts_n) {
    PHASE_FENCE(F); const float* x = karg(F, 0); const float* p = karg(F, 1); const int* pos = (const int*)karg(F, 2); const float* norm_mix = karg(F, 3); const float* norm_ffn = karg(F, 4); const float* norm_ple = karg(F, 5); const float* hy_w_in = karg(F, 6); const float* hy_b_in = karg(F, 7); const float* rg_wa = karg(F, 10); const float* rg_wx = karg(F, 12); const float* hy_w_out = karg(F, 18); const float* at_w_qkv = karg(F, 19); const float* at_w_out = karg(F, 23); const float* ff_w_up = karg(F, 24); const float* ff_w_down = karg(F, 27); const float* ple_w_gate = karg(F, 28); const float* ple_w_proj = karg(F, 29);
    LAS float* scr = (LAS float*)(F.lds + F.wave * 16640);
    const int gw = F.vcu * NWAVES + F.wave, NGW = F.G * NWAVES;
    unsigned char* ws = F.ws;
    LAS float* GW = (LAS float*)(F.lds);
    for (int i = F.tid; i < 8192; i += NWAVES * 64) { const int k = i >> 3, g = i & 7; GW[i] = hy_w_in[(size_t)k * HYIN + 3072 + g] * norm_mix[k]; }
    __syncthreads();
    P0_SPLIT();
    bf16* xb = (bf16*)(ws + WS_XBA);
    const float bgate = (F.lane < 64) ? hy_b_in[3072 + (F.lane >> 3)] : 0.f;
    for (int row0 = 2 * gw; row0 < T; row0 += 2 * NGW) {
        f32x4 v[2][4];
#pragma unroll
        for (int rr = 0; rr < 2; ++rr) { const GAS f32x4* xr = (const GAS f32x4*)(x + (size_t)(row0 + rr) * DM) + F.lane;
#pragma unroll
            for (int j = 0; j < 4; ++j) v[rr][j] = xr[64 * j]; }
#pragma unroll
        for (int rr = 0; rr < 2; ++rr) { const int row = row0 + rr; float s = 0.f; float d[8];
#pragma unroll
            for (int g = 0; g < 8; ++g) d[g] = 0.f;
#pragma unroll
            for (int j = 0; j < 4; ++j) { s += (v[rr][j].x * v[rr][j].x + v[rr][j].y * v[rr][j].y) + (v[rr][j].z * v[rr][j].z + v[rr][j].w * v[rr][j].w);
#pragma unroll
                for (int e = 0; e < 4; ++e) { const int k = 4 * (F.lane + 64 * j) + e; const f32x4 w0 = *(const LAS f32x4*)(GW + k * 8), w1 = *(const LAS f32x4*)(GW + k * 8 + 4);
                    const float xv = v[rr][j][e];
                    d[0] += xv * w0[0]; d[1] += xv * w0[1]; d[2] += xv * w0[2]; d[3] += xv * w0[3]; d[4] += xv * w1[0]; d[5] += xv * w1[1]; d[6] += xv * w1[2]; d[7] += xv * w1[3]; } }
            s = wave_sum(s);
            const bool b5 = F.lane & 32, b4 = F.lane & 16, b3 = F.lane & 8; float r4[4], r2[2];
#pragma unroll
            for (int i = 0; i < 4; ++i) { const float recv = __shfl_xor(b5 ? d[i] : d[i + 4], 32); r4[i] = (b5 ? d[i + 4] : d[i]) + recv; }
#pragma unroll
            for (int i = 0; i < 2; ++i) { const float recv = __shfl_xor(b4 ? r4[i] : r4[i + 2], 16); r2[i] = (b4 ? r4[i + 2] : r4[i]) + recv; }
            float dg; { const float recv = __shfl_xor(b3 ? r2[0] : r2[1], 8); dg = (b3 ? r2[1] : r2[0]) + recv; }
            dg = sum8(dg);
            const float rstd = rsqrtf(s * (1.0f / DM) + 1e-6f);
            if ((F.lane & 7) == 0) P_GATES[(size_t)row * 8 + (F.lane >> 3)] = rstd * dg + bgate;
            GAS unsigned long long* o8 = (GAS unsigned long long*)(xb + (size_t)row * DM) + F.lane;
#pragma unroll
            for (int j = 0; j < 4; ++j) o8[64 * j] = (unsigned long long)pk2(v[rr][j].x * rstd, v[rr][j].y * rstd) | ((unsigned long long)pk2(v[rr][j].z * rstd, v[rr][j].w * rstd) << 32);
#if DBG_STOP < 3
            { GAS f32x4* oo = (GAS f32x4*)(F.out + (size_t)row * DM) + F.lane;
#pragma unroll
              for (int j = 0; j < 4; ++j) oo[64 * j] = v[rr][j]; }
#endif
        }
    }
    P0_SPLIT();
    { const GAS f32x4* ps = (const GAS f32x4*)p; GAS v4u* pd = (GAS v4u*)(ws + WS_PB); const int n8 = 2 * T * 256 / 8;
      for (int i0 = gw * 64 + F.lane; i0 < n8; i0 += 4 * NGW * 64) { f32x4 a[4], b[4];
#pragma unroll
          for (int k = 0; k < 4; ++k) { const int i = i0 + k * NGW * 64; if (i < n8) { a[k] = ps[2 * i]; b[k] = ps[2 * i + 1]; } }
#pragma unroll
          for (int k = 0; k < 4; ++k) { const int i = i0 + k * NGW * 64; if (i < n8) { v4u o; o.x = pk2(a[k].x, a[k].y); o.y = pk2(a[k].z, a[k].w); o.z = pk2(b[k].x, b[k].y); o.w = pk2(b[k].z, b[k].w); pd[i] = o; } } } }
    for (int i = (F.vcu * NWAVES * 64) + F.tid; i < T * 16; i += F.G * NWAVES * 64) { const int t = i >> 4, f2 = i & 15; unsigned cw = 0u, sw = 0u;
#pragma unroll
        for (int h = 0; h < 2; ++h) { const int f = 2 * f2 + h;
            const float inv = exp2f(-(float)f * (13.287712379549449f / 32.0f));
            const float ang = (float)pos[t] * inv;
            float sn, cs; sincosf(ang, &sn, &cs);
            cw |= (unsigned)__builtin_bit_cast(unsigned short, (_Float16)cs) << (16 * h); sw |= (unsigned)__builtin_bit_cast(unsigned short, (_Float16)sn) << (16 * h); }
        ((unsigned*)P_ROPE16)[(size_t)t * 32 + f2] = cw; ((unsigned*)P_ROPE16)[(size_t)t * 32 + 16 + f2] = sw; }
    P0_SPLIT();
    __syncthreads();
    constexpr int NITEMS = 768 + 256 + 2 * 1536 + 2 * 768 + 2 * 256 + 2 * 64 + 384 + 256 + 16;
    auto decode = [&](int it) -> TrI { int r = it; const float* W = nullptr; const float* scale = nullptr; bf16* WT = nullptr; int ldw = 0, K = 0, Nd = 0, mode = 0; bool found = false;
#define TRM(W_, ldw_, K_, Nd_, mode_, scale_, WT_) if (!found) { const int items_ = ((K_) / 64) * ((Nd_) / 64); if (r < items_) { W = (W_); ldw = (ldw_); K = (K_); Nd = (Nd_); mode = (mode_); scale = (scale_); WT = (bf16*)(ws + (WT_)); found = true; } else r -= items_; }
        TRM(hy_w_in, HYIN, 1024, 3072, 2, norm_mix, WS_WIN)
        TRM(hy_w_out, 1024, 1024, 1024, 2, nullptr, WS_WOUT0)
        TRM(ff_w_up, 6144, 1024, 6144, 1, norm_ffn, WS_WUP0)
        TRM(ff_w_up + (size_t)1024 * 6144, 6144, 1024, 6144, 1, norm_ffn + 1024, WS_WUP1)
        TRM(ff_w_down, 1024, 3072, 1024, 2, nullptr, WS_WDN0)
        TRM(ff_w_down + (size_t)3072 * 1024, 1024, 3072, 1024, 2, nullptr, WS_WDN1)
        TRM(ple_w_gate, 1024, 1024, 1024, 2, norm_ple, WS_WGT0)
        TRM(ple_w_gate + (size_t)1024 * 1024, 1024, 1024, 1024, 2, norm_ple + 1024, WS_WGT1)
        TRM(ple_w_proj, 1024, 256, 1024, 2, nullptr, WS_WPJ0)
        TRM(ple_w_proj + (size_t)256 * 1024, 1024, 256, 1024, 2, nullptr, WS_WPJ1)
        TRM(at_w_qkv, 1536, 1024, 1536, 2, norm_mix + 1024, WS_WQKV)
        TRM(at_w_out, 1024, 1024, 1024, 2, nullptr, WS_WO1)
#undef TRM
        TrI I;
        if (found) { const int nblk = Nd / 64, kb = r / nblk, sb = r - kb * nblk; I = TrI{W, scale, WT, ldw, K, mode, 64 * sb, 64 * kb, true}; }
        else { const int g = r >> 3, n = r & 7;
          I = TrI{(g ? rg_wx : rg_wa) + (size_t)n * 4096, nullptr, P_RGW + (size_t)r * 4096, 64, 64, 0, 0, 0, false}; }
        return I; };
    { int it = gw; TrI IA, IB; TrR RA, RB; bool va = it < NITEMS; if (va) { IA = decode(it); tr_ld(IA, F.lane, RA); }
      while (va) {
          const int ib = it + NGW; const bool vb = ib < NITEMS; if (vb) { IB = decode(ib); tr_ld(IB, F.lane, RB); }
          tr_st(IA, RA, scr, F.lane);
          it = ib + NGW; va = vb && (it < NITEMS); if (va) { IA = decode(it); tr_ld(IA, F.lane, RA); }
          if (vb) tr_st(IB, RB, scr, F.lane); } }
}

__device__ __forceinline__ void ld8f(const bf16* p, float (&o)[8]) { const v4u v = *(const v4u*)p; o[0] = bflo(v.x); o[1] = bfhi(v.x); o[2] = bflo(v.y); o[3] = bfhi(v.y); o[4] = bflo(v.z); o[5] = bfhi(v.z); o[6] = bflo(v.w); o[7] = bfhi(v.w); }
__device__ __forceinline__ void conv4x8(const bf16* zp, int s, const float* cw, int ldw, const float* cb, float (&out)[8]) {
    { const f32x4 b0 = *(const f32x4*)cb, b1 = *(const f32x4*)(cb + 4); out[0] = b0[0]; out[1] = b0[1]; out[2] = b0[2]; out[3] = b0[3]; out[4] = b1[0]; out[5] = b1[1]; out[6] = b1[2]; out[7] = b1[3]; }
#pragma unroll
    for (int j = 0; j < 4; ++j) if (s - 3 + j >= 0) { float xv[8]; ld8f(zp + (ptrdiff_t)(j - 3) * ZW, xv);
        const f32x4 w0 = *(const f32x4*)(cw + j * ldw), w1 = *(const f32x4*)(cw + j * ldw + 4);
        out[0] += w0[0] * xv[0]; out[1] += w0[1] * xv[1]; out[2] += w0[2] * xv[2]; out[3] += w0[3] * xv[3]; out[4] += w1[0] * xv[4]; out[5] += w1[1] * xv[5]; out[6] += w1[2] * xv[6]; out[7] += w1[3] * xv[7]; }
}
__device__ __forceinline__ v4u pk8f(const float (&a)[8]) { v4u o; o.x = pk2(a[0], a[1]); o.y = pk2(a[2], a[3]); o.z = pk2(a[4], a[5]); o.w = pk2(a[6], a[7]); return o; }
__device__ __forceinline__ float logsig(float f) { return fminf(f, 0.f) - __logf(1.0f + __expf(-fabsf(f))); }

template <int CTRL, int ROWMASK> __device__ __forceinline__ float dpp_f(float idv, float v) { return __int_as_float(__builtin_amdgcn_update_dpp(__float_as_int(idv), __float_as_int(v), CTRL, ROWMASK, 0xF, false)); }
__device__ __forceinline__ float scan_add(float v) {
    v += dpp_f<0x111, 0xF>(0.f, v); v += dpp_f<0x112, 0xF>(0.f, v); v += dpp_f<0x114, 0xF>(0.f, v); v += dpp_f<0x118, 0xF>(0.f, v);
    v += dpp_f<0x142, 0xA>(0.f, v); v += dpp_f<0x143, 0xC>(0.f, v); return v; }
__device__ __forceinline__ float scan_max(float v) {
    v = fmaxf(v, dpp_f<0x111, 0xF>(-INFINITY, v)); v = fmaxf(v, dpp_f<0x112, 0xF>(-INFINITY, v)); v = fmaxf(v, dpp_f<0x114, 0xF>(-INFINITY, v)); v = fmaxf(v, dpp_f<0x118, 0xF>(-INFINITY, v));
    v = fmaxf(v, dpp_f<0x142, 0xA>(-INFINITY, v)); v = fmaxf(v, dpp_f<0x143, 0xC>(-INFINITY, v)); return v; }
__device__ __forceinline__ float lane63(float v) { return __int_as_float(__builtin_amdgcn_readlane(__float_as_int(v), 63)); }
struct MlPre { v4u q[3], k[3], v[2]; float ip, fp, np, mp; };
template <bool PC> __device__ __forceinline__ void ml_prefetch(Frame& F, int u, MlPre& R) {
    const int c = u & 63, bh = u >> 6, h = bh & 3, b = bh >> 2, tok0 = b * SEQ + c * 64;
    const bf16* z = P_Z;
    int tid = F.tid; asm volatile("" : "+v"(tid));
#pragma unroll
    for (int s = 0; s < 3; ++s) { const int i = tid + 512 * s, row = s < 2 ? 3 + (i >> 4) : (tid >> 4), ch = s < 2 ? (i & 15) : (tid & 15); const bool ok = s < 2 || (tid < 48 && c > 0);
        const bf16* zp = z + (size_t)(tok0 - 3 + row) * ZW + 128 * h + 8 * ch;
        R.k[s] = ok ? *(const v4u*)(zp + 1536) : (v4u){0u, 0u, 0u, 0u};
        if (PC) R.q[s] = ok ? *(const v4u*)(zp + 1024) : (v4u){0u, 0u, 0u, 0u}; }
#pragma unroll
    for (int s = 0; s < 2; ++s) { const int i = tid + 512 * s, l = i >> 4, ch = i & 15; R.v[s] = *(const v4u*)(z + (size_t)(tok0 + l) * ZW + 2048 + 128 * h + 8 * ch); }
    if (tid < 64) { R.ip = P_GATES[(size_t)(tok0 + tid) * 8 + h]; R.fp = P_GATES[(size_t)(tok0 + tid) * 8 + 4 + h]; }
    if (PC) {
        if (tid >= 128 && tid < 256) R.np = P_NPREV[(size_t)u * 128 + tid - 128];
        R.mp = P_MPREV[u];
    }
}
__device__ __forceinline__ void vt_scatter(LAS unsigned short* VT, int stride, int ch, int l, const v4u& vv) {
    VT[(8 * ch + 0) * stride + l] = (unsigned short)(vv.x & 0xffffu); VT[(8 * ch + 1) * stride + l] = (unsigned short)(vv.x >> 16);
    VT[(8 * ch + 2) * stride + l] = (unsigned short)(vv.y & 0xffffu); VT[(8 * ch + 3) * stride + l] = (unsigned short)(vv.y >> 16);
    VT[(8 * ch + 4) * stride + l] = (unsigned short)(vv.z & 0xffffu); VT[(8 * ch + 5) * stride + l] = (unsigned short)(vv.z >> 16);
    VT[(8 * ch + 6) * stride + l] = (unsigned short)(vv.w & 0xffffu); VT[(8 * ch + 7) * stride + l] = (unsigned short)(vv.w >> 16);
}
__device__ __forceinline__ void conv4_lds(ldsp raw, int l, int ch, const LAS float* cw, const LAS float* cb, float (&out)[8]) {
    { const f32x4 b0 = *(const LAS f32x4*)(cb + 8 * ch), b1 = *(const LAS f32x4*)(cb + 8 * ch + 4); out[0] = b0[0]; out[1] = b0[1]; out[2] = b0[2]; out[3] = b0[3]; out[4] = b1[0]; out[5] = b1[1]; out[6] = b1[2]; out[7] = b1[3]; }
#pragma unroll
    for (int j = 0; j < 4; ++j) { const v4u v = *(const LAS v4u*)(raw + (l + j) * 272 + 16 * ch); const f32x4 w0 = *(const LAS f32x4*)(cw + j * 128 + 8 * ch), w1 = *(const LAS f32x4*)(cw + j * 128 + 8 * ch + 4);
        out[0] += w0[0] * bflo(v.x); out[1] += w0[1] * bfhi(v.x); out[2] += w0[2] * bflo(v.y); out[3] += w0[3] * bfhi(v.y); out[4] += w1[0] * bflo(v.z); out[5] += w1[1] * bfhi(v.z); out[6] += w1[2] * bflo(v.w); out[7] += w1[3] * bfhi(v.w); }
}

template <int NT> __device__ __forceinline__ void conv4_tok(ldsp raw, int t0, int g, const LAS float* cw, const LAS float* cb, f32x4 (&out)[NT][2]) {
    f32x4 w0[4], w1[4];
#pragma unroll
    for (int j = 0; j < 4; ++j) { w0[j] = *(const LAS f32x4*)(cw + j * 128 + 8 * g); w1[j] = *(const LAS f32x4*)(cw + j * 128 + 8 * g + 4); }
    const f32x4 b0 = *(const LAS f32x4*)(cb + 8 * g), b1 = *(const LAS f32x4*)(cb + 8 * g + 4);
    v4u rv[NT + 3];
#pragma unroll
    for (int r = 0; r < NT + 3; ++r) rv[r] = *(const LAS v4u*)(raw + (t0 + r) * 272 + 16 * g);
#pragma unroll
    for (int i = 0; i < NT; ++i) { out[i][0] = b0; out[i][1] = b1; }
#pragma unroll
    for (int r = 0; r < NT + 3; ++r) { f32x4 xa, xb2; pg8::unpack8(rv[r], xa, xb2);
#pragma unroll
        for (int i = 0; i < NT; ++i) { const int j = r - i; if (j >= 0 && j < 4) { out[i][0] += w0[j] * xa; out[i][1] += w1[j] * xb2; } } }
}

__device__ __forceinline__ void mlA_phase(Frame& F) {
    PHASE_FENCE(F);
    const float* ml_cw = karg(F, 15); const float* ml_cb = karg(F, 16);
    ldsp L = F.lds;
    constexpr int RAWK = 0, KTO = 18432, VTO = 36864, WLO = 57600, CWO = 57856, VRO = 61440  ;
    LAS unsigned short* KT = (LAS unsigned short*)(L + KTO); LAS unsigned short* VT = (LAS unsigned short*)(L + VTO); LAS float* WL = (LAS float*)(L + WLO); LAS float* CW = (LAS float*)(L + CWO);
    int u = F.vcu; if (u >= 2048) return;
    int hcw = -1;
    MlPre R; ml_prefetch<false>(F, u, R); STG_DECL;
    for (; u < 2048; u += F.G) { STG(10);
        { const int h = (u >> 6) & 3; if (h != hcw) { hcw = h; for (int i = F.tid; i < 640; i += NWAVES * 64) CW[i] = (i < 512) ? ml_cw[(i >> 7) * 1024 + 512 + 128 * h + (i & 127)] : ml_cb[512 + 128 * h + (i - 512)]; } }
#pragma unroll
        for (int s = 0; s < 3; ++s) { const int i = F.tid + 512 * s, row = s < 2 ? 3 + (i >> 4) : (F.tid >> 4), ch = s < 2 ? (i & 15) : (F.tid & 15); if (s < 2 || F.tid < 48) *(LAS v4u*)(L + RAWK + row * 272 + 16 * ch) = R.k[s]; }
#pragma unroll
        for (int s = 0; s < 2; ++s) { const int i = F.tid + 512 * s; *(LAS v4u*)(L + VRO + (i >> 4) * 272 + 16 * (i & 15)) = R.v[s]; }
        for (int i = F.tid; i < 16 * 64; i += NWAVES * 64) { const int r = i >> 6, l = i & 63; VT[(128 + r) * 72 + l] = (r == 0) ? (unsigned short)0x3F80 : (unsigned short)0; }
        if (F.wave == 0) {
            const int l = F.lane; const float bc = scan_add(logsig(R.fp));
            const float bl = lane63(bc); const float g = bl - bc + R.ip; const float mx = lane63(scan_max(g));
            WL[l] = __expf(g - mx);
            if (l == 0) { P_MLOC[u] = mx; P_BLAST[u] = bl; }
        }
        __syncthreads(); STG(11);
        if (u + F.G < 2048) ml_prefetch<false>(F, u + F.G, R);
#pragma unroll
        for (int s = 0; s < 2; ++s) { const int i = F.tid + 512 * s, l = i & 63, ch = i >> 6; const v4u vv = *(const LAS v4u*)(L + VRO + l * 272 + 16 * ch); vt_scatter(VT, 72, ch, l, vv); }
        { const int l = F.tid & 63;
#pragma unroll
          for (int it = 0; it < 2; ++it) { const int ch = (F.tid >> 6) + 8 * it; float kc[8]; conv4_lds(L + RAWK, l, ch, CW, CW + 512, kc);
            const float wl = WL[l] * 0.08838834764831845f;
#pragma unroll
            for (int i = 0; i < 8; ++i) KT[(8 * ch + i) * 72 + l] = f2bf1(fsilu(kc[i]) * wl); } }
        __syncthreads(); STG(12);
        { const int fr = F.lane & 15, fq = F.lane >> 4, w = F.wave;
          bf16x8 a[2];
#pragma unroll
          for (int ks = 0; ks < 2; ++ks) a[ks] = *(const LAS bf16x8*)(L + KTO + (16 * w + fr) * 144 + (32 * ks + 8 * fq) * 2);
#pragma unroll
          for (int nt = 0; nt < 9; ++nt) { f32x4 acc = {0.f, 0.f, 0.f, 0.f};
#pragma unroll
            for (int ks = 0; ks < 2; ++ks) { const bf16x8 bb = *(const LAS bf16x8*)(L + VTO + (16 * nt + fr) * 144 + (32 * ks + 8 * fq) * 2); acc = MFMA16(a[ks], bb, acc); }
            if (nt < 8) { v2u o; o.x = pk2(acc[0], acc[1]); o.y = pk2(acc[2], acc[3]); *(v2u*)(P_CST + (size_t)u * 16384 + (nt * 8 + w) * 256 + (fr * 4 + fq) * 4) = o; }
            else if (fr == 0) { *(f32x4*)(P_NLOC + (size_t)u * 128 + 16 * w + 4 * fq) = acc; } } }
        __syncthreads(); STG(13);
    }
#if defined(PROBE_SA) && PROBE_SA >= 10 && PROBE_SA < 20
    STG_END(F);
#endif
}

__device__ __forceinline__ void mlC_phase(Frame& F) {
    PHASE_FENCE(F);
    const float* ml_cw = karg(F, 15); const float* ml_cb = karg(F, 16); const float* ml_norm = karg(F, 17);
    ldsp L = F.lds;
    constexpr int RAWQ = 0, RAWK = 18432, QI = 36864, KI = 54272, VTO = 71680, SQO = 90112, CTO = 99328, ARR = 134144  , CWO = 136704  , HFO = 0, VRO = 142336  ;
    static_assert(ARR + 576 * 4 <= CWO && CWO + 1408 * 4 <= VRO && VRO + 64 * 272 <= LDSCTL_OFF, "mlC LDS map");
    LAS unsigned short* VT = (LAS unsigned short*)(L + VTO); LAS unsigned short* SQ = (LAS unsigned short*)(L + SQO); LAS float* HF = (LAS float*)(L + HFO); LAS float* CW = (LAS float*)(L + CWO);
    LAS float* DV = (LAS float*)(L + ARR); LAS float* MU = DV + 64; LAS float* AI = DV + 128; LAS float* EM = DV + 192; LAS float* DENP = DV + 256  ; LAS float* DNI = DV + 384; LAS float* NP = DV + 448  ;
    int u = F.vcu; if (u >= 2048) return;
    float s_nl2e = -1.4426950408889634f, s_one = 1.0f; asm("" : "+s"(s_nl2e), "+s"(s_one)); const f32x4 SNL2E = {s_nl2e, s_nl2e, s_nl2e, s_nl2e}, SONE = {s_one, s_one, s_one, s_one};
    int hcw = -1;
    MlPre R; ml_prefetch<true>(F, u, R); STG_DECL;
    for (; u < 2048; u += F.G) { STG(0);
        const int c = u & 63, bh = u >> 6, h = bh & 3, b = bh >> 2, tok0 = b * SEQ + c * 64;
        if (h != hcw) { hcw = h;
            for (int i = F.tid; i < 1280; i += NWAVES * 64) { const int qk = i / 640, r = i % 640; CW[i] = (r < 512) ? ml_cw[(r >> 7) * 1024 + 512 * qk + 128 * h + (r & 127)] : ml_cb[512 * qk + 128 * h + (r - 512)]; }
            if (F.tid < 128) CW[1280 + F.tid] = ml_norm[128 * h + F.tid]; }
#pragma unroll
        for (int s = 0; s < 3; ++s) { const int i = F.tid + 512 * s, row = s < 2 ? 3 + (i >> 4) : (F.tid >> 4), ch = s < 2 ? (i & 15) : (F.tid & 15); if (s < 2 || F.tid < 48) { *(LAS v4u*)(L + RAWQ + row * 272 + 16 * ch) = R.q[s]; *(LAS v4u*)(L + RAWK + row * 272 + 16 * ch) = R.k[s]; } }
#pragma unroll
        for (int s = 0; s < 2; ++s) { const int i = F.tid + 512 * s; *(LAS v4u*)(L + VRO + (i >> 4) * 272 + 16 * (i & 15)) = R.v[s]; }
        if (F.wave == 0) {
            const int l = F.lane; const float bc = scan_add(logsig(R.fp));
            const float dv = R.ip - bc; const float cm = scan_max(dv);
            const float bm = bc + R.mp, mt = fmaxf(bm, bc + cm);
            AI[l] = __expf(bm - mt); MU[l] = mt - bc; DV[l] = dv; EM[l] = __expf(-mt);
        }
        if (F.tid >= 128 && F.tid < 256) NP[F.tid - 128] = R.np;
        __syncthreads(); STG(1);
        v4u ct[4];
#pragma unroll
        for (int s = 0; s < 4; ++s) ct[s] = *(const v4u*)(P_CST + (size_t)u * 16384 + (size_t)(F.tid + 512 * s) * 8);
        if (u + F.G < 2048) ml_prefetch<true>(F, u + F.G, R);
#pragma unroll
        for (int s = 0; s < 2; ++s) { const int i = F.tid + 512 * s, l = i & 63, ch = i >> 6; const v4u vv = *(const LAS v4u*)(L + VRO + l * 272 + 16 * ch); vt_scatter(VT, 72, ch, l, vv); }
        { const int qk = F.wave >> 2, g = F.lane & 15, t0 = 16 * (F.wave & 3) + 4 * (F.lane >> 4); f32x4 cv[4][2];
          conv4_tok<4>(L + (qk ? RAWK : RAWQ), t0, g, CW + 640 * qk, CW + 640 * qk + 512, cv);
          const float sc = qk ? 0.08838834764831845f : 1.0f; const f32x4 SC = {sc, sc, sc, sc};
#pragma unroll
          for (int tt = 0; tt < 4; ++tt) {
#pragma unroll
            for (int hv = 0; hv < 2; ++hv) { const f32x4 x = cv[tt][hv], tneg = x * SNL2E; f32x4 ex, rc;
#pragma unroll
                for (int e = 0; e < 4; ++e) ex[e] = __builtin_amdgcn_exp2f(tneg[e]);
                const f32x4 den = ex + SONE;
#pragma unroll
                for (int e = 0; e < 4; ++e) rc[e] = __builtin_amdgcn_rcpf(den[e]);
                cv[tt][hv] = x * SC * rc; }
            *(LAS pg8::u32x4*)(L + (qk ? KI : QI) + (t0 + tt) * 272 + 16 * g) = pg8::pk8(cv[tt][0], cv[tt][1]); } }
        __syncthreads(); STG(2);
        const int fr = F.lane & 15, fq = F.lane >> 4, w = F.wave, tt = w >> 1;
        {
          float rs[4] = {0.f, 0.f, 0.f, 0.f}, mu4[4]; bf16x8 aq2[4];
#pragma unroll
          for (int ks = 0; ks < 4; ++ks) aq2[ks] = *(const LAS bf16x8*)(L + QI + (16 * tt + fr) * 272 + (32 * ks + 8 * fq) * 2);
#pragma unroll
          for (int r = 0; r < 4; ++r) mu4[r] = MU[16 * tt + 4 * fq + r];
#pragma unroll 1
          for (int si = 0; si < 2; ++si) { const int st = 2 * (w & 1) + si; f32x4 acc = {0.f, 0.f, 0.f, 0.f};
#pragma unroll
            for (int ks = 0; ks < 4; ++ks) { const bf16x8 bb = *(const LAS bf16x8*)(L + KI + (16 * st + fr) * 272 + (32 * ks + 8 * fq) * 2); acc = MFMA16(aq2[ks], bb, acc); }
            const int s = 16 * st + fr; const float dvs = DV[s];
#pragma unroll
            for (int r = 0; r < 4; ++r) { const int t = 16 * tt + 4 * fq + r; const float wgt = (s <= t) ? __expf(dvs - mu4[r]) : 0.f; const float v = acc[r] * wgt; rs[r] += v; SQ[t * 72 + s] = f2bf1(v); } }
#pragma unroll
          for (int r = 0; r < 4; ++r) { const float v = sum16(rs[r]); if (fr == 0) DENP[(w & 1) * 64 + 16 * tt + 4 * fq + r] = v; }
          const int t = F.tid >> 3, part = F.tid & 7; float acc = 0.f;
          { const v4u v0 = *(const LAS v4u*)(L + QI + t * 272 + 32 * part), v1 = *(const LAS v4u*)(L + QI + t * 272 + 32 * part + 16);
            const float q0[8] = {bflo(v0.x), bfhi(v0.x), bflo(v0.y), bfhi(v0.y), bflo(v0.z), bfhi(v0.z), bflo(v0.w), bfhi(v0.w)};
            const float q1[8] = {bflo(v1.x), bfhi(v1.x), bflo(v1.y), bfhi(v1.y), bflo(v1.z), bfhi(v1.z), bflo(v1.w), bfhi(v1.w)};
#pragma unroll
            for (int i = 0; i < 8; ++i) acc += q0[i] * NP[16 * part + i] + q1[i] * NP[16 * part + 8 + i]; }
          acc = sum8(acc);
          if (part == 0) DNI[t] = acc; }
#pragma unroll
        for (int s = 0; s < 4; ++s) { const int i = F.tid + 512 * s, tile = i >> 5, fr_ = (i >> 1) & 15; *(LAS v4u*)(L + CTO + (16 * (tile >> 3) + fr_) * 272 + 32 * (tile & 7) + 16 * (i & 1)) = ct[s]; }
        __syncthreads(); STG(3);
        v4u o0, o1; { const bf16* op = P_Z + (size_t)(tok0 + (F.tid >> 3)) * ZW + 2560 + 128 * h + 16 * (F.tid & 7); o0 = *(const v4u*)op; o1 = *(const v4u*)(op + 8); }
        {
          bf16x8 as_[2], aq_[4];
#pragma unroll
          for (int ks = 0; ks < 2; ++ks) as_[ks] = *(const LAS bf16x8*)(L + SQO + (16 * tt + fr) * 144 + (32 * ks + 8 * fq) * 2);
#pragma unroll
          for (int ks = 0; ks < 4; ++ks) aq_[ks] = *(const LAS bf16x8*)(L + QI + (16 * tt + fr) * 272 + (32 * ks + 8 * fq) * 2);
          float aint4[4], idd[4];
#pragma unroll
          for (int r = 0; r < 4; ++r) { const int t = 16 * tt + 4 * fq + r; aint4[r] = AI[t]; const float den = DENP[t] + DENP[64 + t] + aint4[r] * DNI[t]; idd[r] = 1.0f / fmaxf(fabsf(den), EM[t]); }
#pragma unroll 1
          for (int ei = 0; ei < 4; ++ei) { const int et = 4 * (w & 1) + ei; f32x4 ai_ = {0.f, 0.f, 0.f, 0.f}, ax = {0.f, 0.f, 0.f, 0.f};
#pragma unroll
            for (int ks = 0; ks < 2; ++ks) { const bf16x8 bb = *(const LAS bf16x8*)(L + VTO + (16 * et + fr) * 144 + (32 * ks + 8 * fq) * 2); ai_ = MFMA16(as_[ks], bb, ai_); }
#pragma unroll
            for (int ks = 0; ks < 4; ++ks) { const bf16x8 bb = *(const LAS bf16x8*)(L + CTO + (16 * et + fr) * 272 + (32 * ks + 8 * fq) * 2); ax = MFMA16(aq_[ks], bb, ax); }
#pragma unroll
            for (int r = 0; r < 4; ++r) { const int t = 16 * tt + 4 * fq + r; HF[t * 132 + 16 * et + fr] = (ai_[r] + aint4[r] * ax[r]) * idd[r]; } } }
        __syncthreads(); STG(4);
        {
          const int t = F.tid >> 3, part = F.tid & 7; f32x4 hv[4]; float ss = 0.f;
#pragma unroll
          for (int i = 0; i < 4; ++i) { hv[i] = *(const LAS f32x4*)(HF + t * 132 + 16 * part + 4 * i); ss += pg8::dot4(hv[i]); }
          ss = sum8(ss);
          const float rstd = rsqrtf(ss * (1.0f / 128.0f) + 1e-6f);
          const float og0[8] = {bflo(o0.x), bfhi(o0.x), bflo(o0.y), bfhi(o0.y), bflo(o0.z), bfhi(o0.z), bflo(o0.w), bfhi(o0.w)};
          const float og1[8] = {bflo(o1.x), bfhi(o1.x), bflo(o1.y), bfhi(o1.y), bflo(o1.z), bfhi(o1.z), bflo(o1.w), bfhi(o1.w)};
          float y0[8], y1[8]; const LAS float* gn = CW + 1280 + 16 * part;
#pragma unroll
          for (int i = 0; i < 8; ++i) { y0[i] = hv[i >> 2][i & 3] * rstd * gn[i] * fsigmoid(og0[i]); y1[i] = hv[2 + (i >> 2)][i & 3] * rstd * gn[8 + i] * fsigmoid(og1[i]); }
          bf16* yp = P_YBUF + (size_t)(tok0 + t) * DM + 512 + 128 * h + 16 * part; *(v4u*)yp = pk8f(y0); *(v4u*)(yp + 8) = pk8f(y1); }
        __syncthreads(); STG(5);
    }
#if defined(PROBE_SA) && PROBE_SA < 10
    STG_END(F);
#endif
}

struct RgPre { v4u raw[11]; float carry[4]; };
template <bool FINAL> __device__ __forceinline__ void rg_prefetch(Frame& F, int u, RgPre& R) {
    const int b = u >> 6, c = u & 63, tok0 = b * SEQ + c * 64;
    int tid = F.tid; asm volatile("" : "+v"(tid));
    const int chunk = tid & 63, run = tid >> 6, col0 = 8 * chunk;
#pragma unroll
    for (int k = 0; k < 11; ++k) { const int s = c * 64 + 8 * run - 3 + k; R.raw[k] = (s >= 0) ? *(const v4u*)(P_Z + (size_t)(tok0 + 8 * run - 3 + k) * ZW + col0) : (v4u){0u, 0u, 0u, 0u}; }
    if (FINAL) {
        const int fr = tid & 15, w = tid >> 6;
#pragma unroll
        for (int jt = 0; jt < 4; ++jt) R.carry[jt] = P_RGC[(size_t)u * 512 + 64 * w + 16 * jt + fr];
    }
}
template <bool FINAL> __device__ __forceinline__ void rg_phase(Frame& F) {
    PHASE_FENCE(F);
    const float* rg_cw = karg(F, 8); const float* rg_cb = karg(F, 9); const float* rg_ba = karg(F, 11); const float* rg_bx = karg(F, 13); const float* rg_lam = karg(F, 14);
    ldsp L = F.lds;
    constexpr int XCO = 0, GRO = 66560;
    LAS unsigned short* XC = (LAS unsigned short*)(L + XCO); LAS unsigned short* GR = (LAS unsigned short*)(L + GRO);
    const int fr = F.lane & 15, fq = F.lane >> 4, w = F.wave;
    int u = F.vcu; if (u >= 512) return;
    RgPre R; rg_prefetch<FINAL>(F, u, R);
    bf16x8 bfr[2][4][2]; float ba[4], bx[4], sp8[4];
#pragma unroll
    for (int g = 0; g < 2; ++g)
#pragma unroll
        for (int jt = 0; jt < 4; ++jt)
#pragma unroll
            for (int ks = 0; ks < 2; ++ks) bfr[g][jt][ks] = *(const bf16x8*)(P_RGW + (size_t)(g * 8 + w) * 4096 + (16 * jt + fr) * 64 + 32 * ks + 8 * fq);
#pragma unroll
    for (int jt = 0; jt < 4; ++jt) { const int chn = 64 * w + 16 * jt + fr; ba[jt] = rg_ba[chn] * -1.4426950408889634f; bx[jt] = rg_bx[chn] * -1.4426950408889634f; sp8[jt] = 8.0f * 1.4426950408889634f * log1pf(__expf(-rg_lam[chn]));     }
    const int chunk = F.tid & 63, run = F.tid >> 6, col0 = 8 * chunk;
    float c_nl2e = -1.4426950408889634f, c_one = 1.0f; asm("" : "+s"(c_nl2e), "+s"(c_one));
    LAS float* CWL = (LAS float*)(L + 132096);
    for (int i = F.tid; i < 2560; i += NWAVES * 64) CWL[i] = (i < 2048) ? rg_cw[i] : rg_cb[i - 2048];
    __syncthreads(); STG_DECL;
    for (; u < 512; u += F.G) { if (FINAL) STG(20);
        const int b = u >> 6, c = u & 63, tok0 = b * SEQ + c * 64;
        f32x4 wa[4], wb[4];
#pragma unroll
        for (int j = 0; j < 4; ++j) { wa[j] = *(const LAS f32x4*)(CWL + j * 512 + col0); wb[j] = *(const LAS f32x4*)(CWL + j * 512 + col0 + 4); }
        const f32x4 b0 = *(const LAS f32x4*)(CWL + 2048 + col0), b1 = *(const LAS f32x4*)(CWL + 2048 + col0 + 4);
#pragma unroll
        for (int t = 0; t < 8; ++t) { f32x4 oa = b0, ob = b1;
#pragma unroll
            for (int j = 0; j < 4; ++j) { f32x4 xa, xb2; pg8::unpack8(R.raw[t + j], xa, xb2); oa += wa[j] * xa; ob += wb[j] * xb2; }
            *(LAS v4u*)(L + XCO + (8 * run + t) * 1040 + 16 * chunk) = pg8::pk8(oa, ob); }
        float carry[4], ptot[4]; v4u gk[8];
#pragma unroll
        for (int jt = 0; jt < 4; ++jt) { carry[jt] = FINAL ? R.carry[jt] : 0.f; ptot[jt] = 1.f; }
        __syncthreads(); if (FINAL) STG(21);
        if (u + F.G < 512) rg_prefetch<FINAL>(F, u + F.G, R);
        if (FINAL) {
#pragma unroll
            for (int k = 0; k < 8; ++k) gk[k] = *(const v4u*)(P_Z + (size_t)(tok0 + run + 8 * k) * ZW + 512 + col0); }
#pragma unroll 1
        for (int tt = 0; tt < 4; ++tt) {
            bf16x8 a[2];
#pragma unroll
            for (int ks = 0; ks < 2; ++ks) a[ks] = *(const LAS bf16x8*)(L + XCO + (16 * tt + fr) * 1040 + (64 * w + 32 * ks + 8 * fq) * 2);
#pragma unroll
            for (int jt = 0; jt < 4; ++jt) { f32x4 ga = {0.f, 0.f, 0.f, 0.f}, gx = {0.f, 0.f, 0.f, 0.f};
#pragma unroll
                for (int ks = 0; ks < 2; ++ks) { ga = MFMA16(a[ks], bfr[0][jt][ks], ga); gx = MFMA16(a[ks], bfr[1][jt][ks], gx); }
                const int chn = 64 * w + 16 * jt + fr; f32x4 av, uv;
                {
                  typedef float f32x2 __attribute__((ext_vector_type(2)));
                  const f32x2 BA = {ba[jt], ba[jt]}, BX = {bx[jt], bx[jt]}, NSP = {-sp8[jt], -sp8[jt]}, NL2 = {c_nl2e, c_nl2e}, ONE2 = {c_one, c_one};
#pragma unroll
                  for (int hf = 0; hf < 2; ++hf) { f32x2 xc2, g2a = {ga[2 * hf], ga[2 * hf + 1]}, g2x = {gx[2 * hf], gx[2 * hf + 1]}, ea, ex, sa, sx, a2, sq;
#pragma unroll
                    for (int r = 0; r < 2; ++r) xc2[r] = bf2f(XC[(16 * tt + 4 * fq + 2 * hf + r) * 520 + chn]);
                    const f32x2 ta = g2a * NL2 + BA, tx = g2x * NL2 + BX;
#pragma unroll
                    for (int r = 0; r < 2; ++r) { ea[r] = __builtin_amdgcn_exp2f(ta[r]); ex[r] = __builtin_amdgcn_exp2f(tx[r]); }
                    const f32x2 da = ea + ONE2, dx = ex + ONE2;
#pragma unroll
                    for (int r = 0; r < 2; ++r) { sa[r] = __builtin_amdgcn_rcpf(da[r]); sx[r] = __builtin_amdgcn_rcpf(dx[r]); }
                    const f32x2 la = sa * NSP;
#pragma unroll
                    for (int r = 0; r < 2; ++r) a2[r] = __builtin_amdgcn_exp2f(la[r]);
                    const f32x2 om = ONE2 - a2 * a2;
#pragma unroll
                    for (int r = 0; r < 2; ++r) sq[r] = __builtin_amdgcn_sqrtf(om[r]);
                    const f32x2 u2 = sq * sx * xc2;
                    av[2 * hf] = a2[0]; av[2 * hf + 1] = a2[1]; uv[2 * hf] = u2[0]; uv[2 * hf + 1] = u2[1]; } }
                float Pi = av[0] * av[1] * av[2] * av[3], hi = ((uv[0] * av[1] + uv[1]) * av[2] + uv[2]) * av[3] + uv[3];
                { const float tP = __shfl_up(Pi, 16), th = __shfl_up(hi, 16); if (fq >= 1) { hi = Pi * th + hi; Pi = Pi * tP; } }
                { const float tP = __shfl_up(Pi, 32), th = __shfl_up(hi, 32); if (fq >= 2) { hi = Pi * th + hi; Pi = Pi * tP; } }
                float Pe = __shfl_up(Pi, 16), he = __shfl_up(hi, 16); if (fq == 0) { Pe = 1.f; he = 0.f; }
                const float P3 = __shfl(Pi, 48 + fr), h3 = __shfl(hi, 48 + fr);
                if (FINAL) { float hc = Pe * carry[jt] + he;
#pragma unroll
                    for (int r = 0; r < 4; ++r) { const int t = 16 * tt + 4 * fq + r; hc = av[r] * hc + uv[r]; GR[t * 512 + chn] = f2bf1(hc); } }
                carry[jt] = P3 * carry[jt] + h3; ptot[jt] *= P3; }
        }
        if (!FINAL) { if (fq == 0) {
#pragma unroll
            for (int jt = 0; jt < 4; ++jt) { P_RGA[(size_t)u * 512 + 64 * w + 16 * jt + fr] = ptot[jt]; P_RGH[(size_t)u * 512 + 64 * w + 16 * jt + fr] = carry[jt]; } } }
        else { __syncthreads(); STG(22);
#pragma unroll
            for (int k = 0; k < 8; ++k) { const int t = run + 8 * k; f32x4 h0, h1, g0, g1; const v4u hw = *(const LAS v4u*)(L + GRO + t * 1024 + 16 * chunk); pg8::unpack8(hw, h0, h1); pg8::unpack8(gk[k], g0, g1);
#pragma unroll
                for (int e = 0; e < 4; ++e) { h0[e] *= gelu_tanh(g0[e]); h1[e] *= gelu_tanh(g1[e]); }
                *(v4u*)(P_YBUF + (size_t)(tok0 + t) * DM + 8 * chunk) = pg8::pk8(h0, h1); } }
        __syncthreads(); if (FINAL) STG(23);
    }
#if defined(PROBE_SA) && PROBE_SA >= 20
    if (FINAL) STG_END(F);
#endif
}

__device__ __forceinline__ void mixB_unit(Frame& F, int unit) {
    PHASE_FENCE(F);
    const int bh = unit >> 3, sl = unit & 7; ldsp L = F.lds;
    LAS float* AP = (LAS float*)L; LAS float* AL = AP + 64;
    bf16* base = P_CST + (size_t)bh * 64 * 16384 + sl * 2048 + F.tid * 4; v2u cl[64];
#pragma unroll
    for (int c = 0; c < 64; ++c) cl[c] = *(const v2u*)(base + (size_t)c * 16384);
    if (F.wave == 0) {
        const float mlv = P_MLOC[bh * 64 + F.lane], blv = P_BLAST[bh * 64 + F.lane]; float mst = -INFINITY, mp = 0.f, mn_ = 0.f;
#pragma unroll
        for (int c = 0; c < 64; ++c) { const float ml = __int_as_float(__builtin_amdgcn_readlane(__float_as_int(mlv), c));
            const float bl = __int_as_float(__builtin_amdgcn_readlane(__float_as_int(blv), c)); const float mn = fmaxf(bl + mst, ml);
            if (F.lane == c) { mp = mst; mn_ = mn; }
            mst = mn; }
        AP[F.lane] = __expf(blv + mp - mn_); AL[F.lane] = __expf(mlv - mn_); if (sl == 0) P_MPREV[bh * 64 + F.lane] = mp; }
    __syncthreads();
    { float st[4] = {0.f, 0.f, 0.f, 0.f};
#pragma unroll
      for (int c = 0; c < 64; ++c) { v2u o; o.x = pk2(st[0], st[1]); o.y = pk2(st[2], st[3]); *(v2u*)(base + (size_t)c * 16384) = o;
          const float ap = AP[c], al = AL[c];
          st[0] = ap * st[0] + al * bflo(cl[c].x); st[1] = ap * st[1] + al * bfhi(cl[c].x); st[2] = ap * st[2] + al * bflo(cl[c].y); st[3] = ap * st[3] + al * bfhi(cl[c].y); } }
    asm volatile("" ::: "memory");
    if (sl == 0 && F.tid < 128) { float ns = 0.f, nl[64];
#pragma unroll
        for (int c = 0; c < 64; ++c) nl[c] = P_NLOC[(size_t)(bh * 64 + c) * 128 + F.tid];
#pragma unroll
        for (int c = 0; c < 64; ++c) { P_NPREV[(size_t)(bh * 64 + c) * 128 + F.tid] = ns; ns = AP[c] * ns + AL[c] * nl[c]; } }
#pragma unroll
    for (int j = 0; j < 2; ++j) { const int idx = unit * 16 + 2 * F.wave + j, b = idx >> 9, chn = idx & 511; const size_t o = (size_t)(b * 64 + F.lane) * 512 + chn;
        float Pi = P_RGA[o], hi = P_RGH[o];
#pragma unroll
        for (int off = 1; off < 64; off <<= 1) { const float tP = __shfl_up(Pi, off), th = __shfl_up(hi, off); if (F.lane >= off) { hi = Pi * th + hi; Pi = Pi * tP; } }
        float he = __shfl_up(hi, 1); if (F.lane == 0) he = 0.f;
        P_RGC[o] = he; }
    __syncthreads();
}

__device__ __forceinline__ void attn_unit(Frame& F, int u, bool fresh, const bf16* Qb, const bf16* Kb, const bf16* Vb, bf16* Ob) { const float* at_sinks = karg(F, 22);
    const int qb = u & 31, kvh = (u >> 5) & 3, b = u >> 7; const int row0 = b * SEQ + 128 * qb; const int sp = qb & 1;
    ldsp L = F.lds;
    constexpr int KI = 0, VTO = 36864, VRO = 70144;
    LAS unsigned short* VT = (LAS unsigned short*)(L + VTO);
    STG(30);
    bf16x8 qf[4];
    { const int r_ = F.lane & 31, hh_ = F.lane >> 5, w_ = F.wave; const size_t qrow_ = (size_t)(row0 + 64 * (w_ & 1) + r_);
#pragma unroll
      for (int ks = 0; ks < 4; ++ks) qf[ks] = *(const bf16x8*)(Qb + qrow_ * 1024 + 64 * (4 * kvh + (w_ >> 1)) + 16 * ks + 8 * hh_); }
#pragma unroll
    for (int it = 0; it < 4; ++it) { if (!fresh && it < 2) continue;
        const int idx = F.tid + 512 * it, kr = idx >> 3, chk = idx & 7; const bool ok = (qb > 0) || (kr >= 128);
        v4u kv = {0u, 0u, 0u, 0u}, vv = {0u, 0u, 0u, 0u};
        if (ok) { const size_t o = (size_t)(row0 - 128 + kr) * 256 + 64 * kvh + 8 * chk; kv = *(const v4u*)(Kb + o); vv = *(const v4u*)(Vb + o); }
        const int krow = 128 * ((kr >> 7) ? sp : (sp ^ 1)) + (kr & 127);
        *(LAS v4u*)(L + KI + krow * 144 + 16 * chk) = kv; *(LAS v4u*)(L + VRO + kr * 144 + 16 * chk) = vv; }
    __syncthreads(); STG(31);
#pragma unroll
    for (int it = 0; it < 4; ++it) { if (!fresh && it >= 2) continue;
        const int idx = F.tid + 512 * it, kr = fresh ? (idx & 255) : 128 + (idx & 127), chk = fresh ? (idx >> 8) : (idx >> 7);
        const v4u vv = *(const LAS v4u*)(L + VRO + kr * 144 + 16 * chk); const int kcol = 128 * ((kr >> 7) ? sp : (sp ^ 1)) + (kr & 127);
        VT[(8 * chk + 0) * 260 + kcol] = (unsigned short)(vv.x & 0xffffu); VT[(8 * chk + 1) * 260 + kcol] = (unsigned short)(vv.x >> 16);
        VT[(8 * chk + 2) * 260 + kcol] = (unsigned short)(vv.y & 0xffffu); VT[(8 * chk + 3) * 260 + kcol] = (unsigned short)(vv.y >> 16);
        VT[(8 * chk + 4) * 260 + kcol] = (unsigned short)(vv.z & 0xffffu); VT[(8 * chk + 5) * 260 + kcol] = (unsigned short)(vv.z >> 16);
        VT[(8 * chk + 6) * 260 + kcol] = (unsigned short)(vv.w & 0xffffu); VT[(8 * chk + 7) * 260 + kcol] = (unsigned short)(vv.w >> 16); }
    __syncthreads(); STG(32);
    const int r = F.lane & 31, hh = F.lane >> 5, w = F.wave, head = 4 * kvh + (w >> 1);
    const float sink = at_sinks[head] * 1.4426950408889634f;
#pragma unroll 1
    for (int qt = 0; qt < 2; ++qt) {
        const int q0 = 64 * (w & 1) + 32 * qt, kt0 = q0 >> 5; const size_t qrow = (size_t)(row0 + q0 + r);
        f32x16 S[5];
#pragma unroll
        for (int i = 0; i < 5; ++i) {
#pragma unroll
            for (int e = 0; e < 16; ++e) S[i][e] = 0.f;
#pragma unroll
            for (int ks = 0; ks < 4; ++ks) { const int tI = kt0 + i, rb = 128 * ((tI >> 2) ^ (sp ^ 1)) + 32 * (tI & 3); const bf16x8 kf = *(const LAS bf16x8*)(L + KI + (rb + r) * 144 + (16 * ks + 8 * hh) * 2); S[i] = MFMA32(kf, qf[ks], S[i]); } }
        if (qt == 0) {
#pragma unroll
            for (int ks = 0; ks < 4; ++ks) qf[ks] = *(const bf16x8*)(Qb + (qrow + 32) * 1024 + 64 * head + 16 * ks + 8 * hh); }
        float mx = sink;
#pragma unroll
        for (int i = 0; i < 5; ++i) {
            if (i == 0 || i == 4) {
#pragma unroll
                for (int e = 0; e < 16; ++e) { const int cr = (e & 3) + 8 * (e >> 2) + 4 * hh; const float v = S[i][e]; S[i][e] = (i == 0) ? ((cr > r) ? v : -INFINITY) : ((cr <= r) ? v : -INFINITY); } }
            if (qb == 0) { if (kt0 + i < 4) { asm volatile("" ::: "memory");
#pragma unroll
                for (int e = 0; e < 16; ++e) S[i][e] = -INFINITY; } }
#pragma unroll
            for (int e = 0; e < 16; ++e) mx = fmaxf(mx, S[i][e]); }
        mx = fmaxf(mx, __shfl_xor(mx, 32));
        float sum;
        { f32x16 tot;
          typedef float f32x2 __attribute__((ext_vector_type(2))); const f32x2 NMX = {-mx, -mx};
#pragma unroll
          for (int i = 0; i < 5; ++i) {
#pragma unroll
              for (int e = 0; e < 16; e += 2) { f32x2 d = (f32x2){S[i][e], S[i][e + 1]} + NMX; asm("" : "+v"(d));
                  S[i][e] = __builtin_amdgcn_exp2f(d[0]); S[i][e + 1] = __builtin_amdgcn_exp2f(d[1]); }
              tot = (i == 0) ? S[0] : tot + S[i]; }
          const f32x4 t4 = (tot.lo.lo + tot.lo.hi) + (tot.hi.lo + tot.hi.hi); sum = (t4[0] + t4[1]) + (t4[2] + t4[3]); }
        sum += __shfl_xor(sum, 32); sum += __builtin_amdgcn_exp2f(sink - mx);
        const float inv = 1.0f / sum;
        f32x16 O[2];
#pragma unroll
        for (int e = 0; e < 16; ++e) { O[0][e] = 0.f; O[1][e] = 0.f; }
#pragma unroll
        for (int i = 0; i < 5; ++i)
#pragma unroll
            for (int s = 0; s < 2; ++s) {
                v4u pw; pw.x = pk2(S[i][8 * s + 0], S[i][8 * s + 1]); pw.y = pk2(S[i][8 * s + 2], S[i][8 * s + 3]); pw.z = pk2(S[i][8 * s + 4], S[i][8 * s + 5]); pw.w = pk2(S[i][8 * s + 6], S[i][8 * s + 7]);
                const bf16x8 pf = __builtin_bit_cast(bf16x8, pw);
#pragma unroll
                for (int dt = 0; dt < 2; ++dt) { const int tI = kt0 + i, rb = 128 * ((tI >> 2) ^ (sp ^ 1)) + 32 * (tI & 3); const int ko = (32 * dt + r) * 520 + (rb + 16 * s + 4 * hh) * 2;
                    const s16x4 lo = *(const LAS s16x4*)(L + VTO + ko), hi = *(const LAS s16x4*)(L + VTO + ko + 16);
                    const bf16x8 vf = __builtin_shufflevector(lo, hi, 0, 1, 2, 3, 4, 5, 6, 7);
                    O[dt] = MFMA32(vf, pf, O[dt]); } }
        bf16* op = Ob + qrow * 1024 + 64 * head + 4 * hh;
#pragma unroll
        for (int dt = 0; dt < 2; ++dt)
#pragma unroll
            for (int g4 = 0; g4 < 4; ++g4) { v2u o; o.x = pk2(O[dt][4 * g4] * inv, O[dt][4 * g4 + 1] * inv); o.y = pk2(O[dt][4 * g4 + 2] * inv, O[dt][4 * g4 + 3] * inv); *(v2u*)(op + 32 * dt + 8 * g4) = o; }
    }
    __syncthreads(); STG(33);
}

__device__ __forceinline__ void fixup_panel(Frame& F, int pm, int half, const float* cw, const float* cb, bf16* A2, const bf16* GH, const bf16* UH, const bf16* GT) {
    v4u gq[3], uq[3], p1q[3], p2q[3]; float m1[3], m2[3]; int ch0a[3], dsto[3];
#pragma unroll
    for (int k = 0; k < 3; ++k) { const int idx = half * 1536 + F.tid + NWAVES * 64 * k;
        const int chk = idx % 384, rg = idx / 384, rr = rg & 1, grp = 4 * pm + (rg >> 1), ch0 = 8 * chk; const bool first = (grp & 63) == 0;
        const bf16* gh = GH + ((size_t)grp * 2 + rr) * 3072 + ch0;
        const bf16* q1 = rr ? GH + ((size_t)grp * 2) * 3072 + ch0 : (first ? gh : GT + ((size_t)(grp - 1) * 2 + 1) * 3072 + ch0);
        const bf16* q2 = first ? gh : GT + ((size_t)(grp - 1) * 2 + (rr ? 1 : 0)) * 3072 + ch0;
        gq[k] = *(const v4u*)gh; uq[k] = *(const v4u*)(UH + ((size_t)grp * 2 + rr) * 3072 + ch0); p1q[k] = *(const v4u*)q1; p2q[k] = *(const v4u*)q2;
        m1[k] = (rr || !first) ? 1.0f : 0.0f; m2[k] = first ? 0.0f : 1.0f; ch0a[k] = ch0;
        dsto[k] = (int)((size_t)0) + ((ch0 >> 6) * 128 + ((ch0 >> 5) & 1) * 64 + rr * 32 + (ch0 & 31)) + grp * 32 * 6144; }
#pragma unroll
    for (int k = 0; k < 3; ++k) { const int ch0 = ch0a[k]; pg8::f32x4 g0, g1, u0, u1, a0, a1, b0, b1;
        pg8::unpack8(gq[k], g0, g1); pg8::unpack8(uq[k], u0, u1); pg8::unpack8(p1q[k], a0, a1); pg8::unpack8(p2q[k], b0, b1);
        float o[8];
#pragma unroll
        for (int i = 0; i < 8; ++i) { const float gv = i < 4 ? g0[i & 3] : g1[i & 3], uv = i < 4 ? u0[i & 3] : u1[i & 3], p1 = (i < 4 ? a0[i & 3] : a1[i & 3]) * m1[k], p2 = (i < 4 ? b0[i & 3] : b1[i & 3]) * m2[k];
            const float y = cw[ch0 + i] * p2 + cw[3072 + ch0 + i] * p1 + cw[6144 + ch0 + i] * gv + cb[ch0 + i]; o[i] = gelu_tanh(y) * uv; }
        *(v4u*)(A2 + (size_t)dsto[k]) = pk8f(o); }
}

#define GRID_BAR() do { xcd_barrier(bar); TSTAMP(); } while (0)
template <int L> __device__ __forceinline__ bool layer_part(Frame& F, const XcdBarrier& bar, int& ts_n) {
    constexpr int l = L;
    unsigned char* ws = F.ws; const int bx = (int)blockIdx.x;
    bf16* const XBA = (bf16*)(ws + WS_XBA); bf16* const XBB = (bf16*)(ws + WS_XBB);
    float* const SSA = (float*)(ws + WS_SSA); float* const SSB = (float*)(ws + WS_SSB);
    bf16* const PP = (bf16*)(ws + WS_CST); bf16* const A2 = (bf16*)(ws + WS_BIG);

        if (l == 1) {
            bf16* const Qb = (bf16*)(ws + WS_BIG); bf16* const Kb = (bf16*)(ws + WS_BIG + 64 * MiB); bf16* const Vb = (bf16*)(ws + WS_BIG + 80 * MiB); bf16* const Ob = (bf16*)(ws + WS_BIG + 96 * MiB);
PREP(7) {
            { pg8::Gemm g{XBB, (const bf16*)(ws + WS_WQKV), T, 1536, DM}; pg8::StaticOrder S; S.init(T, 1536, F.G, bx);
              pg8::EpiQkv E{SSB, P_ROPE16, karg(F, 20), karg(F, 21), Qb, Kb, Vb, F.lds};
              pg8::gemm_phase<pg8::EpiQkv, pg8::StaticOrder, true, true>(F.lds, g, S, E, F.wave); }
            { pg8::Gemm g{(const bf16*)(ws + WS_PB) + (size_t)T * 256, (const bf16*)(ws + WS_WPJ1), T, DM, 256}; pg8::StaticOrder S; S.init(T, DM, F.G, bx);
              pg8::EpiZ<true> E{PP, DM, nullptr};
              pg8::gemm_phase<pg8::EpiZ<true>, pg8::StaticOrder, true, true>(F.lds, g, S, E, F.wave); }
            GRID_BAR();
    }

            PREP(8) {
            PHASE_FENCE(F); for (int seg = F.vcu; seg < 256; seg += F.G) for (int j = 0; j < 4; ++j) attn_unit(F, (seg >> 3) * 32 + (seg & 7) * 4 + j, j == 0, Qb, Kb, Vb, Ob);
#if defined(PROBE_SA) && PROBE_SA >= 30 && PROBE_SA < 40
            STG_END(F); STG_END_ALL(F);
#endif
            GRID_BAR();
            }
            { pg8::Gemm g{Ob, (const bf16*)(ws + WS_WO1), T, DM, DM}; pg8::StaticOrder S; S.init(T, DM, F.G, bx);
              pg8::EpiRes<false, false> E{XBB, XBA, SSA};
              pg8::gemm_phase<pg8::EpiRes<false, false>, pg8::StaticOrder, true, true>(F.lds, g, S, E, F.wave); }
            GRID_BAR();
            if (DBG_STOP == 9) return true;
        } else {
PREP(3) {
            { pg8::Gemm g{P_YBUF, (const bf16*)(ws + WS_WOUT0), T, DM, DM}; pg8::StaticOrder S; S.init(T, DM, F.G, bx);
              pg8::EpiRes<true, false> E{karg(F, 0), XBB, SSB};
              pg8::gemm_phase<pg8::EpiRes<true, false>, pg8::StaticOrder, true, true>(F.lds, g, S, E, F.wave); }
            { pg8::Gemm g{(const bf16*)(ws + WS_PB), (const bf16*)(ws + WS_WPJ0), T, DM, 256}; pg8::StaticOrder S; S.init(T, DM, F.G, bx);
              pg8::EpiZ<true> E{PP, DM, nullptr};
              pg8::gemm_phase<pg8::EpiZ<true>, pg8::StaticOrder, true, true>(F.lds, g, S, E, F.wave); }
            GRID_BAR();
    }

            if (DBG_STOP == 3) return true;
        }
        const bf16* xin = l ? XBA : XBB; const float* ssin = l ? SSA : SSB; bf16* side = l ? XBB : XBA;
        bf16* const GH = side; bf16* const UH = side + (size_t)3 * MiB; bf16* const GT = side + (size_t)6 * MiB;
        const float* cw = karg(F, 25) + (size_t)l * 3 * 3072; const float* cb = karg(F, 26) + (size_t)l * 3072;
#ifdef PROBE_UP
        if (L == 0) { pg8::Gemm g{xin, (const bf16*)(ws + (l ? WS_WUP1 : WS_WUP0)), T, 2 * FFD, DM}; pg8::StaticOrder S; S.init(T, 2 * FFD, F.G, bx);
#if PROBE_UP == 4
          pg8::EpiNone E0{}; pg8::gemm_phase<pg8::EpiNone, pg8::StaticOrder, true, true>(F.lds, g, S, E0, F.wave);
#else
          pg8::EpiUpT<PROBE_UP> E0{ssin, cw, cb, A2, GH, UH, GT}; pg8::gemm_phase<pg8::EpiUpT<PROBE_UP>, pg8::StaticOrder, true, true>(F.lds, g, S, E0, F.wave);
#endif
          GRID_BAR(); }
#endif
        PREP(10 + 10 * l) {
        { pg8::Gemm g{xin, (const bf16*)(ws + (l ? WS_WUP1 : WS_WUP0)), T, 2 * FFD, DM}; pg8::StaticOrder S; S.init(T, 2 * FFD, F.G, bx);
          pg8::EpiUp E{ssin, cw, cb, A2, GH, UH, GT};
          pg8::gemm_phase<pg8::EpiUp, pg8::StaticOrder, true, true>(F.lds, g, S, E, F.wave); }
        GRID_BAR();
        }
        PHASE_FENCE(F); for (int hp = F.vcu; hp < 2 * (T / 256); hp += F.G) fixup_panel(F, hp >> 1, hp & 1, cw, cb, A2, GH, UH, GT);
        GRID_BAR();
        bf16* const xdn = l ? XBB : XBA; float* const ssdn = l ? SSB : SSA;
        { pg8::Gemm g{A2, (const bf16*)(ws + (l ? WS_WDN1 : WS_WDN0)), T, DM, FFD}; pg8::StaticOrder S; S.init(T, DM, F.G, bx);
          pg8::EpiRes<false, true> E{xin, xdn, ssdn};
          pg8::gemm_phase<pg8::EpiRes<false, true>, pg8::StaticOrder, true, true>(F.lds, g, S, E, F.wave); }
        GRID_BAR();
        if ((l == 0 && DBG_STOP == 5) || (l == 1 && DBG_STOP == 11)) return true;
#ifdef PROBE_P6MODE
        if (L == 0) { pg8::Gemm g{xdn, (const bf16*)(ws + (l ? WS_WGT1 : WS_WGT0)), T, DM, DM}; pg8::StaticOrder S; S.init(T, DM, F.G, bx);
#if PROBE_P6MODE == 0
          pg8::EpiNone E0{}; pg8::gemm_phase<pg8::EpiNone, pg8::StaticOrder, true, true>(F.lds, g, S, E0, F.wave);
#else
          pg8::EpiPleProbe<PROBE_P6MODE> E0{ssdn, PP, xdn, A2, (float*)(ws + WS_BIG + 100 * MiB)}; pg8::gemm_phase<pg8::EpiPleProbe<PROBE_P6MODE>, pg8::StaticOrder, true, true>(F.lds, g, S, E0, F.wave);
#endif
          GRID_BAR(); }
#endif
        { pg8::Gemm g{xdn, (const bf16*)(ws + (l ? WS_WGT1 : WS_WGT0)), T, DM, DM}; pg8::StaticOrder S; S.init(T, DM, F.G, bx);
          pg8::EpiPle<(L == 1)> E{ssdn, PP, xdn, XBB, SSB, F.out};
          pg8::gemm_phase<pg8::EpiPle<(L == 1)>, pg8::StaticOrder, true, true>(F.lds, g, S, E, F.wave); }
        if (l == 0) GRID_BAR();
        if (l == 0 && DBG_STOP == 6) return true;

    return false;
}
struct Args { const void* in[30]; float* out; unsigned char* ws; };
__global__ void __launch_bounds__(NWAVES * 64, 2) hy_fwd(Args args) {
    extern __shared__ __attribute__((aligned(16))) unsigned char lds[];
    Frame F;
    F.lds = (ldsp)lds; F.MISC = (volatile LAS unsigned*)(F.lds + MISC_OFF);
    F.tid = threadIdx.x; F.lane = F.tid & 63; F.wave = __builtin_amdgcn_readfirstlane(F.tid >> 6);
    F.G = gridDim.x; { const int bx = blockIdx.x; F.vcu = (F.G % 8 == 0) ? (bx % 8) * (F.G / 8) + bx / 8 : bx; }
    unsigned char* ws = args.ws; F.ws = ws; F.out = args.out;
    F.kb = (unsigned long long)__builtin_amdgcn_kernarg_segment_ptr();
#ifdef PROBE_SA
    F.stg_t0 = 0u; F.stg_acc = 0u;
#endif
    for (int i = F.tid; i < (LDS_BYTES - LDSCTL_OFF) / 4; i += NWAVES * 64) ((LAS unsigned*)(F.lds + LDSCTL_OFF))[i] = 0u;
    __syncthreads();
    XcdBarrier bar = xcd_barrier_post((unsigned*)(ws + WS_CTL) + CW_BAR, F.MISC + 8, F.wave);
    bf16* const XBA = (bf16*)(ws + WS_XBA); bf16* const XBB = (bf16*)(ws + WS_XBB);
    float* const SSA = (float*)(ws + WS_SSA); float* const SSB = (float*)(ws + WS_SSB);
    bf16* const PP = (bf16*)(ws + WS_CST); bf16* const A2 = (bf16*)(ws + WS_BIG);
    const int bx = (int)blockIdx.x; int ts_n = 0; (void)ts_n;
    TSTAMP();

    PREP(100) {
    p0_prologue(F, bar, ts_n);
    GRID_BAR();
    }
#if DBG_STOP >= 1
PREP(1) {
    { pg8::Gemm g{XBA, (const bf16*)(ws + WS_WIN), T, ZW, DM}; pg8::StaticOrder S; S.init(T, ZW, F.G, bx);
#if PROBE_PHASE == 1 && defined(PROBE_VARIANT)
      if (rep_ < PROBE_N) {
#if PROBE_VARIANT == 1
        pg8::EpiNone E0{}; pg8::gemm_phase<pg8::EpiNone, pg8::StaticOrder, true, true>(F.lds, g, S, E0, F.wave);
#elif PROBE_VARIANT == 4
        pg8::EpiNone E0{}; pg8::gemm_phase<pg8::EpiNone, pg8::StaticOrder, false, true>(F.lds, g, S, E0, F.wave);
#elif PROBE_VARIANT == 5
        pg8::EpiNone E0{}; pg8::gemm_phase<pg8::EpiNone, pg8::StaticOrder, true, false>(F.lds, g, S, E0, F.wave);
#elif PROBE_VARIANT == 3
        pg8::EpiZLine E0{P_Z, ZW}; pg8::gemm_phase<pg8::EpiZLine, pg8::StaticOrder, true, true>(F.lds, g, S, E0, F.wave);
#else
        pg8::EpiZ<false> E0{P_Z, ZW, nullptr}; pg8::gemm_phase<pg8::EpiZ<false>, pg8::StaticOrder, true, true>(F.lds, g, S, E0, F.wave);
#endif
      } else
#endif
      { pg8::EpiZ<false> E{P_Z, ZW, karg(F, 7)};
      pg8::gemm_phase<pg8::EpiZ<false>, pg8::StaticOrder, true, true>(F.lds, g, S, E, F.wave); } }
    GRID_BAR();
    }

    PREP(21) { mlA_phase(F); }
#ifdef PROBE_P2CSPLIT
    GRID_BAR();
#endif
    PREP(22) { rg_phase<false>(F); }
    GRID_BAR();
    for (int u = F.vcu; u < 256; u += F.G) mixB_unit(F, u);
    GRID_BAR();
    PREP(41) { mlC_phase(F); }
#ifdef PROBE_P2CSPLIT
    GRID_BAR();
#endif
    PREP(42) { rg_phase<true>(F); }
    GRID_BAR();
#endif
    PREP(99) { if (rep_ > 0) GRID_BAR(); }
#if DBG_STOP >= 3
    if (layer_part<0>(F, bar, ts_n)) return;
    if (layer_part<1>(F, bar, ts_n)) return;
#ifdef PROBE_SA
    xcd_barrier(bar);
    if (blockIdx.x == 0 && threadIdx.x == 0) { unsigned val = F.MISC[40];
#if defined(PROBE_SMAX)
      val = 0u;
#pragma unroll 1
      for (int i = 0; i < (int)gridDim.x; ++i) { const unsigned x = __hip_atomic_load((unsigned*)(ws + 512 * 1024) + i, __ATOMIC_RELAXED, __HIP_MEMORY_SCOPE_AGENT); val = x > val ? x : val; }
#elif defined(PROBE_SMIN)
      val = 0xffffffffu;
#pragma unroll 1
      for (int i = 0; i < (int)gridDim.x; ++i) { const unsigned x = __hip_atomic_load((unsigned*)(ws + 512 * 1024) + i, __ATOMIC_RELAXED, __HIP_MEMORY_SCOPE_AGENT); val = x < val ? x : val; }
#endif
      F.out[0] += floorf((float)val * (float)(PROBE_SSCALE) * 0.5f) * 2.0f; }
#endif
#ifdef PROBE_TA
    GRID_BAR();
    if (blockIdx.x == 0 && threadIdx.x == 0) { const unsigned dt = F.MISC[16 + PROBE_TB] - F.MISC[16 + PROBE_TA] - (unsigned)(PROBE_TOFF); F.out[0] += floorf((float)dt * (float)(PROBE_TSCALE) * 0.5f) * 2.0f; }
#endif
#endif
}

extern "C" void kernel_launch(void* const* d_in, const int* in_sizes, int n_in, void* d_out, int out_size, void* d_ws, size_t ws_size, hipStream_t stream) {
    static int grid = 0;
    if (grid == 0) {
        if (n_in != 30 || in_sizes[0] != T * DM || out_size != T * DM || ws_size < WS_END) { fprintf(stderr, "kernel_launch: unexpected shapes (n_in %d, in0 %d, out %d, ws %zu < %zu); nothing launched\n", n_in, n_in > 0 ? in_sizes[0] : -1, out_size, ws_size, (size_t)WS_END); grid = -1; return; }
        int dev = 0, cus = 0, per_cu = 0;
        if (hipGetDevice(&dev) != hipSuccess || hipDeviceGetAttribute(&cus, hipDeviceAttributeMultiprocessorCount, dev) != hipSuccess) { fprintf(stderr, "kernel_launch: device query failed\n"); grid = -1; return; }
        if (hipFuncSetAttribute((const void*)hy_fwd, hipFuncAttributeMaxDynamicSharedMemorySize, LDS_BYTES) != hipSuccess) { fprintf(stderr, "kernel_launch: hipFuncSetAttribute failed\n"); grid = -1; return; }
        if (hipOccupancyMaxActiveBlocksPerMultiprocessor(&per_cu, (const void*)hy_fwd, NWAVES * 64, LDS_BYTES) != hipSuccess || per_cu < 1) { fprintf(stderr, "kernel_launch: occupancy query says %d workgroups per CU; nothing launched\n", per_cu); (void)hipGetLastError(); grid = -1; return; }
        grid = cus;
    }
    if (grid < 0) return;
    if (hipMemsetAsync((char*)d_ws + WS_CTL, 0, CTL_ZERO_BYTES, stream) != hipSuccess) { fprintf(stderr, "kernel_launch: hipMemsetAsync failed\n"); return; }
    Args a{};
    for (int i = 0; i < 30; ++i) a.in[i] = d_in[i];
    a.out = (float*)d_out; a.ws = (unsigned char*)d_ws;
    hipLaunchKernelGGL(hy_fwd, dim3(grid), dim3(NWAVES * 64), LDS_BYTES, stream, a);
    const hipError_t le = hipPeekAtLastError();
    if (le != hipSuccess) fprintf(stderr, "kernel_launch: launch failed: %s\n", hipGetErrorName(le));
}
```
